# Optimizing an MI355X kernel written in HIP

```python
import jax, jax.numpy as jnp
from jax import lax
import numpy as np

D_MODEL = 1024
BATCH = 16
SEQ = 2048
DEPTH = 2

CTX_LEN = 256
GRID_W = 64
MIX_WIDTH = D_MODEL
GROUP_W = MIX_WIDTH // 4
HEAD_DIM = 64
CONV_CH = GROUP_W
CONV_K = 31
FNET_GROUPS = GROUP_W // HEAD_DIM
NAT_HEADS = GROUP_W // HEAD_DIM
NAT_MAX_ROWS = 8
NAT_COLS = 16
NAT_QC = 16
NAT_KC = NAT_QC + NAT_COLS
SWA_Q_HEADS = GROUP_W // HEAD_DIM
SWA_KV_HEADS = 2
SWA_WINDOW = 128
SWA_BLOCK = 128
ROPE_BASE = 10000.0
FFN_DIM = 2816
MACARON_W = 0.5
N_MOD = 9
EPS = 1e-6
NEG = -1e30
IN_WIDTHS = (2 * CONV_CH, GROUP_W,
             NAT_HEADS * HEAD_DIM, NAT_HEADS * HEAD_DIM, NAT_HEADS * HEAD_DIM,
             SWA_Q_HEADS * HEAD_DIM, SWA_KV_HEADS * HEAD_DIM, SWA_KV_HEADS * HEAD_DIM)
IN_DIM = sum(IN_WIDTHS)
IN_SPLITS = tuple(int(v) for v in np.cumsum(IN_WIDTHS)[:-1])

kernel_name = "hybrid_parallel_group_dit_block"


def rms_norm(x, g):
    x32 = x.astype(jnp.float32)
    y = x32 * lax.rsqrt(jnp.mean(x32 * x32, axis=-1, keepdims=True) + EPS)
    return (y * g.astype(jnp.float32)).astype(x.dtype)


def modulate(x, shift, scale):
    return x * (1 + scale) + shift


def ffn_sublayer(x, shift, scale, gate, g_pre, g_post, w1, w3, w2):
    h = modulate(rms_norm(x, g_pre), shift, scale)
    y = (jax.nn.silu(h @ w1) * (h @ w3)) @ w2
    return x + MACARON_W * gate * rms_norm(y, g_post)


def split_heads(t, nh):
    return t.reshape(t.shape[0], t.shape[1], nh, t.shape[-1] // nh)


def conformer_conv(u, w, b, ln_g, ln_b):
    a = u[..., :CONV_CH] * jax.nn.sigmoid(u[..., CONV_CH:])
    y = lax.conv_general_dilated(a, w[:, None, :], window_strides=(1,),
                                 padding=[(CONV_K // 2, CONV_K // 2)],
                                 dimension_numbers=('NWC', 'WIO', 'NWC'),
                                 feature_group_count=CONV_CH) + b
    y32 = y.astype(jnp.float32)
    mu = jnp.mean(y32, axis=-1, keepdims=True)
    var = jnp.mean(jnp.square(y32 - mu), axis=-1, keepdims=True)
    yn = (y32 - mu) * lax.rsqrt(var + EPS) * ln_g.astype(jnp.float32) + ln_b.astype(jnp.float32)
    return jax.nn.silu(yn).astype(u.dtype)


def fourier_mix(u):
    b, n, _ = u.shape
    z = u.astype(jnp.float32).reshape(b, n, FNET_GROUPS, -1)
    y = jnp.fft.fft2(z, axes=(1, 3), norm='ortho').real
    return y.reshape(b, n, -1).astype(u.dtype)


def rope_1d(x, pos):
    half = x.shape[-1] // 2
    inv = ROPE_BASE ** (-jnp.arange(half, dtype=jnp.float32) / half)
    ang = pos[:, None] * inv[None, :]
    cos = jnp.cos(ang)[:, None, :]
    sin = jnp.sin(ang)[:, None, :]
    x1, x2 = x[..., :half], x[..., half:]
    return jnp.concatenate([x1 * cos - x2 * sin, x1 * sin + x2 * cos], axis=-1)


def axial_rope(x, rows, cols):
    x32 = x.astype(jnp.float32)
    h = x.shape[-1] // 2
    return jnp.concatenate([rope_1d(x32[..., :h], rows), rope_1d(x32[..., h:], cols)], axis=-1).astype(x.dtype)


def nat_geometry(rows):
    wr = min(NAT_MAX_ROWS, rows)
    ncb = GRID_W // NAT_QC
    r = np.arange(rows)
    rs = np.clip(r - wr // 2, 0, rows - wr)
    kr = rs[:, None] + np.arange(wr)[None, :]
    cb = np.clip(np.arange(ncb) * NAT_QC - NAT_COLS // 2, 0, GRID_W - NAT_KC)
    kc = cb[:, None] + np.arange(NAT_KC)[None, :]
    qc = np.arange(ncb)[:, None] * NAT_QC + np.arange(NAT_QC)[None, :]
    ws = np.clip(qc - NAT_COLS // 2, 0, GRID_W - NAT_COLS)
    col_ok = (kc[:, None, :] >= ws[..., None]) & (kc[:, None, :] < ws[..., None] + NAT_COLS)
    idx = kr[:, None, :, None] * GRID_W + kc[None, :, None, :]
    dr = kr - r[:, None] + NAT_MAX_ROWS - 1
    dc = np.clip(kc[:, None, :] - qc[..., None] + NAT_COLS - 1, 0, 2 * NAT_COLS - 2)
    return wr, idx, col_ok, dr, dc


def nat_attention(q, k, v, kx, vx, rel_bias):
    b, n, h, d = q.shape
    rows = n // GRID_W
    ncb = GRID_W // NAT_QC
    wr, idx, col_ok, dr, dc = nat_geometry(rows)
    nj = wr * NAT_KC
    qb = q.reshape(b, rows, ncb, NAT_QC, h, d)
    flat = jnp.asarray(idx.reshape(-1))
    kb = jnp.take(k, flat, axis=1).reshape(b, rows, ncb, nj, h, d)
    vb = jnp.take(v, flat, axis=1).reshape(b, rows, ncb, nj, h, d)
    bias = rel_bias.astype(jnp.float32)[:, dr[:, None, None, :, None], dc[None, :, :, None, :]]
    bias = jnp.where(col_ok[None, None, :, :, None, :], bias, NEG)
    bias = bias.reshape(h, rows, ncb, NAT_QC, nj).transpose(1, 2, 0, 3, 4)
    scale = d ** -0.5
    s_loc = jnp.einsum('brcqhd,brcjhd->brchqj', qb, kb).astype(jnp.float32) * scale + bias
    s_ctx = jnp.einsum('brcqhd,blhd->brchql', qb, kx).astype(jnp.float32) * scale
    p = jax.nn.softmax(jnp.concatenate([s_loc, s_ctx], axis=-1), axis=-1).astype(v.dtype)
    o = (jnp.einsum('brchqj,brcjhd->brcqhd', p[..., :nj], vb)
         + jnp.einsum('brchql,blhd->brcqhd', p[..., nj:], vx))
    return o.reshape(b, n, h * d)


def band_attention(q, k, v, kx, vx, sink):
    b, n, hq, d = q.shape
    hkv = k.shape[2]
    g = hq // hkv
    nb = n // SWA_BLOCK
    nl = kx.shape[1]
    qb = q.reshape(b, nb, SWA_BLOCK, hkv, g, d)

    def band(t):
        tp = jnp.pad(t, ((0, 0), (SWA_BLOCK, SWA_BLOCK), (0, 0), (0, 0))).reshape(b, nb + 2, SWA_BLOCK, hkv, d)
        return jnp.concatenate([tp[:, :-2], tp[:, 1:-1], tp[:, 2:]], axis=2)

    kb, vb = band(k), band(v)
    nj = 3 * SWA_BLOCK
    rel = np.arange(nj)[None, :] - SWA_BLOCK - np.arange(SWA_BLOCK)[:, None]
    kpos = (np.arange(nb)[:, None] - 1) * SWA_BLOCK + np.arange(nj)[None, :]
    ok = (np.abs(rel) <= SWA_WINDOW)[None] & ((kpos >= 0) & (kpos < n))[:, None, :]
    scale = d ** -0.5
    s_loc = jnp.einsum('bnqkgd,bnjkd->bnkgqj', qb, kb).astype(jnp.float32) * scale
    s_loc = jnp.where(ok[None, :, None, None], s_loc, NEG)
    s_ctx = jnp.einsum('bnqkgd,blkd->bnkgql', qb, kx).astype(jnp.float32) * scale
    s_sink = jnp.broadcast_to(sink.astype(jnp.float32).reshape(hkv, g)[None, None, :, :, None, None],
                              s_loc.shape[:-1] + (1,))
    p = jax.nn.softmax(jnp.concatenate([s_loc, s_ctx, s_sink], axis=-1), axis=-1).astype(v.dtype)
    o = (jnp.einsum('bnkgqj,bnjkd->bnqkgd', p[..., :nj], vb)
         + jnp.einsum('bnkgql,blkd->bnqkgd', p[..., nj:nj + nl], vx))
    return o.reshape(b, n, hq * d)


def dense_ctx_attention(q, k, v, sink):
    bsz, nl, nk, g, d = q.shape
    s = jnp.einsum('blkgd,bmkd->bkglm', q, k).astype(jnp.float32) * d ** -0.5
    if sink is None:
        p = jax.nn.softmax(s, axis=-1)
    else:
        s_sink = jnp.broadcast_to(sink.astype(jnp.float32).reshape(nk, g)[None, :, :, None, None], s.shape[:-1] + (1,))
        p = jax.nn.softmax(jnp.concatenate([s, s_sink], axis=-1), axis=-1)[..., :-1]
    o = jnp.einsum('bkglm,bmkd->blkgd', p.astype(v.dtype), v)
    return o.reshape(bsz, nl, nk * g * d)


def token_mix(h, hc, w_in, conv_w, conv_b, conv_ln_g, conv_ln_b, nat_bias, sinks, w_out, ctx_out):
    n = h.shape[1]
    t = jnp.arange(n, dtype=jnp.int32)
    rows = (t // GRID_W).astype(jnp.float32)
    cols = (t % GRID_W).astype(jnp.float32)
    ua, ub, qn, kn, vn, qs, ks, vs = jnp.split(h @ w_in, IN_SPLITS, axis=-1)
    xa, xb, cqn, ckn, cvn, cqs, cks, cvs = jnp.split(hc @ w_in, IN_SPLITS, axis=-1)
    ckn, cvn = split_heads(ckn, NAT_HEADS), split_heads(cvn, NAT_HEADS)
    cks, cvs = split_heads(cks, SWA_KV_HEADS), split_heads(cvs, SWA_KV_HEADS)
    y_a = conformer_conv(ua, conv_w, conv_b, conv_ln_g, conv_ln_b)
    y_b = fourier_mix(ub)
    y_c = nat_attention(split_heads(qn, NAT_HEADS), split_heads(kn, NAT_HEADS), split_heads(vn, NAT_HEADS),
                        ckn, cvn, nat_bias)
    y_d = band_attention(axial_rope(split_heads(qs, SWA_Q_HEADS), rows, cols),
                         axial_rope(split_heads(ks, SWA_KV_HEADS), rows, cols),
                         split_heads(vs, SWA_KV_HEADS), cks, cvs, sinks)
    y = jnp.concatenate([y_a, y_b, y_c, y_d], axis=-1) @ w_out
    if not ctx_out:
        return y, None
    bsz, nl = hc.shape[0], hc.shape[1]
    yc_a = conformer_conv(xa, conv_w, conv_b, conv_ln_g, conv_ln_b)
    yc_b = fourier_mix(xb)
    yc_c = dense_ctx_attention(cqn.reshape(bsz, nl, NAT_HEADS, 1, HEAD_DIM), ckn, cvn, None)
    yc_d = dense_ctx_attention(cqs.reshape(bsz, nl, SWA_KV_HEADS, SWA_Q_HEADS // SWA_KV_HEADS, HEAD_DIM),
                               cks, cvs, sinks)
    yc = jnp.concatenate([yc_a, yc_b, yc_c, yc_d], axis=-1) @ w_out
    return y, yc


def setup_inputs(seed: int = 0) -> dict:
    key = jax.random.key(seed)
    ks = jax.random.split(key, 20)
    nrm = jax.random.normal
    f32 = jnp.float32
    d = D_MODEL
    return {
        'x': nrm(ks[0], (BATCH, SEQ, d), f32),
        'c': nrm(ks[1], (BATCH, d), f32),
        'ctx': nrm(ks[2], (BATCH, CTX_LEN, d), f32),
        'c_ctx': nrm(ks[3], (d,), f32),
        'w_ada': nrm(ks[4], (DEPTH, d, N_MOD * d), f32) * (0.5 * d ** -0.5),
        'b_ada': nrm(ks[5], (DEPTH, N_MOD * d), f32) * 0.01,
        'norm_g': 1.0 + 0.05 * nrm(ks[6], (DEPTH, 6, d), f32),
        'ffn_w1': nrm(ks[7], (DEPTH, 2, d, FFN_DIM), f32) * d ** -0.5,
        'ffn_w3': nrm(ks[8], (DEPTH, 2, d, FFN_DIM), f32) * d ** -0.5,
        'ffn_w2': nrm(ks[9], (DEPTH, 2, FFN_DIM, d), f32) * FFN_DIM ** -0.5,
        'w_in': nrm(ks[10], (DEPTH, d, IN_DIM), f32) * d ** -0.5,
        'conv_w': nrm(ks[11], (DEPTH, CONV_K, CONV_CH), f32) * CONV_K ** -0.5,
        'conv_b': nrm(ks[12], (DEPTH, CONV_CH), f32) * 0.02,
        'conv_ln_g': 1.0 + 0.05 * nrm(ks[13], (DEPTH, CONV_CH), f32),
        'conv_ln_b': nrm(ks[14], (DEPTH, CONV_CH), f32) * 0.02,
        'nat_rel_bias': nrm(ks[15], (DEPTH, NAT_HEADS, 2 * NAT_MAX_ROWS - 1, 2 * NAT_COLS - 1), f32) * 0.2,
        'sink_logits': nrm(ks[16], (DEPTH, SWA_Q_HEADS), f32) * 0.5,
        'w_out': nrm(ks[17], (DEPTH, MIX_WIDTH, d), f32) * MIX_WIDTH ** -0.5,
    }


def reference(x, c, ctx, c_ctx, w_ada, b_ada, norm_g, ffn_w1, ffn_w3, ffn_w2, w_in, conv_w, conv_b,
              conv_ln_g, conv_ln_b, nat_rel_bias, sink_logits, w_out):
    bsz, d = x.shape[0], x.shape[-1]
    xl, xc = x, ctx
    sc = jax.nn.silu(c)
    scc = jax.nn.silu(c_ctx)
    for l in range(DEPTH):
        last = l == DEPTH - 1
        mod_l = (sc @ w_ada[l] + b_ada[l]).reshape(bsz, 1, N_MOD, d)
        mod_c = (scc @ w_ada[l] + b_ada[l]).reshape(N_MOD, d)
        xl = ffn_sublayer(xl, mod_l[..., 0, :], mod_l[..., 1, :], mod_l[..., 2, :], norm_g[l, 0], norm_g[l, 1],
                          ffn_w1[l, 0], ffn_w3[l, 0], ffn_w2[l, 0])
        xc = ffn_sublayer(xc, mod_c[0], mod_c[1], mod_c[2], norm_g[l, 0], norm_g[l, 1],
                          ffn_w1[l, 0], ffn_w3[l, 0], ffn_w2[l, 0])
        hl = modulate(rms_norm(xl, norm_g[l, 2]), mod_l[..., 3, :], mod_l[..., 4, :])
        hc = modulate(rms_norm(xc, norm_g[l, 2]), mod_c[3], mod_c[4])
        yl, yc = token_mix(hl, hc, w_in[l], conv_w[l], conv_b[l], conv_ln_g[l], conv_ln_b[l],
                           nat_rel_bias[l], sink_logits[l], w_out[l], not last)
        xl = xl + mod_l[..., 5, :] * rms_norm(yl, norm_g[l, 3])
        xl = ffn_sublayer(xl, mod_l[..., 6, :], mod_l[..., 7, :], mod_l[..., 8, :], norm_g[l, 4], norm_g[l, 5],
                          ffn_w1[l, 1], ffn_w3[l, 1], ffn_w2[l, 1])
        if not last:
            xc = xc + mod_c[5] * rms_norm(yc, norm_g[l, 3])
            xc = ffn_sublayer(xc, mod_c[6], mod_c[7], mod_c[8], norm_g[l, 4], norm_g[l, 5],
                              ffn_w1[l, 1], ffn_w3[l, 1], ffn_w2[l, 1])
    return xl
```

```cpp
#include <hip/hip_runtime.h>
#include <hip/hip_cooperative_groups.h>
#include <cstdio>
#include <cstdint>
namespace cg = cooperative_groups;
namespace pg8 {
#define PG8_LAS __attribute__((address_space(3)))
typedef unsigned short bf16_t;
typedef short bf16x8 __attribute__((ext_vector_type(8)));
typedef float f32x4 __attribute__((ext_vector_type(4)));
typedef unsigned u32x4 __attribute__((ext_vector_type(4)));
constexpr int BM = 256, BK = 64, HALF = 128, HTB = HALF * BK * 2  , STAGE_BYTES = 8 * HTB, NXCD = 8, WGM = 8;

__host__ __device__ __forceinline__ int lds_byte(int r, int c) { const int st = (r >> 4) * 2 + (c >> 5), rr = r & 15, cc = c & 31, ob = rr * 64 + cc * 2; return st * 1024 + (ob ^ (((ob >> 9) & 1) << 5)); }
__host__ __device__ __forceinline__ void stage_rc(int b, int& R, int& C) { const int st = b / 1024, sb = b % 1024, swz = sb ^ (((sb >> 9) & 1) << 5); R = (st >> 1) * 16 + swz / 64; C = (st & 1) * 32 + (swz % 64) / 2; }
__host__ __device__ __forceinline__ int perm32(int rho) { const int n = rho >> 4, i = rho & 15; return 8 * (i >> 2) + 4 * n + (i & 3); }

struct Unit { int pm, pn; };
struct Gemm { const bf16_t* A; const bf16_t* Bt; int M, N, K; };

struct StaticOrder {
    int nM, nN, nwg, G, c;
    __host__ __device__ void init(int M, int N, int G_, int c_) { nM = M / BM; nN = N / BM; nwg = nM * nN; G = G_; c = c_; }
    __host__ __device__ bool next(int i, Unit& u) const {
        const long L = (long)i * G + c; if (L >= nwg) return false;
        int wgid = (int)L; { const int q = nwg / NXCD, r = nwg % NXCD, xcd = wgid % NXCD, off = wgid / NXCD; wgid = (xcd < r ? xcd * (q + 1) : r * (q + 1) + (xcd - r) * q) + off; }
        const int nig = WGM * nN, gid = wgid / nig, fm = gid * WGM, gsz = (nM - fm) < WGM ? (nM - fm) : WGM;
        u.pm = fm + ((wgid % nig) % gsz); u.pn = (wgid % nig) / gsz; return true;
    }
    __device__ __forceinline__ void a_ready(const Unit&) const {}
    __device__ __forceinline__ void done(const Unit&) const {}
};
__device__ __forceinline__ unsigned cvt_pk_bf16(float lo, float hi) { unsigned r; asm volatile("v_cvt_pk_bf16_f32 %0, %1, %2" : "=v"(r) : "v"(lo), "v"(hi)); return r; }
typedef float f32x2 __attribute__((ext_vector_type(2)));
template <class Epi, class Sched, bool ALIGN_EPI = false, bool SP2 = false>
__device__ __forceinline__ void gemm_phase(PG8_LAS unsigned char* lds, const Gemm g, const Sched& S, const Epi& E) {
    int tid_ = threadIdx.x; asm volatile("" : "+v"(tid_));
    const int tid = tid_, wid = __builtin_amdgcn_readfirstlane(tid >> 6), lane = tid & 63, wr = wid >> 2, wc = wid & 3, fr = lane & 15, fq = lane >> 4;
    const int K = g.K, nt = K / BK;
    unsigned voffA[2], voffB[2];
#pragma unroll
    for (int i = 0; i < 2; ++i) { int R, C; stage_rc(tid * 16 + i * 8192, R, C); const int Rb = Epi::PERM ? ((R & ~31) + perm32(R & 31)) : R;
        voffA[i] = (unsigned)(R * K + C) * 2u; voffB[i] = (unsigned)(Rb * K + C) * 2u; }
    const size_t kstep = (size_t)(BK * 2);
    const size_t hstep = (size_t)HALF * K * 2;
    const size_t tstep = 2 * hstep;
    const unsigned ldsw = (unsigned)wid * 1024u;
    const int aoff = lds_byte(wr * 64 + fr, fq * 8), boff = lds_byte(wc * 32 + fr, fq * 8);
#define PG8_SA(b, h) (((b) * 2 + (h)) * HTB)
#define PG8_SB(b, h) ((4 + (b) * 2 + (h)) * HTB)
#define PG8_STAGE(bufoff, gbase, voff) do { _Pragma("unroll") for (int _i = 0; _i < 2; ++_i) \
        __builtin_amdgcn_global_load_lds((const unsigned*)((const char*)(gbase) + (voff)[_i]), (PG8_LAS unsigned*)(lds + (bufoff) + ldsw + _i * 8192), 16, 0, 0); } while (0)
#define PG8_LDA(dst, b, h) do { _Pragma("unroll") for (int m = 0; m < 4; ++m) _Pragma("unroll") for (int k = 0; k < 2; ++k) dst[m][k] = *(const PG8_LAS bf16x8*)(lds + PG8_SA(b, h) + aoff + m * 2048 + k * 1024); } while (0)
#define PG8_LDB(dst, b, h) do { _Pragma("unroll") for (int n = 0; n < 2; ++n) _Pragma("unroll") for (int k = 0; k < 2; ++k) dst[n][k] = *(const PG8_LAS bf16x8*)(lds + PG8_SB(b, h) + boff + n * 2048 + k * 1024); } while (0)
#define PG8_MMA(ai, bj, At, Bt) do { __builtin_amdgcn_s_setprio(1); _Pragma("unroll") for (int m = 0; m < 4; ++m) _Pragma("unroll") for (int n = 0; n < 2; ++n) _Pragma("unroll") for (int k = 0; k < 2; ++k) \
        acc[ai][bj][m][n] = __builtin_amdgcn_mfma_f32_16x16x32_bf16(Bt[n][k], At[m][k], acc[ai][bj][m][n], 0, 0, 0); __builtin_amdgcn_s_setprio(0); } while (0)
#define PG8_WAIT_V(n) asm volatile("s_waitcnt vmcnt(" #n ")" ::: "memory")
#define PG8_WAIT_L(n) asm volatile("s_waitcnt lgkmcnt(" #n ")" ::: "memory")
#define PG8_BAR __builtin_amdgcn_s_barrier()
#define PG8_SCHED __builtin_amdgcn_sched_barrier(0)
    Unit cur, nxt; int ui = 0;
    if (!S.next(0, cur)) return;
    f32x4 acc[2][2][4][2];
#pragma unroll
    for (int a = 0; a < 2; ++a)
#pragma unroll
        for (int b = 0; b < 2; ++b)
#pragma unroll
            for (int m = 0; m < 4; ++m)
#pragma unroll
                for (int n = 0; n < 2; ++n) acc[a][b][m][n] = (f32x4){0.f, 0.f, 0.f, 0.f};
    bf16x8 At[4][2], B0[2][2], B1[2][2];
    const char* cA = (const char*)g.A + (size_t)cur.pm * tstep; const char* cB = (const char*)g.Bt + (size_t)cur.pn * tstep;
    S.a_ready(cur);
    if constexpr (SP2) {
        PG8_STAGE(PG8_SB(0, 0), cB, voffB); PG8_STAGE(PG8_SB(0, 1), cB + hstep, voffB); PG8_STAGE(PG8_SA(0, 0), cA, voffA); PG8_STAGE(PG8_SA(0, 1), cA + hstep, voffA);
        if (wr == 1) PG8_BAR;
        PG8_WAIT_V(2); PG8_BAR;
        PG8_STAGE(PG8_SB(1, 0), cB + kstep, voffB); PG8_STAGE(PG8_SA(1, 0), cA + kstep, voffA); PG8_STAGE(PG8_SB(1, 1), cB + hstep + kstep, voffB);
        PG8_WAIT_V(6); PG8_BAR;
    } else {
        PG8_STAGE(PG8_SB(0, 0), cB, voffB); PG8_STAGE(PG8_SA(0, 0), cA, voffA); PG8_STAGE(PG8_SB(0, 1), cB + hstep, voffB); PG8_STAGE(PG8_SA(0, 1), cA + hstep, voffA);
        if (wr == 1) PG8_BAR;
        PG8_WAIT_V(4); PG8_BAR;
        PG8_STAGE(PG8_SB(1, 0), cB + kstep, voffB); PG8_STAGE(PG8_SA(1, 0), cA + kstep, voffA); PG8_STAGE(PG8_SB(1, 1), cB + hstep + kstep, voffB);
        PG8_WAIT_V(6); PG8_BAR;
    }
    for (;;) {
        const bool has_next = S.next(ui + 1, nxt);
        const char* nA = has_next ? (const char*)g.A + (size_t)nxt.pm * tstep : cA; const char* nB = has_next ? (const char*)g.Bt + (size_t)nxt.pn * tstep : cB;
        for (int t = 0; t < nt; t += 2) {
            const bool last = (t == nt - 2);
            const char* a1 = cA + (size_t)(t + 1) * kstep;
            const char* a2 = last ? nA : cA + (size_t)(t + 2) * kstep; const char* b2 = last ? nB : cB + (size_t)(t + 2) * kstep;
            const char* a3 = a2 + kstep; const char* b3 = b2 + kstep;
            if (last && has_next) S.a_ready(nxt);
            if constexpr (SP2) {
            PG8_LDB(B0, 0, 0); PG8_LDB(B1, 0, 1); PG8_SCHED; PG8_LDA(At, 0, 0); PG8_STAGE(PG8_SA(1, 1), a1 + hstep, voffA);
            PG8_WAIT_V(8); PG8_WAIT_L(0); PG8_BAR; PG8_MMA(0, 0, At, B0); PG8_MMA(0, 1, At, B1); PG8_BAR; PG8_SCHED;
            PG8_LDA(At, 0, 1); PG8_STAGE(PG8_SB(0, 0), b2, voffB); PG8_STAGE(PG8_SB(0, 1), b2 + hstep, voffB); PG8_STAGE(PG8_SA(0, 0), a2, voffA);
            PG8_WAIT_V(8); PG8_WAIT_L(0); PG8_BAR; PG8_MMA(1, 0, At, B0); PG8_MMA(1, 1, At, B1); PG8_BAR; PG8_SCHED;
            PG8_LDB(B0, 1, 0); PG8_LDB(B1, 1, 1); PG8_SCHED; PG8_LDA(At, 1, 0); PG8_STAGE(PG8_SA(0, 1), a2 + hstep, voffA);
            PG8_WAIT_V(8); PG8_WAIT_L(0); PG8_BAR; PG8_MMA(0, 0, At, B0); PG8_MMA(0, 1, At, B1); PG8_BAR; PG8_SCHED;
            PG8_LDA(At, 1, 1); PG8_STAGE(PG8_SB(1, 0), b3, voffB); PG8_STAGE(PG8_SB(1, 1), b3 + hstep, voffB); PG8_STAGE(PG8_SA(1, 0), a3, voffA);
            PG8_WAIT_V(8); PG8_WAIT_L(0); PG8_BAR; PG8_MMA(1, 0, At, B0); PG8_MMA(1, 1, At, B1); PG8_BAR; PG8_SCHED;
            } else {
            PG8_LDB(B0, 0, 0); PG8_SCHED; PG8_LDA(At, 0, 0); PG8_STAGE(PG8_SA(1, 1), a1 + hstep, voffA);
            PG8_WAIT_L(8); PG8_BAR; PG8_WAIT_L(0); PG8_MMA(0, 0, At, B0); PG8_BAR; PG8_SCHED;
            PG8_LDB(B1, 0, 1); PG8_STAGE(PG8_SB(0, 0), b2, voffB);
            PG8_BAR; PG8_WAIT_L(0); PG8_MMA(0, 1, At, B1); PG8_BAR;
            PG8_LDA(At, 0, 1); PG8_STAGE(PG8_SA(0, 0), a2, voffA);
            PG8_BAR; PG8_WAIT_L(0); PG8_MMA(1, 0, At, B0); PG8_BAR; PG8_SCHED;
            PG8_STAGE(PG8_SB(0, 1), b2 + hstep, voffB);
            PG8_WAIT_V(6); PG8_BAR; PG8_MMA(1, 1, At, B1); PG8_BAR;
            PG8_LDB(B0, 1, 0); PG8_SCHED; PG8_LDA(At, 1, 0); PG8_STAGE(PG8_SA(0, 1), a2 + hstep, voffA);
            PG8_WAIT_L(8); PG8_BAR; PG8_WAIT_L(0); PG8_MMA(0, 0, At, B0); PG8_BAR; PG8_SCHED;
            PG8_LDB(B1, 1, 1); PG8_STAGE(PG8_SB(1, 0), b3, voffB);
            PG8_BAR; PG8_WAIT_L(0); PG8_MMA(0, 1, At, B1); PG8_BAR;
            PG8_LDA(At, 1, 1); PG8_STAGE(PG8_SA(1, 0), a3, voffA);
            PG8_BAR; PG8_WAIT_L(0); PG8_MMA(1, 0, At, B0); PG8_BAR; PG8_SCHED;
            PG8_STAGE(PG8_SB(1, 1), b3 + hstep, voffB);
            PG8_WAIT_V(6); PG8_BAR; PG8_MMA(1, 1, At, B1); PG8_BAR;
            }
        }
        if constexpr (ALIGN_EPI) { if (wr == 0) PG8_BAR; }
        if constexpr (!Epi::AFTER_DRAIN) { E(acc, cur, wr, wc, fr, fq); S.done(cur); }
        if (!has_next) break;
#pragma unroll
        for (int a = 0; a < 2; ++a)
#pragma unroll
            for (int b = 0; b < 2; ++b)
#pragma unroll
                for (int m = 0; m < 4; ++m)
#pragma unroll
                    for (int n = 0; n < 2; ++n) acc[a][b][m][n] = (f32x4){0.f, 0.f, 0.f, 0.f};
        cur = nxt; cA = nA; cB = nB; ++ui;
        if constexpr (ALIGN_EPI) { if (wr == 1) PG8_BAR; }
    }
    PG8_WAIT_V(0);
    if constexpr (!ALIGN_EPI) { if (wr == 0) PG8_BAR; }
    PG8_BAR;
    if constexpr (Epi::AFTER_DRAIN) { E.fused(acc, cur, wr, wc, fr, fq, lds, wid, lane); S.done(cur); }
#undef PG8_SA
#undef PG8_SB
#undef PG8_STAGE
#undef PG8_LDA
#undef PG8_LDB
#undef PG8_MMA
#undef PG8_WAIT_V
#undef PG8_WAIT_L
#undef PG8_BAR
#undef PG8_SCHED
}
}

#define LAS __attribute__((address_space(3)))
typedef unsigned short bf16_t;
typedef float f32x4 __attribute__((ext_vector_type(4)));
typedef float f32x2 __attribute__((ext_vector_type(2)));
typedef unsigned u32x4 __attribute__((ext_vector_type(4)));
typedef unsigned u32x2 __attribute__((ext_vector_type(2)));
typedef short bf16x8 __attribute__((ext_vector_type(8)));
typedef short bf16x4 __attribute__((ext_vector_type(4)));

constexpr int TL = 32768, TC = 4096, TA = 36864, DM = 1024, FF = 2816, NP = 1792, NMODC = 9216;
constexpr int LDS_BYTES = 131072;
#ifndef MIXMASK
#define MIXMASK 7
#endif
constexpr float EPSV = 1e-6f;
constexpr float LOG2E = 1.4426950408889634f;

constexpr size_t WS_XC   = 0;
constexpr size_t WS_YH   = WS_XC + (size_t)TC * DM * 4;
constexpr size_t WS_R1   = WS_YH + (size_t)TA * DM * 2;
constexpr size_t WS_PROJ = WS_R1;
constexpr size_t WS_PQT  = WS_PROJ + (size_t)TA * NP * 2;
constexpr size_t WS_PQTC = WS_PQT + (size_t)4096 * 4096 * 2;
constexpr size_t WS_YCAT = WS_PQTC + (size_t)4096 * 512 * 2;
constexpr size_t WS_R1END= WS_YCAT + (size_t)TA * DM * 2;
constexpr size_t WS_W13  = WS_R1END;
constexpr size_t WS_W2T  = WS_W13 + (size_t)4 * 5632 * 1024 * 2;
constexpr size_t WS_WIN  = WS_W2T + (size_t)4 * 1024 * 2816 * 2;
constexpr size_t WS_WOUT = WS_WIN + (size_t)2 * 2304 * 1024 * 2;
constexpr size_t WS_DFT  = WS_WOUT + (size_t)2 * 1024 * 1024 * 2;
constexpr size_t WS_DFTC = WS_DFT + (size_t)2048 * 4096 * 2;
constexpr size_t WS_MOD  = WS_DFTC + (size_t)256 * 512 * 2;
constexpr size_t WS_ROPE = WS_MOD + (size_t)2 * 17 * NMODC * 4;
constexpr size_t WS_END  = WS_ROPE + 64 * 16 * 2 * 4;
static_assert((size_t)TA * FF * 2 <= WS_R1END - WS_R1, "U must fit in R1");

struct Params {
    const float *x, *c, *ctx, *c_ctx, *w_ada, *b_ada, *norm_g, *w1, *w3, *w2, *w_in, *conv_w, *conv_b, *ln_g, *ln_b, *nat_bias, *sink, *w_out;
    float* out; unsigned char* ws;
};
typedef const __attribute__((address_space(4))) Params CParams;

__device__ __forceinline__ unsigned pk2(float lo, float hi) { return pg8::cvt_pk_bf16(lo, hi); }
__device__ __forceinline__ float bflo(unsigned v) { return __uint_as_float(v << 16); }
__device__ __forceinline__ float bfhi(unsigned v) { return __uint_as_float(v & 0xffff0000u); }
__device__ __forceinline__ float wave_sum(float v) {
#pragma unroll
    for (int o = 1; o < 64; o <<= 1) v += __shfl_xor(v, o);
    return v;
}
__device__ __forceinline__ int otid() { int t = threadIdx.x; asm volatile("" : "+v"(t)); return t; }
__device__ __forceinline__ int obid() { int t = blockIdx.x; asm volatile("" : "+s"(t)); return t; }
__device__ __forceinline__ float fast_exp2(float x) { return __builtin_amdgcn_exp2f(x); }
__device__ __forceinline__ float fast_rcp(float x) { return __builtin_amdgcn_rcpf(x); }
__device__ __forceinline__ float silu_f(float v) { return v * fast_rcp(1.0f + fast_exp2(-v * LOG2E)); }
__device__ __forceinline__ float sigmoid_f(float v) { return fast_rcp(1.0f + fast_exp2(-v * LOG2E)); }

struct EpiSwiGLU {
    static constexpr bool PERM = true, AFTER_DRAIN = false;
    bf16_t* U;
    __device__ __forceinline__ void operator()(const f32x4 (&acc)[2][2][4][2], const pg8::Unit& u, int wr, int wc, int fr, int fq) const {
        const int row0 = u.pm * 256 + wr * 64 + fr, col0 = u.pn * 128 + wc * 32 + 8 * fq;
#pragma unroll
        for (int ai = 0; ai < 2; ++ai)
#pragma unroll
            for (int m = 0; m < 4; ++m) {
                bf16_t* rowp = U + (size_t)(row0 + ai * 128 + m * 16) * FF + col0;
                float v[8];
#pragma unroll
                for (int n = 0; n < 2; ++n)
#pragma unroll
                    for (int j = 0; j < 4; ++j) v[n * 4 + j] = silu_f(acc[ai][0][m][n][j]) * acc[ai][1][m][n][j];
                u32x4 w; w.x = pk2(v[0], v[1]); w.y = pk2(v[2], v[3]); w.z = pk2(v[4], v[5]); w.w = pk2(v[6], v[7]);
                *(u32x4*)rowp = w;
            }
    }
};
struct EpiBf16Tile {
    static constexpr bool PERM = true, AFTER_DRAIN = false;
    bf16_t* O; int ldc, row_pn, col_pn;
    __device__ __forceinline__ void operator()(const f32x4 (&acc)[2][2][4][2], const pg8::Unit& u, int wr, int wc, int fr, int fq) const {
        const int row0 = u.pm * 256 + u.pn * row_pn + wr * 64 + fr, col0 = u.pn * col_pn + wc * 32 + 8 * fq;
#pragma unroll
        for (int ai = 0; ai < 2; ++ai)
#pragma unroll
            for (int m = 0; m < 4; ++m) {
                bf16_t* rowp = O + (size_t)(row0 + ai * 128 + m * 16) * ldc + col0;
#pragma unroll
                for (int bj = 0; bj < 2; ++bj) {
                    const f32x4 v0 = acc[ai][bj][m][0], v1 = acc[ai][bj][m][1];
                    u32x4 w; w.x = pk2(v0[0], v0[1]); w.y = pk2(v0[2], v0[3]); w.z = pk2(v1[0], v1[1]); w.w = pk2(v1[2], v1[3]);
                    *(u32x4*)(rowp + bj * 128) = w;
                }
            }
    }
};
struct EpiPQ {
    static constexpr bool PERM = true, AFTER_DRAIN = false;
    bf16_t* PQT; bf16_t* PQTC;
    __device__ __forceinline__ void operator()(const f32x4 (&acc)[2][2][4][2], const pg8::Unit& u, int wr, int wc, int fr, int fq) const {
        const int cl = wc * 32 + 8 * fq;
#pragma unroll
        for (int ai = 0; ai < 2; ++ai)
#pragma unroll
            for (int m = 0; m < 4; ++m) {
                const int mp = u.pm * 256 + ai * 128 + wr * 64 + m * 16 + fr;
                const int g = mp >> 7, pq = (mp >> 6) & 1, cp = mp & 63;
                bf16_t* rowp;
                if (u.pn < 128) { const int b = u.pn >> 3, n0 = (u.pn & 7) * 256; rowp = PQT + (size_t)(b * 256 + g * 64 + cp) * 4096 + pq * 2048 + n0 + cl; }
                else { const int b = u.pn - 128; rowp = PQTC + (size_t)(b * 256 + g * 64 + cp) * 512 + pq * 256 + cl; }
#pragma unroll
                for (int bj = 0; bj < 2; ++bj) {
                    const f32x4 v0 = acc[ai][bj][m][0], v1 = acc[ai][bj][m][1];
                    u32x4 w; w.x = pk2(v0[0], v0[1]); w.y = pk2(v0[2], v0[3]); w.z = pk2(v1[0], v1[1]); w.w = pk2(v1[2], v1[3]);
                    *(u32x4*)(rowp + bj * 128) = w;
                }
            }
    }
};
struct EpiWin {
    static constexpr bool PERM = false, AFTER_DRAIN = false;
    bf16_t* P; const float* rope;
    __device__ __forceinline__ void operator()(const f32x4 (&acc)[2][2][4][2], const pg8::Unit& u, int wr, int wc, int fr, int fq) const {
        const int row0 = u.pm * 256 + wr * 64 + fr, col0 = u.pn * 256 + wc * 32 + 4 * fq;
        const float qs = (u.pn == 2 || u.pn == 5) ? 0.125f : 1.0f;
        const bool lat = u.pm < 128;
#pragma unroll
        for (int ai = 0; ai < 2; ++ai)
#pragma unroll
            for (int m = 0; m < 4; ++m) {
                const int r = row0 + ai * 128 + m * 16;
                bf16_t* rowp = P + (size_t)r * NP + col0;
                const int t = r & 2047;
                const int pos = (wc & 1) ? (t & 63) : (t >> 6);
#pragma unroll
                for (int bj = 0; bj < 2; ++bj) {
                    f32x4 v0 = acc[ai][bj][m][0], v1 = acc[ai][bj][m][1];
                    const bool dorope = lat && (u.pn == 5 || (u.pn == 6 && bj == 0));
                    if (dorope) {
                        const f32x4 cs0 = *(const f32x4*)(rope + (pos * 16 + 4 * fq) * 2), cs1 = *(const f32x4*)(rope + (pos * 16 + 4 * fq) * 2 + 4);
                        const float c0 = cs0[0], s0 = cs0[1], c1 = cs0[2], s1 = cs0[3], c2 = cs1[0], s2 = cs1[1], c3 = cs1[2], s3 = cs1[3];
                        f32x4 a, b;
                        a[0] = v0[0] * c0 - v1[0] * s0; b[0] = v0[0] * s0 + v1[0] * c0;
                        a[1] = v0[1] * c1 - v1[1] * s1; b[1] = v0[1] * s1 + v1[1] * c1;
                        a[2] = v0[2] * c2 - v1[2] * s2; b[2] = v0[2] * s2 + v1[2] * c2;
                        a[3] = v0[3] * c3 - v1[3] * s3; b[3] = v0[3] * s3 + v1[3] * c3;
                        v0 = a; v1 = b;
                    }
                    v0 = v0 * qs; v1 = v1 * qs;
                    u32x2 w0, w1; w0.x = pk2(v0[0], v0[1]); w0.y = pk2(v0[2], v0[3]); w1.x = pk2(v1[0], v1[1]); w1.y = pk2(v1[2], v1[3]);
                    *(u32x2*)(rowp + bj * 128) = w0; *(u32x2*)(rowp + bj * 128 + 16) = w1;
                }
            }
    }
};

__device__ __forceinline__ void transpose_tile(LAS unsigned char* lds, const float* src, int ld_src, int col0, int k0, bf16_t* dst, int ld_dst, int r0) {
    LAS float* t = (LAS float*)lds;
    const int tid = otid();
#pragma unroll
    for (int i = 0; i < 8; ++i) { const int kk = (tid >> 6) + 8 * i, cc = tid & 63; t[kk * 65 + cc] = src[(size_t)(k0 + kk) * ld_src + col0 + cc]; }
    __syncthreads();
    { const int r = tid >> 3, c8 = tid & 7; const LAS float* s = t + (8 * c8) * 65 + r;
      u32x4 o; o.x = pk2(s[0], s[65]); o.y = pk2(s[2 * 65], s[3 * 65]); o.z = pk2(s[4 * 65], s[5 * 65]); o.w = pk2(s[6 * 65], s[7 * 65]);
      *(u32x4*)(dst + (size_t)(r0 + r) * ld_dst + k0 + 8 * c8) = o; }
    __syncthreads();
}

__device__ __forceinline__ void phase0(CParams& p, LAS unsigned char* lds) {
    const int tid = otid(), wave = tid >> 6, lane = tid & 63;
    unsigned char* ws = p.ws;
    constexpr int N_MODS = 288, N_TR_L = 2 * 1408 + 2 * 704 + 448 + 256, N_TR = 2 * N_TR_L, N_FOLD = 256, N_DFT = 2048 + 256, N_ROPE = 1;
    constexpr int TOTAL = N_MODS + N_TR + N_FOLD + N_DFT + N_ROPE;
    bool mods_loaded = false;
    for (int it = obid(); it < TOTAL; it += gridDim.x) {
        int r = it;
        if (r < N_MODS) {
            LAS float* sS = (LAS float*)lds;
            LAS float* sR = sS + 17 * 1024;
            if (!mods_loaded) {
                for (int i = tid; i < 17 * 1024; i += 512) { const float v = (i < 16384) ? p.c[i] : p.c_ctx[i - 16384]; sS[i] = v / (1.0f + __expf(-v)); }
                __syncthreads(); mods_loaded = true;
            }
            const int l = r / 144, j0 = (r % 144) * 64, k0 = wave * 128;
            float acc[17];
#pragma unroll
            for (int q = 0; q < 17; ++q) acc[q] = 0.f;
            const float* wp = p.w_ada + ((size_t)l * 1024 + k0) * NMODC + j0 + lane;
#pragma unroll 4
            for (int kk = 0; kk < 128; ++kk) {
                const float wv = wp[(size_t)kk * NMODC];
#pragma unroll
                for (int q = 0; q < 17; ++q) acc[q] += sS[q * 1024 + k0 + kk] * wv;
            }
#pragma unroll
            for (int q = 0; q < 17; ++q) sR[(wave * 17 + q) * 64 + lane] = acc[q];
            __syncthreads();
            float* MOD = (float*)(ws + WS_MOD);
            for (int o = tid; o < 17 * 64; o += 512) {
                const int q = o >> 6, ln = o & 63; float s = p.b_ada[l * NMODC + j0 + ln];
#pragma unroll
                for (int w = 0; w < 8; ++w) s += sR[(w * 17 + q) * 64 + ln];
                MOD[(size_t)(l * 17 + q) * NMODC + j0 + ln] = s;
            }
            __syncthreads();
            continue;
        }
        r -= N_MODS;
        if (mods_loaded) { __syncthreads(); mods_loaded = false; }
        if (r < N_TR) {
            const int l = r / N_TR_L; int q = r % N_TR_L;
            if (q < 2 * 1408) { const int f = q / 1408; q %= 1408; const int rt = q / 16, kt = q % 16; const int R0 = rt * 64, tile = R0 >> 8, w = R0 & 255, bj = w >> 7, cc = w & 127;
                const float* src = (bj ? p.w3 : p.w1) + (size_t)(l * 2 + f) * 1024 * FF;
                transpose_tile(lds, src, FF, 128 * tile + cc, kt * 64, (bf16_t*)(ws + WS_W13) + (size_t)(l * 2 + f) * 5632 * 1024, 1024, R0); continue; }
            q -= 2 * 1408;
            if (q < 2 * 704) { const int f = q / 704; q %= 704; const int rt = q / 44, kt = q % 44;
                transpose_tile(lds, p.w2 + (size_t)(l * 2 + f) * FF * 1024, 1024, rt * 64, kt * 64, (bf16_t*)(ws + WS_W2T) + (size_t)(l * 2 + f) * 1024 * FF, FF, rt * 64); continue; }
            q -= 2 * 704;
            if (q < 448) { const int rt = q / 16, kt = q % 16; const int R0 = rt * 64; const int col0 = R0 < 512 ? R0 : R0 + 256;
                transpose_tile(lds, p.w_in + (size_t)l * 1024 * 2048, 2048, col0, kt * 64, (bf16_t*)(ws + WS_WIN) + (size_t)l * 2304 * 1024, 1024, R0); continue; }
            q -= 448;
            { const int rt = q / 16, kt = q % 16;
                transpose_tile(lds, p.w_out + (size_t)l * 1024 * 1024, 1024, rt * 64, kt * 64, (bf16_t*)(ws + WS_WOUT) + (size_t)l * 1024 * 1024, 1024, rt * 64); continue; }
        }
        r -= N_TR;
        if (r < N_FOLD) {
            const int l = r >> 7, k0 = (r & 127) * 8;
            LAS float* sW = (LAS float*)lds;
            LAS float* sC = sW + 2048;
            for (int i = tid; i < 2048; i += 512) { const int kk = i >> 8, cc = i & 255; sW[i] = p.w_in[((size_t)l * 1024 + k0 + kk) * 2048 + 512 + cc]; }
            if (tid < 64) sC[tid] = cospif((float)tid * (1.0f / 32.0f));
            __syncthreads();
            const int g = tid >> 7, j = tid & 127, jj = j & 63, isS = j >> 6;
            float acc[8];
#pragma unroll
            for (int q = 0; q < 8; ++q) acc[q] = 0.f;
            for (int c = 0; c < 64; ++c) {
                const int mm = (c * jj) & 63; const float tv = sC[isS ? ((mm - 16) & 63) : mm];
#pragma unroll
                for (int q = 0; q < 8; ++q) acc[q] += sW[q * 256 + g * 64 + c] * tv;
            }
            u32x4 o; o.x = pk2(acc[0] * 0.125f, acc[1] * 0.125f); o.y = pk2(acc[2] * 0.125f, acc[3] * 0.125f); o.z = pk2(acc[4] * 0.125f, acc[5] * 0.125f); o.w = pk2(acc[6] * 0.125f, acc[7] * 0.125f);
            *(u32x4*)((bf16_t*)(ws + WS_WIN) + ((size_t)l * 2304 + 1792 + g * 128 + j) * 1024 + k0) = o;
            __syncthreads();
            continue;
        }
        r -= N_FOLD;
        if (r < N_DFT) {
            if (r < 2048) { const int np = r; const float sc = 0.022097086912079608f;
                float v[8];
#pragma unroll
                for (int e = 0; e < 8; ++e) { const int k = tid * 8 + e, kk = k & 2047, mm = (np * kk) & 2047; const float a = (float)mm * (1.0f / 1024.0f);
                    v[e] = (k < 2048 ? cospif(a) : -sinpif(a)) * sc; }
                u32x4 o; o.x = pk2(v[0], v[1]); o.y = pk2(v[2], v[3]); o.z = pk2(v[4], v[5]); o.w = pk2(v[6], v[7]);
                *(u32x4*)((bf16_t*)(ws + WS_DFT) + (size_t)np * 4096 + tid * 8) = o;
            } else if (tid < 64) { const int np = r - 2048; const float sc = 0.0625f;
                float v[8];
#pragma unroll
                for (int e = 0; e < 8; ++e) { const int k = tid * 8 + e, kk = k & 255, mm = (np * kk) & 255; const float a = (float)mm * (1.0f / 128.0f);
                    v[e] = (k < 256 ? cospif(a) : -sinpif(a)) * sc; }
                u32x4 o; o.x = pk2(v[0], v[1]); o.y = pk2(v[2], v[3]); o.z = pk2(v[4], v[5]); o.w = pk2(v[6], v[7]);
                *(u32x4*)((bf16_t*)(ws + WS_DFTC) + (size_t)np * 512 + tid * 8) = o;
            }
            continue;
        }
        r -= N_DFT;
        {
            float* tab = (float*)(ws + WS_ROPE);
            for (int e = tid; e < 1024; e += 512) { const int pos = e >> 4, i = e & 15;
                const float inv = fast_exp2(-(float)i * (13.287712379549449f / 16.0f));
                const float tt = (float)pos * inv * 0.3183098861837907f;
                tab[2 * e] = cospif(tt); tab[2 * e + 1] = sinpif(tt); }
        }
    }
}

struct EwArgs {
    const float* xin_lat; const float* xin_ctx; float* xout_lat; float* xout_ctx;
    const bf16_t* Y; const float* gpost; float fac; const float* gate;
    bf16_t* H; const float* gpre; const float* shift; const float* scale;
    int nrows;
};
__device__ __forceinline__ void ew_pass(const float* xin_lat, const float* xin_ctx, float* xout_lat, float* xout_ctx, const bf16_t* Yp, const float* gpost, float fac, const float* gate,
                                        bf16_t* Hp, const float* gpre, const float* shift, const float* scale, int nrows) {
    EwArgs a; a.xin_lat = xin_lat; a.xin_ctx = xin_ctx; a.xout_lat = xout_lat; a.xout_ctx = xout_ctx; a.Y = Yp; a.gpost = gpost; a.fac = fac; a.gate = gate; a.H = Hp; a.gpre = gpre; a.shift = shift; a.scale = scale; a.nrows = nrows;
    const int tid = otid(); const int wave = tid >> 6, lane = tid & 63;
    for (int t = obid() * 8 + wave; t < a.nrows; t += gridDim.x * 8) {
        const bool lat = t < TL; const int b = lat ? (t >> 11) : 16;
        const float* xr = lat ? a.xin_lat + (size_t)t * DM : a.xin_ctx + (size_t)(t - TL) * DM;
        f32x4 x[4];
#pragma unroll
        for (int j = 0; j < 4; ++j) x[j] = *(const f32x4*)(xr + 4 * lane + 256 * j);
        if (a.Y) {
            f32x4 y[4]; float ss = 0.f;
#pragma unroll
            for (int j = 0; j < 4; ++j) { const u32x2 w = *(const u32x2*)(a.Y + (size_t)t * DM + 4 * lane + 256 * j);
                y[j][0] = bflo(w.x); y[j][1] = bfhi(w.x); y[j][2] = bflo(w.y); y[j][3] = bfhi(w.y);
                ss += (y[j][0] * y[j][0] + y[j][1] * y[j][1]) + (y[j][2] * y[j][2] + y[j][3] * y[j][3]); }
            const float rstd = 1.0f / sqrtf(wave_sum(ss) * (1.0f / DM) + EPSV);
#pragma unroll
            for (int j = 0; j < 4; ++j) { const f32x4 gt = *(const f32x4*)(a.gate + (size_t)b * NMODC + 4 * lane + 256 * j); const f32x4 gp = *(const f32x4*)(a.gpost + 4 * lane + 256 * j);
                x[j] = x[j] + (gt * a.fac) * (y[j] * rstd * gp); }
        }
        float* xo = lat ? (a.xout_lat ? a.xout_lat + (size_t)t * DM : nullptr) : (a.xout_ctx ? a.xout_ctx + (size_t)(t - TL) * DM : nullptr);
        if (xo) {
#pragma unroll
            for (int j = 0; j < 4; ++j) *(f32x4*)(xo + 4 * lane + 256 * j) = x[j];
        }
        if (a.H) {
            float ss = 0.f;
#pragma unroll
            for (int j = 0; j < 4; ++j) ss += (x[j][0] * x[j][0] + x[j][1] * x[j][1]) + (x[j][2] * x[j][2] + x[j][3] * x[j][3]);
            const float rstd = 1.0f / sqrtf(wave_sum(ss) * (1.0f / DM) + EPSV);
#pragma unroll
            for (int j = 0; j < 4; ++j) { const int cidx = 4 * lane + 256 * j;
                const f32x4 g = *(const f32x4*)(a.gpre + cidx), sh = *(const f32x4*)(a.shift + (size_t)b * NMODC + cidx), sc = *(const f32x4*)(a.scale + (size_t)b * NMODC + cidx);
                const f32x4 h = (x[j] * rstd * g) * (sc + 1.0f) + sh;
                u32x2 w; w.x = pk2(h[0], h[1]); w.y = pk2(h[2], h[3]);
                *(u32x2*)(a.H + (size_t)t * DM + cidx) = w; }
        }
    }
}

__device__ __forceinline__ void conv_item(CParams& p, LAS unsigned char* lds, int l, int s, int tb) {
    const int tid = otid(), wave = tid >> 6, lane = tid & 63;
    const bf16_t* PROJ = (const bf16_t*)(p.ws + WS_PROJ); bf16_t* YCAT = (bf16_t*)(p.ws + WS_YCAT);
    LAS float* sA = (LAS float*)lds;
    LAS float* sY = sA + 62 * 256;
    const int tokbase = s < 16 ? s * 2048 : TL + (s - 16) * 256, len = s < 16 ? 2048 : 256, t0 = tb * 32;
    for (int u = tid; u < 62 * 32; u += 512) {
        const int rr = u >> 5, c8 = (u & 31) * 8, tt = t0 - 15 + rr;
        float v[8];
        if (tt >= 0 && tt < len) {
            const bf16_t* rp = PROJ + (size_t)(tokbase + tt) * NP + c8;
            const u32x4 ua = *(const u32x4*)rp, ug = *(const u32x4*)(rp + 256);
            v[0] = bflo(ua.x) * sigmoid_f(bflo(ug.x)); v[1] = bfhi(ua.x) * sigmoid_f(bfhi(ug.x));
            v[2] = bflo(ua.y) * sigmoid_f(bflo(ug.y)); v[3] = bfhi(ua.y) * sigmoid_f(bfhi(ug.y));
            v[4] = bflo(ua.z) * sigmoid_f(bflo(ug.z)); v[5] = bfhi(ua.z) * sigmoid_f(bfhi(ug.z));
            v[6] = bflo(ua.w) * sigmoid_f(bflo(ug.w)); v[7] = bfhi(ua.w) * sigmoid_f(bfhi(ug.w));
        } else {
#pragma unroll
            for (int e = 0; e < 8; ++e) v[e] = 0.f;
        }
        *(LAS f32x4*)(sA + rr * 256 + c8) = (f32x4){v[0], v[1], v[2], v[3]};
        *(LAS f32x4*)(sA + rr * 256 + c8 + 4) = (f32x4){v[4], v[5], v[6], v[7]};
    }
    __syncthreads();
    {
        const int ch = tid & 255, half = tid >> 8;
        float w[31];
#pragma unroll
        for (int j = 0; j < 31; ++j) w[j] = p.conv_w[((size_t)l * 31 + j) * 256 + ch];
        const float bias = p.conv_b[l * 256 + ch];
#pragma unroll 4
        for (int tl = 0; tl < 16; ++tl) {
            const int tok = half * 16 + tl; float acc = bias;
#pragma unroll
            for (int j = 0; j < 31; ++j) acc += sA[(tok + j) * 256 + ch] * w[j];
            sY[tok * 256 + ch] = acc;
        }
    }
    __syncthreads();
    {
        const f32x4 lg = *(const f32x4*)(p.ln_g + l * 256 + 4 * lane), lb = *(const f32x4*)(p.ln_b + l * 256 + 4 * lane);
#pragma unroll
        for (int q = 0; q < 4; ++q) {
            const int tok = wave * 4 + q;
            const f32x4 v = *(const LAS f32x4*)(sY + tok * 256 + 4 * lane);
            const float mean = wave_sum((v[0] + v[1]) + (v[2] + v[3])) * (1.0f / 256.0f);
            const f32x4 d = v - mean;
            const float var = wave_sum((d[0] * d[0] + d[1] * d[1]) + (d[2] * d[2] + d[3] * d[3])) * (1.0f / 256.0f);
            const float rstd = 1.0f / sqrtf(var + EPSV);
            const f32x4 yn = d * rstd * lg + lb;
            u32x2 o; o.x = pk2(silu_f(yn[0]), silu_f(yn[1])); o.y = pk2(silu_f(yn[2]), silu_f(yn[3]));
            *(u32x2*)(YCAT + (size_t)(tokbase + t0 + tok) * DM + 4 * lane) = o;
        }
    }
    __syncthreads();
}

struct AttnItem {
    int mode;
    int qtok0;
    int qcol0, qcol1, ocol0, ocol1;
    int kcol0, kcol1, vcol0, vcol1; int nslots;
    int nloc, loctok0;
    int ctxtok0;
    int r, rs;
    int q0, kp0;
    int has_sink; float sink0, sink1;
    int h0;
};
constexpr int KROW = 72;
constexpr int VROW = 68;
constexpr int K_BYTES = 64 * KROW * 2, V_BYTES = 64 * VROW * 2;

__device__ __forceinline__ void attn_item(CParams& p, LAS unsigned char* lds, int l, const AttnItem& it) {
    const int tid = otid(), wave = tid >> 6, lane = tid & 63, g = wave >> 2, wq = wave & 3, fr = lane & 15, fq = lane >> 4;
    const bf16_t* PROJ = (const bf16_t*)(p.ws + WS_PROJ); bf16_t* YCAT = (bf16_t*)(p.ws + WS_YCAT);
    LAS unsigned char* sK = lds;
    LAS unsigned char* sV = lds + 2 * K_BYTES;
    LAS float* sB = (LAS float*)(lds + 2 * K_BYTES + 2 * V_BYTES);
    const int slot = it.nslots == 2 ? g : 0;
    if (it.mode == 0) { for (int i = tid; i < 2 * 465; i += 512) sB[i] = p.nat_bias[(size_t)(l * 4 + it.h0) * 465 + i]; }
    bf16x8 qf[2];
    { const bf16_t* qp = PROJ + (size_t)(it.qtok0 + wq * 16 + fr) * NP + (g ? it.qcol1 : it.qcol0) + 8 * fq;
      qf[0] = *(const bf16x8*)qp; qf[1] = *(const bf16x8*)(qp + 32); }
    float mrun = -3.0e38f, lsum = 0.f;
    f32x4 o[4];
#pragma unroll
    for (int db = 0; db < 4; ++db) o[db] = (f32x4){0.f, 0.f, 0.f, 0.f};
    const int nchunks = 4 + it.nloc;
    const int srow = tid >> 3, sseg = tid & 7;
    u32x4 kreg[2], vreg[2];
    auto chunk_tok = [&](int c) { return c < 4 ? it.ctxtok0 + 64 * c : it.loctok0 + 64 * (c - 4); };
    auto gload = [&](int c) {
        const bf16_t* rp = PROJ + (size_t)(chunk_tok(c) + srow) * NP + 8 * sseg;
#pragma unroll
        for (int s = 0; s < 2; ++s) if (s < it.nslots) { kreg[s] = *(const u32x4*)(rp + (s ? it.kcol1 : it.kcol0)); vreg[s] = *(const u32x4*)(rp + (s ? it.vcol1 : it.vcol0)); }
    };
    gload(0);
    for (int c = 0; c < nchunks; ++c) {
        __syncthreads();
#pragma unroll
        for (int s = 0; s < 2; ++s) if (s < it.nslots) {
            *(LAS u32x4*)(sK + s * K_BYTES + (srow * KROW + 8 * sseg) * 2) = kreg[s];
            LAS bf16_t* vt = (LAS bf16_t*)(sV + s * V_BYTES) + (8 * sseg) * VROW + srow;
            vt[0 * VROW] = (bf16_t)(vreg[s].x & 0xffffu); vt[1 * VROW] = (bf16_t)(vreg[s].x >> 16);
            vt[2 * VROW] = (bf16_t)(vreg[s].y & 0xffffu); vt[3 * VROW] = (bf16_t)(vreg[s].y >> 16);
            vt[4 * VROW] = (bf16_t)(vreg[s].z & 0xffffu); vt[5 * VROW] = (bf16_t)(vreg[s].z >> 16);
            vt[6 * VROW] = (bf16_t)(vreg[s].w & 0xffffu); vt[7 * VROW] = (bf16_t)(vreg[s].w >> 16);
        }
        __syncthreads();
        if (c + 1 < nchunks) gload(c + 1);
        f32x4 sacc[4];
        const LAS unsigned char* kb_base = sK + slot * K_BYTES + (fr * KROW + 8 * fq) * 2;
#pragma unroll
        for (int kb = 0; kb < 4; ++kb) {
            sacc[kb] = (f32x4){0.f, 0.f, 0.f, 0.f};
#pragma unroll
            for (int kk = 0; kk < 2; ++kk) {
                const bf16x8 a = *(const LAS bf16x8*)(kb_base + (16 * kb * KROW + 32 * kk) * 2);
                sacc[kb] = __builtin_amdgcn_mfma_f32_16x16x32_bf16(a, qf[kk], sacc[kb], 0, 0, 0);
            }
        }
        const int qi = wq * 16 + fr;
        if (c >= 4 && it.mode == 0) {
            const int wsx = min(max(qi - 8, 0), 48);
            const int dr = (it.rs + (c - 4)) - it.r + 7;
            const LAS float* bt = sB + g * 465 + dr * 31;
#pragma unroll
            for (int kb = 0; kb < 4; ++kb)
#pragma unroll
                for (int j = 0; j < 4; ++j) { const int kc = 16 * kb + 4 * fq + j; const bool ok = (kc >= wsx) && (kc < wsx + 16);
                    const int dc = min(max(kc - qi + 15, 0), 30);
                    sacc[kb][j] = ok ? (sacc[kb][j] + bt[dc]) * LOG2E : -1.0e30f; }
        } else if (c >= 4 && it.mode == 1) {
            const int qpos = it.q0 + qi, kbase = it.kp0 + 64 * (c - 4);
#pragma unroll
            for (int kb = 0; kb < 4; ++kb)
#pragma unroll
                for (int j = 0; j < 4; ++j) { const int kpos = kbase + 16 * kb + 4 * fq + j; const int d = kpos - qpos; const bool ok = (d <= 128) && (d >= -128);
                    sacc[kb][j] = ok ? sacc[kb][j] * LOG2E : -1.0e30f; }
        } else {
#pragma unroll
            for (int kb = 0; kb < 4; ++kb) sacc[kb] = sacc[kb] * LOG2E;
        }
        float cm = sacc[0][0];
#pragma unroll
        for (int kb = 0; kb < 4; ++kb)
#pragma unroll
            for (int j = 0; j < 4; ++j) cm = fmaxf(cm, sacc[kb][j]);
        cm = fmaxf(cm, __shfl_xor(cm, 16)); cm = fmaxf(cm, __shfl_xor(cm, 32));
        const float mnew = fmaxf(mrun, cm), alpha = fast_exp2(mrun - mnew);
        mrun = mnew;
        float ps = 0.f;
#pragma unroll
        for (int kb = 0; kb < 4; ++kb)
#pragma unroll
            for (int j = 0; j < 4; ++j) { sacc[kb][j] = fast_exp2(sacc[kb][j] - mnew); ps += sacc[kb][j]; }
        lsum = lsum * alpha + ps;
#pragma unroll
        for (int db = 0; db < 4; ++db) o[db] = o[db] * alpha;
        const LAS unsigned char* vb_base = sV + slot * V_BYTES + (fr * VROW + 4 * fq) * 2;
#pragma unroll
        for (int grp = 0; grp < 2; ++grp) {
            union { bf16x8 v; unsigned u[4]; } pb;
            pb.u[0] = pk2(sacc[2 * grp][0], sacc[2 * grp][1]); pb.u[1] = pk2(sacc[2 * grp][2], sacc[2 * grp][3]);
            pb.u[2] = pk2(sacc[2 * grp + 1][0], sacc[2 * grp + 1][1]); pb.u[3] = pk2(sacc[2 * grp + 1][2], sacc[2 * grp + 1][3]);
#pragma unroll
            for (int db = 0; db < 4; ++db) {
                union { bf16x8 v; u32x2 h[2]; } av;
                av.h[0] = *(const LAS u32x2*)(vb_base + (16 * db * VROW + 32 * grp) * 2);
                av.h[1] = *(const LAS u32x2*)(vb_base + (16 * db * VROW + 32 * grp + 16) * 2);
                o[db] = __builtin_amdgcn_mfma_f32_16x16x32_bf16(av.v, pb.v, o[db], 0, 0, 0);
            }
        }
    }
    lsum += __shfl_xor(lsum, 16); lsum += __shfl_xor(lsum, 32);
    if (it.has_sink) lsum += fast_exp2((g ? it.sink1 : it.sink0) * LOG2E - mrun);
    const float inv = 1.0f / lsum;
    bf16_t* op = YCAT + (size_t)(it.qtok0 + wq * 16 + fr) * DM + (g ? it.ocol1 : it.ocol0) + 4 * fq;
#pragma unroll
    for (int db = 0; db < 4; ++db) { u32x2 w; w.x = pk2(o[db][0] * inv, o[db][1] * inv); w.y = pk2(o[db][2] * inv, o[db][3] * inv); *(u32x2*)(op + 16 * db) = w; }
    __syncthreads();
}

constexpr int C_UA = 0, C_QN = 512, C_KN = 768, C_VN = 1024, C_QS = 1280, C_KS = 1536, C_VS = 1664;

__device__ __forceinline__ void mix_items(CParams& p, LAS unsigned char* lds, int l) {
    const int n_attn = (l == 0) ? 2304 : 2048;
    const int n_conv = (l == 0) ? 1024 + 128 : 1024;
    const int start = (obid() + 128) % gridDim.x;
    for (int i = start; i < n_attn + n_conv; i += gridDim.x) {
        if (i >= n_attn) {
            if constexpr ((MIXMASK & 4) == 0) continue;
            const int ci = i - n_attn;
            if (ci < 1024) conv_item(p, lds, l, ci >> 6, ci & 63);
            else { const int cj = ci - 1024; conv_item(p, lds, l, 16 + (cj >> 3), cj & 7); }
            continue;
        }
        AttnItem it{};
        if (i < 1024) {
            const int b = i >> 6, r = (i >> 1) & 31, hp = i & 1;
            it.mode = 0; it.qtok0 = b * 2048 + r * 64; it.nslots = 2; it.h0 = 2 * hp;
            { const int h = 2 * hp; it.qcol0 = C_QN + 64 * h; it.kcol0 = C_KN + 64 * h; it.vcol0 = C_VN + 64 * h; it.ocol0 = 512 + 64 * h;
              it.qcol1 = it.qcol0 + 64; it.kcol1 = it.kcol0 + 64; it.vcol1 = it.vcol0 + 64; it.ocol1 = it.ocol0 + 64; }
            it.r = r; it.rs = min(max(r - 4, 0), 24); it.nloc = 8; it.loctok0 = b * 2048 + it.rs * 64; it.ctxtok0 = TL + b * 256;
        } else if (i < 2048) {
            const int k = i - 1024, b = k >> 6, qb = (k >> 1) & 31, kvh = k & 1;
            it.mode = 1; it.qtok0 = b * 2048 + qb * 64; it.nslots = 1;
            { const int h = 2 * kvh; it.qcol0 = C_QS + 64 * h; it.ocol0 = 768 + 64 * h; it.sink0 = p.sink[l * 4 + h]; it.sink1 = p.sink[l * 4 + h + 1];
              it.qcol1 = it.qcol0 + 64; it.ocol1 = it.ocol0 + 64; it.kcol0 = it.kcol1 = C_KS + 64 * kvh; it.vcol0 = it.vcol1 = C_VS + 64 * kvh; }
            it.has_sink = 1; it.q0 = qb * 64;
            const int ks = max(qb * 64 - 128, 0), ke = min(qb * 64 + 192, 2048);
            it.kp0 = ks; it.nloc = (ke - ks) >> 6; it.loctok0 = b * 2048 + ks; it.ctxtok0 = TL + b * 256;
        } else if (i < 2176) {
            const int k = i - 2048, b = k >> 3, qb = (k >> 1) & 3, hp = k & 1;
            it.mode = 2; it.qtok0 = TL + b * 256 + qb * 64; it.nslots = 2;
            { const int h = 2 * hp; it.qcol0 = C_QN + 64 * h; it.kcol0 = C_KN + 64 * h; it.vcol0 = C_VN + 64 * h; it.ocol0 = 512 + 64 * h;
              it.qcol1 = it.qcol0 + 64; it.kcol1 = it.kcol0 + 64; it.vcol1 = it.vcol0 + 64; it.ocol1 = it.ocol0 + 64; }
            it.nloc = 0; it.ctxtok0 = TL + b * 256;
        } else {
            const int k = i - 2176, b = k >> 3, qb = (k >> 1) & 3, kvh = k & 1;
            it.mode = 2; it.qtok0 = TL + b * 256 + qb * 64; it.nslots = 1;
            { const int h = 2 * kvh; it.qcol0 = C_QS + 64 * h; it.ocol0 = 768 + 64 * h; it.sink0 = p.sink[l * 4 + h]; it.sink1 = p.sink[l * 4 + h + 1];
              it.qcol1 = it.qcol0 + 64; it.ocol1 = it.ocol0 + 64; it.kcol0 = it.kcol1 = C_KS + 64 * kvh; it.vcol0 = it.vcol1 = C_VS + 64 * kvh; }
            it.has_sink = 1; it.nloc = 0; it.ctxtok0 = TL + b * 256;
        }
        if constexpr ((MIXMASK & 2) != 0) attn_item(p, lds, l, it);
    }
}

constexpr int N_PHASES = 22;
#ifndef PHMASK
#define PHMASK 0xff
#endif

__device__ __forceinline__ void run_phase(CParams& p, LAS unsigned char* lds, int ph) {
    unsigned char* ws = p.ws;
    bf16_t* YH = (bf16_t*)(ws + WS_YH); bf16_t* U = (bf16_t*)(ws + WS_R1); bf16_t* PROJ = (bf16_t*)(ws + WS_PROJ); bf16_t* YCAT = (bf16_t*)(ws + WS_YCAT);
    float* XC = (float*)(ws + WS_XC); const float* MOD = (const float*)(ws + WS_MOD);
    const int G = gridDim.x, c = obid();
    if (ph == 0) { if constexpr ((PHMASK & 1) != 0) phase0(p, lds); return; }
    if (ph == 1) {
        if constexpr ((PHMASK & 2) == 0) return;
        ew_pass(p.x, p.ctx, p.out, XC, nullptr, nullptr, 0.f, nullptr, YH, p.norm_g, MOD, MOD + 1024, TA); return;
    }
    const int l = (ph - 2) / 10, k = (ph - 2) % 10;
    const float* MODL = MOD + (size_t)l * 17 * NMODC; const float* NG = p.norm_g + (size_t)l * 6 * DM;
    const int rows_late = (l == 0) ? TA : TL;
    switch (k) {
    case 0: case 7: {
        if constexpr ((PHMASK & 4) == 0) break;
        const int f = (k == 7), M = f ? rows_late : TA;
        pg8::Gemm g{YH, (const bf16_t*)(ws + WS_W13) + (size_t)(l * 2 + f) * 5632 * 1024, M, 5632, 1024};
        pg8::StaticOrder S; S.init(M, 5632, G, c); EpiSwiGLU E{U};
        pg8::gemm_phase<EpiSwiGLU, pg8::StaticOrder, true, true>(lds, g, S, E);
    } break;
    case 1: case 8: case 5: {
        if constexpr ((PHMASK & 8) == 0) break;
        const bool isout = (k == 5); const int f = (k == 8), M = (k == 1) ? TA : rows_late;
        pg8::Gemm g{isout ? YCAT : U, isout ? (const bf16_t*)(ws + WS_WOUT) + (size_t)l * 1024 * 1024 : (const bf16_t*)(ws + WS_W2T) + (size_t)(l * 2 + f) * 1024 * FF, M, 1024, isout ? 1024 : FF};
        pg8::StaticOrder S; S.init(M, 1024, G, c); EpiBf16Tile E{YH, 1024, 0, 256};
        pg8::gemm_phase<EpiBf16Tile, pg8::StaticOrder, true, true>(lds, g, S, E);
    } break;
    case 2: case 6: case 9: {
        if constexpr ((PHMASK & 2) == 0) break;
        const int gi = (k == 2) ? 2 : (k == 6 ? 5 : 8), ni = (k == 2) ? 1 : (k == 6 ? 3 : 5);
        const int nrows = (k == 2) ? TA : rows_late;
        const bool lastl = (k == 9 && l == 1);
        const float* gpre = (k == 2) ? NG + 2 * DM : (k == 6 ? NG + 4 * DM : p.norm_g + 6 * DM);
        const float* shift = (k == 2) ? MODL + 3 * 1024 : (k == 6 ? MODL + 6 * 1024 : MOD + 17 * NMODC);
        const float* scale = (k == 2) ? MODL + 4 * 1024 : (k == 6 ? MODL + 7 * 1024 : MOD + 17 * NMODC + 1024);
        float* outp = p.out;
        ew_pass(outp, XC, outp, XC, YH, NG + ni * DM, (k == 6) ? 1.0f : 0.5f, MODL + gi * 1024, lastl ? nullptr : YH, gpre, shift, scale, nrows);
    } break;
    case 3: {
        if constexpr ((PHMASK & 16) == 0) break;
        const bf16_t* W = (const bf16_t*)(ws + WS_WIN) + (size_t)l * 2304 * 1024;
        { pg8::Gemm g{YH, W, TA, NP, 1024}; pg8::StaticOrder S; S.init(TA, NP, G, c); EpiWin E{PROJ, (const float*)(ws + WS_ROPE)};
          pg8::gemm_phase<EpiWin, pg8::StaticOrder, true, true>(lds, g, S, E); }
        { const int N = (l == 0) ? TA : TL; pg8::Gemm g{W + (size_t)1792 * 1024, YH, 512, N, 1024}; pg8::StaticOrder S; S.init(512, N, G, (c + 16) % G);
          EpiPQ E{(bf16_t*)(ws + WS_PQT), (bf16_t*)(ws + WS_PQTC)};
          pg8::gemm_phase<EpiPQ, pg8::StaticOrder, true, true>(lds, g, S, E); }
    } break;
    case 4: {
        if constexpr ((PHMASK & 32) == 0) break;
        if constexpr ((MIXMASK & 1) != 0)
        for (int v = 0; v < ((l == 0) ? 2 : 1); ++v) {
            pg8::Gemm g = v == 0 ? pg8::Gemm{(const bf16_t*)(ws + WS_DFT), (const bf16_t*)(ws + WS_PQT), 2048, 4096, 4096}
                                 : pg8::Gemm{(const bf16_t*)(ws + WS_DFTC), (const bf16_t*)(ws + WS_PQTC), 256, 4096, 512};
            pg8::StaticOrder S; S.init(g.M, g.N, G, v == 0 ? c : (c + G - 128) % G);
            EpiBf16Tile E = v == 0 ? EpiBf16Tile{YCAT + 256, 1024, 2048, 0} : EpiBf16Tile{YCAT + (size_t)TL * DM + 256, 1024, 256, 0};
            pg8::gemm_phase<EpiBf16Tile, pg8::StaticOrder, true, true>(lds, g, S, E);
        }
        if constexpr ((MIXMASK & 6) != 0) mix_items(p, lds, l);
    } break;
    }
}

__global__ void __launch_bounds__(512, 2) mega(Params p, int ph0, int ph1) {
    extern __shared__ __attribute__((aligned(16))) unsigned char lds_raw[];
    LAS unsigned char* lds = (LAS unsigned char*)lds_raw;
    cg::grid_group grid = cg::this_grid();
    for (int ph = ph0; ph < ph1; ++ph) {
        CParams* q = (CParams*)__builtin_amdgcn_kernarg_segment_ptr(); asm volatile("" : "+s"(q));
        run_phase(*q, lds, ph);
        if (ph + 1 < ph1) grid.sync();
    }
}

#ifndef ONE_LAUNCH
#define ONE_LAUNCH 0
#endif

extern "C" void kernel_launch(void* const* d_in, const int* in_sizes, int n_in, void* d_out, int out_size, void* d_ws, size_t ws_size, hipStream_t stream) {
    static int grid = 0;
    if (grid == 0) {
        if (ws_size < WS_END) { fprintf(stderr, "kernel_launch: workspace too small: %zu < %zu\n", ws_size, (size_t)WS_END); grid = -1; return; }
        int dev = 0, cus = 0, per_cu = 0;
        hipGetDevice(&dev); hipDeviceGetAttribute(&cus, hipDeviceAttributeMultiprocessorCount, dev);
        hipFuncSetAttribute((const void*)mega, hipFuncAttributeMaxDynamicSharedMemorySize, LDS_BYTES);
        hipOccupancyMaxActiveBlocksPerMultiprocessor(&per_cu, (const void*)mega, 512, LDS_BYTES);
        if (per_cu < 1) { fprintf(stderr, "kernel_launch: occupancy query says %d blocks per CU\n", per_cu); per_cu = 1; }
        (void)hipGetLastError();
        grid = cus;
    }
    if (grid < 0) return;
    Params p{};
    p.x = (const float*)d_in[0]; p.c = (const float*)d_in[1]; p.ctx = (const float*)d_in[2]; p.c_ctx = (const float*)d_in[3];
    p.w_ada = (const float*)d_in[4]; p.b_ada = (const float*)d_in[5]; p.norm_g = (const float*)d_in[6];
    p.w1 = (const float*)d_in[7]; p.w3 = (const float*)d_in[8]; p.w2 = (const float*)d_in[9]; p.w_in = (const float*)d_in[10];
    p.conv_w = (const float*)d_in[11]; p.conv_b = (const float*)d_in[12]; p.ln_g = (const float*)d_in[13]; p.ln_b = (const float*)d_in[14];
    p.nat_bias = (const float*)d_in[15]; p.sink = (const float*)d_in[16]; p.w_out = (const float*)d_in[17];
    p.out = (float*)d_out; p.ws = (unsigned char*)d_ws;
#if ONE_LAUNCH
    int ph0 = 0, ph1 = N_PHASES;
    void* args[] = {&p, &ph0, &ph1};
    hipError_t e = hipLaunchCooperativeKernel((const void*)mega, dim3(grid), dim3(512), args, LDS_BYTES, stream);
    if (e != hipSuccess) fprintf(stderr, "cooperative launch failed: %s (grid %d)\n", hipGetErrorString(e), grid);
#else
    for (int ph = 0; ph < N_PHASES; ++ph) {
        int ph0 = ph, ph1 = ph + 1;
        void* args[] = {&p, &ph0, &ph1};
        hipError_t e = hipLaunchCooperativeKernel((const void*)mega, dim3(grid), dim3(512), args, LDS_BYTES, stream);
        if (e != hipSuccess) { fprintf(stderr, "launch %d failed: %s (grid %d)\n", ph, hipGetErrorString(e), grid); break; }
    }
#endif
}
```

```cpp
#include <hip/hip_runtime.h>
#include <hip/hip_cooperative_groups.h>
#include <cstdio>
#include <cstdint>
namespace cg = cooperative_groups;
namespace pg8 {
#define PG8_LAS __attribute__((address_space(3)))
typedef unsigned short bf16_t;
typedef short bf16x8 __attribute__((ext_vector_type(8)));
typedef float f32x4 __attribute__((ext_vector_type(4)));
typedef unsigned u32x4 __attribute__((ext_vector_type(4)));
constexpr int BM = 256, BK = 64, HALF = 128, HTB = HALF * BK * 2  , STAGE_BYTES = 8 * HTB, NXCD = 8, WGM = 8;

__host__ __device__ __forceinline__ int lds_byte(int r, int c) { const int st = (r >> 4) * 2 + (c >> 5), rr = r & 15, cc = c & 31, ob = rr * 64 + cc * 2; return st * 1024 + (ob ^ (((ob >> 9) & 1) << 5)); }
__host__ __device__ __forceinline__ void stage_rc(int b, int& R, int& C) { const int st = b / 1024, sb = b % 1024, swz = sb ^ (((sb >> 9) & 1) << 5); R = (st >> 1) * 16 + swz / 64; C = (st & 1) * 32 + (swz % 64) / 2; }
__host__ __device__ __forceinline__ int perm32(int rho) { const int n = rho >> 4, i = rho & 15; return 8 * (i >> 2) + 4 * n + (i & 3); }

struct Unit { int pm, pn; };
struct Gemm { const bf16_t* A; const bf16_t* Bt; int M, N, K; };

struct StaticOrder {
    int nM, nN, nwg, G, c;
    __host__ __device__ void init(int M, int N, int G_, int c_) { nM = M / BM; nN = N / BM; nwg = nM * nN; G = G_; c = c_; }
    __host__ __device__ bool next(int i, Unit& u) const {
        const long L = (long)i * G + c; if (L >= nwg) return false;
        int wgid = (int)L; { const int q = nwg / NXCD, r = nwg % NXCD, xcd = wgid % NXCD, off = wgid / NXCD; wgid = (xcd < r ? xcd * (q + 1) : r * (q + 1) + (xcd - r) * q) + off; }
        const int nig = WGM * nN, gid = wgid / nig, fm = gid * WGM, gsz = (nM - fm) < WGM ? (nM - fm) : WGM;
        u.pm = fm + ((wgid % nig) % gsz); u.pn = (wgid % nig) / gsz; return true;
    }
    __device__ __forceinline__ void a_ready(const Unit&) const {}
    __device__ __forceinline__ void done(const Unit&) const {}
};
__device__ __forceinline__ unsigned cvt_pk_bf16(float lo, float hi) { unsigned r; asm volatile("v_cvt_pk_bf16_f32 %0, %1, %2" : "=v"(r) : "v"(lo), "v"(hi)); return r; }
typedef float f32x2 __attribute__((ext_vector_type(2)));
template <class Epi, class Sched, bool ALIGN_EPI = false, bool SP2 = false>
__device__ __forceinline__ void gemm_phase(PG8_LAS unsigned char* lds, const Gemm g, const Sched& S, const Epi& E) {
    int tid_ = threadIdx.x; asm volatile("" : "+v"(tid_));
    const int tid = tid_, wid = __builtin_amdgcn_readfirstlane(tid >> 6), lane = tid & 63, wr = wid >> 2, wc = wid & 3, fr = lane & 15, fq = lane >> 4;
    const int K = g.K, nt = K / BK;
    unsigned voffA[2], voffB[2];
#pragma unroll
    for (int i = 0; i < 2; ++i) { int R, C; stage_rc(tid * 16 + i * 8192, R, C); const int Rb = Epi::PERM ? ((R & ~31) + perm32(R & 31)) : R;
        voffA[i] = (unsigned)(R * K + C) * 2u; voffB[i] = (unsigned)(Rb * K + C) * 2u; }
    const size_t kstep = (size_t)(BK * 2);
    const size_t hstep = (size_t)HALF * K * 2;
    const size_t tstep = 2 * hstep;
    const unsigned ldsw = (unsigned)wid * 1024u;
    const int aoff = lds_byte(wr * 64 + fr, fq * 8), boff = lds_byte(wc * 32 + fr, fq * 8);
#define PG8_SA(b, h) (((b) * 2 + (h)) * HTB)
#define PG8_SB(b, h) ((4 + (b) * 2 + (h)) * HTB)
#define PG8_STAGE(bufoff, gbase, voff) do { _Pragma("unroll") for (int _i = 0; _i < 2; ++_i) \
        __builtin_amdgcn_global_load_lds((const unsigned*)((const char*)(gbase) + (voff)[_i]), (PG8_LAS unsigned*)(lds + (bufoff) + ldsw + _i * 8192), 16, 0, 0); } while (0)
#define PG8_LDA(dst, b, h) do { _Pragma("unroll") for (int m = 0; m < 4; ++m) _Pragma("unroll") for (int k = 0; k < 2; ++k) dst[m][k] = *(const PG8_LAS bf16x8*)(lds + PG8_SA(b, h) + aoff + m * 2048 + k * 1024); } while (0)
#define PG8_LDB(dst, b, h) do { _Pragma("unroll") for (int n = 0; n < 2; ++n) _Pragma("unroll") for (int k = 0; k < 2; ++k) dst[n][k] = *(const PG8_LAS bf16x8*)(lds + PG8_SB(b, h) + boff + n * 2048 + k * 1024); } while (0)
#define PG8_MMA(ai, bj, At, Bt) do { __builtin_amdgcn_s_setprio(1); _Pragma("unroll") for (int m = 0; m < 4; ++m) _Pragma("unroll") for (int n = 0; n < 2; ++n) _Pragma("unroll") for (int k = 0; k < 2; ++k) \
        acc[ai][bj][m][n] = __builtin_amdgcn_mfma_f32_16x16x32_bf16(Bt[n][k], At[m][k], acc[ai][bj][m][n], 0, 0, 0); __builtin_amdgcn_s_setprio(0); } while (0)
#define PG8_WAIT_V(n) asm volatile("s_waitcnt vmcnt(" #n ")" ::: "memory")
#define PG8_WAIT_L(n) asm volatile("s_waitcnt lgkmcnt(" #n ")" ::: "memory")
#define PG8_BAR __builtin_amdgcn_s_barrier()
#define PG8_SCHED __builtin_amdgcn_sched_barrier(0)
    Unit cur, nxt; int ui = 0;
    if (!S.next(0, cur)) return;
    f32x4 acc[2][2][4][2];
#pragma unroll
    for (int a = 0; a < 2; ++a)
#pragma unroll
        for (int b = 0; b < 2; ++b)
#pragma unroll
            for (int m = 0; m < 4; ++m)
#pragma unroll
                for (int n = 0; n < 2; ++n) acc[a][b][m][n] = (f32x4){0.f, 0.f, 0.f, 0.f};
    bf16x8 At[4][2], B0[2][2], B1[2][2];
    const char* cA = (const char*)g.A + (size_t)cur.pm * tstep; const char* cB = (const char*)g.Bt + (size_t)cur.pn * tstep;
    S.a_ready(cur);
    if constexpr (SP2) {
        PG8_STAGE(PG8_SB(0, 0), cB, voffB); PG8_STAGE(PG8_SB(0, 1), cB + hstep, voffB); PG8_STAGE(PG8_SA(0, 0), cA, voffA); PG8_STAGE(PG8_SA(0, 1), cA + hstep, voffA);
        if (wr == 1) PG8_BAR;
        PG8_WAIT_V(2); PG8_BAR;
        PG8_STAGE(PG8_SB(1, 0), cB + kstep, voffB); PG8_STAGE(PG8_SA(1, 0), cA + kstep, voffA); PG8_STAGE(PG8_SB(1, 1), cB + hstep + kstep, voffB);
        PG8_WAIT_V(6); PG8_BAR;
    } else {
        PG8_STAGE(PG8_SB(0, 0), cB, voffB); PG8_STAGE(PG8_SA(0, 0), cA, voffA); PG8_STAGE(PG8_SB(0, 1), cB + hstep, voffB); PG8_STAGE(PG8_SA(0, 1), cA + hstep, voffA);
        if (wr == 1) PG8_BAR;
        PG8_WAIT_V(4); PG8_BAR;
        PG8_STAGE(PG8_SB(1, 0), cB + kstep, voffB); PG8_STAGE(PG8_SA(1, 0), cA + kstep, voffA); PG8_STAGE(PG8_SB(1, 1), cB + hstep + kstep, voffB);
        PG8_WAIT_V(6); PG8_BAR;
    }
    for (;;) {
        const bool has_next = S.next(ui + 1, nxt);
        const char* nA = has_next ? (const char*)g.A + (size_t)nxt.pm * tstep : cA; const char* nB = has_next ? (const char*)g.Bt + (size_t)nxt.pn * tstep : cB;
        for (int t = 0; t < nt; t += 2) {
            const bool last = (t == nt - 2);
            const char* a1 = cA + (size_t)(t + 1) * kstep;
            const char* a2 = last ? nA : cA + (size_t)(t + 2) * kstep; const char* b2 = last ? nB : cB + (size_t)(t + 2) * kstep;
            const char* a3 = a2 + kstep; const char* b3 = b2 + kstep;
            if (last && has_next) S.a_ready(nxt);
            if constexpr (SP2) {
            PG8_LDB(B0, 0, 0); PG8_LDB(B1, 0, 1); PG8_SCHED; PG8_LDA(At, 0, 0); PG8_STAGE(PG8_SA(1, 1), a1 + hstep, voffA);
            PG8_WAIT_V(8); PG8_WAIT_L(0); PG8_BAR; PG8_MMA(0, 0, At, B0); PG8_MMA(0, 1, At, B1); PG8_BAR; PG8_SCHED;
            PG8_LDA(At, 0, 1); PG8_STAGE(PG8_SB(0, 0), b2, voffB); PG8_STAGE(PG8_SB(0, 1), b2 + hstep, voffB); PG8_STAGE(PG8_SA(0, 0), a2, voffA);
            PG8_WAIT_V(8); PG8_WAIT_L(0); PG8_BAR; PG8_MMA(1, 0, At, B0); PG8_MMA(1, 1, At, B1); PG8_BAR; PG8_SCHED;
            PG8_LDB(B0, 1, 0); PG8_LDB(B1, 1, 1); PG8_SCHED; PG8_LDA(At, 1, 0); PG8_STAGE(PG8_SA(0, 1), a2 + hstep, voffA);
            PG8_WAIT_V(8); PG8_WAIT_L(0); PG8_BAR; PG8_MMA(0, 0, At, B0); PG8_MMA(0, 1, At, B1); PG8_BAR; PG8_SCHED;
            PG8_LDA(At, 1, 1); PG8_STAGE(PG8_SB(1, 0), b3, voffB); PG8_STAGE(PG8_SB(1, 1), b3 + hstep, voffB); PG8_STAGE(PG8_SA(1, 0), a3, voffA);
            PG8_WAIT_V(8); PG8_WAIT_L(0); PG8_BAR; PG8_MMA(1, 0, At, B0); PG8_MMA(1, 1, At, B1); PG8_BAR; PG8_SCHED;
            } else {
            PG8_LDB(B0, 0, 0); PG8_SCHED; PG8_LDA(At, 0, 0); PG8_STAGE(PG8_SA(1, 1), a1 + hstep, voffA);
            PG8_WAIT_L(8); PG8_BAR; PG8_WAIT_L(0); PG8_MMA(0, 0, At, B0); PG8_BAR; PG8_SCHED;
            PG8_LDB(B1, 0, 1); PG8_STAGE(PG8_SB(0, 0), b2, voffB);
            PG8_BAR; PG8_WAIT_L(0); PG8_MMA(0, 1, At, B1); PG8_BAR;
            PG8_LDA(At, 0, 1); PG8_STAGE(PG8_SA(0, 0), a2, voffA);
            PG8_BAR; PG8_WAIT_L(0); PG8_MMA(1, 0, At, B0); PG8_BAR; PG8_SCHED;
            PG8_STAGE(PG8_SB(0, 1), b2 + hstep, voffB);
            PG8_WAIT_V(6); PG8_BAR; PG8_MMA(1, 1, At, B1); PG8_BAR;
            PG8_LDB(B0, 1, 0); PG8_SCHED; PG8_LDA(At, 1, 0); PG8_STAGE(PG8_SA(0, 1), a2 + hstep, voffA);
            PG8_WAIT_L(8); PG8_BAR; PG8_WAIT_L(0); PG8_MMA(0, 0, At, B0); PG8_BAR; PG8_SCHED;
            PG8_LDB(B1, 1, 1); PG8_STAGE(PG8_SB(1, 0), b3, voffB);
            PG8_BAR; PG8_WAIT_L(0); PG8_MMA(0, 1, At, B1); PG8_BAR;
            PG8_LDA(At, 1, 1); PG8_STAGE(PG8_SA(1, 0), a3, voffA);
            PG8_BAR; PG8_WAIT_L(0); PG8_MMA(1, 0, At, B0); PG8_BAR; PG8_SCHED;
            PG8_STAGE(PG8_SB(1, 1), b3 + hstep, voffB);
            PG8_WAIT_V(6); PG8_BAR; PG8_MMA(1, 1, At, B1); PG8_BAR;
            }
        }
        if constexpr (ALIGN_EPI) { if (wr == 0) PG8_BAR; }
        if constexpr (!Epi::AFTER_DRAIN) { E(acc, cur, wr, wc, fr, fq); S.done(cur); }
        if (!has_next) break;
#pragma unroll
        for (int a = 0; a < 2; ++a)
#pragma unroll
            for (int b = 0; b < 2; ++b)
#pragma unroll
                for (int m = 0; m < 4; ++m)
#pragma unroll
                    for (int n = 0; n < 2; ++n) acc[a][b][m][n] = (f32x4){0.f, 0.f, 0.f, 0.f};
        cur = nxt; cA = nA; cB = nB; ++ui;
        if constexpr (ALIGN_EPI) { if (wr == 1) PG8_BAR; }
    }
    PG8_WAIT_V(0);
    if constexpr (!ALIGN_EPI) { if (wr == 0) PG8_BAR; }
    PG8_BAR;
    if constexpr (Epi::AFTER_DRAIN) { E.fused(acc, cur, wr, wc, fr, fq, lds, wid, lane); S.done(cur); }
#undef PG8_SA
#undef PG8_SB
#undef PG8_STAGE
#undef PG8_LDA
#undef PG8_LDB
#undef PG8_MMA
#undef PG8_WAIT_V
#undef PG8_WAIT_L
#undef PG8_BAR
#undef PG8_SCHED
}
}

#define LAS __attribute__((address_space(3)))
typedef unsigned short bf16_t;
typedef float f32x4 __attribute__((ext_vector_type(4)));
typedef float f32x2 __attribute__((ext_vector_type(2)));
typedef unsigned u32x4 __attribute__((ext_vector_type(4)));
typedef unsigned u32x2 __attribute__((ext_vector_type(2)));
typedef short bf16x8 __attribute__((ext_vector_type(8)));
typedef short bf16x4 __attribute__((ext_vector_type(4)));

constexpr int TL = 32768, TC = 4096, TA = 36864, DM = 1024, FF = 2816, NP = 1792, NMODC = 9216;
constexpr int LDS_BYTES = 131072;
#ifndef MIXMASK
#define MIXMASK 7
#endif
constexpr float EPSV = 1e-6f;
constexpr float LOG2E = 1.4426950408889634f;

constexpr size_t WS_XC   = 0;
constexpr size_t WS_YH   = WS_XC + (size_t)TC * DM * 4;
constexpr size_t WS_R1   = WS_YH + (size_t)TA * DM * 2;
constexpr size_t WS_PROJ = WS_R1;
constexpr size_t WS_PQT  = WS_PROJ + (size_t)TA * NP * 2;
constexpr size_t WS_PQTC = WS_PQT + (size_t)4096 * 4096 * 2;
constexpr size_t WS_YCAT = WS_PQTC + (size_t)4096 * 512 * 2;
constexpr size_t WS_R1END= WS_YCAT + (size_t)TA * DM * 2;
constexpr size_t WS_W13  = WS_R1END;
constexpr size_t WS_W2T  = WS_W13 + (size_t)4 * 5632 * 1024 * 2;
constexpr size_t WS_WIN  = WS_W2T + (size_t)4 * 1024 * 2816 * 2;
constexpr size_t WS_WOUT = WS_WIN + (size_t)2 * 2304 * 1024 * 2;
constexpr size_t WS_DFT  = WS_WOUT + (size_t)2 * 1024 * 1024 * 2;
constexpr size_t WS_DFTC = WS_DFT + (size_t)2048 * 4096 * 2;
constexpr size_t WS_MOD  = WS_DFTC + (size_t)256 * 512 * 2;
constexpr size_t WS_ROPE = WS_MOD + (size_t)2 * 17 * NMODC * 4;
constexpr size_t WS_END  = WS_ROPE + 64 * 16 * 2 * 4;
static_assert((size_t)TA * FF * 2 <= WS_R1END - WS_R1, "U must fit in R1");

struct Params {
    const float *x, *c, *ctx, *c_ctx, *w_ada, *b_ada, *norm_g, *w1, *w3, *w2, *w_in, *conv_w, *conv_b, *ln_g, *ln_b, *nat_bias, *sink, *w_out;
    float* out; unsigned char* ws;
};
typedef const __attribute__((address_space(4))) Params CParams;

__device__ __forceinline__ unsigned pk2(float lo, float hi) { return pg8::cvt_pk_bf16(lo, hi); }
__device__ __forceinline__ float bflo(unsigned v) { return __uint_as_float(v << 16); }
__device__ __forceinline__ float bfhi(unsigned v) { return __uint_as_float(v & 0xffff0000u); }
__device__ __forceinline__ float wave_sum(float v) {
#pragma unroll
    for (int o = 1; o < 64; o <<= 1) v += __shfl_xor(v, o);
    return v;
}
__device__ __forceinline__ int otid() { int t = threadIdx.x; asm volatile("" : "+v"(t)); return t; }
__device__ __forceinline__ int obid() { int t = blockIdx.x; asm volatile("" : "+s"(t)); return t; }
__device__ __forceinline__ float fast_exp2(float x) { return __builtin_amdgcn_exp2f(x); }
__device__ __forceinline__ float fast_rcp(float x) { return __builtin_amdgcn_rcpf(x); }
__device__ __forceinline__ float silu_f(float v) { return v * fast_rcp(1.0f + fast_exp2(-v * LOG2E)); }
__device__ __forceinline__ float sigmoid_f(float v) { return fast_rcp(1.0f + fast_exp2(-v * LOG2E)); }

struct EpiSwiGLU {
    static constexpr bool PERM = true, AFTER_DRAIN = false;
    bf16_t* U;
    __device__ __forceinline__ void operator()(const f32x4 (&acc)[2][2][4][2], const pg8::Unit& u, int wr, int wc, int fr, int fq) const {
        const int row0 = u.pm * 256 + wr * 64 + fr, col0 = u.pn * 128 + wc * 32 + 8 * fq;
#pragma unroll
        for (int ai = 0; ai < 2; ++ai)
#pragma unroll
            for (int m = 0; m < 4; ++m) {
                bf16_t* rowp = U + (size_t)(row0 + ai * 128 + m * 16) * FF + col0;
                float v[8];
#pragma unroll
                for (int n = 0; n < 2; ++n)
#pragma unroll
                    for (int j = 0; j < 4; ++j) v[n * 4 + j] = silu_f(acc[ai][0][m][n][j]) * acc[ai][1][m][n][j];
                u32x4 w; w.x = pk2(v[0], v[1]); w.y = pk2(v[2], v[3]); w.z = pk2(v[4], v[5]); w.w = pk2(v[6], v[7]);
                *(u32x4*)rowp = w;
            }
    }
};
struct EpiBf16Tile {
    static constexpr bool PERM = true, AFTER_DRAIN = false;
    bf16_t* O; int ldc, row_pn, col_pn;
    __device__ __forceinline__ void operator()(const f32x4 (&acc)[2][2][4][2], const pg8::Unit& u, int wr, int wc, int fr, int fq) const {
        const int row0 = u.pm * 256 + u.pn * row_pn + wr * 64 + fr, col0 = u.pn * col_pn + wc * 32 + 8 * fq;
#pragma unroll
        for (int ai = 0; ai < 2; ++ai)
#pragma unroll
            for (int m = 0; m < 4; ++m) {
                bf16_t* rowp = O + (size_t)(row0 + ai * 128 + m * 16) * ldc + col0;
#pragma unroll
                for (int bj = 0; bj < 2; ++bj) {
                    const f32x4 v0 = acc[ai][bj][m][0], v1 = acc[ai][bj][m][1];
                    u32x4 w; w.x = pk2(v0[0], v0[1]); w.y = pk2(v0[2], v0[3]); w.z = pk2(v1[0], v1[1]); w.w = pk2(v1[2], v1[3]);
                    *(u32x4*)(rowp + bj * 128) = w;
                }
            }
    }
};
struct EpiPQ {
    static constexpr bool PERM = true, AFTER_DRAIN = false;
    bf16_t* PQT; bf16_t* PQTC;
    __device__ __forceinline__ void operator()(const f32x4 (&acc)[2][2][4][2], const pg8::Unit& u, int wr, int wc, int fr, int fq) const {
        const int cl = wc * 32 + 8 * fq;
#pragma unroll
        for (int ai = 0; ai < 2; ++ai)
#pragma unroll
            for (int m = 0; m < 4; ++m) {
                const int mp = u.pm * 256 + ai * 128 + wr * 64 + m * 16 + fr;
                const int g = mp >> 7, pq = (mp >> 6) & 1, cp = mp & 63;
                bf16_t* rowp;
                if (u.pn < 128) { const int b = u.pn >> 3, n0 = (u.pn & 7) * 256; rowp = PQT + (size_t)(b * 256 + g * 64 + cp) * 4096 + pq * 2048 + n0 + cl; }
                else { const int b = u.pn - 128; rowp = PQTC + (size_t)(b * 256 + g * 64 + cp) * 512 + pq * 256 + cl; }
#pragma unroll
                for (int bj = 0; bj < 2; ++bj) {
                    const f32x4 v0 = acc[ai][bj][m][0], v1 = acc[ai][bj][m][1];
                    u32x4 w; w.x = pk2(v0[0], v0[1]); w.y = pk2(v0[2], v0[3]); w.z = pk2(v1[0], v1[1]); w.w = pk2(v1[2], v1[3]);
                    *(u32x4*)(rowp + bj * 128) = w;
                }
            }
    }
};
struct EpiWin {
    static constexpr bool PERM = false, AFTER_DRAIN = false;
    bf16_t* P; const float* rope;
    __device__ __forceinline__ void operator()(const f32x4 (&acc)[2][2][4][2], const pg8::Unit& u, int wr, int wc, int fr, int fq) const {
        const int row0 = u.pm * 256 + wr * 64 + fr, col0 = u.pn * 256 + wc * 32 + 4 * fq;
        const float qs = (u.pn == 2 || u.pn == 5) ? 0.125f : 1.0f;
        const bool lat = u.pm < 128;
#pragma unroll
        for (int ai = 0; ai < 2; ++ai)
#pragma unroll
            for (int m = 0; m < 4; ++m) {
                const int r = row0 + ai * 128 + m * 16;
                bf16_t* rowp = P + (size_t)r * NP + col0;
                const int t = r & 2047;
                const int pos = (wc & 1) ? (t & 63) : (t >> 6);
#pragma unroll
                for (int bj = 0; bj < 2; ++bj) {
                    f32x4 v0 = acc[ai][bj][m][0], v1 = acc[ai][bj][m][1];
                    const bool dorope = lat && (u.pn == 5 || (u.pn == 6 && bj == 0));
                    if (dorope) {
                        const f32x4 cs0 = *(const f32x4*)(rope + (pos * 16 + 4 * fq) * 2), cs1 = *(const f32x4*)(rope + (pos * 16 + 4 * fq) * 2 + 4);
                        const float c0 = cs0[0], s0 = cs0[1], c1 = cs0[2], s1 = cs0[3], c2 = cs1[0], s2 = cs1[1], c3 = cs1[2], s3 = cs1[3];
                        f32x4 a, b;
                        a[0] = v0[0] * c0 - v1[0] * s0; b[0] = v0[0] * s0 + v1[0] * c0;
                        a[1] = v0[1] * c1 - v1[1] * s1; b[1] = v0[1] * s1 + v1[1] * c1;
                        a[2] = v0[2] * c2 - v1[2] * s2; b[2] = v0[2] * s2 + v1[2] * c2;
                        a[3] = v0[3] * c3 - v1[3] * s3; b[3] = v0[3] * s3 + v1[3] * c3;
                        v0 = a; v1 = b;
                    }
                    v0 = v0 * qs; v1 = v1 * qs;
                    u32x2 w0, w1; w0.x = pk2(v0[0], v0[1]); w0.y = pk2(v0[2], v0[3]); w1.x = pk2(v1[0], v1[1]); w1.y = pk2(v1[2], v1[3]);
                    *(u32x2*)(rowp + bj * 128) = w0; *(u32x2*)(rowp + bj * 128 + 16) = w1;
                }
            }
    }
};

__device__ __forceinline__ void transpose_tile(LAS unsigned char* lds, const float* src, int ld_src, int col0, int k0, bf16_t* dst, int ld_dst, int r0) {
    LAS float* t = (LAS float*)lds;
    const int tid = otid();
#pragma unroll
    for (int i = 0; i < 8; ++i) { const int kk = (tid >> 6) + 8 * i, cc = tid & 63; t[kk * 65 + cc] = src[(size_t)(k0 + kk) * ld_src + col0 + cc]; }
    __syncthreads();
    { const int r = tid >> 3, c8 = tid & 7; const LAS float* s = t + (8 * c8) * 65 + r;
      u32x4 o; o.x = pk2(s[0], s[65]); o.y = pk2(s[2 * 65], s[3 * 65]); o.z = pk2(s[4 * 65], s[5 * 65]); o.w = pk2(s[6 * 65], s[7 * 65]);
      *(u32x4*)(dst + (size_t)(r0 + r) * ld_dst + k0 + 8 * c8) = o; }
    __syncthreads();
}

__device__ __forceinline__ void phase0(CParams& p, LAS unsigned char* lds) {
    const int tid = otid(), wave = tid >> 6, lane = tid & 63;
    unsigned char* ws = p.ws;
    constexpr int N_MODS = 288, N_TR_L = 2 * 1408 + 2 * 704 + 448 + 256, N_TR = 2 * N_TR_L, N_FOLD = 256, N_DFT = 2048 + 256, N_ROPE = 1;
    constexpr int TOTAL = N_MODS + N_TR + N_FOLD + N_DFT + N_ROPE;
    bool mods_loaded = false;
    for (int it = obid(); it < TOTAL; it += gridDim.x) {
        int r = it;
        if (r < N_MODS) {
            LAS float* sS = (LAS float*)lds;
            LAS float* sR = sS + 17 * 1024;
            if (!mods_loaded) {
                for (int i = tid; i < 17 * 1024; i += 512) { const float v = (i < 16384) ? p.c[i] : p.c_ctx[i - 16384]; sS[i] = v / (1.0f + __expf(-v)); }
                __syncthreads(); mods_loaded = true;
            }
            const int l = r / 144, j0 = (r % 144) * 64, k0 = wave * 128;
            float acc[17];
#pragma unroll
            for (int q = 0; q < 17; ++q) acc[q] = 0.f;
            const float* wp = p.w_ada + ((size_t)l * 1024 + k0) * NMODC + j0 + lane;
#pragma unroll 4
            for (int kk = 0; kk < 128; ++kk) {
                const float wv = wp[(size_t)kk * NMODC];
#pragma unroll
                for (int q = 0; q < 17; ++q) acc[q] += sS[q * 1024 + k0 + kk] * wv;
            }
#pragma unroll
            for (int q = 0; q < 17; ++q) sR[(wave * 17 + q) * 64 + lane] = acc[q];
            __syncthreads();
            float* MOD = (float*)(ws + WS_MOD);
            for (int o = tid; o < 17 * 64; o += 512) {
                const int q = o >> 6, ln = o & 63; float s = p.b_ada[l * NMODC + j0 + ln];
#pragma unroll
                for (int w = 0; w < 8; ++w) s += sR[(w * 17 + q) * 64 + ln];
                MOD[(size_t)(l * 17 + q) * NMODC + j0 + ln] = s;
            }
            __syncthreads();
            continue;
        }
        r -= N_MODS;
        if (mods_loaded) { __syncthreads(); mods_loaded = false; }
        if (r < N_TR) {
            const int l = r / N_TR_L; int q = r % N_TR_L;
            if (q < 2 * 1408) { const int f = q / 1408; q %= 1408; const int rt = q / 16, kt = q % 16; const int R0 = rt * 64, tile = R0 >> 8, w = R0 & 255, bj = w >> 7, cc = w & 127;
                const float* src = (bj ? p.w3 : p.w1) + (size_t)(l * 2 + f) * 1024 * FF;
                transpose_tile(lds, src, FF, 128 * tile + cc, kt * 64, (bf16_t*)(ws + WS_W13) + (size_t)(l * 2 + f) * 5632 * 1024, 1024, R0); continue; }
            q -= 2 * 1408;
            if (q < 2 * 704) { const int f = q / 704; q %= 704; const int rt = q / 44, kt = q % 44;
                transpose_tile(lds, p.w2 + (size_t)(l * 2 + f) * FF * 1024, 1024, rt * 64, kt * 64, (bf16_t*)(ws + WS_W2T) + (size_t)(l * 2 + f) * 1024 * FF, FF, rt * 64); continue; }
            q -= 2 * 704;
            if (q < 448) { const int rt = q / 16, kt = q % 16; const int R0 = rt * 64; const int col0 = R0 < 512 ? R0 : R0 + 256;
                transpose_tile(lds, p.w_in + (size_t)l * 1024 * 2048, 2048, col0, kt * 64, (bf16_t*)(ws + WS_WIN) + (size_t)l * 2304 * 1024, 1024, R0); continue; }
            q -= 448;
            { const int rt = q / 16, kt = q % 16;
                transpose_tile(lds, p.w_out + (size_t)l * 1024 * 1024, 1024, rt * 64, kt * 64, (bf16_t*)(ws + WS_WOUT) + (size_t)l * 1024 * 1024, 1024, rt * 64); continue; }
        }
        r -= N_TR;
        if (r < N_FOLD) {
            const int l = r >> 7, k0 = (r & 127) * 8;
            LAS float* sW = (LAS float*)lds;
            LAS float* sC = sW + 2048;
            for (int i = tid; i < 2048; i += 512) { const int kk = i >> 8, cc = i & 255; sW[i] = p.w_in[((size_t)l * 1024 + k0 + kk) * 2048 + 512 + cc]; }
            if (tid < 64) sC[tid] = cospif((float)tid * (1.0f / 32.0f));
            __syncthreads();
            const int g = tid >> 7, j = tid & 127, jj = j & 63, isS = j >> 6;
            float acc[8];
#pragma unroll
            for (int q = 0; q < 8; ++q) acc[q] = 0.f;
            for (int c = 0; c < 64; ++c) {
                const int mm = (c * jj) & 63; const float tv = sC[isS ? ((mm - 16) & 63) : mm];
#pragma unroll
                for (int q = 0; q < 8; ++q) acc[q] += sW[q * 256 + g * 64 + c] * tv;
            }
            u32x4 o; o.x = pk2(acc[0] * 0.125f, acc[1] * 0.125f); o.y = pk2(acc[2] * 0.125f, acc[3] * 0.125f); o.z = pk2(acc[4] * 0.125f, acc[5] * 0.125f); o.w = pk2(acc[6] * 0.125f, acc[7] * 0.125f);
            *(u32x4*)((bf16_t*)(ws + WS_WIN) + ((size_t)l * 2304 + 1792 + g * 128 + j) * 1024 + k0) = o;
            __syncthreads();
            continue;
        }
        r -= N_FOLD;
        if (r < N_DFT) {
            if (r < 2048) { const int np = r; const float sc = 0.022097086912079608f;
                float v[8];
#pragma unroll
                for (int e = 0; e < 8; ++e) { const int k = tid * 8 + e, kk = k & 2047, mm = (np * kk) & 2047; const float a = (float)mm * (1.0f / 1024.0f);
                    v[e] = (k < 2048 ? cospif(a) : -sinpif(a)) * sc; }
                u32x4 o; o.x = pk2(v[0], v[1]); o.y = pk2(v[2], v[3]); o.z = pk2(v[4], v[5]); o.w = pk2(v[6], v[7]);
                *(u32x4*)((bf16_t*)(ws + WS_DFT) + (size_t)np * 4096 + tid * 8) = o;
            } else if (tid < 64) { const int np = r - 2048; const float sc = 0.0625f;
                float v[8];
#pragma unroll
                for (int e = 0; e < 8; ++e) { const int k = tid * 8 + e, kk = k & 255, mm = (np * kk) & 255; const float a = (float)mm * (1.0f / 128.0f);
                    v[e] = (k < 256 ? cospif(a) : -sinpif(a)) * sc; }
                u32x4 o; o.x = pk2(v[0], v[1]); o.y = pk2(v[2], v[3]); o.z = pk2(v[4], v[5]); o.w = pk2(v[6], v[7]);
                *(u32x4*)((bf16_t*)(ws + WS_DFTC) + (size_t)np * 512 + tid * 8) = o;
            }
            continue;
        }
        r -= N_DFT;
        {
            float* tab = (float*)(ws + WS_ROPE);
            for (int e = tid; e < 1024; e += 512) { const int pos = e >> 4, i = e & 15;
                const float inv = fast_exp2(-(float)i * (13.287712379549449f / 16.0f));
                const float tt = (float)pos * inv * 0.3183098861837907f;
                tab[2 * e] = cospif(tt); tab[2 * e + 1] = sinpif(tt); }
        }
    }
}

struct EwArgs {
    const float* xin_lat; const float* xin_ctx; float* xout_lat; float* xout_ctx;
    const bf16_t* Y; const float* gpost; float fac; const float* gate;
    bf16_t* H; const float* gpre; const float* shift; const float* scale;
    int nrows;
};
__device__ __forceinline__ void ew_pass(const float* xin_lat, const float* xin_ctx, float* xout_lat, float* xout_ctx, const bf16_t* Yp, const float* gpost, float fac, const float* gate,
                                        bf16_t* Hp, const float* gpre, const float* shift, const float* scale, int nrows) {
    EwArgs a; a.xin_lat = xin_lat; a.xin_ctx = xin_ctx; a.xout_lat = xout_lat; a.xout_ctx = xout_ctx; a.Y = Yp; a.gpost = gpost; a.fac = fac; a.gate = gate; a.H = Hp; a.gpre = gpre; a.shift = shift; a.scale = scale; a.nrows = nrows;
    const int tid = otid(); const int wave = tid >> 6, lane = tid & 63;
    for (int t = obid() * 8 + wave; t < a.nrows; t += gridDim.x * 8) {
        const bool lat = t < TL; const int b = lat ? (t >> 11) : 16;
        const float* xr = lat ? a.xin_lat + (size_t)t * DM : a.xin_ctx + (size_t)(t - TL) * DM;
        f32x4 x[4];
#pragma unroll
        for (int j = 0; j < 4; ++j) x[j] = *(const f32x4*)(xr + 4 * lane + 256 * j);
        if (a.Y) {
            f32x4 y[4]; float ss = 0.f;
#pragma unroll
            for (int j = 0; j < 4; ++j) { const u32x2 w = *(const u32x2*)(a.Y + (size_t)t * DM + 4 * lane + 256 * j);
                y[j][0] = bflo(w.x); y[j][1] = bfhi(w.x); y[j][2] = bflo(w.y); y[j][3] = bfhi(w.y);
                ss += (y[j][0] * y[j][0] + y[j][1] * y[j][1]) + (y[j][2] * y[j][2] + y[j][3] * y[j][3]); }
            const float rstd = 1.0f / sqrtf(wave_sum(ss) * (1.0f / DM) + EPSV);
#pragma unroll
            for (int j = 0; j < 4; ++j) { const f32x4 gt = *(const f32x4*)(a.gate + (size_t)b * NMODC + 4 * lane + 256 * j); const f32x4 gp = *(const f32x4*)(a.gpost + 4 * lane + 256 * j);
                x[j] = x[j] + (gt * a.fac) * (y[j] * rstd * gp); }
        }
        float* xo = lat ? (a.xout_lat ? a.xout_lat + (size_t)t * DM : nullptr) : (a.xout_ctx ? a.xout_ctx + (size_t)(t - TL) * DM : nullptr);
        if (xo) {
#pragma unroll
            for (int j = 0; j < 4; ++j) *(f32x4*)(xo + 4 * lane + 256 * j) = x[j];
        }
        if (a.H) {
            float ss = 0.f;
#pragma unroll
            for (int j = 0; j < 4; ++j) ss += (x[j][0] * x[j][0] + x[j][1] * x[j][1]) + (x[j][2] * x[j][2] + x[j][3] * x[j][3]);
            const float rstd = 1.0f / sqrtf(wave_sum(ss) * (1.0f / DM) + EPSV);
#pragma unroll
            for (int j = 0; j < 4; ++j) { const int cidx = 4 * lane + 256 * j;
                const f32x4 g = *(const f32x4*)(a.gpre + cidx), sh = *(const f32x4*)(a.shift + (size_t)b * NMODC + cidx), sc = *(const f32x4*)(a.scale + (size_t)b * NMODC + cidx);
                const f32x4 h = (x[j] * rstd * g) * (sc + 1.0f) + sh;
                u32x2 w; w.x = pk2(h[0], h[1]); w.y = pk2(h[2], h[3]);
                *(u32x2*)(a.H + (size_t)t * DM + cidx) = w; }
        }
    }
}

__device__ __forceinline__ void conv_item(CParams& p, LAS unsigned char* lds, int l, int s, int tb) {
    const int tid = otid(), wave = tid >> 6, lane = tid & 63;
    const bf16_t* PROJ = (const bf16_t*)(p.ws + WS_PROJ); bf16_t* YCAT = (bf16_t*)(p.ws + WS_YCAT);
    LAS float* sA = (LAS float*)lds;
    LAS float* sY = sA + 62 * 256;
    const int tokbase = s < 16 ? s * 2048 : TL + (s - 16) * 256, len = s < 16 ? 2048 : 256, t0 = tb * 32;
    for (int u = tid; u < 62 * 32; u += 512) {
        const int rr = u >> 5, c8 = (u & 31) * 8, tt = t0 - 15 + rr;
        float v[8];
        if (tt >= 0 && tt < len) {
            const bf16_t* rp = PROJ + (size_t)(tokbase + tt) * NP + c8;
            const u32x4 ua = *(const u32x4*)rp, ug = *(const u32x4*)(rp + 256);
            v[0] = bflo(ua.x) * sigmoid_f(bflo(ug.x)); v[1] = bfhi(ua.x) * sigmoid_f(bfhi(ug.x));
            v[2] = bflo(ua.y) * sigmoid_f(bflo(ug.y)); v[3] = bfhi(ua.y) * sigmoid_f(bfhi(ug.y));
            v[4] = bflo(ua.z) * sigmoid_f(bflo(ug.z)); v[5] = bfhi(ua.z) * sigmoid_f(bfhi(ug.z));
            v[6] = bflo(ua.w) * sigmoid_f(bflo(ug.w)); v[7] = bfhi(ua.w) * sigmoid_f(bfhi(ug.w));
        } else {
#pragma unroll
            for (int e = 0; e < 8; ++e) v[e] = 0.f;
        }
        *(LAS f32x4*)(sA + rr * 256 + c8) = (f32x4){v[0], v[1], v[2], v[3]};
        *(LAS f32x4*)(sA + rr * 256 + c8 + 4) = (f32x4){v[4], v[5], v[6], v[7]};
    }
    __syncthreads();
    {
        const int ch = tid & 255, half = tid >> 8;
        float w[31];
#pragma unroll
        for (int j = 0; j < 31; ++j) w[j] = p.conv_w[((size_t)l * 31 + j) * 256 + ch];
        const float bias = p.conv_b[l * 256 + ch];
#pragma unroll 4
        for (int tl = 0; tl < 16; ++tl) {
            const int tok = half * 16 + tl; float acc = bias;
#pragma unroll
            for (int j = 0; j < 31; ++j) acc += sA[(tok + j) * 256 + ch] * w[j];
            sY[tok * 256 + ch] = acc;
        }
    }
    __syncthreads();
    {
        const f32x4 lg = *(const f32x4*)(p.ln_g + l * 256 + 4 * lane), lb = *(const f32x4*)(p.ln_b + l * 256 + 4 * lane);
#pragma unroll
        for (int q = 0; q < 4; ++q) {
            const int tok = wave * 4 + q;
            const f32x4 v = *(const LAS f32x4*)(sY + tok * 256 + 4 * lane);
            const float mean = wave_sum((v[0] + v[1]) + (v[2] + v[3])) * (1.0f / 256.0f);
            const f32x4 d = v - mean;
            const float var = wave_sum((d[0] * d[0] + d[1] * d[1]) + (d[2] * d[2] + d[3] * d[3])) * (1.0f / 256.0f);
            const float rstd = 1.0f / sqrtf(var + EPSV);
            const f32x4 yn = d * rstd * lg + lb;
            u32x2 o; o.x = pk2(silu_f(yn[0]), silu_f(yn[1])); o.y = pk2(silu_f(yn[2]), silu_f(yn[3]));
            *(u32x2*)(YCAT + (size_t)(tokbase + t0 + tok) * DM + 4 * lane) = o;
        }
    }
    __syncthreads();
}

struct AttnItem {
    int mode;
    int qtok0;
    int qcol0, qcol1, ocol0, ocol1;
    int kcol0, kcol1, vcol0, vcol1; int nslots;
    int nloc, loctok0;
    int ctxtok0;
    int r, rs;
    int q0, kp0;
    int has_sink; float sink0, sink1;
    int h0;
};
constexpr int KROW = 72;
constexpr int VROW = 68;
constexpr int K_BYTES = 64 * KROW * 2, V_BYTES = 64 * VROW * 2;

__device__ __forceinline__ void attn_item(CParams& p, LAS unsigned char* lds, int l, const AttnItem& it) {
    const int tid = otid(), wave = tid >> 6, lane = tid & 63, g = wave >> 2, wq = wave & 3, fr = lane & 15, fq = lane >> 4;
    const bf16_t* PROJ = (const bf16_t*)(p.ws + WS_PROJ); bf16_t* YCAT = (bf16_t*)(p.ws + WS_YCAT);
    LAS unsigned char* sK = lds;
    LAS unsigned char* sV = lds + 2 * K_BYTES;
    LAS float* sB = (LAS float*)(lds + 2 * K_BYTES + 2 * V_BYTES);
    const int slot = it.nslots == 2 ? g : 0;
    if (it.mode == 0) { for (int i = tid; i < 2 * 465; i += 512) sB[i] = p.nat_bias[(size_t)(l * 4 + it.h0) * 465 + i]; }
    bf16x8 qf[2];
    { const bf16_t* qp = PROJ + (size_t)(it.qtok0 + wq * 16 + fr) * NP + (g ? it.qcol1 : it.qcol0) + 8 * fq;
      qf[0] = *(const bf16x8*)qp; qf[1] = *(const bf16x8*)(qp + 32); }
    float mrun = -3.0e38f, lsum = 0.f;
    f32x4 o[4];
#pragma unroll
    for (int db = 0; db < 4; ++db) o[db] = (f32x4){0.f, 0.f, 0.f, 0.f};
    const int nchunks = 4 + it.nloc;
    const int srow = tid >> 3, sseg = tid & 7;
    u32x4 kreg[2], vreg[2];
    auto chunk_tok = [&](int c) { return c < 4 ? it.ctxtok0 + 64 * c : it.loctok0 + 64 * (c - 4); };
    auto gload = [&](int c) {
        const bf16_t* rp = PROJ + (size_t)(chunk_tok(c) + srow) * NP + 8 * sseg;
#pragma unroll
        for (int s = 0; s < 2; ++s) if (s < it.nslots) { kreg[s] = *(const u32x4*)(rp + (s ? it.kcol1 : it.kcol0)); vreg[s] = *(const u32x4*)(rp + (s ? it.vcol1 : it.vcol0)); }
    };
    gload(0);
    for (int c = 0; c < nchunks; ++c) {
        __syncthreads();
#pragma unroll
        for (int s = 0; s < 2; ++s) if (s < it.nslots) {
            *(LAS u32x4*)(sK + s * K_BYTES + (srow * KROW + 8 * sseg) * 2) = kreg[s];
            LAS bf16_t* vt = (LAS bf16_t*)(sV + s * V_BYTES) + (8 * sseg) * VROW + srow;
            vt[0 * VROW] = (bf16_t)(vreg[s].x & 0xffffu); vt[1 * VROW] = (bf16_t)(vreg[s].x >> 16);
            vt[2 * VROW] = (bf16_t)(vreg[s].y & 0xffffu); vt[3 * VROW] = (bf16_t)(vreg[s].y >> 16);
            vt[4 * VROW] = (bf16_t)(vreg[s].z & 0xffffu); vt[5 * VROW] = (bf16_t)(vreg[s].z >> 16);
            vt[6 * VROW] = (bf16_t)(vreg[s].w & 0xffffu); vt[7 * VROW] = (bf16_t)(vreg[s].w >> 16);
        }
        __syncthreads();
        if (c + 1 < nchunks) gload(c + 1);
        f32x4 sacc[4];
        const LAS unsigned char* kb_base = sK + slot * K_BYTES + (fr * KROW + 8 * fq) * 2;
#pragma unroll
        for (int kb = 0; kb < 4; ++kb) {
            sacc[kb] = (f32x4){0.f, 0.f, 0.f, 0.f};
#pragma unroll
            for (int kk = 0; kk < 2; ++kk) {
                const bf16x8 a = *(const LAS bf16x8*)(kb_base + (16 * kb * KROW + 32 * kk) * 2);
                sacc[kb] = __builtin_amdgcn_mfma_f32_16x16x32_bf16(a, qf[kk], sacc[kb], 0, 0, 0);
            }
        }
        const int qi = wq * 16 + fr;
        if (c >= 4 && it.mode == 0) {
            const int wsx = min(max(qi - 8, 0), 48);
            const int dr = (it.rs + (c - 4)) - it.r + 7;
            const LAS float* bt = sB + g * 465 + dr * 31;
#pragma unroll
            for (int kb = 0; kb < 4; ++kb)
#pragma unroll
                for (int j = 0; j < 4; ++j) { const int kc = 16 * kb + 4 * fq + j; const bool ok = (kc >= wsx) && (kc < wsx + 16);
                    const int dc = min(max(kc - qi + 15, 0), 30);
                    sacc[kb][j] = ok ? (sacc[kb][j] + bt[dc]) * LOG2E : -1.0e30f; }
        } else if (c >= 4 && it.mode == 1) {
            const int qpos = it.q0 + qi, kbase = it.kp0 + 64 * (c - 4);
#pragma unroll
            for (int kb = 0; kb < 4; ++kb)
#pragma unroll
                for (int j = 0; j < 4; ++j) { const int kpos = kbase + 16 * kb + 4 * fq + j; const int d = kpos - qpos; const bool ok = (d <= 128) && (d >= -128);
                    sacc[kb][j] = ok ? sacc[kb][j] * LOG2E : -1.0e30f; }
        } else {
#pragma unroll
            for (int kb = 0; kb < 4; ++kb) sacc[kb] = sacc[kb] * LOG2E;
        }
        float cm = sacc[0][0];
#pragma unroll
        for (int kb = 0; kb < 4; ++kb)
#pragma unroll
            for (int j = 0; j < 4; ++j) cm = fmaxf(cm, sacc[kb][j]);
        cm = fmaxf(cm, __shfl_xor(cm, 16)); cm = fmaxf(cm, __shfl_xor(cm, 32));
        const float mnew = fmaxf(mrun, cm), alpha = fast_exp2(mrun - mnew);
        mrun = mnew;
        float ps = 0.f;
#pragma unroll
        for (int kb = 0; kb < 4; ++kb)
#pragma unroll
            for (int j = 0; j < 4; ++j) { sacc[kb][j] = fast_exp2(sacc[kb][j] - mnew); ps += sacc[kb][j]; }
        lsum = lsum * alpha + ps;
#pragma unroll
        for (int db = 0; db < 4; ++db) o[db] = o[db] * alpha;
        const LAS unsigned char* vb_base = sV + slot * V_BYTES + (fr * VROW + 4 * fq) * 2;
#pragma unroll
        for (int grp = 0; grp < 2; ++grp) {
            union { bf16x8 v; unsigned u[4]; } pb;
            pb.u[0] = pk2(sacc[2 * grp][0], sacc[2 * grp][1]); pb.u[1] = pk2(sacc[2 * grp][2], sacc[2 * grp][3]);
            pb.u[2] = pk2(sacc[2 * grp + 1][0], sacc[2 * grp + 1][1]); pb.u[3] = pk2(sacc[2 * grp + 1][2], sacc[2 * grp + 1][3]);
#pragma unroll
            for (int db = 0; db < 4; ++db) {
                union { bf16x8 v; u32x2 h[2]; } av;
                av.h[0] = *(const LAS u32x2*)(vb_base + (16 * db * VROW + 32 * grp) * 2);
                av.h[1] = *(const LAS u32x2*)(vb_base + (16 * db * VROW + 32 * grp + 16) * 2);
                o[db] = __builtin_amdgcn_mfma_f32_16x16x32_bf16(av.v, pb.v, o[db], 0, 0, 0);
            }
        }
    }
    lsum += __shfl_xor(lsum, 16); lsum += __shfl_xor(lsum, 32);
    if (it.has_sink) lsum += fast_exp2((g ? it.sink1 : it.sink0) * LOG2E - mrun);
    const float inv = 1.0f / lsum;
    bf16_t* op = YCAT + (size_t)(it.qtok0 + wq * 16 + fr) * DM + (g ? it.ocol1 : it.ocol0) + 4 * fq;
#pragma unroll
    for (int db = 0; db < 4; ++db) { u32x2 w; w.x = pk2(o[db][0] * inv, o[db][1] * inv); w.y = pk2(o[db][2] * inv, o[db][3] * inv); *(u32x2*)(op + 16 * db) = w; }
    __syncthreads();
}

constexpr int C_UA = 0, C_QN = 512, C_KN = 768, C_VN = 1024, C_QS = 1280, C_KS = 1536, C_VS = 1664;

__device__ __forceinline__ void mix_items(CParams& p, LAS unsigned char* lds, int l) {
    const int n_attn = (l == 0) ? 2304 : 2048;
    const int n_conv = (l == 0) ? 1024 + 128 : 1024;
    const int start = (obid() + 128) % gridDim.x;
    for (int i = start; i < n_attn + n_conv; i += gridDim.x) {
        if (i >= n_attn) {
            if constexpr ((MIXMASK & 4) == 0) continue;
            const int ci = i - n_attn;
            if (ci < 1024) conv_item(p, lds, l, ci >> 6, ci & 63);
            else { const int cj = ci - 1024; conv_item(p, lds, l, 16 + (cj >> 3), cj & 7); }
            continue;
        }
        AttnItem it{};
        if (i < 1024) {
            const int b = i >> 6, r = (i >> 1) & 31, hp = i & 1;
            it.mode = 0; it.qtok0 = b * 2048 + r * 64; it.nslots = 2; it.h0 = 2 * hp;
            { const int h = 2 * hp; it.qcol0 = C_QN + 64 * h; it.kcol0 = C_KN + 64 * h; it.vcol0 = C_VN + 64 * h; it.ocol0 = 512 + 64 * h;
              it.qcol1 = it.qcol0 + 64; it.kcol1 = it.kcol0 + 64; it.vcol1 = it.vcol0 + 64; it.ocol1 = it.ocol0 + 64; }
            it.r = r; it.rs = min(max(r - 4, 0), 24); it.nloc = 8; it.loctok0 = b * 2048 + it.rs * 64; it.ctxtok0 = TL + b * 256;
        } else if (i < 2048) {
            const int k = i - 1024, b = k >> 6, qb = (k >> 1) & 31, kvh = k & 1;
            it.mode = 1; it.qtok0 = b * 2048 + qb * 64; it.nslots = 1;
            { const int h = 2 * kvh; it.qcol0 = C_QS + 64 * h; it.ocol0 = 768 + 64 * h; it.sink0 = p.sink[l * 4 + h]; it.sink1 = p.sink[l * 4 + h + 1];
              it.qcol1 = it.qcol0 + 64; it.ocol1 = it.ocol0 + 64; it.kcol0 = it.kcol1 = C_KS + 64 * kvh; it.vcol0 = it.vcol1 = C_VS + 64 * kvh; }
            it.has_sink = 1; it.q0 = qb * 64;
            const int ks = max(qb * 64 - 128, 0), ke = min(qb * 64 + 192, 2048);
            it.kp0 = ks; it.nloc = (ke - ks) >> 6; it.loctok0 = b * 2048 + ks; it.ctxtok0 = TL + b * 256;
        } else if (i < 2176) {
            const int k = i - 2048, b = k >> 3, qb = (k >> 1) & 3, hp = k & 1;
            it.mode = 2; it.qtok0 = TL + b * 256 + qb * 64; it.nslots = 2;
            { const int h = 2 * hp; it.qcol0 = C_QN + 64 * h; it.kcol0 = C_KN + 64 * h; it.vcol0 = C_VN + 64 * h; it.ocol0 = 512 + 64 * h;
              it.qcol1 = it.qcol0 + 64; it.kcol1 = it.kcol0 + 64; it.vcol1 = it.vcol0 + 64; it.ocol1 = it.ocol0 + 64; }
            it.nloc = 0; it.ctxtok0 = TL + b * 256;
        } else {
            const int k = i - 2176, b = k >> 3, qb = (k >> 1) & 3, kvh = k & 1;
            it.mode = 2; it.qtok0 = TL + b * 256 + qb * 64; it.nslots = 1;
            { const int h = 2 * kvh; it.qcol0 = C_QS + 64 * h; it.ocol0 = 768 + 64 * h; it.sink0 = p.sink[l * 4 + h]; it.sink1 = p.sink[l * 4 + h + 1];
              it.qcol1 = it.qcol0 + 64; it.ocol1 = it.ocol0 + 64; it.kcol0 = it.kcol1 = C_KS + 64 * kvh; it.vcol0 = it.vcol1 = C_VS + 64 * kvh; }
            it.has_sink = 1; it.nloc = 0; it.ctxtok0 = TL + b * 256;
        }
        if constexpr ((MIXMASK & 2) != 0) attn_item(p, lds, l, it);
    }
}

constexpr int N_PHASES = 22;
#ifndef PHMASK
#define PHMASK 0xff
#endif

__device__ __forceinline__ void run_phase(CParams& p, LAS unsigned char* lds, int ph) {
    unsigned char* ws = p.ws;
    bf16_t* YH = (bf16_t*)(ws + WS_YH); bf16_t* U = (bf16_t*)(ws + WS_R1); bf16_t* PROJ = (bf16_t*)(ws + WS_PROJ); bf16_t* YCAT = (bf16_t*)(ws + WS_YCAT);
    float* XC = (float*)(ws + WS_XC); const float* MOD = (const float*)(ws + WS_MOD);
    const int G = gridDim.x, c = obid();
    if (ph == 0) { if constexpr ((PHMASK & 1) != 0) phase0(p, lds); return; }
    if (ph == 1) {
        if constexpr ((PHMASK & 2) == 0) return;
        ew_pass(p.x, p.ctx, p.out, XC, nullptr, nullptr, 0.f, nullptr, YH, p.norm_g, MOD, MOD + 1024, TA); return;
    }
    const int l = (ph - 2) / 10, k = (ph - 2) % 10;
    const float* MODL = MOD + (size_t)l * 17 * NMODC; const float* NG = p.norm_g + (size_t)l * 6 * DM;
    const int rows_late = (l == 0) ? TA : TL;
    switch (k) {
    case 0: case 7: {
        if constexpr ((PHMASK & 4) == 0) break;
        const int f = (k == 7), M = f ? rows_late : TA;
        pg8::Gemm g{YH, (const bf16_t*)(ws + WS_W13) + (size_t)(l * 2 + f) * 5632 * 1024, M, 5632, 1024};
        pg8::StaticOrder S; S.init(M, 5632, G, c); EpiSwiGLU E{U};
        pg8::gemm_phase<EpiSwiGLU, pg8::StaticOrder, true, true>(lds, g, S, E);
    } break;
    case 1: case 8: case 5: {
        if constexpr ((PHMASK & 8) == 0) break;
        const bool isout = (k == 5); const int f = (k == 8), M = (k == 1) ? TA : rows_late;
        pg8::Gemm g{isout ? YCAT : U, isout ? (const bf16_t*)(ws + WS_WOUT) + (size_t)l * 1024 * 1024 : (const bf16_t*)(ws + WS_W2T) + (size_t)(l * 2 + f) * 1024 * FF, M, 1024, isout ? 1024 : FF};
        pg8::StaticOrder S; S.init(M, 1024, G, c); EpiBf16Tile E{YH, 1024, 0, 256};
        pg8::gemm_phase<EpiBf16Tile, pg8::StaticOrder, true, true>(lds, g, S, E);
    } break;
    case 2: case 6: case 9: {
        if constexpr ((PHMASK & 2) == 0) break;
        const int gi = (k == 2) ? 2 : (k == 6 ? 5 : 8), ni = (k == 2) ? 1 : (k == 6 ? 3 : 5);
        const int nrows = (k == 2) ? TA : rows_late;
        const bool lastl = (k == 9 && l == 1);
        const float* gpre = (k == 2) ? NG + 2 * DM : (k == 6 ? NG + 4 * DM : p.norm_g + 6 * DM);
        const float* shift = (k == 2) ? MODL + 3 * 1024 : (k == 6 ? MODL + 6 * 1024 : MOD + 17 * NMODC);
        const float* scale = (k == 2) ? MODL + 4 * 1024 : (k == 6 ? MODL + 7 * 1024 : MOD + 17 * NMODC + 1024);
        float* outp = p.out;
        ew_pass(outp, XC, outp, XC, YH, NG + ni * DM, (k == 6) ? 1.0f : 0.5f, MODL + gi * 1024, lastl ? nullptr : YH, gpre, shift, scale, nrows);
    } break;
    case 3: {
        if constexpr ((PHMASK & 16) == 0) break;
        const bf16_t* W = (const bf16_t*)(ws + WS_WIN) + (size_t)l * 2304 * 1024;
        { pg8::Gemm g{YH, W, TA, NP, 1024}; pg8::StaticOrder S; S.init(TA, NP, G, c); EpiWin E{PROJ, (const float*)(ws + WS_ROPE)};
          pg8::gemm_phase<EpiWin, pg8::StaticOrder, true, true>(lds, g, S, E); }
        { const int N = (l == 0) ? TA : TL; pg8::Gemm g{W + (size_t)1792 * 1024, YH, 512, N, 1024}; pg8::StaticOrder S; S.init(512, N, G, (c + 16) % G);
          EpiPQ E{(bf16_t*)(ws + WS_PQT), (bf16_t*)(ws + WS_PQTC)};
          pg8::gemm_phase<EpiPQ, pg8::StaticOrder, true, true>(lds, g, S, E); }
    } break;
    case 4: {
        if constexpr ((PHMASK & 32) == 0) break;
        if constexpr ((MIXMASK & 1) != 0)
        for (int v = 0; v < ((l == 0) ? 2 : 1); ++v) {
            pg8::Gemm g = v == 0 ? pg8::Gemm{(const bf16_t*)(ws + WS_DFT), (const bf16_t*)(ws + WS_PQT), 2048, 4096, 4096}
                                 : pg8::Gemm{(const bf16_t*)(ws + WS_DFTC), (const bf16_t*)(ws + WS_PQTC), 256, 4096, 512};
            pg8::StaticOrder S; S.init(g.M, g.N, G, v == 0 ? c : (c + G - 128) % G);
            EpiBf16Tile E = v == 0 ? EpiBf16Tile{YCAT + 256, 1024, 2048, 0} : EpiBf16Tile{YCAT + (size_t)TL * DM + 256, 1024, 256, 0};
            pg8::gemm_phase<EpiBf16Tile, pg8::StaticOrder, true, true>(lds, g, S, E);
        }
        if constexpr ((MIXMASK & 6) != 0) mix_items(p, lds, l);
    } break;
    }
}

__global__ void __launch_bounds__(512, 2) mega(Params p, int ph0, int ph1) {
    extern __shared__ __attribute__((aligned(16))) unsigned char lds_raw[];
    LAS unsigned char* lds = (LAS unsigned char*)lds_raw;
    cg::grid_group grid = cg::this_grid();
    for (int ph = ph0; ph < ph1; ++ph) {
        CParams* q = (CParams*)__builtin_amdgcn_kernarg_segment_ptr(); asm volatile("" : "+s"(q));
        run_phase(*q, lds, ph);
        if (ph + 1 < ph1) grid.sync();
    }
}

#ifndef ONE_LAUNCH
#define ONE_LAUNCH 1
#endif

extern "C" void kernel_launch(void* const* d_in, const int* in_sizes, int n_in, void* d_out, int out_size, void* d_ws, size_t ws_size, hipStream_t stream) {
    static int grid = 0;
    if (grid == 0) {
        if (ws_size < WS_END) { fprintf(stderr, "kernel_launch: workspace too small: %zu < %zu\n", ws_size, (size_t)WS_END); grid = -1; return; }
        int dev = 0, cus = 0, per_cu = 0;
        hipGetDevice(&dev); hipDeviceGetAttribute(&cus, hipDeviceAttributeMultiprocessorCount, dev);
        hipFuncSetAttribute((const void*)mega, hipFuncAttributeMaxDynamicSharedMemorySize, LDS_BYTES);
        hipOccupancyMaxActiveBlocksPerMultiprocessor(&per_cu, (const void*)mega, 512, LDS_BYTES);
        if (per_cu < 1) { fprintf(stderr, "kernel_launch: occupancy query says %d blocks per CU\n", per_cu); per_cu = 1; }
        (void)hipGetLastError();
        grid = cus;
    }
    if (grid < 0) return;
    Params p{};
    p.x = (const float*)d_in[0]; p.c = (const float*)d_in[1]; p.ctx = (const float*)d_in[2]; p.c_ctx = (const float*)d_in[3];
    p.w_ada = (const float*)d_in[4]; p.b_ada = (const float*)d_in[5]; p.norm_g = (const float*)d_in[6];
    p.w1 = (const float*)d_in[7]; p.w3 = (const float*)d_in[8]; p.w2 = (const float*)d_in[9]; p.w_in = (const float*)d_in[10];
    p.conv_w = (const float*)d_in[11]; p.conv_b = (const float*)d_in[12]; p.ln_g = (const float*)d_in[13]; p.ln_b = (const float*)d_in[14];
    p.nat_bias = (const float*)d_in[15]; p.sink = (const float*)d_in[16]; p.w_out = (const float*)d_in[17];
    p.out = (float*)d_out; p.ws = (unsigned char*)d_ws;
#if ONE_LAUNCH
    int ph0 = 0, ph1 = N_PHASES;
    void* args[] = {&p, &ph0, &ph1};
    hipError_t e = hipLaunchCooperativeKernel((const void*)mega, dim3(grid), dim3(512), args, LDS_BYTES, stream);
    if (e != hipSuccess) fprintf(stderr, "cooperative launch failed: %s (grid %d)\n", hipGetErrorString(e), grid);
#else
    for (int ph = 0; ph < N_PHASES; ++ph) {
        int ph0 = ph, ph1 = ph + 1;
        void* args[] = {&p, &ph0, &ph1};
        hipError_t e = hipLaunchCooperativeKernel((const void*)mega, dim3(grid), dim3(512), args, LDS_BYTES, stream);
        if (e != hipSuccess) { fprintf(stderr, "launch %d failed: %s (grid %d)\n", ph, hipGetErrorString(e), grid); break; }
    }
#endif
}
```

```cpp
#include <hip/hip_runtime.h>
#include <hip/hip_cooperative_groups.h>
#include <cstdio>
#include <cstdint>
namespace cg = cooperative_groups;
namespace pg8 {
#define PG8_LAS __attribute__((address_space(3)))
typedef unsigned short bf16_t;
typedef short bf16x8 __attribute__((ext_vector_type(8)));
typedef float f32x4 __attribute__((ext_vector_type(4)));
typedef unsigned u32x4 __attribute__((ext_vector_type(4)));
constexpr int BM = 256, BK = 64, HALF = 128, HTB = HALF * BK * 2  , STAGE_BYTES = 8 * HTB, NXCD = 8, WGM = 8;

__host__ __device__ __forceinline__ int lds_byte(int r, int c) { const int st = (r >> 4) * 2 + (c >> 5), rr = r & 15, cc = c & 31, ob = rr * 64 + cc * 2; return st * 1024 + (ob ^ (((ob >> 9) & 1) << 5)); }
__host__ __device__ __forceinline__ void stage_rc(int b, int& R, int& C) { const int st = b / 1024, sb = b % 1024, swz = sb ^ (((sb >> 9) & 1) << 5); R = (st >> 1) * 16 + swz / 64; C = (st & 1) * 32 + (swz % 64) / 2; }
__host__ __device__ __forceinline__ int perm32(int rho) { const int n = rho >> 4, i = rho & 15; return 8 * (i >> 2) + 4 * n + (i & 3); }

struct Unit { int pm, pn; };
struct Gemm { const bf16_t* A; const bf16_t* Bt; int M, N, K, lda, ldb; };

struct StaticOrder {
    int nM, nN, nwg, G, c;
    __host__ __device__ void init(int M, int N, int G_, int c_) { nM = M / BM; nN = N / BM; nwg = nM * nN; G = G_; c = c_; }
    __host__ __device__ bool next(int i, Unit& u) const {
        const long L = (long)i * G + c; if (L >= nwg) return false;
        int wgid = (int)L; { const int q = nwg / NXCD, r = nwg % NXCD, xcd = wgid % NXCD, off = wgid / NXCD; wgid = (xcd < r ? xcd * (q + 1) : r * (q + 1) + (xcd - r) * q) + off; }
        const int nig = WGM * nN, gid = wgid / nig, fm = gid * WGM, gsz = (nM - fm) < WGM ? (nM - fm) : WGM;
        u.pm = fm + ((wgid % nig) % gsz); u.pn = (wgid % nig) / gsz; return true;
    }
    __device__ __forceinline__ void a_ready(const Unit&) const {}
    __device__ __forceinline__ void done(const Unit&) const {}
};
__device__ __forceinline__ unsigned cvt_pk_bf16(float lo, float hi) { unsigned r; asm volatile("v_cvt_pk_bf16_f32 %0, %1, %2" : "=v"(r) : "v"(lo), "v"(hi)); return r; }
typedef float f32x2 __attribute__((ext_vector_type(2)));
template <class Epi, class Sched, bool ALIGN_EPI = false, bool SP2 = false>
__device__ __forceinline__ void gemm_phase(PG8_LAS unsigned char* lds, const Gemm g, const Sched& S, const Epi& E) {
    int tid_ = threadIdx.x; asm volatile("" : "+v"(tid_));
    const int tid = tid_, wid = __builtin_amdgcn_readfirstlane(tid >> 6), lane = tid & 63, wr = wid >> 2, wc = wid & 3, fr = lane & 15, fq = lane >> 4;
    const int K = g.K, nt = K / BK;
    unsigned voffA[2], voffB[2];
#pragma unroll
    for (int i = 0; i < 2; ++i) { int R, C; stage_rc(tid * 16 + i * 8192, R, C); const int Rb = Epi::PERM ? ((R & ~31) + perm32(R & 31)) : R;
        voffA[i] = (unsigned)(R * g.lda + C) * 2u; voffB[i] = (unsigned)(Rb * g.ldb + C) * 2u; }
    const size_t kstep = (size_t)(BK * 2);
    const size_t hstepA = (size_t)HALF * g.lda * 2, hstepB = (size_t)HALF * g.ldb * 2;
    const size_t tstepA = 2 * hstepA, tstepB = 2 * hstepB;
    const unsigned ldsw = (unsigned)wid * 1024u;
    const int aoff = lds_byte(wr * 64 + fr, fq * 8), boff = lds_byte(wc * 32 + fr, fq * 8);
#define PG8_SA(b, h) (((b) * 2 + (h)) * HTB)
#define PG8_SB(b, h) ((4 + (b) * 2 + (h)) * HTB)
#define PG8_STAGE(bufoff, gbase, voff) do { _Pragma("unroll") for (int _i = 0; _i < 2; ++_i) \
        __builtin_amdgcn_global_load_lds((const unsigned*)((const char*)(gbase) + (voff)[_i]), (PG8_LAS unsigned*)(lds + (bufoff) + ldsw + _i * 8192), 16, 0, 0); } while (0)
#define PG8_LDA(dst, b, h) do { _Pragma("unroll") for (int m = 0; m < 4; ++m) _Pragma("unroll") for (int k = 0; k < 2; ++k) dst[m][k] = *(const PG8_LAS bf16x8*)(lds + PG8_SA(b, h) + aoff + m * 2048 + k * 1024); } while (0)
#define PG8_LDB(dst, b, h) do { _Pragma("unroll") for (int n = 0; n < 2; ++n) _Pragma("unroll") for (int k = 0; k < 2; ++k) dst[n][k] = *(const PG8_LAS bf16x8*)(lds + PG8_SB(b, h) + boff + n * 2048 + k * 1024); } while (0)
#define PG8_MMA(ai, bj, At, Bt) do { __builtin_amdgcn_s_setprio(1); _Pragma("unroll") for (int m = 0; m < 4; ++m) _Pragma("unroll") for (int n = 0; n < 2; ++n) _Pragma("unroll") for (int k = 0; k < 2; ++k) \
        acc[ai][bj][m][n] = __builtin_amdgcn_mfma_f32_16x16x32_bf16(Bt[n][k], At[m][k], acc[ai][bj][m][n], 0, 0, 0); __builtin_amdgcn_s_setprio(0); } while (0)
#define PG8_WAIT_V(n) asm volatile("s_waitcnt vmcnt(" #n ")" ::: "memory")
#define PG8_WAIT_L(n) asm volatile("s_waitcnt lgkmcnt(" #n ")" ::: "memory")
#define PG8_BAR __builtin_amdgcn_s_barrier()
#define PG8_SCHED __builtin_amdgcn_sched_barrier(0)
    Unit cur, nxt; int ui = 0;
    if (!S.next(0, cur)) return;
    f32x4 acc[2][2][4][2];
#pragma unroll
    for (int a = 0; a < 2; ++a)
#pragma unroll
        for (int b = 0; b < 2; ++b)
#pragma unroll
            for (int m = 0; m < 4; ++m)
#pragma unroll
                for (int n = 0; n < 2; ++n) acc[a][b][m][n] = (f32x4){0.f, 0.f, 0.f, 0.f};
    bf16x8 At[4][2], B0[2][2], B1[2][2];
    const char* cA = (const char*)g.A + (size_t)cur.pm * tstepA; const char* cB = (const char*)g.Bt + (size_t)cur.pn * tstepB;
    S.a_ready(cur);
    if constexpr (SP2) {
        PG8_STAGE(PG8_SB(0, 0), cB, voffB); PG8_STAGE(PG8_SB(0, 1), cB + hstepB, voffB); PG8_STAGE(PG8_SA(0, 0), cA, voffA); PG8_STAGE(PG8_SA(0, 1), cA + hstepA, voffA);
        if (wr == 1) PG8_BAR;
        PG8_WAIT_V(2); PG8_BAR;
        PG8_STAGE(PG8_SB(1, 0), cB + kstep, voffB); PG8_STAGE(PG8_SA(1, 0), cA + kstep, voffA); PG8_STAGE(PG8_SB(1, 1), cB + hstepB + kstep, voffB);
        PG8_WAIT_V(6); PG8_BAR;
    } else {
        PG8_STAGE(PG8_SB(0, 0), cB, voffB); PG8_STAGE(PG8_SA(0, 0), cA, voffA); PG8_STAGE(PG8_SB(0, 1), cB + hstepB, voffB); PG8_STAGE(PG8_SA(0, 1), cA + hstepA, voffA);
        if (wr == 1) PG8_BAR;
        PG8_WAIT_V(4); PG8_BAR;
        PG8_STAGE(PG8_SB(1, 0), cB + kstep, voffB); PG8_STAGE(PG8_SA(1, 0), cA + kstep, voffA); PG8_STAGE(PG8_SB(1, 1), cB + hstepB + kstep, voffB);
        PG8_WAIT_V(6); PG8_BAR;
    }
    for (;;) {
        const bool has_next = S.next(ui + 1, nxt);
        const char* nA = has_next ? (const char*)g.A + (size_t)nxt.pm * tstepA : cA; const char* nB = has_next ? (const char*)g.Bt + (size_t)nxt.pn * tstepB : cB;
        for (int t = 0; t < nt; t += 2) {
            const bool last = (t == nt - 2);
            const char* a1 = cA + (size_t)(t + 1) * kstep;
            const char* a2 = last ? nA : cA + (size_t)(t + 2) * kstep; const char* b2 = last ? nB : cB + (size_t)(t + 2) * kstep;
            const char* a3 = a2 + kstep; const char* b3 = b2 + kstep;
            if (last && has_next) S.a_ready(nxt);
            if constexpr (SP2) {
            PG8_LDB(B0, 0, 0); PG8_LDB(B1, 0, 1); PG8_SCHED; PG8_LDA(At, 0, 0); PG8_STAGE(PG8_SA(1, 1), a1 + hstepA, voffA);
            PG8_WAIT_V(8); PG8_WAIT_L(0); PG8_BAR; PG8_MMA(0, 0, At, B0); PG8_MMA(0, 1, At, B1); PG8_BAR; PG8_SCHED;
            PG8_LDA(At, 0, 1); PG8_STAGE(PG8_SB(0, 0), b2, voffB); PG8_STAGE(PG8_SB(0, 1), b2 + hstepB, voffB); PG8_STAGE(PG8_SA(0, 0), a2, voffA);
            PG8_WAIT_V(8); PG8_WAIT_L(0); PG8_BAR; PG8_MMA(1, 0, At, B0); PG8_MMA(1, 1, At, B1); PG8_BAR; PG8_SCHED;
            PG8_LDB(B0, 1, 0); PG8_LDB(B1, 1, 1); PG8_SCHED; PG8_LDA(At, 1, 0); PG8_STAGE(PG8_SA(0, 1), a2 + hstepA, voffA);
            PG8_WAIT_V(8); PG8_WAIT_L(0); PG8_BAR; PG8_MMA(0, 0, At, B0); PG8_MMA(0, 1, At, B1); PG8_BAR; PG8_SCHED;
            PG8_LDA(At, 1, 1); PG8_STAGE(PG8_SB(1, 0), b3, voffB); PG8_STAGE(PG8_SB(1, 1), b3 + hstepB, voffB); PG8_STAGE(PG8_SA(1, 0), a3, voffA);
            PG8_WAIT_V(8); PG8_WAIT_L(0); PG8_BAR; PG8_MMA(1, 0, At, B0); PG8_MMA(1, 1, At, B1); PG8_BAR; PG8_SCHED;
            } else {
            PG8_LDB(B0, 0, 0); PG8_SCHED; PG8_LDA(At, 0, 0); PG8_STAGE(PG8_SA(1, 1), a1 + hstepA, voffA);
            PG8_WAIT_L(8); PG8_BAR; PG8_WAIT_L(0); PG8_MMA(0, 0, At, B0); PG8_BAR; PG8_SCHED;
            PG8_LDB(B1, 0, 1); PG8_STAGE(PG8_SB(0, 0), b2, voffB);
            PG8_BAR; PG8_WAIT_L(0); PG8_MMA(0, 1, At, B1); PG8_BAR;
            PG8_LDA(At, 0, 1); PG8_STAGE(PG8_SA(0, 0), a2, voffA);
            PG8_BAR; PG8_WAIT_L(0); PG8_MMA(1, 0, At, B0); PG8_BAR; PG8_SCHED;
            PG8_STAGE(PG8_SB(0, 1), b2 + hstepB, voffB);
            PG8_WAIT_V(6); PG8_BAR; PG8_MMA(1, 1, At, B1); PG8_BAR;
            PG8_LDB(B0, 1, 0); PG8_SCHED; PG8_LDA(At, 1, 0); PG8_STAGE(PG8_SA(0, 1), a2 + hstepA, voffA);
            PG8_WAIT_L(8); PG8_BAR; PG8_WAIT_L(0); PG8_MMA(0, 0, At, B0); PG8_BAR; PG8_SCHED;
            PG8_LDB(B1, 1, 1); PG8_STAGE(PG8_SB(1, 0), b3, voffB);
            PG8_BAR; PG8_WAIT_L(0); PG8_MMA(0, 1, At, B1); PG8_BAR;
            PG8_LDA(At, 1, 1); PG8_STAGE(PG8_SA(1, 0), a3, voffA);
            PG8_BAR; PG8_WAIT_L(0); PG8_MMA(1, 0, At, B0); PG8_BAR; PG8_SCHED;
            PG8_STAGE(PG8_SB(1, 1), b3 + hstepB, voffB);
            PG8_WAIT_V(6); PG8_BAR; PG8_MMA(1, 1, At, B1); PG8_BAR;
            }
        }
        if constexpr (ALIGN_EPI) { if (wr == 0) PG8_BAR; }
        if constexpr (!Epi::AFTER_DRAIN) { E(acc, cur, wr, wc, fr, fq); S.done(cur); }
        if (!has_next) break;
#pragma unroll
        for (int a = 0; a < 2; ++a)
#pragma unroll
            for (int b = 0; b < 2; ++b)
#pragma unroll
                for (int m = 0; m < 4; ++m)
#pragma unroll
                    for (int n = 0; n < 2; ++n) acc[a][b][m][n] = (f32x4){0.f, 0.f, 0.f, 0.f};
        cur = nxt; cA = nA; cB = nB; ++ui;
        if constexpr (ALIGN_EPI) { if (wr == 1) PG8_BAR; }
    }
    PG8_WAIT_V(0);
    if constexpr (!ALIGN_EPI) { if (wr == 0) PG8_BAR; }
    PG8_BAR;
    if constexpr (Epi::AFTER_DRAIN) { E.fused(acc, cur, wr, wc, fr, fq, lds, wid, lane); S.done(cur); }
#undef PG8_SA
#undef PG8_SB
#undef PG8_STAGE
#undef PG8_LDA
#undef PG8_LDB
#undef PG8_MMA
#undef PG8_WAIT_V
#undef PG8_WAIT_L
#undef PG8_BAR
#undef PG8_SCHED
}
}

#define LAS __attribute__((address_space(3)))
typedef unsigned short bf16_t;
typedef float f32x4 __attribute__((ext_vector_type(4)));
typedef float f32x2 __attribute__((ext_vector_type(2)));
typedef unsigned u32x4 __attribute__((ext_vector_type(4)));
typedef unsigned u32x2 __attribute__((ext_vector_type(2)));
typedef short bf16x8 __attribute__((ext_vector_type(8)));
typedef short bf16x4 __attribute__((ext_vector_type(4)));

constexpr int TL = 32768, TC = 4096, TA = 36864, DM = 1024, FF = 2816, NP = 1792, NMODC = 9216;
constexpr int YC_LD = 1280, DFT_LD = 4160, PQT_LD = 4160, DFTC_LD = 576, PQTC_LD = 576;
constexpr int LDS_BYTES = 131072 + 16;
#ifndef MIXMASK
#define MIXMASK 7
#endif
constexpr float EPSV = 1e-6f;
constexpr float LOG2E = 1.4426950408889634f;

constexpr size_t WS_XC   = 0;
constexpr size_t WS_YH   = WS_XC + (size_t)TC * DM * 4;
constexpr size_t WS_R1   = WS_YH + (size_t)TA * DM * 2;
constexpr size_t WS_PROJ = WS_R1;
constexpr size_t WS_PQT  = WS_PROJ + (size_t)TA * NP * 2;
constexpr size_t WS_PQTC = WS_PQT + (size_t)4096 * PQT_LD * 2;
constexpr size_t WS_YCAT = WS_PQTC + (size_t)4096 * PQTC_LD * 2;
constexpr size_t WS_R1END= WS_YCAT + (size_t)TA * YC_LD * 2;
constexpr size_t WS_W13  = WS_R1END;
constexpr size_t WS_W2T  = WS_W13 + (size_t)4 * 5632 * 1024 * 2;
constexpr size_t WS_WIN  = WS_W2T + (size_t)4 * 1024 * 2816 * 2;
constexpr size_t WS_WOUT = WS_WIN + (size_t)2 * 2304 * 1024 * 2;
constexpr size_t WS_DFT  = WS_WOUT + (size_t)2 * 1024 * YC_LD * 2;
constexpr size_t WS_DFTC = WS_DFT + (size_t)2048 * DFT_LD * 2;
constexpr size_t WS_MOD  = WS_DFTC + (size_t)256 * DFTC_LD * 2;
constexpr size_t WS_ROPE = WS_MOD + (size_t)2 * 17 * NMODC * 4;
constexpr size_t WS_BAR  = WS_ROPE + 64 * 16 * 2 * 4;
constexpr size_t WS_END  = WS_BAR + 3456 * 4;
static_assert((size_t)TA * FF * 2 <= WS_R1END - WS_R1, "U must fit in R1");

struct Params {
    const float *x, *c, *ctx, *c_ctx, *w_ada, *b_ada, *norm_g, *w1, *w3, *w2, *w_in, *conv_w, *conv_b, *ln_g, *ln_b, *nat_bias, *sink, *w_out;
    float* out; unsigned char* ws;
};
typedef const __attribute__((address_space(4))) Params CParams;

__device__ __forceinline__ unsigned pk2(float lo, float hi) { return pg8::cvt_pk_bf16(lo, hi); }
__device__ __forceinline__ float bflo(unsigned v) { return __uint_as_float(v << 16); }
__device__ __forceinline__ float bfhi(unsigned v) { return __uint_as_float(v & 0xffff0000u); }
__device__ __forceinline__ float wave_sum(float v) {
#pragma unroll
    for (int o = 1; o < 64; o <<= 1) v += __shfl_xor(v, o);
    return v;
}
__device__ __forceinline__ int otid() { int t = threadIdx.x; asm volatile("" : "+v"(t)); return t; }
__device__ __forceinline__ int obid() { int t = blockIdx.x; asm volatile("" : "+s"(t)); return t; }
__device__ __forceinline__ float fast_exp2(float x) { return __builtin_amdgcn_exp2f(x); }
__device__ __forceinline__ float fast_rcp(float x) { return __builtin_amdgcn_rcpf(x); }
__device__ __forceinline__ float silu_f(float v) { return v * fast_rcp(1.0f + fast_exp2(-v * LOG2E)); }
__device__ __forceinline__ float sigmoid_f(float v) { return fast_rcp(1.0f + fast_exp2(-v * LOG2E)); }

#define XB_TMO      128
#define XB_XCNT(j)  (256  + 64 * (j))
#define XB_XSUB(j)  (1280 + 64 * (j))
#define XB_XGEN(j)  (2304 + 64 * (j))
#define XB_TOP      3328
#define XB_TOPGEN   3392
#define XCD_BAR_WORDS 3456
#define XB_SPIN_CAP (1u << 18)

__device__ __forceinline__ unsigned xb_ld(unsigned* p)              { return __hip_atomic_load(p, __ATOMIC_RELAXED, __HIP_MEMORY_SCOPE_AGENT); }
__device__ __forceinline__ unsigned xb_add(unsigned* p, unsigned v) { return __hip_atomic_fetch_add(p, v, __ATOMIC_RELAXED, __HIP_MEMORY_SCOPE_AGENT); }
__device__ __forceinline__ unsigned xb_xcc_id() { return (unsigned)__builtin_amdgcn_s_getreg((3 << 11) | 20) & 0xFu; }
#define XB_SPIN(cond, bar) do { unsigned _sp = 0; while (cond) { __builtin_amdgcn_s_sleep(1); \
    if ((++_sp & 255u) == 0u) { if (xb_ld(&(bar)[XB_TMO])) break; if (_sp > XB_SPIN_CAP) { atomicAdd(&(bar)[XB_TMO], 1u); break; } } } } while (0)

struct XcdBarrier {
    unsigned* bar; unsigned x;
    volatile LAS unsigned* st;
};

__device__ __forceinline__ XcdBarrier xcd_barrier_post(unsigned* bar, volatile LAS unsigned* st) {
    XcdBarrier b; b.bar = bar; b.x = xb_xcc_id(); b.st = st;
    if (threadIdx.x == 0) (void)xb_add(&bar[XB_XCNT(b.x)], 1u);
    return b;
}
__device__ __forceinline__ void xcd_barrier_complete(unsigned* bar, unsigned x, unsigned& nloc, unsigned& nx) {
    const unsigned G = gridDim.x * gridDim.y * gridDim.z;
    unsigned sum, cnt, mine, sp = 0u;
    for (;;) {
        sum = 0u; cnt = 0u; mine = 0u;
#pragma unroll
        for (unsigned j = 0; j < 16; ++j) { const unsigned c = xb_ld(&bar[XB_XCNT(j)]); sum += c; cnt += (c > 0u) ? 1u : 0u; mine = (j == x) ? c : mine; }
        if (sum == G) break;
        __builtin_amdgcn_s_sleep(1);
        if ((++sp & 255u) == 0u) { if (xb_ld(&bar[XB_TMO])) break; if (sp > XB_SPIN_CAP) { atomicAdd(&bar[XB_TMO], 1u); break; } }
    }
    nloc = mine > 0u ? mine : 1u; nx = cnt > 0u ? cnt : 1u;
}

__device__ __forceinline__ void xcd_barrier(const XcdBarrier& b) {
    asm volatile("s_waitcnt vmcnt(0)" ::: "memory");
    __syncthreads();
    if (threadIdx.x == 0) {
        unsigned* bar = b.bar;
        __builtin_amdgcn_s_waitcnt(0);
        unsigned nloc = b.st[0], nx = b.st[1];
        if (nloc == 0u) { xcd_barrier_complete(bar, b.x, nloc, nx); b.st[0] = nloc; b.st[1] = nx; }
        const unsigned old = xb_add(&bar[XB_XSUB(b.x)], 1u);
        const unsigned gen = old / nloc;
        if (old + 1u == (gen + 1u) * nloc) {
            __builtin_amdgcn_fence(__ATOMIC_RELEASE, "agent");
            asm volatile("s_waitcnt vmcnt(0)" ::: "memory");
            const unsigned og = xb_add(&bar[XB_TOP], 1u);
            const unsigned tg = og / nx;
            if (og + 1u == (tg + 1u) * nx) xb_add(&bar[XB_TOPGEN], 1u);
            else XB_SPIN(xb_ld(&bar[XB_TOPGEN]) == tg, bar);
            __builtin_amdgcn_fence(__ATOMIC_ACQUIRE, "agent");
            xb_add(&bar[XB_XGEN(b.x)], 1u);
            asm volatile("s_waitcnt vmcnt(0)" ::: "memory");
        } else {
            XB_SPIN(xb_ld(&bar[XB_XGEN(b.x)]) == gen, bar);
            __builtin_amdgcn_fence(__ATOMIC_ACQUIRE, "agent");
            asm volatile("s_waitcnt vmcnt(0)" ::: "memory");
        }
    }
    __syncthreads();
}


struct EpiSwiGLU {
    static constexpr bool PERM = true, AFTER_DRAIN = false;
    bf16_t* U;
    __device__ __forceinline__ void operator()(const f32x4 (&acc)[2][2][4][2], const pg8::Unit& u, int wr, int wc, int fr, int fq) const {
        const int row0 = u.pm * 256 + wr * 64 + fr, col0 = u.pn * 128 + wc * 32 + 8 * fq;
#pragma unroll
        for (int ai = 0; ai < 2; ++ai)
#pragma unroll
            for (int m = 0; m < 4; ++m) {
                bf16_t* rowp = U + (size_t)(row0 + ai * 128 + m * 16) * FF + col0;
                float v[8];
#pragma unroll
                for (int n = 0; n < 2; ++n)
#pragma unroll
                    for (int j = 0; j < 4; ++j) v[n * 4 + j] = silu_f(acc[ai][0][m][n][j]) * acc[ai][1][m][n][j];
                u32x4 w; w.x = pk2(v[0], v[1]); w.y = pk2(v[2], v[3]); w.z = pk2(v[4], v[5]); w.w = pk2(v[6], v[7]);
                *(u32x4*)rowp = w;
            }
    }
};
struct EpiBf16Tile {
    static constexpr bool PERM = true, AFTER_DRAIN = false;
    bf16_t* O; int ldc, row_pn, col_pn;
    __device__ __forceinline__ void operator()(const f32x4 (&acc)[2][2][4][2], const pg8::Unit& u, int wr, int wc, int fr, int fq) const {
        const int row0 = u.pm * 256 + u.pn * row_pn + wr * 64 + fr, col0 = u.pn * col_pn + wc * 32 + 8 * fq;
#pragma unroll
        for (int ai = 0; ai < 2; ++ai)
#pragma unroll
            for (int m = 0; m < 4; ++m) {
                bf16_t* rowp = O + (size_t)(row0 + ai * 128 + m * 16) * ldc + col0;
#pragma unroll
                for (int bj = 0; bj < 2; ++bj) {
                    const f32x4 v0 = acc[ai][bj][m][0], v1 = acc[ai][bj][m][1];
                    u32x4 w; w.x = pk2(v0[0], v0[1]); w.y = pk2(v0[2], v0[3]); w.z = pk2(v1[0], v1[1]); w.w = pk2(v1[2], v1[3]);
                    *(u32x4*)(rowp + bj * 128) = w;
                }
            }
    }
};
struct EpiPQ {
    static constexpr bool PERM = true, AFTER_DRAIN = false;
    bf16_t* PQT; bf16_t* PQTC;
    __device__ __forceinline__ void operator()(const f32x4 (&acc)[2][2][4][2], const pg8::Unit& u, int wr, int wc, int fr, int fq) const {
        const int cl = wc * 32 + 8 * fq;
#pragma unroll
        for (int ai = 0; ai < 2; ++ai)
#pragma unroll
            for (int m = 0; m < 4; ++m) {
                const int mp = u.pm * 256 + ai * 128 + wr * 64 + m * 16 + fr;
                const int g = mp >> 7, pq = (mp >> 6) & 1, cp = mp & 63;
                bf16_t* rowp;
                if (u.pn < 128) { const int b = u.pn >> 3, n0 = (u.pn & 7) * 256; rowp = PQT + (size_t)(b * 256 + g * 64 + cp) * PQT_LD + pq * 2048 + n0 + cl; }
                else { const int b = u.pn - 128; rowp = PQTC + (size_t)(b * 256 + g * 64 + cp) * PQTC_LD + pq * 256 + cl; }
#pragma unroll
                for (int bj = 0; bj < 2; ++bj) {
                    const f32x4 v0 = acc[ai][bj][m][0], v1 = acc[ai][bj][m][1];
                    u32x4 w; w.x = pk2(v0[0], v0[1]); w.y = pk2(v0[2], v0[3]); w.z = pk2(v1[0], v1[1]); w.w = pk2(v1[2], v1[3]);
                    *(u32x4*)(rowp + bj * 128) = w;
                }
            }
    }
};
struct EpiWin {
    static constexpr bool PERM = false, AFTER_DRAIN = false;
    bf16_t* P; const float* rope;
    __device__ __forceinline__ void operator()(const f32x4 (&acc)[2][2][4][2], const pg8::Unit& u, int wr, int wc, int fr, int fq) const {
        const int row0 = u.pm * 256 + wr * 64 + fr, col0 = u.pn * 256 + wc * 32 + 4 * fq;
        const float qs = (u.pn == 2 || u.pn == 5) ? 0.125f : 1.0f;
        const bool lat = u.pm < 128;
#pragma unroll
        for (int ai = 0; ai < 2; ++ai)
#pragma unroll
            for (int m = 0; m < 4; ++m) {
                const int r = row0 + ai * 128 + m * 16;
                bf16_t* rowp = P + (size_t)r * NP + col0;
                const int t = r & 2047;
                const int pos = (wc & 1) ? (t & 63) : (t >> 6);
#pragma unroll
                for (int bj = 0; bj < 2; ++bj) {
                    f32x4 v0 = acc[ai][bj][m][0], v1 = acc[ai][bj][m][1];
                    const bool dorope = lat && (u.pn == 5 || (u.pn == 6 && bj == 0));
                    if (dorope) {
                        const f32x4 cs0 = *(const f32x4*)(rope + (pos * 16 + 4 * fq) * 2), cs1 = *(const f32x4*)(rope + (pos * 16 + 4 * fq) * 2 + 4);
                        const float c0 = cs0[0], s0 = cs0[1], c1 = cs0[2], s1 = cs0[3], c2 = cs1[0], s2 = cs1[1], c3 = cs1[2], s3 = cs1[3];
                        f32x4 a, b;
                        a[0] = v0[0] * c0 - v1[0] * s0; b[0] = v0[0] * s0 + v1[0] * c0;
                        a[1] = v0[1] * c1 - v1[1] * s1; b[1] = v0[1] * s1 + v1[1] * c1;
                        a[2] = v0[2] * c2 - v1[2] * s2; b[2] = v0[2] * s2 + v1[2] * c2;
                        a[3] = v0[3] * c3 - v1[3] * s3; b[3] = v0[3] * s3 + v1[3] * c3;
                        v0 = a; v1 = b;
                    }
                    v0 = v0 * qs; v1 = v1 * qs;
                    u32x2 w0, w1; w0.x = pk2(v0[0], v0[1]); w0.y = pk2(v0[2], v0[3]); w1.x = pk2(v1[0], v1[1]); w1.y = pk2(v1[2], v1[3]);
                    *(u32x2*)(rowp + bj * 128) = w0; *(u32x2*)(rowp + bj * 128 + 16) = w1;
                }
            }
    }
};

struct TrItem { const float* src; bf16_t* dst; int ld_src, ld_dst; };
__device__ __forceinline__ TrItem tr_decode(CParams& p, int it) {
    constexpr int PER_L = 2 * 704 + 2 * 352 + 224 + 160;
    unsigned char* ws = p.ws;
    const int l = it / PER_L; int q = it % PER_L;
    const float* src; bf16_t* dst; int ld_src, ld_dst, col0, k0, r0;
    if (q < 2 * 704) { const int f = q / 704; q %= 704; const int rt = q >> 4, kt = q & 15, R0 = rt * 128, tile = R0 >> 8, bj = (R0 >> 7) & 1;
        src = (bj ? p.w3 : p.w1) + (size_t)(l * 2 + f) * 1024 * FF; ld_src = FF; col0 = 128 * tile; k0 = 64 * kt; dst = (bf16_t*)(ws + WS_W13) + (size_t)(l * 2 + f) * 5632 * 1024; r0 = R0; ld_dst = 1024; }
    else if (q < 2 * 704 + 2 * 352) { q -= 2 * 704; const int f = q / 352; q %= 352; const int rt = q / 44, kt = q % 44;
        src = p.w2 + (size_t)(l * 2 + f) * FF * 1024; ld_src = 1024; col0 = 128 * rt; k0 = 64 * kt; dst = (bf16_t*)(ws + WS_W2T) + (size_t)(l * 2 + f) * 1024 * FF; r0 = 128 * rt; ld_dst = FF; }
    else if (q < 2 * 704 + 2 * 352 + 224) { q -= 2 * 704 + 2 * 352; const int rt = q >> 4, kt = q & 15, R0 = rt * 128;
        src = p.w_in + (size_t)l * 1024 * 2048; ld_src = 2048; col0 = R0 < 512 ? R0 : R0 + 256; k0 = 64 * kt; dst = (bf16_t*)(ws + WS_WIN) + (size_t)l * 2304 * 1024; r0 = R0; ld_dst = 1024; }
    int ks = -1;
    if (q >= 2 * 704 + 2 * 352 + 224) { q -= 2 * 704 + 2 * 352 + 224; const int rt = q / 20, kt = q % 20;
        src = p.w_out + (size_t)l * 1024 * 1024; ld_src = 1024; col0 = 128 * rt; k0 = 64 * kt; ks = kt < 16 ? 64 * kt : 256 + 64 * (kt - 16); dst = (bf16_t*)(ws + WS_WOUT) + (size_t)l * 1024 * YC_LD; r0 = 128 * rt; ld_dst = YC_LD; }
    if (ks < 0) ks = k0;
    TrItem t; t.src = src + (size_t)ks * ld_src + col0; t.dst = dst + (size_t)r0 * ld_dst + k0; t.ld_src = ld_src; t.ld_dst = ld_dst; return t;
}

__device__ __forceinline__ void phase0(CParams& p, LAS unsigned char* lds) {
    const int tid = otid(), wave = tid >> 6, lane = tid & 63;
    unsigned char* ws = p.ws;
    const int bid = obid(), G = gridDim.x;
    if (bid < 288) {
        LAS float* sS = (LAS float*)lds;
        LAS float* sR = sS + 17 * 1024;
        for (int i = tid; i < 17 * 1024; i += 512) { const float v = (i < 16384) ? p.c[i] : p.c_ctx[i - 16384]; sS[i] = v / (1.0f + __expf(-v)); }
        __syncthreads();
        for (int r = bid; r < 288; r += G) {
            const int l = r / 144, j0 = (r % 144) * 64, k0 = wave * 128;
            float acc[17];
#pragma unroll
            for (int q = 0; q < 17; ++q) acc[q] = 0.f;
            const float* wp = p.w_ada + ((size_t)l * 1024 + k0) * NMODC + j0 + lane;
#pragma unroll 1
            for (int kb = 0; kb < 128; kb += 16) {
                float wv[16];
#pragma unroll
                for (int kk = 0; kk < 16; ++kk) wv[kk] = wp[(size_t)(kb + kk) * NMODC];
#pragma unroll
                for (int kk = 0; kk < 16; ++kk)
#pragma unroll
                    for (int q = 0; q < 17; ++q) acc[q] += sS[q * 1024 + k0 + kb + kk] * wv[kk];
            }
#pragma unroll
            for (int q = 0; q < 17; ++q) sR[(wave * 17 + q) * 64 + lane] = acc[q];
            __syncthreads();
            float* MOD = (float*)(ws + WS_MOD);
            for (int o = tid; o < 17 * 64; o += 512) {
                const int q = o >> 6, ln = o & 63; float s = p.b_ada[l * NMODC + j0 + ln];
#pragma unroll
                for (int w = 0; w < 8; ++w) s += sR[(w * 17 + q) * 64 + ln];
                MOD[(size_t)(l * 17 + q) * NMODC + j0 + ln] = s;
            }
            __syncthreads();
        }
    }
    {
        constexpr int N_TR = 2 * (2 * 704 + 2 * 352 + 224 + 160);
        LAS float* t = (LAS float*)lds;
        const int lk = tid >> 5, lc = (tid & 31) * 4;
        const int sr = tid >> 2, sk = (tid & 3) * 16;
        int it = bid; f32x4 pre[4]; TrItem cur;
        if (it < N_TR) { cur = tr_decode(p, it);
#pragma unroll
            for (int i = 0; i < 4; ++i) pre[i] = *(const f32x4*)(cur.src + (size_t)(lk + 16 * i) * cur.ld_src + lc); }
        while (it < N_TR) {
#pragma unroll
            for (int i = 0; i < 4; ++i) { LAS float* d = t + (lk + 16 * i) * 129 + lc; d[0] = pre[i][0]; d[1] = pre[i][1]; d[2] = pre[i][2]; d[3] = pre[i][3]; }
            __syncthreads();
            bf16_t* dp = cur.dst + (size_t)sr * cur.ld_dst + sk;
            const int nxt = it + G;
            if (nxt < N_TR) { cur = tr_decode(p, nxt);
#pragma unroll
                for (int i = 0; i < 4; ++i) pre[i] = *(const f32x4*)(cur.src + (size_t)(lk + 16 * i) * cur.ld_src + lc); }
            { const LAS float* s = t + sk * 129 + sr;
              u32x4 o0, o1;
              o0.x = pk2(s[0 * 129], s[1 * 129]); o0.y = pk2(s[2 * 129], s[3 * 129]); o0.z = pk2(s[4 * 129], s[5 * 129]); o0.w = pk2(s[6 * 129], s[7 * 129]);
              o1.x = pk2(s[8 * 129], s[9 * 129]); o1.y = pk2(s[10 * 129], s[11 * 129]); o1.z = pk2(s[12 * 129], s[13 * 129]); o1.w = pk2(s[14 * 129], s[15 * 129]);
              *(u32x4*)dp = o0; *(u32x4*)(dp + 8) = o1; }
            __syncthreads();
            it = nxt;
        }
    }
    for (int r = bid; r < 256; r += G) {
        const int l = r >> 7, k0 = (r & 127) * 8;
        LAS float* sW = (LAS float*)lds;
        LAS float* sC = sW + 2048;
        for (int i = tid; i < 2048; i += 512) { const int kk = i >> 8, cc = i & 255; sW[i] = p.w_in[((size_t)l * 1024 + k0 + kk) * 2048 + 512 + cc]; }
        if (tid < 64) sC[tid] = cospif((float)tid * (1.0f / 32.0f));
        __syncthreads();
        const int g = tid >> 7, j = tid & 127, jj = j & 63, isS = j >> 6;
        float acc[8];
#pragma unroll
        for (int q = 0; q < 8; ++q) acc[q] = 0.f;
        for (int c = 0; c < 64; ++c) {
            const int mm = (c * jj) & 63; const float tv = sC[isS ? ((mm - 16) & 63) : mm];
#pragma unroll
            for (int q = 0; q < 8; ++q) acc[q] += sW[q * 256 + g * 64 + c] * tv;
        }
        u32x4 o; o.x = pk2(acc[0] * 0.125f, acc[1] * 0.125f); o.y = pk2(acc[2] * 0.125f, acc[3] * 0.125f); o.z = pk2(acc[4] * 0.125f, acc[5] * 0.125f); o.w = pk2(acc[6] * 0.125f, acc[7] * 0.125f);
        *(u32x4*)((bf16_t*)(ws + WS_WIN) + ((size_t)l * 2304 + 1792 + g * 128 + j) * 1024 + k0) = o;
        __syncthreads();
    }
    {
        LAS float* tab = (LAS float*)lds;
        for (int m = tid; m < 2048; m += 512) tab[m] = cospif((float)m * (1.0f / 1024.0f)) * 0.022097086912079608f;
        __syncthreads();
        for (int r = bid; r < 2048 + 256; r += G) {
            if (r < 2048) {
                float v[8];
#pragma unroll
                for (int e = 0; e < 8; ++e) { const int k = tid * 8 + e, idx = (r * (k & 2047)) & 2047; v[e] = tab[k < 2048 ? idx : ((idx + 512) & 2047)]; }
                u32x4 o; o.x = pk2(v[0], v[1]); o.y = pk2(v[2], v[3]); o.z = pk2(v[4], v[5]); o.w = pk2(v[6], v[7]);
                *(u32x4*)((bf16_t*)(ws + WS_DFT) + (size_t)r * DFT_LD + tid * 8) = o;
            } else if (tid < 64) {
                const int np = r - 2048; const float sc = 2.8284271247461903f;
                float v[8];
#pragma unroll
                for (int e = 0; e < 8; ++e) { const int k = tid * 8 + e, idx = ((np * (k & 255)) & 255) * 8; v[e] = tab[k < 256 ? idx : ((idx + 512) & 2047)] * sc; }
                u32x4 o; o.x = pk2(v[0], v[1]); o.y = pk2(v[2], v[3]); o.z = pk2(v[4], v[5]); o.w = pk2(v[6], v[7]);
                *(u32x4*)((bf16_t*)(ws + WS_DFTC) + (size_t)np * DFTC_LD + tid * 8) = o;
            }
        }
        __syncthreads();
    }
    if (bid == G - 1) {
        float* rtab = (float*)(ws + WS_ROPE);
        for (int e = tid; e < 1024; e += 512) { const int pos = e >> 4, i = e & 15;
            const float inv = fast_exp2(-(float)i * (13.287712379549449f / 16.0f));
            const float tt = (float)pos * inv * 0.3183098861837907f;
            rtab[2 * e] = cospif(tt); rtab[2 * e + 1] = sinpif(tt); }
    }
}

struct EwArgs {
    const float* xin_lat; const float* xin_ctx; float* xout_lat; float* xout_ctx;
    const bf16_t* Y; const float* gpost; float fac; const float* gate;
    bf16_t* H; const float* gpre; const float* shift; const float* scale;
    int nrows;
};
__device__ __forceinline__ void ew_pass(const float* xin_lat, const float* xin_ctx, float* xout_lat, float* xout_ctx, const bf16_t* Yp, const float* gpost, float fac, const float* gate,
                                        bf16_t* Hp, const float* gpre, const float* shift, const float* scale, int nrows) {
    EwArgs a; a.xin_lat = xin_lat; a.xin_ctx = xin_ctx; a.xout_lat = xout_lat; a.xout_ctx = xout_ctx; a.Y = Yp; a.gpost = gpost; a.fac = fac; a.gate = gate; a.H = Hp; a.gpre = gpre; a.shift = shift; a.scale = scale; a.nrows = nrows;
    const int tid = otid(); const int wave = tid >> 6, lane = tid & 63;
    for (int t = obid() * 8 + wave; t < a.nrows; t += gridDim.x * 8) {
        const bool lat = t < TL; const int b = lat ? (t >> 11) : 16;
        const float* xr = lat ? a.xin_lat + (size_t)t * DM : a.xin_ctx + (size_t)(t - TL) * DM;
        f32x4 x[4];
#pragma unroll
        for (int j = 0; j < 4; ++j) x[j] = *(const f32x4*)(xr + 4 * lane + 256 * j);
        if (a.Y) {
            f32x4 y[4]; float ss = 0.f;
#pragma unroll
            for (int j = 0; j < 4; ++j) { const u32x2 w = *(const u32x2*)(a.Y + (size_t)t * DM + 4 * lane + 256 * j);
                y[j][0] = bflo(w.x); y[j][1] = bfhi(w.x); y[j][2] = bflo(w.y); y[j][3] = bfhi(w.y);
                ss += (y[j][0] * y[j][0] + y[j][1] * y[j][1]) + (y[j][2] * y[j][2] + y[j][3] * y[j][3]); }
            const float rstd = 1.0f / sqrtf(wave_sum(ss) * (1.0f / DM) + EPSV);
#pragma unroll
            for (int j = 0; j < 4; ++j) { const f32x4 gt = *(const f32x4*)(a.gate + (size_t)b * NMODC + 4 * lane + 256 * j); const f32x4 gp = *(const f32x4*)(a.gpost + 4 * lane + 256 * j);
                x[j] = x[j] + (gt * a.fac) * (y[j] * rstd * gp); }
        }
        float* xo = lat ? (a.xout_lat ? a.xout_lat + (size_t)t * DM : nullptr) : (a.xout_ctx ? a.xout_ctx + (size_t)(t - TL) * DM : nullptr);
        if (xo) {
#pragma unroll
            for (int j = 0; j < 4; ++j) *(f32x4*)(xo + 4 * lane + 256 * j) = x[j];
        }
        if (a.H) {
            float ss = 0.f;
#pragma unroll
            for (int j = 0; j < 4; ++j) ss += (x[j][0] * x[j][0] + x[j][1] * x[j][1]) + (x[j][2] * x[j][2] + x[j][3] * x[j][3]);
            const float rstd = 1.0f / sqrtf(wave_sum(ss) * (1.0f / DM) + EPSV);
#pragma unroll
            for (int j = 0; j < 4; ++j) { const int cidx = 4 * lane + 256 * j;
                const f32x4 g = *(const f32x4*)(a.gpre + cidx), sh = *(const f32x4*)(a.shift + (size_t)b * NMODC + cidx), sc = *(const f32x4*)(a.scale + (size_t)b * NMODC + cidx);
                const f32x4 h = (x[j] * rstd * g) * (sc + 1.0f) + sh;
                u32x2 w; w.x = pk2(h[0], h[1]); w.y = pk2(h[2], h[3]);
                *(u32x2*)(a.H + (size_t)t * DM + cidx) = w; }
        }
    }
}

__device__ __forceinline__ void conv_item(CParams& p, LAS unsigned char* lds, int l, int s, int tb) {
    const int tid = otid(), wave = tid >> 6, lane = tid & 63;
    const bf16_t* PROJ = (const bf16_t*)(p.ws + WS_PROJ); bf16_t* YCAT = (bf16_t*)(p.ws + WS_YCAT);
    LAS float* sA = (LAS float*)lds;
    LAS float* sY = sA + 62 * 256;
    const int tokbase = s < 16 ? s * 2048 : TL + (s - 16) * 256, len = s < 16 ? 2048 : 256, t0 = tb * 32;
    for (int u = tid; u < 62 * 32; u += 512) {
        const int rr = u >> 5, c8 = (u & 31) * 8, tt = t0 - 15 + rr;
        float v[8];
        if (tt >= 0 && tt < len) {
            const bf16_t* rp = PROJ + (size_t)(tokbase + tt) * NP + c8;
            const u32x4 ua = *(const u32x4*)rp, ug = *(const u32x4*)(rp + 256);
            v[0] = bflo(ua.x) * sigmoid_f(bflo(ug.x)); v[1] = bfhi(ua.x) * sigmoid_f(bfhi(ug.x));
            v[2] = bflo(ua.y) * sigmoid_f(bflo(ug.y)); v[3] = bfhi(ua.y) * sigmoid_f(bfhi(ug.y));
            v[4] = bflo(ua.z) * sigmoid_f(bflo(ug.z)); v[5] = bfhi(ua.z) * sigmoid_f(bfhi(ug.z));
            v[6] = bflo(ua.w) * sigmoid_f(bflo(ug.w)); v[7] = bfhi(ua.w) * sigmoid_f(bfhi(ug.w));
        } else {
#pragma unroll
            for (int e = 0; e < 8; ++e) v[e] = 0.f;
        }
        *(LAS f32x4*)(sA + rr * 256 + c8) = (f32x4){v[0], v[1], v[2], v[3]};
        *(LAS f32x4*)(sA + rr * 256 + c8 + 4) = (f32x4){v[4], v[5], v[6], v[7]};
    }
    __syncthreads();
    {
        const int ch = tid & 255, half = tid >> 8;
        float w[31];
#pragma unroll
        for (int j = 0; j < 31; ++j) w[j] = p.conv_w[((size_t)l * 31 + j) * 256 + ch];
        const float bias = p.conv_b[l * 256 + ch];
#pragma unroll 4
        for (int tl = 0; tl < 16; ++tl) {
            const int tok = half * 16 + tl; float acc = bias;
#pragma unroll
            for (int j = 0; j < 31; ++j) acc += sA[(tok + j) * 256 + ch] * w[j];
            sY[tok * 256 + ch] = acc;
        }
    }
    __syncthreads();
    {
        const f32x4 lg = *(const f32x4*)(p.ln_g + l * 256 + 4 * lane), lb = *(const f32x4*)(p.ln_b + l * 256 + 4 * lane);
#pragma unroll
        for (int q = 0; q < 4; ++q) {
            const int tok = wave * 4 + q;
            const f32x4 v = *(const LAS f32x4*)(sY + tok * 256 + 4 * lane);
            const float mean = wave_sum((v[0] + v[1]) + (v[2] + v[3])) * (1.0f / 256.0f);
            const f32x4 d = v - mean;
            const float var = wave_sum((d[0] * d[0] + d[1] * d[1]) + (d[2] * d[2] + d[3] * d[3])) * (1.0f / 256.0f);
            const float rstd = 1.0f / sqrtf(var + EPSV);
            const f32x4 yn = d * rstd * lg + lb;
            u32x2 o; o.x = pk2(silu_f(yn[0]), silu_f(yn[1])); o.y = pk2(silu_f(yn[2]), silu_f(yn[3]));
            *(u32x2*)(YCAT + (size_t)(tokbase + t0 + tok) * YC_LD + 4 * lane) = o;
        }
    }
    __syncthreads();
}

struct AttnItem {
    int mode;
    int qtok0;
    int qcol0, qcol1, ocol0, ocol1;
    int kcol0, kcol1, vcol0, vcol1; int nslots;
    int nloc, loctok0;
    int ctxtok0;
    int r, rs;
    int q0, kp0;
    int has_sink; float sink0, sink1;
    int h0;
};
constexpr int KROW = 72;
constexpr int VROW = 68;
constexpr int K_BYTES = 64 * KROW * 2, V_BYTES = 64 * VROW * 2;

__device__ __forceinline__ void attn_item(CParams& p, LAS unsigned char* lds, int l, const AttnItem& it) {
    const int tid = otid(), wave = tid >> 6, lane = tid & 63, g = wave >> 2, wq = wave & 3, fr = lane & 15, fq = lane >> 4;
    const bf16_t* PROJ = (const bf16_t*)(p.ws + WS_PROJ); bf16_t* YCAT = (bf16_t*)(p.ws + WS_YCAT);
    LAS unsigned char* sK = lds;
    LAS unsigned char* sV = lds + 2 * K_BYTES;
    LAS float* sB = (LAS float*)(lds + 2 * K_BYTES + 2 * V_BYTES);
    const int slot = it.nslots == 2 ? g : 0;
    if (it.mode == 0) { for (int i = tid; i < 2 * 465; i += 512) sB[i] = p.nat_bias[(size_t)(l * 4 + it.h0) * 465 + i]; }
    bf16x8 qf[2];
    { const bf16_t* qp = PROJ + (size_t)(it.qtok0 + wq * 16 + fr) * NP + (g ? it.qcol1 : it.qcol0) + 8 * fq;
      qf[0] = *(const bf16x8*)qp; qf[1] = *(const bf16x8*)(qp + 32); }
    float mrun = -3.0e38f, lsum = 0.f;
    f32x4 o[4];
#pragma unroll
    for (int db = 0; db < 4; ++db) o[db] = (f32x4){0.f, 0.f, 0.f, 0.f};
    const int nchunks = 4 + it.nloc;
    const int srow = tid >> 3, sseg = tid & 7;
    u32x4 kreg[2], vreg[2];
    auto chunk_tok = [&](int c) { return c < 4 ? it.ctxtok0 + 64 * c : it.loctok0 + 64 * (c - 4); };
    auto gload = [&](int c) {
        const bf16_t* rp = PROJ + (size_t)(chunk_tok(c) + srow) * NP + 8 * sseg;
#pragma unroll
        for (int s = 0; s < 2; ++s) if (s < it.nslots) { kreg[s] = *(const u32x4*)(rp + (s ? it.kcol1 : it.kcol0)); vreg[s] = *(const u32x4*)(rp + (s ? it.vcol1 : it.vcol0)); }
    };
    gload(0);
    for (int c = 0; c < nchunks; ++c) {
        __syncthreads();
#pragma unroll
        for (int s = 0; s < 2; ++s) if (s < it.nslots) {
            *(LAS u32x4*)(sK + s * K_BYTES + (srow * KROW + 8 * sseg) * 2) = kreg[s];
            LAS bf16_t* vt = (LAS bf16_t*)(sV + s * V_BYTES) + (8 * sseg) * VROW + srow;
            vt[0 * VROW] = (bf16_t)(vreg[s].x & 0xffffu); vt[1 * VROW] = (bf16_t)(vreg[s].x >> 16);
            vt[2 * VROW] = (bf16_t)(vreg[s].y & 0xffffu); vt[3 * VROW] = (bf16_t)(vreg[s].y >> 16);
            vt[4 * VROW] = (bf16_t)(vreg[s].z & 0xffffu); vt[5 * VROW] = (bf16_t)(vreg[s].z >> 16);
            vt[6 * VROW] = (bf16_t)(vreg[s].w & 0xffffu); vt[7 * VROW] = (bf16_t)(vreg[s].w >> 16);
        }
        __syncthreads();
        if (c + 1 < nchunks) gload(c + 1);
        f32x4 sacc[4];
        const LAS unsigned char* kb_base = sK + slot * K_BYTES + (fr * KROW + 8 * fq) * 2;
#pragma unroll
        for (int kb = 0; kb < 4; ++kb) {
            sacc[kb] = (f32x4){0.f, 0.f, 0.f, 0.f};
#pragma unroll
            for (int kk = 0; kk < 2; ++kk) {
                const bf16x8 a = *(const LAS bf16x8*)(kb_base + (16 * kb * KROW + 32 * kk) * 2);
                sacc[kb] = __builtin_amdgcn_mfma_f32_16x16x32_bf16(a, qf[kk], sacc[kb], 0, 0, 0);
            }
        }
        const int qi = wq * 16 + fr;
        if (c >= 4 && it.mode == 0) {
            const int wsx = min(max(qi - 8, 0), 48);
            const int dr = (it.rs + (c - 4)) - it.r + 7;
            const LAS float* bt = sB + g * 465 + dr * 31;
#pragma unroll
            for (int kb = 0; kb < 4; ++kb)
#pragma unroll
                for (int j = 0; j < 4; ++j) { const int kc = 16 * kb + 4 * fq + j; const bool ok = (kc >= wsx) && (kc < wsx + 16);
                    const int dc = min(max(kc - qi + 15, 0), 30);
                    sacc[kb][j] = ok ? (sacc[kb][j] + bt[dc]) * LOG2E : -1.0e30f; }
        } else if (c >= 4 && it.mode == 1) {
            const int qpos = it.q0 + qi, kbase = it.kp0 + 64 * (c - 4);
#pragma unroll
            for (int kb = 0; kb < 4; ++kb)
#pragma unroll
                for (int j = 0; j < 4; ++j) { const int kpos = kbase + 16 * kb + 4 * fq + j; const int d = kpos - qpos; const bool ok = (d <= 128) && (d >= -128);
                    sacc[kb][j] = ok ? sacc[kb][j] * LOG2E : -1.0e30f; }
        } else {
#pragma unroll
            for (int kb = 0; kb < 4; ++kb) sacc[kb] = sacc[kb] * LOG2E;
        }
        float cm = sacc[0][0];
#pragma unroll
        for (int kb = 0; kb < 4; ++kb)
#pragma unroll
            for (int j = 0; j < 4; ++j) cm = fmaxf(cm, sacc[kb][j]);
        cm = fmaxf(cm, __shfl_xor(cm, 16)); cm = fmaxf(cm, __shfl_xor(cm, 32));
        const float mnew = fmaxf(mrun, cm), alpha = fast_exp2(mrun - mnew);
        mrun = mnew;
        float ps = 0.f;
#pragma unroll
        for (int kb = 0; kb < 4; ++kb)
#pragma unroll
            for (int j = 0; j < 4; ++j) { sacc[kb][j] = fast_exp2(sacc[kb][j] - mnew); ps += sacc[kb][j]; }
        lsum = lsum * alpha + ps;
#pragma unroll
        for (int db = 0; db < 4; ++db) o[db] = o[db] * alpha;
        const LAS unsigned char* vb_base = sV + slot * V_BYTES + (fr * VROW + 4 * fq) * 2;
#pragma unroll
        for (int grp = 0; grp < 2; ++grp) {
            union { bf16x8 v; unsigned u[4]; } pb;
            pb.u[0] = pk2(sacc[2 * grp][0], sacc[2 * grp][1]); pb.u[1] = pk2(sacc[2 * grp][2], sacc[2 * grp][3]);
            pb.u[2] = pk2(sacc[2 * grp + 1][0], sacc[2 * grp + 1][1]); pb.u[3] = pk2(sacc[2 * grp + 1][2], sacc[2 * grp + 1][3]);
#pragma unroll
            for (int db = 0; db < 4; ++db) {
                union { bf16x8 v; u32x2 h[2]; } av;
                av.h[0] = *(const LAS u32x2*)(vb_base + (16 * db * VROW + 32 * grp) * 2);
                av.h[1] = *(const LAS u32x2*)(vb_base + (16 * db * VROW + 32 * grp + 16) * 2);
                o[db] = __builtin_amdgcn_mfma_f32_16x16x32_bf16(av.v, pb.v, o[db], 0, 0, 0);
            }
        }
    }
    lsum += __shfl_xor(lsum, 16); lsum += __shfl_xor(lsum, 32);
    if (it.has_sink) lsum += fast_exp2((g ? it.sink1 : it.sink0) * LOG2E - mrun);
    const float inv = 1.0f / lsum;
    bf16_t* op = YCAT + (size_t)(it.qtok0 + wq * 16 + fr) * YC_LD + (g ? it.ocol1 : it.ocol0) + 4 * fq;
#pragma unroll
    for (int db = 0; db < 4; ++db) { u32x2 w; w.x = pk2(o[db][0] * inv, o[db][1] * inv); w.y = pk2(o[db][2] * inv, o[db][3] * inv); *(u32x2*)(op + 16 * db) = w; }
    __syncthreads();
}

constexpr int C_UA = 0, C_QN = 512, C_KN = 768, C_VN = 1024, C_QS = 1280, C_KS = 1536, C_VS = 1664;

__device__ __forceinline__ void mix_items(CParams& p, LAS unsigned char* lds, int l, int sub) {
    const int n_attn = (l == 0) ? 2304 : 2048;
    const int n_conv = (l == 0) ? 1024 + 128 : 1024;
    const int start = (obid() + 128) % gridDim.x;
    for (int i = start; i < n_attn + n_conv; i += gridDim.x) {
        if (i >= n_attn) {
            if (!(sub & 4)) continue;
            const int ci = i - n_attn;
            if (ci < 1024) conv_item(p, lds, l, ci >> 6, ci & 63);
            else { const int cj = ci - 1024; conv_item(p, lds, l, 16 + (cj >> 3), cj & 7); }
            continue;
        }
        AttnItem it{};
        if (i < 1024) {
            const int b = i >> 6, r = (i >> 1) & 31, hp = i & 1;
            it.mode = 0; it.qtok0 = b * 2048 + r * 64; it.nslots = 2; it.h0 = 2 * hp;
            { const int h = 2 * hp; it.qcol0 = C_QN + 64 * h; it.kcol0 = C_KN + 64 * h; it.vcol0 = C_VN + 64 * h; it.ocol0 = 512 + 64 * h;
              it.qcol1 = it.qcol0 + 64; it.kcol1 = it.kcol0 + 64; it.vcol1 = it.vcol0 + 64; it.ocol1 = it.ocol0 + 64; }
            it.r = r; it.rs = min(max(r - 4, 0), 24); it.nloc = 8; it.loctok0 = b * 2048 + it.rs * 64; it.ctxtok0 = TL + b * 256;
        } else if (i < 2048) {
            const int k = i - 1024, b = k >> 6, qb = (k >> 1) & 31, kvh = k & 1;
            it.mode = 1; it.qtok0 = b * 2048 + qb * 64; it.nslots = 1;
            { const int h = 2 * kvh; it.qcol0 = C_QS + 64 * h; it.ocol0 = 768 + 64 * h; it.sink0 = p.sink[l * 4 + h]; it.sink1 = p.sink[l * 4 + h + 1];
              it.qcol1 = it.qcol0 + 64; it.ocol1 = it.ocol0 + 64; it.kcol0 = it.kcol1 = C_KS + 64 * kvh; it.vcol0 = it.vcol1 = C_VS + 64 * kvh; }
            it.has_sink = 1; it.q0 = qb * 64;
            const int ks = max(qb * 64 - 128, 0), ke = min(qb * 64 + 192, 2048);
            it.kp0 = ks; it.nloc = (ke - ks) >> 6; it.loctok0 = b * 2048 + ks; it.ctxtok0 = TL + b * 256;
        } else if (i < 2176) {
            const int k = i - 2048, b = k >> 3, qb = (k >> 1) & 3, hp = k & 1;
            it.mode = 2; it.qtok0 = TL + b * 256 + qb * 64; it.nslots = 2;
            { const int h = 2 * hp; it.qcol0 = C_QN + 64 * h; it.kcol0 = C_KN + 64 * h; it.vcol0 = C_VN + 64 * h; it.ocol0 = 512 + 64 * h;
              it.qcol1 = it.qcol0 + 64; it.kcol1 = it.kcol0 + 64; it.vcol1 = it.vcol0 + 64; it.ocol1 = it.ocol0 + 64; }
            it.nloc = 0; it.ctxtok0 = TL + b * 256;
        } else {
            const int k = i - 2176, b = k >> 3, qb = (k >> 1) & 3, kvh = k & 1;
            it.mode = 2; it.qtok0 = TL + b * 256 + qb * 64; it.nslots = 1;
            { const int h = 2 * kvh; it.qcol0 = C_QS + 64 * h; it.ocol0 = 768 + 64 * h; it.sink0 = p.sink[l * 4 + h]; it.sink1 = p.sink[l * 4 + h + 1];
              it.qcol1 = it.qcol0 + 64; it.ocol1 = it.ocol0 + 64; it.kcol0 = it.kcol1 = C_KS + 64 * kvh; it.vcol0 = it.vcol1 = C_VS + 64 * kvh; }
            it.has_sink = 1; it.nloc = 0; it.ctxtok0 = TL + b * 256;
        }
        if (sub & 2) attn_item(p, lds, l, it);
    }
}

constexpr int N_PHASES = 22;
#ifndef PHMASK
#define PHMASK 0xff
#endif

__device__ __forceinline__ void run_phase(CParams& p, LAS unsigned char* lds, int ph, int sub) {
    unsigned char* ws = p.ws;
    bf16_t* YH = (bf16_t*)(ws + WS_YH); bf16_t* U = (bf16_t*)(ws + WS_R1); bf16_t* PROJ = (bf16_t*)(ws + WS_PROJ); bf16_t* YCAT = (bf16_t*)(ws + WS_YCAT);
    float* XC = (float*)(ws + WS_XC); const float* MOD = (const float*)(ws + WS_MOD);
    const int G = gridDim.x, c = obid();
    if (ph == 0) { if constexpr ((PHMASK & 1) != 0) phase0(p, lds); return; }
    if (ph == 1) {
        if constexpr ((PHMASK & 2) == 0) return;
        ew_pass(p.x, p.ctx, nullptr, nullptr, nullptr, nullptr, 0.f, nullptr, YH, p.norm_g, MOD, MOD + 1024, TA); return;
    }
    const int l = (ph - 2) / 10, k = (ph - 2) % 10;
    const float* MODL = MOD + (size_t)l * 17 * NMODC; const float* NG = p.norm_g + (size_t)l * 6 * DM;
    const int rows_late = (l == 0) ? TA : TL;
    switch (k) {
    case 0: case 7: {
        if constexpr ((PHMASK & 4) == 0) break;
        const int f = (k == 7), M = f ? rows_late : TA;
        pg8::Gemm g{YH, (const bf16_t*)(ws + WS_W13) + (size_t)(l * 2 + f) * 5632 * 1024, M, 5632, 1024, 1024, 1024};
        pg8::StaticOrder S; S.init(M, 5632, G, c); EpiSwiGLU E{U};
        pg8::gemm_phase<EpiSwiGLU, pg8::StaticOrder, true, true>(lds, g, S, E);
    } break;
    case 1: case 8: case 5: {
        if constexpr ((PHMASK & 8) == 0) break;
        const bool isout = (k == 5); const int f = (k == 8), M = (k == 1) ? TA : rows_late;
        const int Kd = isout ? YC_LD : FF;
        pg8::Gemm g{isout ? YCAT : U, isout ? (const bf16_t*)(ws + WS_WOUT) + (size_t)l * 1024 * YC_LD : (const bf16_t*)(ws + WS_W2T) + (size_t)(l * 2 + f) * 1024 * FF, M, 1024, Kd, Kd, Kd};
        pg8::StaticOrder S; S.init(M, 1024, G, c); EpiBf16Tile E{YH, 1024, 0, 256};
        pg8::gemm_phase<EpiBf16Tile, pg8::StaticOrder, true, true>(lds, g, S, E);
    } break;
    case 2: case 6: case 9: {
        if constexpr ((PHMASK & 2) == 0) break;
        const int gi = (k == 2) ? 2 : (k == 6 ? 5 : 8), ni = (k == 2) ? 1 : (k == 6 ? 3 : 5);
        const int nrows = (k == 2) ? TA : rows_late;
        const bool lastl = (k == 9 && l == 1);
        const float* gpre = (k == 2) ? NG + 2 * DM : (k == 6 ? NG + 4 * DM : p.norm_g + 6 * DM);
        const float* shift = (k == 2) ? MODL + 3 * 1024 : (k == 6 ? MODL + 6 * 1024 : MOD + 17 * NMODC);
        const float* scale = (k == 2) ? MODL + 4 * 1024 : (k == 6 ? MODL + 7 * 1024 : MOD + 17 * NMODC + 1024);
        float* outp = p.out;
        const bool first = (l == 0 && k == 2);
        ew_pass(first ? p.x : outp, first ? p.ctx : XC, outp, XC, YH, NG + ni * DM, (k == 6) ? 1.0f : 0.5f, MODL + gi * 1024, lastl ? nullptr : YH, gpre, shift, scale, nrows);
    } break;
    case 3: {
        if constexpr ((PHMASK & 16) == 0) break;
        const bf16_t* W = (const bf16_t*)(ws + WS_WIN) + (size_t)l * 2304 * 1024;
        { pg8::Gemm g{YH, W, TA, NP, 1024, 1024, 1024}; pg8::StaticOrder S; S.init(TA, NP, G, c); EpiWin E{PROJ, (const float*)(ws + WS_ROPE)};
          pg8::gemm_phase<EpiWin, pg8::StaticOrder, true, true>(lds, g, S, E); }
        { const int N = (l == 0) ? TA : TL; pg8::Gemm g{W + (size_t)1792 * 1024, YH, 512, N, 1024, 1024, 1024}; pg8::StaticOrder S; S.init(512, N, G, (c + 16) % G);
          EpiPQ E{(bf16_t*)(ws + WS_PQT), (bf16_t*)(ws + WS_PQTC)};
          pg8::gemm_phase<EpiPQ, pg8::StaticOrder, true, true>(lds, g, S, E); }
    } break;
    case 4: {
        if constexpr ((PHMASK & 32) == 0) break;
        if (sub & 1)
        for (int v = 0; v < ((l == 0) ? 4 : 2); ++v) {
            const int hs = v & 1, isc = v >> 1;
            const bf16_t* Ap = isc ? (const bf16_t*)(ws + WS_DFTC) + hs * 256 : (const bf16_t*)(ws + WS_DFT) + hs * 2048;
            const bf16_t* Bp = isc ? (const bf16_t*)(ws + WS_PQTC) + hs * 256 : (const bf16_t*)(ws + WS_PQT) + hs * 2048;
            pg8::Gemm g{Ap, Bp, isc ? 256 : 2048, 4096, isc ? 256 : 2048, isc ? DFTC_LD : DFT_LD, isc ? PQTC_LD : PQT_LD};
            pg8::StaticOrder S; S.init(g.M, g.N, G, isc ? (c + G - 16 * hs) % G : (c + G - 128 * hs) % G);
            EpiBf16Tile E{YCAT + (isc ? (size_t)TL * YC_LD : 0) + (hs ? 1024 : 256), YC_LD, isc ? 256 : 2048, 0};
            pg8::gemm_phase<EpiBf16Tile, pg8::StaticOrder, true, true>(lds, g, S, E);
        }
        if (sub & 6) mix_items(p, lds, l, sub);
    } break;
    }
}

__global__ void __launch_bounds__(512, 2) mega(Params p, int ph0, int ph1) {
    extern __shared__ __attribute__((aligned(16))) unsigned char lds_raw[];
    LAS unsigned char* lds = (LAS unsigned char*)lds_raw;
    cg::grid_group grid = cg::this_grid();
    if (ph1 < 0) grid.sync();
    volatile LAS unsigned* xst = (volatile LAS unsigned*)(lds + 131072);
    if (threadIdx.x < 4) xst[threadIdx.x] = 0u;
    __syncthreads();
    XcdBarrier xb = xcd_barrier_post((unsigned*)(p.ws + WS_BAR), xst);
    for (int ph = ph0; ph < ph1; ++ph) {
        CParams* q = (CParams*)__builtin_amdgcn_kernarg_segment_ptr(); asm volatile("" : "+s"(q));
        run_phase(*q, lds, ph, 7);
#ifdef DUPK
        { const int kind = ph == 0 ? 10 : (ph == 1 ? 11 : (ph - 2) % 10);
          if ((DUPK >> kind) & 1) { xcd_barrier(xb); run_phase(*q, lds, ph, DUPSUB); } }
#endif
        if (ph + 1 < ph1) xcd_barrier(xb);
    }
#ifdef XSYNC
    for (int i = 0; i < XSYNC; ++i) xcd_barrier(xb);
#endif
}

#ifndef ONE_LAUNCH
#define ONE_LAUNCH 1
#endif

extern "C" void kernel_launch(void* const* d_in, const int* in_sizes, int n_in, void* d_out, int out_size, void* d_ws, size_t ws_size, hipStream_t stream) {
    static int grid = 0;
    if (grid == 0) {
        if (ws_size < WS_END) { fprintf(stderr, "kernel_launch: workspace too small: %zu < %zu\n", ws_size, (size_t)WS_END); grid = -1; return; }
        int dev = 0, cus = 0, per_cu = 0;
        hipGetDevice(&dev); hipDeviceGetAttribute(&cus, hipDeviceAttributeMultiprocessorCount, dev);
        hipFuncSetAttribute((const void*)mega, hipFuncAttributeMaxDynamicSharedMemorySize, LDS_BYTES);
        hipOccupancyMaxActiveBlocksPerMultiprocessor(&per_cu, (const void*)mega, 512, LDS_BYTES);
        if (per_cu < 1) { fprintf(stderr, "kernel_launch: occupancy query says %d blocks per CU\n", per_cu); per_cu = 1; }
        (void)hipGetLastError();
        grid = cus;
    }
    if (grid < 0) return;
    (void)hipMemsetAsync((unsigned char*)d_ws + WS_BAR, 0, 3456 * 4, stream);
    Params p{};
    p.x = (const float*)d_in[0]; p.c = (const float*)d_in[1]; p.ctx = (const float*)d_in[2]; p.c_ctx = (const float*)d_in[3];
    p.w_ada = (const float*)d_in[4]; p.b_ada = (const float*)d_in[5]; p.norm_g = (const float*)d_in[6];
    p.w1 = (const float*)d_in[7]; p.w3 = (const float*)d_in[8]; p.w2 = (const float*)d_in[9]; p.w_in = (const float*)d_in[10];
    p.conv_w = (const float*)d_in[11]; p.conv_b = (const float*)d_in[12]; p.ln_g = (const float*)d_in[13]; p.ln_b = (const float*)d_in[14];
    p.nat_bias = (const float*)d_in[15]; p.sink = (const float*)d_in[16]; p.w_out = (const float*)d_in[17];
    p.out = (float*)d_out; p.ws = (unsigned char*)d_ws;
#if ONE_LAUNCH
    int ph0 = 0, ph1 = N_PHASES;
    void* args[] = {&p, &ph0, &ph1};
    hipError_t e = hipLaunchCooperativeKernel((const void*)mega, dim3(grid), dim3(512), args, LDS_BYTES, stream);
    if (e != hipSuccess) fprintf(stderr, "cooperative launch failed: %s (grid %d)\n", hipGetErrorString(e), grid);
#else
    for (int ph = 0; ph < N_PHASES; ++ph) {
        int ph0 = ph, ph1 = ph + 1;
        void* args[] = {&p, &ph0, &ph1};
        hipError_t e = hipLaunchCooperativeKernel((const void*)mega, dim3(grid), dim3(512), args, LDS_BYTES, stream);
        if (e != hipSuccess) { fprintf(stderr, "launch %d failed: %s (grid %d)\n", ph, hipGetErrorString(e), grid); break; }
    }
#endif
}
```

```cpp
#include <hip/hip_runtime.h>
#include <hip/hip_cooperative_groups.h>
#include <cstdio>
#include <cstdint>
namespace cg = cooperative_groups;
namespace pg8 {
#define PG8_LAS __attribute__((address_space(3)))
typedef unsigned short bf16_t;
typedef short bf16x8 __attribute__((ext_vector_type(8)));
typedef float f32x4 __attribute__((ext_vector_type(4)));
typedef unsigned u32x4 __attribute__((ext_vector_type(4)));
constexpr int BM = 256, BK = 64, HALF = 128, HTB = HALF * BK * 2  , STAGE_BYTES = 8 * HTB, NXCD = 8, WGM = 8;

__host__ __device__ __forceinline__ int lds_byte(int r, int c) { const int st = (r >> 4) * 2 + (c >> 5), rr = r & 15, cc = c & 31, ob = rr * 64 + cc * 2; return st * 1024 + (ob ^ (((ob >> 9) & 1) << 5)); }
__host__ __device__ __forceinline__ void stage_rc(int b, int& R, int& C) { const int st = b / 1024, sb = b % 1024, swz = sb ^ (((sb >> 9) & 1) << 5); R = (st >> 1) * 16 + swz / 64; C = (st & 1) * 32 + (swz % 64) / 2; }
__host__ __device__ __forceinline__ int perm32(int rho) { const int n = rho >> 4, i = rho & 15; return 8 * (i >> 2) + 4 * n + (i & 3); }

struct Unit { int pm, pn; };
struct Gemm { const bf16_t* A; const bf16_t* Bt; int M, N, K, lda, ldb; };

struct StaticOrder {
    int nM, nN, nwg, G, c;
    __host__ __device__ void init(int M, int N, int G_, int c_) { nM = M / BM; nN = N / BM; nwg = nM * nN; G = G_; c = c_; }
    __host__ __device__ bool next(int i, Unit& u) const {
        const long L = (long)i * G + c; if (L >= nwg) return false;
        int wgid = (int)L; { const int q = nwg / NXCD, r = nwg % NXCD, xcd = wgid % NXCD, off = wgid / NXCD; wgid = (xcd < r ? xcd * (q + 1) : r * (q + 1) + (xcd - r) * q) + off; }
        const int nig = WGM * nN, gid = wgid / nig, fm = gid * WGM, gsz = (nM - fm) < WGM ? (nM - fm) : WGM;
        u.pm = fm + ((wgid % nig) % gsz); u.pn = (wgid % nig) / gsz; return true;
    }
    __device__ __forceinline__ void a_ready(const Unit&) const {}
    __device__ __forceinline__ void done(const Unit&) const {}
};
__device__ __forceinline__ unsigned cvt_pk_bf16(float lo, float hi) { unsigned r; asm volatile("v_cvt_pk_bf16_f32 %0, %1, %2" : "=v"(r) : "v"(lo), "v"(hi)); return r; }
typedef float f32x2 __attribute__((ext_vector_type(2)));
template <class Epi, class Sched, bool ALIGN_EPI = false, bool SP2 = false>
__device__ __forceinline__ void gemm_phase(PG8_LAS unsigned char* lds, const Gemm g, const Sched& S, const Epi& E) {
    int tid_ = threadIdx.x; asm volatile("" : "+v"(tid_));
    const int tid = tid_, wid = __builtin_amdgcn_readfirstlane(tid >> 6), lane = tid & 63, wr = wid >> 2, wc = wid & 3, fr = lane & 15, fq = lane >> 4;
    const int K = g.K, nt = K / BK;
    unsigned voffA[2], voffB[2];
#pragma unroll
    for (int i = 0; i < 2; ++i) { int R, C; stage_rc(tid * 16 + i * 8192, R, C); const int Rb = Epi::PERM ? ((R & ~31) + perm32(R & 31)) : R;
        voffA[i] = (unsigned)(R * g.lda + C) * 2u; voffB[i] = (unsigned)(Rb * g.ldb + C) * 2u; }
    const size_t kstep = (size_t)(BK * 2);
    const size_t hstepA = (size_t)HALF * g.lda * 2, hstepB = (size_t)HALF * g.ldb * 2;
    const size_t tstepA = 2 * hstepA, tstepB = 2 * hstepB;
    const unsigned ldsw = (unsigned)wid * 1024u;
    const int aoff = lds_byte(wr * 64 + fr, fq * 8), boff = lds_byte(wc * 32 + fr, fq * 8);
#define PG8_SA(b, h) (((b) * 2 + (h)) * HTB)
#define PG8_SB(b, h) ((4 + (b) * 2 + (h)) * HTB)
#define PG8_STAGE(bufoff, gbase, voff) do { _Pragma("unroll") for (int _i = 0; _i < 2; ++_i) \
        __builtin_amdgcn_global_load_lds((const unsigned*)((const char*)(gbase) + (voff)[_i]), (PG8_LAS unsigned*)(lds + (bufoff) + ldsw + _i * 8192), 16, 0, 0); } while (0)
#define PG8_LDA(dst, b, h) do { _Pragma("unroll") for (int m = 0; m < 4; ++m) _Pragma("unroll") for (int k = 0; k < 2; ++k) dst[m][k] = *(const PG8_LAS bf16x8*)(lds + PG8_SA(b, h) + aoff + m * 2048 + k * 1024); } while (0)
#define PG8_LDB(dst, b, h) do { _Pragma("unroll") for (int n = 0; n < 2; ++n) _Pragma("unroll") for (int k = 0; k < 2; ++k) dst[n][k] = *(const PG8_LAS bf16x8*)(lds + PG8_SB(b, h) + boff + n * 2048 + k * 1024); } while (0)
#define PG8_MMA(ai, bj, At, Bt) do { __builtin_amdgcn_s_setprio(1); _Pragma("unroll") for (int m = 0; m < 4; ++m) _Pragma("unroll") for (int n = 0; n < 2; ++n) _Pragma("unroll") for (int k = 0; k < 2; ++k) \
        acc[ai][bj][m][n] = __builtin_amdgcn_mfma_f32_16x16x32_bf16(Bt[n][k], At[m][k], acc[ai][bj][m][n], 0, 0, 0); __builtin_amdgcn_s_setprio(0); } while (0)
#define PG8_WAIT_V(n) asm volatile("s_waitcnt vmcnt(" #n ")" ::: "memory")
#define PG8_WAIT_L(n) asm volatile("s_waitcnt lgkmcnt(" #n ")" ::: "memory")
#define PG8_BAR __builtin_amdgcn_s_barrier()
#define PG8_SCHED __builtin_amdgcn_sched_barrier(0)
    Unit cur, nxt; int ui = 0;
    if (!S.next(0, cur)) return;
    f32x4 acc[2][2][4][2];
#pragma unroll
    for (int a = 0; a < 2; ++a)
#pragma unroll
        for (int b = 0; b < 2; ++b)
#pragma unroll
            for (int m = 0; m < 4; ++m)
#pragma unroll
                for (int n = 0; n < 2; ++n) acc[a][b][m][n] = (f32x4){0.f, 0.f, 0.f, 0.f};
    bf16x8 At[4][2], B0[2][2], B1[2][2];
    const char* cA = (const char*)g.A + (size_t)cur.pm * tstepA; const char* cB = (const char*)g.Bt + (size_t)cur.pn * tstepB;
    S.a_ready(cur);
    if constexpr (SP2) {
        PG8_STAGE(PG8_SB(0, 0), cB, voffB); PG8_STAGE(PG8_SB(0, 1), cB + hstepB, voffB); PG8_STAGE(PG8_SA(0, 0), cA, voffA); PG8_STAGE(PG8_SA(0, 1), cA + hstepA, voffA);
        if (wr == 1) PG8_BAR;
        PG8_WAIT_V(2); PG8_BAR;
        PG8_STAGE(PG8_SB(1, 0), cB + kstep, voffB); PG8_STAGE(PG8_SA(1, 0), cA + kstep, voffA); PG8_STAGE(PG8_SB(1, 1), cB + hstepB + kstep, voffB);
        PG8_WAIT_V(6); PG8_BAR;
    } else {
        PG8_STAGE(PG8_SB(0, 0), cB, voffB); PG8_STAGE(PG8_SA(0, 0), cA, voffA); PG8_STAGE(PG8_SB(0, 1), cB + hstepB, voffB); PG8_STAGE(PG8_SA(0, 1), cA + hstepA, voffA);
        if (wr == 1) PG8_BAR;
        PG8_WAIT_V(4); PG8_BAR;
        PG8_STAGE(PG8_SB(1, 0), cB + kstep, voffB); PG8_STAGE(PG8_SA(1, 0), cA + kstep, voffA); PG8_STAGE(PG8_SB(1, 1), cB + hstepB + kstep, voffB);
        PG8_WAIT_V(6); PG8_BAR;
    }
    for (;;) {
        const bool has_next = S.next(ui + 1, nxt);
        const char* nA = has_next ? (const char*)g.A + (size_t)nxt.pm * tstepA : cA; const char* nB = has_next ? (const char*)g.Bt + (size_t)nxt.pn * tstepB : cB;
        for (int t = 0; t < nt; t += 2) {
            const bool last = (t == nt - 2);
            const char* a1 = cA + (size_t)(t + 1) * kstep;
            const char* a2 = last ? nA : cA + (size_t)(t + 2) * kstep; const char* b2 = last ? nB : cB + (size_t)(t + 2) * kstep;
            const char* a3 = a2 + kstep; const char* b3 = b2 + kstep;
            if (last && has_next) S.a_ready(nxt);
            if constexpr (SP2) {
            PG8_LDB(B0, 0, 0); PG8_LDB(B1, 0, 1); PG8_SCHED; PG8_LDA(At, 0, 0); PG8_STAGE(PG8_SA(1, 1), a1 + hstepA, voffA);
            PG8_WAIT_V(8); PG8_WAIT_L(0); PG8_BAR; PG8_MMA(0, 0, At, B0); PG8_MMA(0, 1, At, B1); PG8_BAR; PG8_SCHED;
            PG8_LDA(At, 0, 1); PG8_STAGE(PG8_SB(0, 0), b2, voffB); PG8_STAGE(PG8_SB(0, 1), b2 + hstepB, voffB); PG8_STAGE(PG8_SA(0, 0), a2, voffA);
            PG8_WAIT_V(8); PG8_WAIT_L(0); PG8_BAR; PG8_MMA(1, 0, At, B0); PG8_MMA(1, 1, At, B1); PG8_BAR; PG8_SCHED;
            PG8_LDB(B0, 1, 0); PG8_LDB(B1, 1, 1); PG8_SCHED; PG8_LDA(At, 1, 0); PG8_STAGE(PG8_SA(0, 1), a2 + hstepA, voffA);
            PG8_WAIT_V(8); PG8_WAIT_L(0); PG8_BAR; PG8_MMA(0, 0, At, B0); PG8_MMA(0, 1, At, B1); PG8_BAR; PG8_SCHED;
            PG8_LDA(At, 1, 1); PG8_STAGE(PG8_SB(1, 0), b3, voffB); PG8_STAGE(PG8_SB(1, 1), b3 + hstepB, voffB); PG8_STAGE(PG8_SA(1, 0), a3, voffA);
            PG8_WAIT_V(8); PG8_WAIT_L(0); PG8_BAR; PG8_MMA(1, 0, At, B0); PG8_MMA(1, 1, At, B1); PG8_BAR; PG8_SCHED;
            } else {
            PG8_LDB(B0, 0, 0); PG8_SCHED; PG8_LDA(At, 0, 0); PG8_STAGE(PG8_SA(1, 1), a1 + hstepA, voffA);
            PG8_WAIT_L(8); PG8_BAR; PG8_WAIT_L(0); PG8_MMA(0, 0, At, B0); PG8_BAR; PG8_SCHED;
            PG8_LDB(B1, 0, 1); PG8_STAGE(PG8_SB(0, 0), b2, voffB);
            PG8_BAR; PG8_WAIT_L(0); PG8_MMA(0, 1, At, B1); PG8_BAR;
            PG8_LDA(At, 0, 1); PG8_STAGE(PG8_SA(0, 0), a2, voffA);
            PG8_BAR; PG8_WAIT_L(0); PG8_MMA(1, 0, At, B0); PG8_BAR; PG8_SCHED;
            PG8_STAGE(PG8_SB(0, 1), b2 + hstepB, voffB);
            PG8_WAIT_V(6); PG8_BAR; PG8_MMA(1, 1, At, B1); PG8_BAR;
            PG8_LDB(B0, 1, 0); PG8_SCHED; PG8_LDA(At, 1, 0); PG8_STAGE(PG8_SA(0, 1), a2 + hstepA, voffA);
            PG8_WAIT_L(8); PG8_BAR; PG8_WAIT_L(0); PG8_MMA(0, 0, At, B0); PG8_BAR; PG8_SCHED;
            PG8_LDB(B1, 1, 1); PG8_STAGE(PG8_SB(1, 0), b3, voffB);
            PG8_BAR; PG8_WAIT_L(0); PG8_MMA(0, 1, At, B1); PG8_BAR;
            PG8_LDA(At, 1, 1); PG8_STAGE(PG8_SA(1, 0), a3, voffA);
            PG8_BAR; PG8_WAIT_L(0); PG8_MMA(1, 0, At, B0); PG8_BAR; PG8_SCHED;
            PG8_STAGE(PG8_SB(1, 1), b3 + hstepB, voffB);
            PG8_WAIT_V(6); PG8_BAR; PG8_MMA(1, 1, At, B1); PG8_BAR;
            }
        }
        if constexpr (ALIGN_EPI) { if (wr == 0) PG8_BAR; }
        if constexpr (!Epi::AFTER_DRAIN) { E(acc, cur, wr, wc, fr, fq); S.done(cur); }
        if (!has_next) break;
#pragma unroll
        for (int a = 0; a < 2; ++a)
#pragma unroll
            for (int b = 0; b < 2; ++b)
#pragma unroll
                for (int m = 0; m < 4; ++m)
#pragma unroll
                    for (int n = 0; n < 2; ++n) acc[a][b][m][n] = (f32x4){0.f, 0.f, 0.f, 0.f};
        cur = nxt; cA = nA; cB = nB; ++ui;
        if constexpr (ALIGN_EPI) { if (wr == 1) PG8_BAR; }
    }
    PG8_WAIT_V(0);
    if constexpr (!ALIGN_EPI) { if (wr == 0) PG8_BAR; }
    PG8_BAR;
    if constexpr (Epi::AFTER_DRAIN) { E.fused(acc, cur, wr, wc, fr, fq, lds, wid, lane); S.done(cur); }
#undef PG8_SA
#undef PG8_SB
#undef PG8_STAGE
#undef PG8_LDA
#undef PG8_LDB
#undef PG8_MMA
#undef PG8_WAIT_V
#undef PG8_WAIT_L
#undef PG8_BAR
#undef PG8_SCHED
}
}

#define LAS __attribute__((address_space(3)))
typedef unsigned short bf16_t;
typedef float f32x4 __attribute__((ext_vector_type(4)));
typedef float f32x2 __attribute__((ext_vector_type(2)));
typedef unsigned u32x4 __attribute__((ext_vector_type(4)));
typedef unsigned u32x2 __attribute__((ext_vector_type(2)));
typedef short bf16x8 __attribute__((ext_vector_type(8)));
typedef short bf16x4 __attribute__((ext_vector_type(4)));

constexpr int TL = 32768, TC = 4096, TA = 36864, DM = 1024, FF = 2816, NP = 1792, NMODC = 9216;
constexpr int YC_LD = 1280, DFT_LD = 4160, PQT_LD = 4160, DFTC_LD = 576, PQTC_LD = 576;
constexpr int LDS_BYTES = 131072 + 16;
#ifndef MIXMASK
#define MIXMASK 7
#endif
constexpr float EPSV = 1e-6f;
constexpr float LOG2E = 1.4426950408889634f;

constexpr size_t WS_XC   = 0;
constexpr size_t WS_YH   = WS_XC + (size_t)TC * DM * 4;
constexpr size_t WS_R1   = WS_YH + (size_t)TA * DM * 2;
constexpr size_t WS_PROJ = WS_R1;
constexpr size_t WS_PQT  = WS_PROJ + (size_t)TA * NP * 2;
constexpr size_t WS_PQTC = WS_PQT + (size_t)4096 * PQT_LD * 2;
constexpr size_t WS_YCAT = WS_PQTC + (size_t)4096 * PQTC_LD * 2;
constexpr size_t WS_R1END= WS_YCAT + (size_t)TA * YC_LD * 2;
constexpr size_t WS_W13  = WS_R1END;
constexpr size_t WS_W2T  = WS_W13 + (size_t)4 * 5632 * 1024 * 2;
constexpr size_t WS_WIN  = WS_W2T + (size_t)4 * 1024 * 2816 * 2;
constexpr size_t WS_WOUT = WS_WIN + (size_t)2 * 2304 * 1024 * 2;
constexpr size_t WS_DFT  = WS_WOUT + (size_t)2 * 1024 * YC_LD * 2;
constexpr size_t WS_DFTC = WS_DFT + (size_t)2048 * DFT_LD * 2;
constexpr size_t WS_MOD  = WS_DFTC + (size_t)256 * DFTC_LD * 2;
constexpr size_t WS_ROPE = WS_MOD + (size_t)2 * 17 * NMODC * 4;
constexpr size_t WS_BAR  = WS_ROPE + 64 * 16 * 2 * 4;
constexpr size_t WS_END  = WS_BAR + 3456 * 4;
static_assert((size_t)TA * FF * 2 <= WS_R1END - WS_R1, "U must fit in R1");

struct Params {
    const float *x, *c, *ctx, *c_ctx, *w_ada, *b_ada, *norm_g, *w1, *w3, *w2, *w_in, *conv_w, *conv_b, *ln_g, *ln_b, *nat_bias, *sink, *w_out;
    float* out; unsigned char* ws;
};
typedef const __attribute__((address_space(4))) Params CParams;

__device__ __forceinline__ unsigned pk2(float lo, float hi) { return pg8::cvt_pk_bf16(lo, hi); }
__device__ __forceinline__ float bflo(unsigned v) { return __uint_as_float(v << 16); }
__device__ __forceinline__ float bfhi(unsigned v) { return __uint_as_float(v & 0xffff0000u); }
__device__ __forceinline__ float wave_sum(float v) {
#pragma unroll
    for (int o = 1; o < 64; o <<= 1) v += __shfl_xor(v, o);
    return v;
}
__device__ __forceinline__ int otid() { int t = threadIdx.x; asm volatile("" : "+v"(t)); return t; }
__device__ __forceinline__ int obid() { int t = blockIdx.x; asm volatile("" : "+s"(t)); return t; }
__device__ __forceinline__ float fast_exp2(float x) { return __builtin_amdgcn_exp2f(x); }
__device__ __forceinline__ float fast_rcp(float x) { return __builtin_amdgcn_rcpf(x); }
__device__ __forceinline__ float silu_f(float v) { return v * fast_rcp(1.0f + fast_exp2(-v * LOG2E)); }
__device__ __forceinline__ float sigmoid_f(float v) { return fast_rcp(1.0f + fast_exp2(-v * LOG2E)); }

#define XB_TMO      128
#define XB_XCNT(j)  (256  + 64 * (j))
#define XB_XSUB(j)  (1280 + 64 * (j))
#define XB_XGEN(j)  (2304 + 64 * (j))
#define XB_TOP      3328
#define XB_TOPGEN   3392
#define XCD_BAR_WORDS 3456
#define XB_SPIN_CAP (1u << 18)

__device__ __forceinline__ unsigned xb_ld(unsigned* p)              { return __hip_atomic_load(p, __ATOMIC_RELAXED, __HIP_MEMORY_SCOPE_AGENT); }
__device__ __forceinline__ unsigned xb_add(unsigned* p, unsigned v) { return __hip_atomic_fetch_add(p, v, __ATOMIC_RELAXED, __HIP_MEMORY_SCOPE_AGENT); }
__device__ __forceinline__ unsigned xb_xcc_id() { return (unsigned)__builtin_amdgcn_s_getreg((3 << 11) | 20) & 0xFu; }
#define XB_SPIN(cond, bar) do { unsigned _sp = 0; while (cond) { __builtin_amdgcn_s_sleep(1); \
    if ((++_sp & 255u) == 0u) { if (xb_ld(&(bar)[XB_TMO])) break; if (_sp > XB_SPIN_CAP) { atomicAdd(&(bar)[XB_TMO], 1u); break; } } } } while (0)

struct XcdBarrier {
    unsigned* bar; unsigned x;
    volatile LAS unsigned* st;
};

__device__ __forceinline__ XcdBarrier xcd_barrier_post(unsigned* bar, volatile LAS unsigned* st) {
    XcdBarrier b; b.bar = bar; b.x = xb_xcc_id(); b.st = st;
    if (threadIdx.x == 0) (void)xb_add(&bar[XB_XCNT(b.x)], 1u);
    return b;
}
__device__ __forceinline__ void xcd_barrier_complete(unsigned* bar, unsigned x, unsigned& nloc, unsigned& nx) {
    const unsigned G = gridDim.x * gridDim.y * gridDim.z;
    unsigned sum, cnt, mine, sp = 0u;
    for (;;) {
        sum = 0u; cnt = 0u; mine = 0u;
#pragma unroll
        for (unsigned j = 0; j < 16; ++j) { const unsigned c = xb_ld(&bar[XB_XCNT(j)]); sum += c; cnt += (c > 0u) ? 1u : 0u; mine = (j == x) ? c : mine; }
        if (sum == G) break;
        __builtin_amdgcn_s_sleep(1);
        if ((++sp & 255u) == 0u) { if (xb_ld(&bar[XB_TMO])) break; if (sp > XB_SPIN_CAP) { atomicAdd(&bar[XB_TMO], 1u); break; } }
    }
    nloc = mine > 0u ? mine : 1u; nx = cnt > 0u ? cnt : 1u;
}

__device__ __forceinline__ void xcd_barrier(const XcdBarrier& b) {
    asm volatile("s_waitcnt vmcnt(0)" ::: "memory");
    __syncthreads();
    if (threadIdx.x == 0) {
        unsigned* bar = b.bar;
        __builtin_amdgcn_s_waitcnt(0);
        unsigned nloc = b.st[0], nx = b.st[1];
        if (nloc == 0u) { xcd_barrier_complete(bar, b.x, nloc, nx); b.st[0] = nloc; b.st[1] = nx; }
        const unsigned old = xb_add(&bar[XB_XSUB(b.x)], 1u);
        const unsigned gen = old / nloc;
        if (old + 1u == (gen + 1u) * nloc) {
            __builtin_amdgcn_fence(__ATOMIC_RELEASE, "agent");
            asm volatile("s_waitcnt vmcnt(0)" ::: "memory");
            const unsigned og = xb_add(&bar[XB_TOP], 1u);
            const unsigned tg = og / nx;
            if (og + 1u == (tg + 1u) * nx) xb_add(&bar[XB_TOPGEN], 1u);
            else XB_SPIN(xb_ld(&bar[XB_TOPGEN]) == tg, bar);
            __builtin_amdgcn_fence(__ATOMIC_ACQUIRE, "agent");
            xb_add(&bar[XB_XGEN(b.x)], 1u);
            asm volatile("s_waitcnt vmcnt(0)" ::: "memory");
        } else {
            XB_SPIN(xb_ld(&bar[XB_XGEN(b.x)]) == gen, bar);
            __builtin_amdgcn_fence(__ATOMIC_ACQUIRE, "agent");
            asm volatile("s_waitcnt vmcnt(0)" ::: "memory");
        }
    }
    __syncthreads();
}


struct EpiSwiGLU {
    static constexpr bool PERM = true, AFTER_DRAIN = false;
    bf16_t* U;
    __device__ __forceinline__ void operator()(const f32x4 (&acc)[2][2][4][2], const pg8::Unit& u, int wr, int wc, int fr, int fq) const {
        const int row0 = u.pm * 256 + wr * 64 + fr, col0 = u.pn * 128 + wc * 32 + 8 * fq;
#pragma unroll
        for (int ai = 0; ai < 2; ++ai)
#pragma unroll
            for (int m = 0; m < 4; ++m) {
                bf16_t* rowp = U + (size_t)(row0 + ai * 128 + m * 16) * FF + col0;
                float v[8];
#pragma unroll
                for (int n = 0; n < 2; ++n)
#pragma unroll
                    for (int j = 0; j < 4; ++j) v[n * 4 + j] = silu_f(acc[ai][0][m][n][j]) * acc[ai][1][m][n][j];
                u32x4 w; w.x = pk2(v[0], v[1]); w.y = pk2(v[2], v[3]); w.z = pk2(v[4], v[5]); w.w = pk2(v[6], v[7]);
                *(u32x4*)rowp = w;
            }
    }
};
struct EpiBf16Tile {
    static constexpr bool PERM = true, AFTER_DRAIN = false;
    bf16_t* O; int ldc, row_pn, col_pn;
    __device__ __forceinline__ void operator()(const f32x4 (&acc)[2][2][4][2], const pg8::Unit& u, int wr, int wc, int fr, int fq) const {
        const int row0 = u.pm * 256 + u.pn * row_pn + wr * 64 + fr, col0 = u.pn * col_pn + wc * 32 + 8 * fq;
#pragma unroll
        for (int ai = 0; ai < 2; ++ai)
#pragma unroll
            for (int m = 0; m < 4; ++m) {
                bf16_t* rowp = O + (size_t)(row0 + ai * 128 + m * 16) * ldc + col0;
#pragma unroll
                for (int bj = 0; bj < 2; ++bj) {
                    const f32x4 v0 = acc[ai][bj][m][0], v1 = acc[ai][bj][m][1];
                    u32x4 w; w.x = pk2(v0[0], v0[1]); w.y = pk2(v0[2], v0[3]); w.z = pk2(v1[0], v1[1]); w.w = pk2(v1[2], v1[3]);
                    *(u32x4*)(rowp + bj * 128) = w;
                }
            }
    }
};
struct EpiPQ {
    static constexpr bool PERM = true, AFTER_DRAIN = false;
    bf16_t* PQT; bf16_t* PQTC;
    __device__ __forceinline__ void operator()(const f32x4 (&acc)[2][2][4][2], const pg8::Unit& u, int wr, int wc, int fr, int fq) const {
        const int cl = wc * 32 + 8 * fq;
#pragma unroll
        for (int ai = 0; ai < 2; ++ai)
#pragma unroll
            for (int m = 0; m < 4; ++m) {
                const int mp = u.pm * 256 + ai * 128 + wr * 64 + m * 16 + fr;
                const int g = mp >> 7, pq = (mp >> 6) & 1, cp = mp & 63;
                bf16_t* rowp;
                if (u.pn < 128) { const int b = u.pn >> 3, n0 = (u.pn & 7) * 256; rowp = PQT + (size_t)(b * 256 + g * 64 + cp) * PQT_LD + pq * 2048 + n0 + cl; }
                else { const int b = u.pn - 128; rowp = PQTC + (size_t)(b * 256 + g * 64 + cp) * PQTC_LD + pq * 256 + cl; }
#pragma unroll
                for (int bj = 0; bj < 2; ++bj) {
                    const f32x4 v0 = acc[ai][bj][m][0], v1 = acc[ai][bj][m][1];
                    u32x4 w; w.x = pk2(v0[0], v0[1]); w.y = pk2(v0[2], v0[3]); w.z = pk2(v1[0], v1[1]); w.w = pk2(v1[2], v1[3]);
                    *(u32x4*)(rowp + bj * 128) = w;
                }
            }
    }
};
struct EpiWin {
    static constexpr bool PERM = false, AFTER_DRAIN = false;
    bf16_t* P; const float* rope;
    __device__ __forceinline__ void operator()(const f32x4 (&acc)[2][2][4][2], const pg8::Unit& u, int wr, int wc, int fr, int fq) const {
        const int row0 = u.pm * 256 + wr * 64 + fr, col0 = u.pn * 256 + wc * 32 + 4 * fq;
        const float qs = (u.pn == 2 || u.pn == 5) ? 0.125f : 1.0f;
        const bool lat = u.pm < 128;
#pragma unroll
        for (int ai = 0; ai < 2; ++ai)
#pragma unroll
            for (int m = 0; m < 4; ++m) {
                const int r = row0 + ai * 128 + m * 16;
                bf16_t* rowp = P + (size_t)r * NP + col0;
                const int t = r & 2047;
                const int pos = (wc & 1) ? (t & 63) : (t >> 6);
#pragma unroll
                for (int bj = 0; bj < 2; ++bj) {
                    f32x4 v0 = acc[ai][bj][m][0], v1 = acc[ai][bj][m][1];
                    const bool dorope = lat && (u.pn == 5 || (u.pn == 6 && bj == 0));
                    if (dorope) {
                        const f32x4 cs0 = *(const f32x4*)(rope + (pos * 16 + 4 * fq) * 2), cs1 = *(const f32x4*)(rope + (pos * 16 + 4 * fq) * 2 + 4);
                        const float c0 = cs0[0], s0 = cs0[1], c1 = cs0[2], s1 = cs0[3], c2 = cs1[0], s2 = cs1[1], c3 = cs1[2], s3 = cs1[3];
                        f32x4 a, b;
                        a[0] = v0[0] * c0 - v1[0] * s0; b[0] = v0[0] * s0 + v1[0] * c0;
                        a[1] = v0[1] * c1 - v1[1] * s1; b[1] = v0[1] * s1 + v1[1] * c1;
                        a[2] = v0[2] * c2 - v1[2] * s2; b[2] = v0[2] * s2 + v1[2] * c2;
                        a[3] = v0[3] * c3 - v1[3] * s3; b[3] = v0[3] * s3 + v1[3] * c3;
                        v0 = a; v1 = b;
                    }
                    v0 = v0 * qs; v1 = v1 * qs;
                    u32x2 w0, w1; w0.x = pk2(v0[0], v0[1]); w0.y = pk2(v0[2], v0[3]); w1.x = pk2(v1[0], v1[1]); w1.y = pk2(v1[2], v1[3]);
                    *(u32x2*)(rowp + bj * 128) = w0; *(u32x2*)(rowp + bj * 128 + 16) = w1;
                }
            }
    }
};

struct TrItem { const float* src; bf16_t* dst; int ld_src, ld_dst; };
__device__ __forceinline__ TrItem tr_decode(CParams& p, int it) {
    constexpr int PER_L = 2 * 704 + 2 * 352 + 224 + 160;
    unsigned char* ws = p.ws;
    const int l = it / PER_L; int q = it % PER_L;
    const float* src; bf16_t* dst; int ld_src, ld_dst, col0, k0, r0;
    if (q < 2 * 704) { const int f = q / 704; q %= 704; const int rt = q >> 4, kt = q & 15, R0 = rt * 128, tile = R0 >> 8, bj = (R0 >> 7) & 1;
        src = (bj ? p.w3 : p.w1) + (size_t)(l * 2 + f) * 1024 * FF; ld_src = FF; col0 = 128 * tile; k0 = 64 * kt; dst = (bf16_t*)(ws + WS_W13) + (size_t)(l * 2 + f) * 5632 * 1024; r0 = R0; ld_dst = 1024; }
    else if (q < 2 * 704 + 2 * 352) { q -= 2 * 704; const int f = q / 352; q %= 352; const int rt = q / 44, kt = q % 44;
        src = p.w2 + (size_t)(l * 2 + f) * FF * 1024; ld_src = 1024; col0 = 128 * rt; k0 = 64 * kt; dst = (bf16_t*)(ws + WS_W2T) + (size_t)(l * 2 + f) * 1024 * FF; r0 = 128 * rt; ld_dst = FF; }
    else if (q < 2 * 704 + 2 * 352 + 224) { q -= 2 * 704 + 2 * 352; const int rt = q >> 4, kt = q & 15, R0 = rt * 128;
        src = p.w_in + (size_t)l * 1024 * 2048; ld_src = 2048; col0 = R0 < 512 ? R0 : R0 + 256; k0 = 64 * kt; dst = (bf16_t*)(ws + WS_WIN) + (size_t)l * 2304 * 1024; r0 = R0; ld_dst = 1024; }
    int ks = -1;
    if (q >= 2 * 704 + 2 * 352 + 224) { q -= 2 * 704 + 2 * 352 + 224; const int rt = q / 20, kt = q % 20;
        src = p.w_out + (size_t)l * 1024 * 1024; ld_src = 1024; col0 = 128 * rt; k0 = 64 * kt; ks = kt < 16 ? 64 * kt : 256 + 64 * (kt - 16); dst = (bf16_t*)(ws + WS_WOUT) + (size_t)l * 1024 * YC_LD; r0 = 128 * rt; ld_dst = YC_LD; }
    if (ks < 0) ks = k0;
    TrItem t; t.src = src + (size_t)ks * ld_src + col0; t.dst = dst + (size_t)r0 * ld_dst + k0; t.ld_src = ld_src; t.ld_dst = ld_dst; return t;
}

__device__ __forceinline__ void phase0(CParams& p, LAS unsigned char* lds) {
    const int tid = otid(), wave = tid >> 6, lane = tid & 63;
    unsigned char* ws = p.ws;
    const int bid = obid(), G = gridDim.x;
    if (bid < 288) {
        LAS float* sS = (LAS float*)lds;
        LAS float* sR = sS + 17 * 1024;
        for (int i = tid; i < 17 * 1024; i += 512) { const float v = (i < 16384) ? p.c[i] : p.c_ctx[i - 16384]; sS[i] = v / (1.0f + __expf(-v)); }
        __syncthreads();
        for (int r = bid; r < 288; r += G) {
            const int l = r / 144, j0 = (r % 144) * 64, k0 = wave * 128;
            float acc[17];
#pragma unroll
            for (int q = 0; q < 17; ++q) acc[q] = 0.f;
            const float* wp = p.w_ada + ((size_t)l * 1024 + k0) * NMODC + j0 + lane;
#pragma unroll 1
            for (int kb = 0; kb < 128; kb += 16) {
                float wv[16];
#pragma unroll
                for (int kk = 0; kk < 16; ++kk) wv[kk] = wp[(size_t)(kb + kk) * NMODC];
#pragma unroll
                for (int kk = 0; kk < 16; ++kk)
#pragma unroll
                    for (int q = 0; q < 17; ++q) acc[q] += sS[q * 1024 + k0 + kb + kk] * wv[kk];
            }
#pragma unroll
            for (int q = 0; q < 17; ++q) sR[(wave * 17 + q) * 64 + lane] = acc[q];
            __syncthreads();
            float* MOD = (float*)(ws + WS_MOD);
            for (int o = tid; o < 17 * 64; o += 512) {
                const int q = o >> 6, ln = o & 63; float s = p.b_ada[l * NMODC + j0 + ln];
#pragma unroll
                for (int w = 0; w < 8; ++w) s += sR[(w * 17 + q) * 64 + ln];
                MOD[(size_t)(l * 17 + q) * NMODC + j0 + ln] = s;
            }
            __syncthreads();
        }
    }
    {
        constexpr int N_TR = 2 * (2 * 704 + 2 * 352 + 224 + 160);
        LAS float* t = (LAS float*)lds;
        const int lk = tid >> 5, lc = (tid & 31) * 4;
        const int sr = tid >> 2, sk = (tid & 3) * 16;
        int it = bid; f32x4 pre[4]; TrItem cur;
        if (it < N_TR) { cur = tr_decode(p, it);
#pragma unroll
            for (int i = 0; i < 4; ++i) pre[i] = *(const f32x4*)(cur.src + (size_t)(lk + 16 * i) * cur.ld_src + lc); }
        while (it < N_TR) {
#pragma unroll
            for (int i = 0; i < 4; ++i) { LAS float* d = t + (lk + 16 * i) * 129 + lc; d[0] = pre[i][0]; d[1] = pre[i][1]; d[2] = pre[i][2]; d[3] = pre[i][3]; }
            __syncthreads();
            bf16_t* dp = cur.dst + (size_t)sr * cur.ld_dst + sk;
            const int nxt = it + G;
            if (nxt < N_TR) { cur = tr_decode(p, nxt);
#pragma unroll
                for (int i = 0; i < 4; ++i) pre[i] = *(const f32x4*)(cur.src + (size_t)(lk + 16 * i) * cur.ld_src + lc); }
            { const LAS float* s = t + sk * 129 + sr;
              u32x4 o0, o1;
              o0.x = pk2(s[0 * 129], s[1 * 129]); o0.y = pk2(s[2 * 129], s[3 * 129]); o0.z = pk2(s[4 * 129], s[5 * 129]); o0.w = pk2(s[6 * 129], s[7 * 129]);
              o1.x = pk2(s[8 * 129], s[9 * 129]); o1.y = pk2(s[10 * 129], s[11 * 129]); o1.z = pk2(s[12 * 129], s[13 * 129]); o1.w = pk2(s[14 * 129], s[15 * 129]);
              *(u32x4*)dp = o0; *(u32x4*)(dp + 8) = o1; }
            __syncthreads();
            it = nxt;
        }
    }
    for (int r = bid; r < 256; r += G) {
        const int l = r >> 7, k0 = (r & 127) * 8;
        LAS float* sW = (LAS float*)lds;
        LAS float* sC = sW + 2048;
        for (int i = tid; i < 2048; i += 512) { const int kk = i >> 8, cc = i & 255; sW[i] = p.w_in[((size_t)l * 1024 + k0 + kk) * 2048 + 512 + cc]; }
        if (tid < 64) sC[tid] = cospif((float)tid * (1.0f / 32.0f));
        __syncthreads();
        const int g = tid >> 7, j = tid & 127, jj = j & 63, isS = j >> 6;
        float acc[8];
#pragma unroll
        for (int q = 0; q < 8; ++q) acc[q] = 0.f;
        for (int c = 0; c < 64; ++c) {
            const int mm = (c * jj) & 63; const float tv = sC[isS ? ((mm - 16) & 63) : mm];
#pragma unroll
            for (int q = 0; q < 8; ++q) acc[q] += sW[q * 256 + g * 64 + c] * tv;
        }
        u32x4 o; o.x = pk2(acc[0] * 0.125f, acc[1] * 0.125f); o.y = pk2(acc[2] * 0.125f, acc[3] * 0.125f); o.z = pk2(acc[4] * 0.125f, acc[5] * 0.125f); o.w = pk2(acc[6] * 0.125f, acc[7] * 0.125f);
        *(u32x4*)((bf16_t*)(ws + WS_WIN) + ((size_t)l * 2304 + 1792 + g * 128 + j) * 1024 + k0) = o;
        __syncthreads();
    }
    {
        LAS float* tab = (LAS float*)lds;
        for (int m = tid; m < 2048; m += 512) tab[m] = cospif((float)m * (1.0f / 1024.0f)) * 0.022097086912079608f;
        __syncthreads();
        for (int r = bid; r < 2048 + 256; r += G) {
            if (r < 2048) {
                float v[8];
#pragma unroll
                for (int e = 0; e < 8; ++e) { const int k = tid * 8 + e, idx = (r * (k & 2047)) & 2047; v[e] = tab[k < 2048 ? idx : ((idx + 512) & 2047)]; }
                u32x4 o; o.x = pk2(v[0], v[1]); o.y = pk2(v[2], v[3]); o.z = pk2(v[4], v[5]); o.w = pk2(v[6], v[7]);
                *(u32x4*)((bf16_t*)(ws + WS_DFT) + (size_t)r * DFT_LD + tid * 8) = o;
            } else if (tid < 64) {
                const int np = r - 2048; const float sc = 2.8284271247461903f;
                float v[8];
#pragma unroll
                for (int e = 0; e < 8; ++e) { const int k = tid * 8 + e, idx = ((np * (k & 255)) & 255) * 8; v[e] = tab[k < 256 ? idx : ((idx + 512) & 2047)] * sc; }
                u32x4 o; o.x = pk2(v[0], v[1]); o.y = pk2(v[2], v[3]); o.z = pk2(v[4], v[5]); o.w = pk2(v[6], v[7]);
                *(u32x4*)((bf16_t*)(ws + WS_DFTC) + (size_t)np * DFTC_LD + tid * 8) = o;
            }
        }
        __syncthreads();
    }
    if (bid == G - 1) {
        float* rtab = (float*)(ws + WS_ROPE);
        for (int e = tid; e < 1024; e += 512) { const int pos = e >> 4, i = e & 15;
            const float inv = fast_exp2(-(float)i * (13.287712379549449f / 16.0f));
            const float tt = (float)pos * inv * 0.3183098861837907f;
            rtab[2 * e] = cospif(tt); rtab[2 * e + 1] = sinpif(tt); }
    }
}

struct EwRow { f32x4 x[4]; u32x2 y[4]; };
__device__ __forceinline__ void ew_load(EwRow& r, const float* xin_lat, const float* xin_ctx, const bf16_t* Yp, int t, int lane) {
    const float* xr = t < TL ? xin_lat + (size_t)t * DM : xin_ctx + (size_t)(t - TL) * DM;
#pragma unroll
    for (int j = 0; j < 4; ++j) r.x[j] = *(const f32x4*)(xr + 4 * lane + 256 * j);
    if (Yp) {
#pragma unroll
        for (int j = 0; j < 4; ++j) r.y[j] = *(const u32x2*)(Yp + (size_t)t * DM + 4 * lane + 256 * j);
    }
}
__device__ __forceinline__ void ew_pass(const float* xin_lat, const float* xin_ctx, float* xout_lat, float* xout_ctx, const bf16_t* Yp, const float* gpost, float fac, const float* gate,
                                        bf16_t* Hp, const float* gpre, const float* shift, const float* scale, int nrows) {
    const int tid = otid(); const int wave = tid >> 6, lane = tid & 63;
    const int per = nrows / gridDim.x, tbeg = obid() * per + wave, tend = obid() * per + per;
    f32x4 vgp[4], vgt[4], vpre[4], vsh[4], vsc[4];
#pragma unroll
    for (int j = 0; j < 4; ++j) { vgp[j] = Yp ? *(const f32x4*)(gpost + 4 * lane + 256 * j) : (f32x4){0.f, 0.f, 0.f, 0.f}; vpre[j] = Hp ? *(const f32x4*)(gpre + 4 * lane + 256 * j) : (f32x4){0.f, 0.f, 0.f, 0.f};
        vgt[j] = vsh[j] = vsc[j] = (f32x4){0.f, 0.f, 0.f, 0.f}; }
    int bcur = -1;
    EwRow A, B;
    auto process = [&](EwRow& r, int t) {
        const bool lat = t < TL; const int b = lat ? (t >> 11) : 16;
        if (b != bcur) { bcur = b;
#pragma unroll
            for (int j = 0; j < 4; ++j) { const int cidx = 4 * lane + 256 * j;
                if (Yp) vgt[j] = *(const f32x4*)(gate + (size_t)b * NMODC + cidx) * fac;
                if (Hp) { vsh[j] = *(const f32x4*)(shift + (size_t)b * NMODC + cidx); vsc[j] = *(const f32x4*)(scale + (size_t)b * NMODC + cidx) + 1.0f; } } }
        if (Yp) {
            f32x4 y[4]; float ss = 0.f;
#pragma unroll
            for (int j = 0; j < 4; ++j) { const u32x2 w = r.y[j];
                y[j][0] = bflo(w.x); y[j][1] = bfhi(w.x); y[j][2] = bflo(w.y); y[j][3] = bfhi(w.y);
                ss += (y[j][0] * y[j][0] + y[j][1] * y[j][1]) + (y[j][2] * y[j][2] + y[j][3] * y[j][3]); }
            const float rstd = 1.0f / sqrtf(wave_sum(ss) * (1.0f / DM) + EPSV);
#pragma unroll
            for (int j = 0; j < 4; ++j) r.x[j] = r.x[j] + vgt[j] * (y[j] * rstd * vgp[j]);
        }
        float* xo = lat ? (xout_lat ? xout_lat + (size_t)t * DM : nullptr) : (xout_ctx ? xout_ctx + (size_t)(t - TL) * DM : nullptr);
        if (xo) {
#pragma unroll
            for (int j = 0; j < 4; ++j) *(f32x4*)(xo + 4 * lane + 256 * j) = r.x[j];
        }
        if (Hp) {
            float ss = 0.f;
#pragma unroll
            for (int j = 0; j < 4; ++j) ss += (r.x[j][0] * r.x[j][0] + r.x[j][1] * r.x[j][1]) + (r.x[j][2] * r.x[j][2] + r.x[j][3] * r.x[j][3]);
            const float rstd = 1.0f / sqrtf(wave_sum(ss) * (1.0f / DM) + EPSV);
#pragma unroll
            for (int j = 0; j < 4; ++j) { const f32x4 h = (r.x[j] * rstd * vpre[j]) * vsc[j] + vsh[j];
                u32x2 w; w.x = pk2(h[0], h[1]); w.y = pk2(h[2], h[3]);
                *(u32x2*)(Hp + (size_t)t * DM + 4 * lane + 256 * j) = w; }
        }
    };
    int t = tbeg;
    if (t < tend) ew_load(A, xin_lat, xin_ctx, Yp, t, lane);
    while (t < tend) {
        const int tn = t + 8;
        if (tn < tend) ew_load(B, xin_lat, xin_ctx, Yp, tn, lane);
        process(A, t);
        const int tnn = tn + 8;
        if (tnn < tend) ew_load(A, xin_lat, xin_ctx, Yp, tnn, lane);
        if (tn < tend) process(B, tn);
        t = tnn;
    }
}

__device__ __forceinline__ void conv_item(CParams& p, LAS unsigned char* lds, int l, int s, int tb) {
    const int tid = otid(), wave = tid >> 6, lane = tid & 63;
    const bf16_t* PROJ = (const bf16_t*)(p.ws + WS_PROJ); bf16_t* YCAT = (bf16_t*)(p.ws + WS_YCAT);
    LAS float* sA = (LAS float*)lds;
    const int tokbase = s < 16 ? s * 2048 : TL + (s - 16) * 256, len = s < 16 ? 2048 : 256, t0 = tb * 64;
    for (int u = tid; u < 94 * 32; u += 512) {
        const int rr = u >> 5, c8 = (u & 31) * 8, tt = t0 - 15 + rr;
        float v[8];
        if (tt >= 0 && tt < len) {
            const bf16_t* rp = PROJ + (size_t)(tokbase + tt) * NP + c8;
            const u32x4 ua = *(const u32x4*)rp, ug = *(const u32x4*)(rp + 256);
            v[0] = bflo(ua.x) * sigmoid_f(bflo(ug.x)); v[1] = bfhi(ua.x) * sigmoid_f(bfhi(ug.x));
            v[2] = bflo(ua.y) * sigmoid_f(bflo(ug.y)); v[3] = bfhi(ua.y) * sigmoid_f(bfhi(ug.y));
            v[4] = bflo(ua.z) * sigmoid_f(bflo(ug.z)); v[5] = bfhi(ua.z) * sigmoid_f(bfhi(ug.z));
            v[6] = bflo(ua.w) * sigmoid_f(bflo(ug.w)); v[7] = bfhi(ua.w) * sigmoid_f(bfhi(ug.w));
        } else {
#pragma unroll
            for (int e = 0; e < 8; ++e) v[e] = 0.f;
        }
        *(LAS f32x4*)(sA + rr * 256 + c8) = (f32x4){v[0], v[1], v[2], v[3]};
        *(LAS f32x4*)(sA + rr * 256 + c8 + 4) = (f32x4){v[4], v[5], v[6], v[7]};
    }
    __syncthreads();
    const int ch = tid & 255, half = tid >> 8;
    float out[32];
    {
        float w[31];
#pragma unroll
        for (int j = 0; j < 31; ++j) w[j] = p.conv_w[((size_t)l * 31 + j) * 256 + ch];
        const float bias = p.conv_b[l * 256 + ch];
        const LAS float* ap = sA + (half * 32) * 256 + ch;
        float in[62];
#pragma unroll
        for (int i = 0; i < 62; ++i) in[i] = ap[i * 256];
#pragma unroll
        for (int q = 0; q < 32; ++q) {
            float acc = bias;
#pragma unroll
            for (int j = 0; j < 31; ++j) acc += in[q + j] * w[j];
            out[q] = acc;
        }
    }
    __syncthreads();
#pragma unroll
    for (int q = 0; q < 32; ++q) sA[(half * 32 + q) * 256 + ch] = out[q];
    __syncthreads();
    {
        const f32x4 lg = *(const f32x4*)(p.ln_g + l * 256 + 4 * lane), lb = *(const f32x4*)(p.ln_b + l * 256 + 4 * lane);
#pragma unroll
        for (int q = 0; q < 8; ++q) {
            const int tok = wave * 8 + q;
            const f32x4 v = *(const LAS f32x4*)(sA + tok * 256 + 4 * lane);
            const float mean = wave_sum((v[0] + v[1]) + (v[2] + v[3])) * (1.0f / 256.0f);
            const f32x4 d = v - mean;
            const float var = wave_sum((d[0] * d[0] + d[1] * d[1]) + (d[2] * d[2] + d[3] * d[3])) * (1.0f / 256.0f);
            const float rstd = 1.0f / sqrtf(var + EPSV);
            const f32x4 yn = d * rstd * lg + lb;
            u32x2 o; o.x = pk2(silu_f(yn[0]), silu_f(yn[1])); o.y = pk2(silu_f(yn[2]), silu_f(yn[3]));
            *(u32x2*)(YCAT + (size_t)(tokbase + t0 + tok) * YC_LD + 4 * lane) = o;
        }
    }
    __syncthreads();
}

struct AttnItem {
    int mode;
    int qtok0;
    int qcol0, qcol1, ocol0, ocol1;
    int kcol0, kcol1, vcol0, vcol1; int nslots;
    int nloc, loctok0;
    int ctxtok0;
    int r, rs;
    int q0, kp0;
    int has_sink; float sink0, sink1;
    int h0;
};
constexpr int KROW = 72;
constexpr int VROW = 68;
constexpr int K_BYTES = 64 * KROW * 2, V_BYTES = 64 * VROW * 2;

__device__ __forceinline__ void attn_item(CParams& p, LAS unsigned char* lds, int l, const AttnItem& it) {
    const int tid = otid(), wave = tid >> 6, lane = tid & 63, g = wave >> 2, wq = wave & 3, fr = lane & 15, fq = lane >> 4;
    const bf16_t* PROJ = (const bf16_t*)(p.ws + WS_PROJ); bf16_t* YCAT = (bf16_t*)(p.ws + WS_YCAT);
    LAS unsigned char* sK = lds;
    LAS unsigned char* sV = lds + 2 * K_BYTES;
    LAS float* sB = (LAS float*)(lds + 2 * K_BYTES + 2 * V_BYTES);
    const int slot = it.nslots == 2 ? g : 0;
    if (it.mode == 0) { for (int i = tid; i < 2 * 465; i += 512) sB[i] = p.nat_bias[(size_t)(l * 4 + it.h0) * 465 + i]; }
    bf16x8 qf[2];
    { const bf16_t* qp = PROJ + (size_t)(it.qtok0 + wq * 16 + fr) * NP + (g ? it.qcol1 : it.qcol0) + 8 * fq;
      qf[0] = *(const bf16x8*)qp; qf[1] = *(const bf16x8*)(qp + 32); }
    float mrun = -3.0e38f, lsum = 0.f;
    f32x4 o[4];
#pragma unroll
    for (int db = 0; db < 4; ++db) o[db] = (f32x4){0.f, 0.f, 0.f, 0.f};
    const int nchunks = 4 + it.nloc;
    const int srow = tid >> 3, sseg = tid & 7;
    u32x4 kreg[2], vreg[2];
    auto chunk_tok = [&](int c) { return c < 4 ? it.ctxtok0 + 64 * c : it.loctok0 + 64 * (c - 4); };
    auto gload = [&](int c) {
        const bf16_t* rp = PROJ + (size_t)(chunk_tok(c) + srow) * NP + 8 * sseg;
#pragma unroll
        for (int s = 0; s < 2; ++s) if (s < it.nslots) { kreg[s] = *(const u32x4*)(rp + (s ? it.kcol1 : it.kcol0)); vreg[s] = *(const u32x4*)(rp + (s ? it.vcol1 : it.vcol0)); }
    };
    gload(0);
    for (int c = 0; c < nchunks; ++c) {
        __syncthreads();
#pragma unroll
        for (int s = 0; s < 2; ++s) if (s < it.nslots) {
            *(LAS u32x4*)(sK + s * K_BYTES + (srow * KROW + 8 * sseg) * 2) = kreg[s];
            LAS bf16_t* vt = (LAS bf16_t*)(sV + s * V_BYTES) + (8 * sseg) * VROW + srow;
            vt[0 * VROW] = (bf16_t)(vreg[s].x & 0xffffu); vt[1 * VROW] = (bf16_t)(vreg[s].x >> 16);
            vt[2 * VROW] = (bf16_t)(vreg[s].y & 0xffffu); vt[3 * VROW] = (bf16_t)(vreg[s].y >> 16);
            vt[4 * VROW] = (bf16_t)(vreg[s].z & 0xffffu); vt[5 * VROW] = (bf16_t)(vreg[s].z >> 16);
            vt[6 * VROW] = (bf16_t)(vreg[s].w & 0xffffu); vt[7 * VROW] = (bf16_t)(vreg[s].w >> 16);
        }
        __syncthreads();
        if (c + 1 < nchunks) gload(c + 1);
        f32x4 sacc[4];
        const LAS unsigned char* kb_base = sK + slot * K_BYTES + (fr * KROW + 8 * fq) * 2;
#pragma unroll
        for (int kb = 0; kb < 4; ++kb) {
            sacc[kb] = (f32x4){0.f, 0.f, 0.f, 0.f};
#pragma unroll
            for (int kk = 0; kk < 2; ++kk) {
                const bf16x8 a = *(const LAS bf16x8*)(kb_base + (16 * kb * KROW + 32 * kk) * 2);
                sacc[kb] = __builtin_amdgcn_mfma_f32_16x16x32_bf16(a, qf[kk], sacc[kb], 0, 0, 0);
            }
        }
        const int qi = wq * 16 + fr;
        if (c >= 4 && it.mode == 0) {
            const int wsx = min(max(qi - 8, 0), 48);
            const int dr = (it.rs + (c - 4)) - it.r + 7;
            const LAS float* bt = sB + g * 465 + dr * 31;
#pragma unroll
            for (int kb = 0; kb < 4; ++kb)
#pragma unroll
                for (int j = 0; j < 4; ++j) { const int kc = 16 * kb + 4 * fq + j; const bool ok = (kc >= wsx) && (kc < wsx + 16);
                    const int dc = min(max(kc - qi + 15, 0), 30);
                    sacc[kb][j] = ok ? (sacc[kb][j] + bt[dc]) * LOG2E : -1.0e30f; }
        } else if (c >= 4 && it.mode == 1) {
            const int qpos = it.q0 + qi, kbase = it.kp0 + 64 * (c - 4);
#pragma unroll
            for (int kb = 0; kb < 4; ++kb)
#pragma unroll
                for (int j = 0; j < 4; ++j) { const int kpos = kbase + 16 * kb + 4 * fq + j; const int d = kpos - qpos; const bool ok = (d <= 128) && (d >= -128);
                    sacc[kb][j] = ok ? sacc[kb][j] * LOG2E : -1.0e30f; }
        } else {
#pragma unroll
            for (int kb = 0; kb < 4; ++kb) sacc[kb] = sacc[kb] * LOG2E;
        }
        float cm = sacc[0][0];
#pragma unroll
        for (int kb = 0; kb < 4; ++kb)
#pragma unroll
            for (int j = 0; j < 4; ++j) cm = fmaxf(cm, sacc[kb][j]);
        cm = fmaxf(cm, __shfl_xor(cm, 16)); cm = fmaxf(cm, __shfl_xor(cm, 32));
        const float mnew = fmaxf(mrun, cm), alpha = fast_exp2(mrun - mnew);
        mrun = mnew;
        float ps = 0.f;
#pragma unroll
        for (int kb = 0; kb < 4; ++kb)
#pragma unroll
            for (int j = 0; j < 4; ++j) { sacc[kb][j] = fast_exp2(sacc[kb][j] - mnew); ps += sacc[kb][j]; }
        lsum = lsum * alpha + ps;
#pragma unroll
        for (int db = 0; db < 4; ++db) o[db] = o[db] * alpha;
        const LAS unsigned char* vb_base = sV + slot * V_BYTES + (fr * VROW + 4 * fq) * 2;
#pragma unroll
        for (int grp = 0; grp < 2; ++grp) {
            union { bf16x8 v; unsigned u[4]; } pb;
            pb.u[0] = pk2(sacc[2 * grp][0], sacc[2 * grp][1]); pb.u[1] = pk2(sacc[2 * grp][2], sacc[2 * grp][3]);
            pb.u[2] = pk2(sacc[2 * grp + 1][0], sacc[2 * grp + 1][1]); pb.u[3] = pk2(sacc[2 * grp + 1][2], sacc[2 * grp + 1][3]);
#pragma unroll
            for (int db = 0; db < 4; ++db) {
                union { bf16x8 v; u32x2 h[2]; } av;
                av.h[0] = *(const LAS u32x2*)(vb_base + (16 * db * VROW + 32 * grp) * 2);
                av.h[1] = *(const LAS u32x2*)(vb_base + (16 * db * VROW + 32 * grp + 16) * 2);
                o[db] = __builtin_amdgcn_mfma_f32_16x16x32_bf16(av.v, pb.v, o[db], 0, 0, 0);
            }
        }
    }
    lsum += __shfl_xor(lsum, 16); lsum += __shfl_xor(lsum, 32);
    if (it.has_sink) lsum += fast_exp2((g ? it.sink1 : it.sink0) * LOG2E - mrun);
    const float inv = 1.0f / lsum;
    bf16_t* op = YCAT + (size_t)(it.qtok0 + wq * 16 + fr) * YC_LD + (g ? it.ocol1 : it.ocol0) + 4 * fq;
#pragma unroll
    for (int db = 0; db < 4; ++db) { u32x2 w; w.x = pk2(o[db][0] * inv, o[db][1] * inv); w.y = pk2(o[db][2] * inv, o[db][3] * inv); *(u32x2*)(op + 16 * db) = w; }
    __syncthreads();
}

constexpr int C_UA = 0, C_QN = 512, C_KN = 768, C_VN = 1024, C_QS = 1280, C_KS = 1536, C_VS = 1664;

__device__ __forceinline__ void mix_items(CParams& p, LAS unsigned char* lds, int l, int sub) {
    const int n_attn = (l == 0) ? 2304 : 2048;
    const int n_conv = (l == 0) ? 512 + 64 : 512;
    const int start = (obid() + 128) % gridDim.x;
    for (int i = start; i < n_attn + n_conv; i += gridDim.x) {
        if (i >= n_attn) {
            if (!(sub & 4)) continue;
            const int ci = i - n_attn;
            if (ci < 512) conv_item(p, lds, l, ci >> 5, ci & 31);
            else { const int cj = ci - 512; conv_item(p, lds, l, 16 + (cj >> 2), cj & 3); }
            continue;
        }
        AttnItem it{};
        if (i < 1024) {
            const int b = i >> 6, r = (i >> 1) & 31, hp = i & 1;
            it.mode = 0; it.qtok0 = b * 2048 + r * 64; it.nslots = 2; it.h0 = 2 * hp;
            { const int h = 2 * hp; it.qcol0 = C_QN + 64 * h; it.kcol0 = C_KN + 64 * h; it.vcol0 = C_VN + 64 * h; it.ocol0 = 512 + 64 * h;
              it.qcol1 = it.qcol0 + 64; it.kcol1 = it.kcol0 + 64; it.vcol1 = it.vcol0 + 64; it.ocol1 = it.ocol0 + 64; }
            it.r = r; it.rs = min(max(r - 4, 0), 24); it.nloc = 8; it.loctok0 = b * 2048 + it.rs * 64; it.ctxtok0 = TL + b * 256;
        } else if (i < 2048) {
            const int k = i - 1024, b = k >> 6, qb = (k >> 1) & 31, kvh = k & 1;
            it.mode = 1; it.qtok0 = b * 2048 + qb * 64; it.nslots = 1;
            { const int h = 2 * kvh; it.qcol0 = C_QS + 64 * h; it.ocol0 = 768 + 64 * h; it.sink0 = p.sink[l * 4 + h]; it.sink1 = p.sink[l * 4 + h + 1];
              it.qcol1 = it.qcol0 + 64; it.ocol1 = it.ocol0 + 64; it.kcol0 = it.kcol1 = C_KS + 64 * kvh; it.vcol0 = it.vcol1 = C_VS + 64 * kvh; }
            it.has_sink = 1; it.q0 = qb * 64;
            const int ks = max(qb * 64 - 128, 0), ke = min(qb * 64 + 192, 2048);
            it.kp0 = ks; it.nloc = (ke - ks) >> 6; it.loctok0 = b * 2048 + ks; it.ctxtok0 = TL + b * 256;
        } else if (i < 2176) {
            const int k = i - 2048, b = k >> 3, qb = (k >> 1) & 3, hp = k & 1;
            it.mode = 2; it.qtok0 = TL + b * 256 + qb * 64; it.nslots = 2;
            { const int h = 2 * hp; it.qcol0 = C_QN + 64 * h; it.kcol0 = C_KN + 64 * h; it.vcol0 = C_VN + 64 * h; it.ocol0 = 512 + 64 * h;
              it.qcol1 = it.qcol0 + 64; it.kcol1 = it.kcol0 + 64; it.vcol1 = it.vcol0 + 64; it.ocol1 = it.ocol0 + 64; }
            it.nloc = 0; it.ctxtok0 = TL + b * 256;
        } else {
            const int k = i - 2176, b = k >> 3, qb = (k >> 1) & 3, kvh = k & 1;
            it.mode = 2; it.qtok0 = TL + b * 256 + qb * 64; it.nslots = 1;
            { const int h = 2 * kvh; it.qcol0 = C_QS + 64 * h; it.ocol0 = 768 + 64 * h; it.sink0 = p.sink[l * 4 + h]; it.sink1 = p.sink[l * 4 + h + 1];
              it.qcol1 = it.qcol0 + 64; it.ocol1 = it.ocol0 + 64; it.kcol0 = it.kcol1 = C_KS + 64 * kvh; it.vcol0 = it.vcol1 = C_VS + 64 * kvh; }
            it.has_sink = 1; it.nloc = 0; it.ctxtok0 = TL + b * 256;
        }
        if (sub & 2) attn_item(p, lds, l, it);
    }
}

constexpr int N_PHASES = 22;
#ifndef PHMASK
#define PHMASK 0xff
#endif

__device__ __forceinline__ void run_phase(CParams& p, LAS unsigned char* lds, int ph, int sub) {
    unsigned char* ws = p.ws;
    bf16_t* YH = (bf16_t*)(ws + WS_YH); bf16_t* U = (bf16_t*)(ws + WS_R1); bf16_t* PROJ = (bf16_t*)(ws + WS_PROJ); bf16_t* YCAT = (bf16_t*)(ws + WS_YCAT);
    float* XC = (float*)(ws + WS_XC); const float* MOD = (const float*)(ws + WS_MOD);
    const int G = gridDim.x, c = obid();
    if (ph == 0) { if constexpr ((PHMASK & 1) != 0) phase0(p, lds); return; }
    if (ph == 1) {
        if constexpr ((PHMASK & 2) == 0) return;
        ew_pass(p.x, p.ctx, nullptr, nullptr, nullptr, nullptr, 0.f, nullptr, YH, p.norm_g, MOD, MOD + 1024, TA); return;
    }
    const int l = (ph - 2) / 10, k = (ph - 2) % 10;
    const float* MODL = MOD + (size_t)l * 17 * NMODC; const float* NG = p.norm_g + (size_t)l * 6 * DM;
    const int rows_late = (l == 0) ? TA : TL;
    switch (k) {
    case 0: case 7: {
        if constexpr ((PHMASK & 4) == 0) break;
        const int f = (k == 7), M = f ? rows_late : TA;
        pg8::Gemm g{YH, (const bf16_t*)(ws + WS_W13) + (size_t)(l * 2 + f) * 5632 * 1024, M, 5632, 1024, 1024, 1024};
        pg8::StaticOrder S; S.init(M, 5632, G, c); EpiSwiGLU E{U};
        pg8::gemm_phase<EpiSwiGLU, pg8::StaticOrder, true, true>(lds, g, S, E);
    } break;
    case 1: case 8: case 5: {
        if constexpr ((PHMASK & 8) == 0) break;
        const bool isout = (k == 5); const int f = (k == 8), M = (k == 1) ? TA : rows_late;
        const int Kd = isout ? YC_LD : FF;
        pg8::Gemm g{isout ? YCAT : U, isout ? (const bf16_t*)(ws + WS_WOUT) + (size_t)l * 1024 * YC_LD : (const bf16_t*)(ws + WS_W2T) + (size_t)(l * 2 + f) * 1024 * FF, M, 1024, Kd, Kd, Kd};
        pg8::StaticOrder S; S.init(M, 1024, G, c); EpiBf16Tile E{YH, 1024, 0, 256};
        pg8::gemm_phase<EpiBf16Tile, pg8::StaticOrder, true, true>(lds, g, S, E);
    } break;
    case 2: case 6: case 9: {
        if constexpr ((PHMASK & 2) == 0) break;
        const int gi = (k == 2) ? 2 : (k == 6 ? 5 : 8), ni = (k == 2) ? 1 : (k == 6 ? 3 : 5);
        const int nrows = (k == 2) ? TA : rows_late;
        const bool lastl = (k == 9 && l == 1);
        const float* gpre = (k == 2) ? NG + 2 * DM : (k == 6 ? NG + 4 * DM : p.norm_g + 6 * DM);
        const float* shift = (k == 2) ? MODL + 3 * 1024 : (k == 6 ? MODL + 6 * 1024 : MOD + 17 * NMODC);
        const float* scale = (k == 2) ? MODL + 4 * 1024 : (k == 6 ? MODL + 7 * 1024 : MOD + 17 * NMODC + 1024);
        float* outp = p.out;
        const bool first = (l == 0 && k == 2);
        ew_pass(first ? p.x : outp, first ? p.ctx : XC, outp, XC, YH, NG + ni * DM, (k == 6) ? 1.0f : 0.5f, MODL + gi * 1024, lastl ? nullptr : YH, gpre, shift, scale, nrows);
    } break;
    case 3: {
        if constexpr ((PHMASK & 16) == 0) break;
        const bf16_t* W = (const bf16_t*)(ws + WS_WIN) + (size_t)l * 2304 * 1024;
        { pg8::Gemm g{YH, W, TA, NP, 1024, 1024, 1024}; pg8::StaticOrder S; S.init(TA, NP, G, c); EpiWin E{PROJ, (const float*)(ws + WS_ROPE)};
          pg8::gemm_phase<EpiWin, pg8::StaticOrder, true, true>(lds, g, S, E); }
        { const int N = (l == 0) ? TA : TL; pg8::Gemm g{W + (size_t)1792 * 1024, YH, 512, N, 1024, 1024, 1024}; pg8::StaticOrder S; S.init(512, N, G, (c + 16) % G);
          EpiPQ E{(bf16_t*)(ws + WS_PQT), (bf16_t*)(ws + WS_PQTC)};
          pg8::gemm_phase<EpiPQ, pg8::StaticOrder, true, true>(lds, g, S, E); }
    } break;
    case 4: {
        if constexpr ((PHMASK & 32) == 0) break;
        if (sub & 1)
        for (int v = 0; v < ((l == 0) ? 4 : 2); ++v) {
            const int hs = v & 1, isc = v >> 1;
            const bf16_t* Ap = isc ? (const bf16_t*)(ws + WS_DFTC) + hs * 256 : (const bf16_t*)(ws + WS_DFT) + hs * 2048;
            const bf16_t* Bp = isc ? (const bf16_t*)(ws + WS_PQTC) + hs * 256 : (const bf16_t*)(ws + WS_PQT) + hs * 2048;
            pg8::Gemm g{Ap, Bp, isc ? 256 : 2048, 4096, isc ? 256 : 2048, isc ? DFTC_LD : DFT_LD, isc ? PQTC_LD : PQT_LD};
            pg8::StaticOrder S; S.init(g.M, g.N, G, isc ? (c + G - 16 * hs) % G : (c + G - 128 * hs) % G);
            EpiBf16Tile E{YCAT + (isc ? (size_t)TL * YC_LD : 0) + (hs ? 1024 : 256), YC_LD, isc ? 256 : 2048, 0};
            pg8::gemm_phase<EpiBf16Tile, pg8::StaticOrder, true, true>(lds, g, S, E);
        }
        if (sub & 6) mix_items(p, lds, l, sub);
    } break;
    }
}

__global__ void __launch_bounds__(512, 2) mega(Params p, int ph0, int ph1) {
    extern __shared__ __attribute__((aligned(16))) unsigned char lds_raw[];
    LAS unsigned char* lds = (LAS unsigned char*)lds_raw;
    cg::grid_group grid = cg::this_grid();
    if (ph1 < 0) grid.sync();
    volatile LAS unsigned* xst = (volatile LAS unsigned*)(lds + 131072);
    if (threadIdx.x < 4) xst[threadIdx.x] = 0u;
    __syncthreads();
    XcdBarrier xb = xcd_barrier_post((unsigned*)(p.ws + WS_BAR), xst);
#ifdef TPROBE
    unsigned long long tacc = 0, tprev = __builtin_amdgcn_s_memrealtime();
#endif
    for (int ph = ph0; ph < ph1; ++ph) {
        CParams* q = (CParams*)__builtin_amdgcn_kernarg_segment_ptr(); asm volatile("" : "+s"(q));
        run_phase(*q, lds, ph, 7);
#ifdef DUPK
        { const int kind = ph == 0 ? 10 : (ph == 1 ? 11 : (ph - 2) % 10);
          if ((DUPK >> kind) & 1) { xcd_barrier(xb); run_phase(*q, lds, ph, DUPSUB); } }
#endif
        if (ph + 1 < ph1) xcd_barrier(xb);
#ifdef TPROBE
        { const unsigned long long now = __builtin_amdgcn_s_memrealtime(); const int kind = ph == 0 ? 10 : (ph == 1 ? 11 : (ph - 2) % 10);
          if ((TPROBE >> kind) & 1) tacc += now - tprev; tprev = now; }
#endif
    }
#ifdef TPROBE
    if (blockIdx.x == 0 && threadIdx.x == 0) { const unsigned long long t0 = __builtin_amdgcn_s_memrealtime(); while (__builtin_amdgcn_s_memrealtime() - t0 < tacc) __builtin_amdgcn_s_sleep(8); }
#endif
#ifdef XSYNC
    for (int i = 0; i < XSYNC; ++i) xcd_barrier(xb);
#endif
}

#ifndef ONE_LAUNCH
#define ONE_LAUNCH 1
#endif

extern "C" void kernel_launch(void* const* d_in, const int* in_sizes, int n_in, void* d_out, int out_size, void* d_ws, size_t ws_size, hipStream_t stream) {
    static int grid = 0;
    if (grid == 0) {
        if (ws_size < WS_END) { fprintf(stderr, "kernel_launch: workspace too small: %zu < %zu\n", ws_size, (size_t)WS_END); grid = -1; return; }
        int dev = 0, cus = 0, per_cu = 0;
        hipGetDevice(&dev); hipDeviceGetAttribute(&cus, hipDeviceAttributeMultiprocessorCount, dev);
        hipFuncSetAttribute((const void*)mega, hipFuncAttributeMaxDynamicSharedMemorySize, LDS_BYTES);
        hipOccupancyMaxActiveBlocksPerMultiprocessor(&per_cu, (const void*)mega, 512, LDS_BYTES);
        if (per_cu < 1) { fprintf(stderr, "kernel_launch: occupancy query says %d blocks per CU\n", per_cu); per_cu = 1; }
        (void)hipGetLastError();
        grid = cus;
    }
    if (grid < 0) return;
    (void)hipMemsetAsync((unsigned char*)d_ws + WS_BAR, 0, 3456 * 4, stream);
    Params p{};
    p.x = (const float*)d_in[0]; p.c = (const float*)d_in[1]; p.ctx = (const float*)d_in[2]; p.c_ctx = (const float*)d_in[3];
    p.w_ada = (const float*)d_in[4]; p.b_ada = (const float*)d_in[5]; p.norm_g = (const float*)d_in[6];
    p.w1 = (const float*)d_in[7]; p.w3 = (const float*)d_in[8]; p.w2 = (const float*)d_in[9]; p.w_in = (const float*)d_in[10];
    p.conv_w = (const float*)d_in[11]; p.conv_b = (const float*)d_in[12]; p.ln_g = (const float*)d_in[13]; p.ln_b = (const float*)d_in[14];
    p.nat_bias = (const float*)d_in[15]; p.sink = (const float*)d_in[16]; p.w_out = (const float*)d_in[17];
    p.out = (float*)d_out; p.ws = (unsigned char*)d_ws;
#if ONE_LAUNCH
    int ph0 = 0, ph1 = N_PHASES;
    void* args[] = {&p, &ph0, &ph1};
    hipError_t e = hipLaunchCooperativeKernel((const void*)mega, dim3(grid), dim3(512), args, LDS_BYTES, stream);
    if (e != hipSuccess) fprintf(stderr, "cooperative launch failed: %s (grid %d)\n", hipGetErrorString(e), grid);
#else
    for (int ph = 0; ph < N_PHASES; ++ph) {
        int ph0 = ph, ph1 = ph + 1;
        void* args[] = {&p, &ph0, &ph1};
        hipError_t e = hipLaunchCooperativeKernel((const void*)mega, dim3(grid), dim3(512), args, LDS_BYTES, stream);
        if (e != hipSuccess) { fprintf(stderr, "launch %d failed: %s (grid %d)\n", ph, hipGetErrorString(e), grid); break; }
    }
#endif
}
```

```cpp
#include <hip/hip_runtime.h>
#include <hip/hip_cooperative_groups.h>
#include <cstdio>
#include <cstdint>
namespace cg = cooperative_groups;
namespace pg8 {
#define PG8_LAS __attribute__((address_space(3)))
typedef unsigned short bf16_t;
typedef short bf16x8 __attribute__((ext_vector_type(8)));
typedef float f32x4 __attribute__((ext_vector_type(4)));
typedef unsigned u32x4 __attribute__((ext_vector_type(4)));
constexpr int BM = 256, BK = 64, HALF = 128, HTB = HALF * BK * 2  , STAGE_BYTES = 8 * HTB, NXCD = 8, WGM = 8;

__host__ __device__ __forceinline__ int lds_byte(int r, int c) { const int st = (r >> 4) * 2 + (c >> 5), rr = r & 15, cc = c & 31, ob = rr * 64 + cc * 2; return st * 1024 + (ob ^ (((ob >> 9) & 1) << 5)); }
__host__ __device__ __forceinline__ void stage_rc(int b, int& R, int& C) { const int st = b / 1024, sb = b % 1024, swz = sb ^ (((sb >> 9) & 1) << 5); R = (st >> 1) * 16 + swz / 64; C = (st & 1) * 32 + (swz % 64) / 2; }
__host__ __device__ __forceinline__ int perm32(int rho) { const int n = rho >> 4, i = rho & 15; return 8 * (i >> 2) + 4 * n + (i & 3); }

struct Unit { int pm, pn; };
struct Gemm { const bf16_t* A; const bf16_t* Bt; int M, N, K, lda, ldb; };

struct StaticOrder {
    int nM, nN, nwg, G, c;
    __host__ __device__ void init(int M, int N, int G_, int c_) { nM = M / BM; nN = N / BM; nwg = nM * nN; G = G_; c = c_; }
    __host__ __device__ bool next(int i, Unit& u) const {
        const long L = (long)i * G + c; if (L >= nwg) return false;
        int wgid = (int)L; { const int q = nwg / NXCD, r = nwg % NXCD, xcd = wgid % NXCD, off = wgid / NXCD; wgid = (xcd < r ? xcd * (q + 1) : r * (q + 1) + (xcd - r) * q) + off; }
        const int nig = WGM * nN, gid = wgid / nig, fm = gid * WGM, gsz = (nM - fm) < WGM ? (nM - fm) : WGM;
        u.pm = fm + ((wgid % nig) % gsz); u.pn = (wgid % nig) / gsz; return true;
    }
    __device__ __forceinline__ void a_ready(const Unit&) const {}
    __device__ __forceinline__ void done(const Unit&) const {}
};
__device__ __forceinline__ unsigned cvt_pk_bf16(float lo, float hi) { unsigned r; asm volatile("v_cvt_pk_bf16_f32 %0, %1, %2" : "=v"(r) : "v"(lo), "v"(hi)); return r; }
typedef float f32x2 __attribute__((ext_vector_type(2)));
template <class Epi, class Sched, bool ALIGN_EPI = false, bool SP2 = false>
__device__ __forceinline__ void gemm_phase(PG8_LAS unsigned char* lds, const Gemm g, const Sched& S, const Epi& E) {
    int tid_ = threadIdx.x; asm volatile("" : "+v"(tid_));
    const int tid = tid_, wid = __builtin_amdgcn_readfirstlane(tid >> 6), lane = tid & 63, wr = wid >> 2, wc = wid & 3, fr = lane & 15, fq = lane >> 4;
    const int K = g.K, nt = K / BK;
    unsigned voffA[2], voffB[2];
#pragma unroll
    for (int i = 0; i < 2; ++i) { int R, C; stage_rc(tid * 16 + i * 8192, R, C); const int Rb = Epi::PERM ? ((R & ~31) + perm32(R & 31)) : R;
        voffA[i] = (unsigned)(R * g.lda + C) * 2u; voffB[i] = (unsigned)(Rb * g.ldb + C) * 2u; }
    const size_t kstep = (size_t)(BK * 2);
    const size_t hstepA = (size_t)HALF * g.lda * 2, hstepB = (size_t)HALF * g.ldb * 2;
    const size_t tstepA = 2 * hstepA, tstepB = 2 * hstepB;
    const unsigned ldsw = (unsigned)wid * 1024u;
    const int aoff = lds_byte(wr * 64 + fr, fq * 8), boff = lds_byte(wc * 32 + fr, fq * 8);
#define PG8_SA(b, h) (((b) * 2 + (h)) * HTB)
#define PG8_SB(b, h) ((4 + (b) * 2 + (h)) * HTB)
#define PG8_STAGE(bufoff, gbase, voff) do { _Pragma("unroll") for (int _i = 0; _i < 2; ++_i) \
        __builtin_amdgcn_global_load_lds((const unsigned*)((const char*)(gbase) + (voff)[_i]), (PG8_LAS unsigned*)(lds + (bufoff) + ldsw + _i * 8192), 16, 0, 0); } while (0)
#define PG8_LDA(dst, b, h) do { _Pragma("unroll") for (int m = 0; m < 4; ++m) _Pragma("unroll") for (int k = 0; k < 2; ++k) dst[m][k] = *(const PG8_LAS bf16x8*)(lds + PG8_SA(b, h) + aoff + m * 2048 + k * 1024); } while (0)
#define PG8_LDB(dst, b, h) do { _Pragma("unroll") for (int n = 0; n < 2; ++n) _Pragma("unroll") for (int k = 0; k < 2; ++k) dst[n][k] = *(const PG8_LAS bf16x8*)(lds + PG8_SB(b, h) + boff + n * 2048 + k * 1024); } while (0)
#define PG8_MMA(ai, bj, At, Bt) do { __builtin_amdgcn_s_setprio(1); _Pragma("unroll") for (int m = 0; m < 4; ++m) _Pragma("unroll") for (int n = 0; n < 2; ++n) _Pragma("unroll") for (int k = 0; k < 2; ++k) \
        acc[ai][bj][m][n] = __builtin_amdgcn_mfma_f32_16x16x32_bf16(Bt[n][k], At[m][k], acc[ai][bj][m][n], 0, 0, 0); __builtin_amdgcn_s_setprio(0); } while (0)
#define PG8_WAIT_V(n) asm volatile("s_waitcnt vmcnt(" #n ")" ::: "memory")
#define PG8_WAIT_L(n) asm volatile("s_waitcnt lgkmcnt(" #n ")" ::: "memory")
#define PG8_BAR __builtin_amdgcn_s_barrier()
#define PG8_SCHED __builtin_amdgcn_sched_barrier(0)
    Unit cur, nxt; int ui = 0;
    if (!S.next(0, cur)) return;
    f32x4 acc[2][2][4][2];
#pragma unroll
    for (int a = 0; a < 2; ++a)
#pragma unroll
        for (int b = 0; b < 2; ++b)
#pragma unroll
            for (int m = 0; m < 4; ++m)
#pragma unroll
                for (int n = 0; n < 2; ++n) acc[a][b][m][n] = (f32x4){0.f, 0.f, 0.f, 0.f};
    bf16x8 At[4][2], B0[2][2], B1[2][2];
    const char* cA = (const char*)g.A + (size_t)cur.pm * tstepA; const char* cB = (const char*)g.Bt + (size_t)cur.pn * tstepB;
    S.a_ready(cur);
    if constexpr (SP2) {
        PG8_STAGE(PG8_SB(0, 0), cB, voffB); PG8_STAGE(PG8_SB(0, 1), cB + hstepB, voffB); PG8_STAGE(PG8_SA(0, 0), cA, voffA); PG8_STAGE(PG8_SA(0, 1), cA + hstepA, voffA);
        if (wr == 1) PG8_BAR;
        PG8_WAIT_V(2); PG8_BAR;
        PG8_STAGE(PG8_SB(1, 0), cB + kstep, voffB); PG8_STAGE(PG8_SA(1, 0), cA + kstep, voffA); PG8_STAGE(PG8_SB(1, 1), cB + hstepB + kstep, voffB);
        PG8_WAIT_V(6); PG8_BAR;
    } else {
        PG8_STAGE(PG8_SB(0, 0), cB, voffB); PG8_STAGE(PG8_SA(0, 0), cA, voffA); PG8_STAGE(PG8_SB(0, 1), cB + hstepB, voffB); PG8_STAGE(PG8_SA(0, 1), cA + hstepA, voffA);
        if (wr == 1) PG8_BAR;
        PG8_WAIT_V(4); PG8_BAR;
        PG8_STAGE(PG8_SB(1, 0), cB + kstep, voffB); PG8_STAGE(PG8_SA(1, 0), cA + kstep, voffA); PG8_STAGE(PG8_SB(1, 1), cB + hstepB + kstep, voffB);
        PG8_WAIT_V(6); PG8_BAR;
    }
    for (;;) {
        const bool has_next = S.next(ui + 1, nxt);
        const char* nA = has_next ? (const char*)g.A + (size_t)nxt.pm * tstepA : cA; const char* nB = has_next ? (const char*)g.Bt + (size_t)nxt.pn * tstepB : cB;
        for (int t = 0; t < nt; t += 2) {
            const bool last = (t == nt - 2);
            const char* a1 = cA + (size_t)(t + 1) * kstep;
            const char* a2 = last ? nA : cA + (size_t)(t + 2) * kstep; const char* b2 = last ? nB : cB + (size_t)(t + 2) * kstep;
            const char* a3 = a2 + kstep; const char* b3 = b2 + kstep;
            if (last && has_next) S.a_ready(nxt);
            if constexpr (SP2) {
            PG8_LDB(B0, 0, 0); PG8_LDB(B1, 0, 1); PG8_SCHED; PG8_LDA(At, 0, 0); PG8_STAGE(PG8_SA(1, 1), a1 + hstepA, voffA);
            PG8_WAIT_V(8); PG8_WAIT_L(0); PG8_BAR; PG8_MMA(0, 0, At, B0); PG8_MMA(0, 1, At, B1); PG8_BAR; PG8_SCHED;
            PG8_LDA(At, 0, 1); PG8_STAGE(PG8_SB(0, 0), b2, voffB); PG8_STAGE(PG8_SB(0, 1), b2 + hstepB, voffB); PG8_STAGE(PG8_SA(0, 0), a2, voffA);
            PG8_WAIT_V(8); PG8_WAIT_L(0); PG8_BAR; PG8_MMA(1, 0, At, B0); PG8_MMA(1, 1, At, B1); PG8_BAR; PG8_SCHED;
            PG8_LDB(B0, 1, 0); PG8_LDB(B1, 1, 1); PG8_SCHED; PG8_LDA(At, 1, 0); PG8_STAGE(PG8_SA(0, 1), a2 + hstepA, voffA);
            PG8_WAIT_V(8); PG8_WAIT_L(0); PG8_BAR; PG8_MMA(0, 0, At, B0); PG8_MMA(0, 1, At, B1); PG8_BAR; PG8_SCHED;
            PG8_LDA(At, 1, 1); PG8_STAGE(PG8_SB(1, 0), b3, voffB); PG8_STAGE(PG8_SB(1, 1), b3 + hstepB, voffB); PG8_STAGE(PG8_SA(1, 0), a3, voffA);
            PG8_WAIT_V(8); PG8_WAIT_L(0); PG8_BAR; PG8_MMA(1, 0, At, B0); PG8_MMA(1, 1, At, B1); PG8_BAR; PG8_SCHED;
            } else {
            PG8_LDB(B0, 0, 0); PG8_SCHED; PG8_LDA(At, 0, 0); PG8_STAGE(PG8_SA(1, 1), a1 + hstepA, voffA);
            PG8_WAIT_L(8); PG8_BAR; PG8_WAIT_L(0); PG8_MMA(0, 0, At, B0); PG8_BAR; PG8_SCHED;
            PG8_LDB(B1, 0, 1); PG8_STAGE(PG8_SB(0, 0), b2, voffB);
            PG8_BAR; PG8_WAIT_L(0); PG8_MMA(0, 1, At, B1); PG8_BAR;
            PG8_LDA(At, 0, 1); PG8_STAGE(PG8_SA(0, 0), a2, voffA);
            PG8_BAR; PG8_WAIT_L(0); PG8_MMA(1, 0, At, B0); PG8_BAR; PG8_SCHED;
            PG8_STAGE(PG8_SB(0, 1), b2 + hstepB, voffB);
            PG8_WAIT_V(6); PG8_BAR; PG8_MMA(1, 1, At, B1); PG8_BAR;
            PG8_LDB(B0, 1, 0); PG8_SCHED; PG8_LDA(At, 1, 0); PG8_STAGE(PG8_SA(0, 1), a2 + hstepA, voffA);
            PG8_WAIT_L(8); PG8_BAR; PG8_WAIT_L(0); PG8_MMA(0, 0, At, B0); PG8_BAR; PG8_SCHED;
            PG8_LDB(B1, 1, 1); PG8_STAGE(PG8_SB(1, 0), b3, voffB);
            PG8_BAR; PG8_WAIT_L(0); PG8_MMA(0, 1, At, B1); PG8_BAR;
            PG8_LDA(At, 1, 1); PG8_STAGE(PG8_SA(1, 0), a3, voffA);
            PG8_BAR; PG8_WAIT_L(0); PG8_MMA(1, 0, At, B0); PG8_BAR; PG8_SCHED;
            PG8_STAGE(PG8_SB(1, 1), b3 + hstepB, voffB);
            PG8_WAIT_V(6); PG8_BAR; PG8_MMA(1, 1, At, B1); PG8_BAR;
            }
        }
        if constexpr (ALIGN_EPI) { if (wr == 0) PG8_BAR; }
        if constexpr (!Epi::AFTER_DRAIN) { E(acc, cur, wr, wc, fr, fq); S.done(cur); }
        if (!has_next) break;
#pragma unroll
        for (int a = 0; a < 2; ++a)
#pragma unroll
            for (int b = 0; b < 2; ++b)
#pragma unroll
                for (int m = 0; m < 4; ++m)
#pragma unroll
                    for (int n = 0; n < 2; ++n) acc[a][b][m][n] = (f32x4){0.f, 0.f, 0.f, 0.f};
        cur = nxt; cA = nA; cB = nB; ++ui;
        if constexpr (ALIGN_EPI) { if (wr == 1) PG8_BAR; }
    }
    PG8_WAIT_V(0);
    if constexpr (!ALIGN_EPI) { if (wr == 0) PG8_BAR; }
    PG8_BAR;
    if constexpr (Epi::AFTER_DRAIN) { E.fused(acc, cur, wr, wc, fr, fq, lds, wid, lane); S.done(cur); }
#undef PG8_SA
#undef PG8_SB
#undef PG8_STAGE
#undef PG8_LDA
#undef PG8_LDB
#undef PG8_MMA
#undef PG8_WAIT_V
#undef PG8_WAIT_L
#undef PG8_BAR
#undef PG8_SCHED
}
}

#define LAS __attribute__((address_space(3)))
typedef unsigned short bf16_t;
typedef float f32x4 __attribute__((ext_vector_type(4)));
typedef float f32x2 __attribute__((ext_vector_type(2)));
typedef unsigned u32x4 __attribute__((ext_vector_type(4)));
typedef unsigned u32x2 __attribute__((ext_vector_type(2)));
typedef short bf16x8 __attribute__((ext_vector_type(8)));
typedef short bf16x4 __attribute__((ext_vector_type(4)));

constexpr int TL = 32768, TC = 4096, TA = 36864, DM = 1024, FF = 2816, NP = 1792, NMODC = 9216;
constexpr int YC_LD = 1280, DFT_LD = 4160, PQT_LD = 4160, DFTC_LD = 576, PQTC_LD = 576;
constexpr int LDS_BYTES = 131072 + 16;
#ifndef MIXMASK
#define MIXMASK 7
#endif
constexpr float EPSV = 1e-6f;
constexpr float LOG2E = 1.4426950408889634f;

constexpr size_t WS_XC   = 0;
constexpr size_t WS_YH   = WS_XC + (size_t)TC * DM * 4;
constexpr size_t WS_R1   = WS_YH + (size_t)TA * DM * 2;
constexpr size_t WS_PROJ = WS_R1;
constexpr size_t WS_PQT  = WS_PROJ + (size_t)TA * NP * 2;
constexpr size_t WS_PQTC = WS_PQT + (size_t)4096 * PQT_LD * 2;
constexpr size_t WS_YCAT = WS_PQTC + (size_t)4096 * PQTC_LD * 2;
constexpr size_t WS_R1END= WS_YCAT + (size_t)TA * YC_LD * 2;
constexpr size_t WS_W13  = WS_R1END;
constexpr size_t WS_W2T  = WS_W13 + (size_t)4 * 5632 * 1024 * 2;
constexpr size_t WS_WIN  = WS_W2T + (size_t)4 * 1024 * 2816 * 2;
constexpr size_t WS_WOUT = WS_WIN + (size_t)2 * 2304 * 1024 * 2;
constexpr size_t WS_DFT  = WS_WOUT + (size_t)2 * 1024 * YC_LD * 2;
constexpr size_t WS_DFTC = WS_DFT + (size_t)2048 * DFT_LD * 2;
constexpr size_t WS_MOD  = WS_DFTC + (size_t)256 * DFTC_LD * 2;
constexpr size_t WS_ROPE = WS_MOD + (size_t)2 * 17 * NMODC * 4;
constexpr size_t WS_BAR  = WS_ROPE + 64 * 16 * 2 * 4;
constexpr size_t WS_Y2   = WS_BAR + 3456 * 4;
constexpr size_t WS_END  = WS_Y2 + (size_t)TC * DM * 2;
static_assert((size_t)TA * FF * 2 <= WS_R1END - WS_R1, "U must fit in R1");

struct Params {
    const float *x, *c, *ctx, *c_ctx, *w_ada, *b_ada, *norm_g, *w1, *w3, *w2, *w_in, *conv_w, *conv_b, *ln_g, *ln_b, *nat_bias, *sink, *w_out;
    float* out; unsigned char* ws;
};
typedef const __attribute__((address_space(4))) Params CParams;

__device__ __forceinline__ unsigned pk2(float lo, float hi) { return pg8::cvt_pk_bf16(lo, hi); }
__device__ __forceinline__ float bflo(unsigned v) { return __uint_as_float(v << 16); }
__device__ __forceinline__ float bfhi(unsigned v) { return __uint_as_float(v & 0xffff0000u); }
__device__ __forceinline__ float wave_sum(float v) {
#pragma unroll
    for (int o = 1; o < 64; o <<= 1) v += __shfl_xor(v, o);
    return v;
}
__device__ __forceinline__ int otid() { int t = threadIdx.x; asm volatile("" : "+v"(t)); return t; }
__device__ __forceinline__ int obid() { int t = blockIdx.x; asm volatile("" : "+s"(t)); return t; }
__device__ __forceinline__ float fast_exp2(float x) { return __builtin_amdgcn_exp2f(x); }
__device__ __forceinline__ float fast_rcp(float x) { return __builtin_amdgcn_rcpf(x); }
__device__ __forceinline__ float silu_f(float v) { return v * fast_rcp(1.0f + fast_exp2(-v * LOG2E)); }
__device__ __forceinline__ float sigmoid_f(float v) { return fast_rcp(1.0f + fast_exp2(-v * LOG2E)); }

#define XB_TMO      128
#define XB_XCNT(j)  (256  + 64 * (j))
#define XB_XSUB(j)  (1280 + 64 * (j))
#define XB_XGEN(j)  (2304 + 64 * (j))
#define XB_TOP      3328
#define XB_TOPGEN   3392
#define XCD_BAR_WORDS 3456
#define XB_SPIN_CAP (1u << 18)

__device__ __forceinline__ unsigned xb_ld(unsigned* p)              { return __hip_atomic_load(p, __ATOMIC_RELAXED, __HIP_MEMORY_SCOPE_AGENT); }
__device__ __forceinline__ unsigned xb_add(unsigned* p, unsigned v) { return __hip_atomic_fetch_add(p, v, __ATOMIC_RELAXED, __HIP_MEMORY_SCOPE_AGENT); }
__device__ __forceinline__ unsigned xb_xcc_id() { return (unsigned)__builtin_amdgcn_s_getreg((3 << 11) | 20) & 0xFu; }
#define XB_SPIN(cond, bar) do { unsigned _sp = 0; while (cond) { __builtin_amdgcn_s_sleep(1); \
    if ((++_sp & 255u) == 0u) { if (xb_ld(&(bar)[XB_TMO])) break; if (_sp > XB_SPIN_CAP) { atomicAdd(&(bar)[XB_TMO], 1u); break; } } } } while (0)

struct XcdBarrier {
    unsigned* bar; unsigned x;
    volatile LAS unsigned* st;
};

__device__ __forceinline__ XcdBarrier xcd_barrier_post(unsigned* bar, volatile LAS unsigned* st) {
    XcdBarrier b; b.bar = bar; b.x = xb_xcc_id(); b.st = st;
    if (threadIdx.x == 0) (void)xb_add(&bar[XB_XCNT(b.x)], 1u);
    return b;
}
__device__ __forceinline__ void xcd_barrier_complete(unsigned* bar, unsigned x, unsigned& nloc, unsigned& nx) {
    const unsigned G = gridDim.x * gridDim.y * gridDim.z;
    unsigned sum, cnt, mine, sp = 0u;
    for (;;) {
        sum = 0u; cnt = 0u; mine = 0u;
#pragma unroll
        for (unsigned j = 0; j < 16; ++j) { const unsigned c = xb_ld(&bar[XB_XCNT(j)]); sum += c; cnt += (c > 0u) ? 1u : 0u; mine = (j == x) ? c : mine; }
        if (sum == G) break;
        __builtin_amdgcn_s_sleep(1);
        if ((++sp & 255u) == 0u) { if (xb_ld(&bar[XB_TMO])) break; if (sp > XB_SPIN_CAP) { atomicAdd(&bar[XB_TMO], 1u); break; } }
    }
    nloc = mine > 0u ? mine : 1u; nx = cnt > 0u ? cnt : 1u;
}

__device__ __forceinline__ void xcd_barrier(const XcdBarrier& b) {
    asm volatile("s_waitcnt vmcnt(0)" ::: "memory");
    __syncthreads();
    if (threadIdx.x == 0) {
        unsigned* bar = b.bar;
        __builtin_amdgcn_s_waitcnt(0);
        unsigned nloc = b.st[0], nx = b.st[1];
        if (nloc == 0u) { xcd_barrier_complete(bar, b.x, nloc, nx); b.st[0] = nloc; b.st[1] = nx; }
        const unsigned old = xb_add(&bar[XB_XSUB(b.x)], 1u);
        const unsigned gen = old / nloc;
        if (old + 1u == (gen + 1u) * nloc) {
            __builtin_amdgcn_fence(__ATOMIC_RELEASE, "agent");
            asm volatile("s_waitcnt vmcnt(0)" ::: "memory");
            const unsigned og = xb_add(&bar[XB_TOP], 1u);
            const unsigned tg = og / nx;
            if (og + 1u == (tg + 1u) * nx) xb_add(&bar[XB_TOPGEN], 1u);
            else XB_SPIN(xb_ld(&bar[XB_TOPGEN]) == tg, bar);
            __builtin_amdgcn_fence(__ATOMIC_ACQUIRE, "agent");
            xb_add(&bar[XB_XGEN(b.x)], 1u);
            asm volatile("s_waitcnt vmcnt(0)" ::: "memory");
        } else {
            XB_SPIN(xb_ld(&bar[XB_XGEN(b.x)]) == gen, bar);
            __builtin_amdgcn_fence(__ATOMIC_ACQUIRE, "agent");
            asm volatile("s_waitcnt vmcnt(0)" ::: "memory");
        }
    }
    __syncthreads();
}


struct EpiSwiGLU {
    static constexpr bool PERM = true, AFTER_DRAIN = false;
    bf16_t* U;
    __device__ __forceinline__ void operator()(const f32x4 (&acc)[2][2][4][2], const pg8::Unit& u, int wr, int wc, int fr, int fq) const {
        const int row0 = u.pm * 256 + wr * 64 + fr, col0 = u.pn * 128 + wc * 32 + 8 * fq;
#pragma unroll
        for (int ai = 0; ai < 2; ++ai)
#pragma unroll
            for (int m = 0; m < 4; ++m) {
                bf16_t* rowp = U + (size_t)(row0 + ai * 128 + m * 16) * FF + col0;
                float v[8];
#pragma unroll
                for (int n = 0; n < 2; ++n)
#pragma unroll
                    for (int j = 0; j < 4; ++j) v[n * 4 + j] = silu_f(acc[ai][0][m][n][j]) * acc[ai][1][m][n][j];
                u32x4 w; w.x = pk2(v[0], v[1]); w.y = pk2(v[2], v[3]); w.z = pk2(v[4], v[5]); w.w = pk2(v[6], v[7]);
                *(u32x4*)rowp = w;
            }
    }
};
struct EpiBf16Tile {
    static constexpr bool PERM = true, AFTER_DRAIN = false;
    bf16_t* O; int ldc, row_pn, col_pn;
    __device__ __forceinline__ void operator()(const f32x4 (&acc)[2][2][4][2], const pg8::Unit& u, int wr, int wc, int fr, int fq) const {
        const int row0 = u.pm * 256 + u.pn * row_pn + wr * 64 + fr, col0 = u.pn * col_pn + wc * 32 + 8 * fq;
#pragma unroll
        for (int ai = 0; ai < 2; ++ai)
#pragma unroll
            for (int m = 0; m < 4; ++m) {
                bf16_t* rowp = O + (size_t)(row0 + ai * 128 + m * 16) * ldc + col0;
#pragma unroll
                for (int bj = 0; bj < 2; ++bj) {
                    const f32x4 v0 = acc[ai][bj][m][0], v1 = acc[ai][bj][m][1];
                    u32x4 w; w.x = pk2(v0[0], v0[1]); w.y = pk2(v0[2], v0[3]); w.z = pk2(v1[0], v1[1]); w.w = pk2(v1[2], v1[3]);
                    *(u32x4*)(rowp + bj * 128) = w;
                }
            }
    }
};
struct EpiPQ {
    static constexpr bool PERM = true, AFTER_DRAIN = false;
    bf16_t* PQT; bf16_t* PQTC;
    __device__ __forceinline__ void operator()(const f32x4 (&acc)[2][2][4][2], const pg8::Unit& u, int wr, int wc, int fr, int fq) const {
        const int cl = wc * 32 + 8 * fq;
#pragma unroll
        for (int ai = 0; ai < 2; ++ai)
#pragma unroll
            for (int m = 0; m < 4; ++m) {
                const int mp = u.pm * 256 + ai * 128 + wr * 64 + m * 16 + fr;
                const int g = mp >> 7, pq = (mp >> 6) & 1, cp = mp & 63;
                bf16_t* rowp;
                if (u.pn < 128) { const int b = u.pn >> 3, n0 = (u.pn & 7) * 256; rowp = PQT + (size_t)(b * 256 + g * 64 + cp) * PQT_LD + pq * 2048 + n0 + cl; }
                else { const int b = u.pn - 128; rowp = PQTC + (size_t)(b * 256 + g * 64 + cp) * PQTC_LD + pq * 256 + cl; }
#pragma unroll
                for (int bj = 0; bj < 2; ++bj) {
                    const f32x4 v0 = acc[ai][bj][m][0], v1 = acc[ai][bj][m][1];
                    u32x4 w; w.x = pk2(v0[0], v0[1]); w.y = pk2(v0[2], v0[3]); w.z = pk2(v1[0], v1[1]); w.w = pk2(v1[2], v1[3]);
                    *(u32x4*)(rowp + bj * 128) = w;
                }
            }
    }
};
struct EpiWin {
    static constexpr bool PERM = false, AFTER_DRAIN = false;
    bf16_t* P; const float* rope;
    __device__ __forceinline__ void operator()(const f32x4 (&acc)[2][2][4][2], const pg8::Unit& u, int wr, int wc, int fr, int fq) const {
        const int row0 = u.pm * 256 + wr * 64 + fr, col0 = u.pn * 256 + wc * 32 + 4 * fq;
        const float qs = (u.pn == 2 || u.pn == 5) ? 0.125f : 1.0f;
        const bool lat = u.pm < 128;
#pragma unroll
        for (int ai = 0; ai < 2; ++ai)
#pragma unroll
            for (int m = 0; m < 4; ++m) {
                const int r = row0 + ai * 128 + m * 16;
                bf16_t* rowp = P + (size_t)r * NP + col0;
                const int t = r & 2047;
                const int pos = (wc & 1) ? (t & 63) : (t >> 6);
#pragma unroll
                for (int bj = 0; bj < 2; ++bj) {
                    f32x4 v0 = acc[ai][bj][m][0], v1 = acc[ai][bj][m][1];
                    const bool dorope = lat && (u.pn == 5 || (u.pn == 6 && bj == 0));
                    if (dorope) {
                        const f32x4 cs0 = *(const f32x4*)(rope + (pos * 16 + 4 * fq) * 2), cs1 = *(const f32x4*)(rope + (pos * 16 + 4 * fq) * 2 + 4);
                        const float c0 = cs0[0], s0 = cs0[1], c1 = cs0[2], s1 = cs0[3], c2 = cs1[0], s2 = cs1[1], c3 = cs1[2], s3 = cs1[3];
                        f32x4 a, b;
                        a[0] = v0[0] * c0 - v1[0] * s0; b[0] = v0[0] * s0 + v1[0] * c0;
                        a[1] = v0[1] * c1 - v1[1] * s1; b[1] = v0[1] * s1 + v1[1] * c1;
                        a[2] = v0[2] * c2 - v1[2] * s2; b[2] = v0[2] * s2 + v1[2] * c2;
                        a[3] = v0[3] * c3 - v1[3] * s3; b[3] = v0[3] * s3 + v1[3] * c3;
                        v0 = a; v1 = b;
                    }
                    v0 = v0 * qs; v1 = v1 * qs;
                    u32x2 w0, w1; w0.x = pk2(v0[0], v0[1]); w0.y = pk2(v0[2], v0[3]); w1.x = pk2(v1[0], v1[1]); w1.y = pk2(v1[2], v1[3]);
                    *(u32x2*)(rowp + bj * 128) = w0; *(u32x2*)(rowp + bj * 128 + 16) = w1;
                }
            }
    }
};

struct TrItem { const float* src; bf16_t* dst; int ld_src, ld_dst; };
__device__ __forceinline__ TrItem tr_decode(CParams& p, int it) {
    constexpr int PER_L = 2 * 704 + 2 * 352 + 224 + 160;
    unsigned char* ws = p.ws;
    const int l = it / PER_L; int q = it % PER_L;
    const float* src; bf16_t* dst; int ld_src, ld_dst, col0, k0, r0;
    if (q < 2 * 704) { const int f = q / 704; q %= 704; const int rt = q >> 4, kt = q & 15, R0 = rt * 128, tile = R0 >> 8, bj = (R0 >> 7) & 1;
        src = (bj ? p.w3 : p.w1) + (size_t)(l * 2 + f) * 1024 * FF; ld_src = FF; col0 = 128 * tile; k0 = 64 * kt; dst = (bf16_t*)(ws + WS_W13) + (size_t)(l * 2 + f) * 5632 * 1024; r0 = R0; ld_dst = 1024; }
    else if (q < 2 * 704 + 2 * 352) { q -= 2 * 704; const int f = q / 352; q %= 352; const int rt = q / 44, kt = q % 44;
        src = p.w2 + (size_t)(l * 2 + f) * FF * 1024; ld_src = 1024; col0 = 128 * rt; k0 = 64 * kt; dst = (bf16_t*)(ws + WS_W2T) + (size_t)(l * 2 + f) * 1024 * FF; r0 = 128 * rt; ld_dst = FF; }
    else if (q < 2 * 704 + 2 * 352 + 224) { q -= 2 * 704 + 2 * 352; const int rt = q >> 4, kt = q & 15, R0 = rt * 128;
        src = p.w_in + (size_t)l * 1024 * 2048; ld_src = 2048; col0 = R0 < 512 ? R0 : R0 + 256; k0 = 64 * kt; dst = (bf16_t*)(ws + WS_WIN) + (size_t)l * 2304 * 1024; r0 = R0; ld_dst = 1024; }
    int ks = -1;
    if (q >= 2 * 704 + 2 * 352 + 224) { q -= 2 * 704 + 2 * 352 + 224; const int rt = q / 20, kt = q % 20;
        src = p.w_out + (size_t)l * 1024 * 1024; ld_src = 1024; col0 = 128 * rt; k0 = 64 * kt; ks = kt < 16 ? 64 * kt : 256 + 64 * (kt - 16); dst = (bf16_t*)(ws + WS_WOUT) + (size_t)l * 1024 * YC_LD; r0 = 128 * rt; ld_dst = YC_LD; }
    if (ks < 0) ks = k0;
    TrItem t; t.src = src + (size_t)ks * ld_src + col0; t.dst = dst + (size_t)r0 * ld_dst + k0; t.ld_src = ld_src; t.ld_dst = ld_dst; return t;
}

__device__ __forceinline__ void phase0(CParams& p, LAS unsigned char* lds) {
    const int tid = otid(), wave = tid >> 6, lane = tid & 63;
    unsigned char* ws = p.ws;
    const int bid = obid(), G = gridDim.x;
    if (bid < 288) {
        LAS float* sS = (LAS float*)lds;
        LAS float* sR = sS + 17 * 1024;
        for (int i = tid; i < 17 * 1024; i += 512) { const float v = (i < 16384) ? p.c[i] : p.c_ctx[i - 16384]; sS[i] = v / (1.0f + __expf(-v)); }
        __syncthreads();
        for (int r = bid; r < 288; r += G) {
            const int l = r / 144, j0 = (r % 144) * 64, k0 = wave * 128;
            float acc[17];
#pragma unroll
            for (int q = 0; q < 17; ++q) acc[q] = 0.f;
            const float* wp = p.w_ada + ((size_t)l * 1024 + k0) * NMODC + j0 + lane;
#pragma unroll 1
            for (int kb = 0; kb < 128; kb += 16) {
                float wv[16];
#pragma unroll
                for (int kk = 0; kk < 16; ++kk) wv[kk] = wp[(size_t)(kb + kk) * NMODC];
#pragma unroll
                for (int kk = 0; kk < 16; ++kk)
#pragma unroll
                    for (int q = 0; q < 17; ++q) acc[q] += sS[q * 1024 + k0 + kb + kk] * wv[kk];
            }
#pragma unroll
            for (int q = 0; q < 17; ++q) sR[(wave * 17 + q) * 64 + lane] = acc[q];
            __syncthreads();
            float* MOD = (float*)(ws + WS_MOD);
            for (int o = tid; o < 17 * 64; o += 512) {
                const int q = o >> 6, ln = o & 63; float s = p.b_ada[l * NMODC + j0 + ln];
#pragma unroll
                for (int w = 0; w < 8; ++w) s += sR[(w * 17 + q) * 64 + ln];
                MOD[(size_t)(l * 17 + q) * NMODC + j0 + ln] = s;
            }
            __syncthreads();
        }
    }
    {
        constexpr int N_TR = 2 * (2 * 704 + 2 * 352 + 224 + 160);
        LAS float* t = (LAS float*)lds;
        const int lk = tid >> 5, lc = (tid & 31) * 4;
        const int sr = tid >> 2, sk = (tid & 3) * 16;
        int it = bid; f32x4 pre[4]; TrItem cur;
        if (it < N_TR) { cur = tr_decode(p, it);
#pragma unroll
            for (int i = 0; i < 4; ++i) pre[i] = *(const f32x4*)(cur.src + (size_t)(lk + 16 * i) * cur.ld_src + lc); }
        while (it < N_TR) {
#pragma unroll
            for (int i = 0; i < 4; ++i) { LAS float* d = t + (lk + 16 * i) * 129 + lc; d[0] = pre[i][0]; d[1] = pre[i][1]; d[2] = pre[i][2]; d[3] = pre[i][3]; }
            __syncthreads();
            bf16_t* dp = cur.dst + (size_t)sr * cur.ld_dst + sk;
            const int nxt = it + G;
            if (nxt < N_TR) { cur = tr_decode(p, nxt);
#pragma unroll
                for (int i = 0; i < 4; ++i) pre[i] = *(const f32x4*)(cur.src + (size_t)(lk + 16 * i) * cur.ld_src + lc); }
            { const LAS float* s = t + sk * 129 + sr;
              u32x4 o0, o1;
              o0.x = pk2(s[0 * 129], s[1 * 129]); o0.y = pk2(s[2 * 129], s[3 * 129]); o0.z = pk2(s[4 * 129], s[5 * 129]); o0.w = pk2(s[6 * 129], s[7 * 129]);
              o1.x = pk2(s[8 * 129], s[9 * 129]); o1.y = pk2(s[10 * 129], s[11 * 129]); o1.z = pk2(s[12 * 129], s[13 * 129]); o1.w = pk2(s[14 * 129], s[15 * 129]);
              *(u32x4*)dp = o0; *(u32x4*)(dp + 8) = o1; }
            __syncthreads();
            it = nxt;
        }
    }
    for (int r = bid; r < 256; r += G) {
        const int l = r >> 7, k0 = (r & 127) * 8;
        LAS float* sW = (LAS float*)lds;
        LAS float* sC = sW + 2048;
        for (int i = tid; i < 2048; i += 512) { const int kk = i >> 8, cc = i & 255; sW[i] = p.w_in[((size_t)l * 1024 + k0 + kk) * 2048 + 512 + cc]; }
        if (tid < 64) sC[tid] = cospif((float)tid * (1.0f / 32.0f));
        __syncthreads();
        const int g = tid >> 7, j = tid & 127, jj = j & 63, isS = j >> 6;
        float acc[8];
#pragma unroll
        for (int q = 0; q < 8; ++q) acc[q] = 0.f;
        for (int c = 0; c < 64; ++c) {
            const int mm = (c * jj) & 63; const float tv = sC[isS ? ((mm - 16) & 63) : mm];
#pragma unroll
            for (int q = 0; q < 8; ++q) acc[q] += sW[q * 256 + g * 64 + c] * tv;
        }
        u32x4 o; o.x = pk2(acc[0] * 0.125f, acc[1] * 0.125f); o.y = pk2(acc[2] * 0.125f, acc[3] * 0.125f); o.z = pk2(acc[4] * 0.125f, acc[5] * 0.125f); o.w = pk2(acc[6] * 0.125f, acc[7] * 0.125f);
        *(u32x4*)((bf16_t*)(ws + WS_WIN) + ((size_t)l * 2304 + 1792 + g * 128 + j) * 1024 + k0) = o;
        __syncthreads();
    }
    {
        LAS float* tab = (LAS float*)lds;
        for (int m = tid; m < 2048; m += 512) tab[m] = cospif((float)m * (1.0f / 1024.0f)) * 0.022097086912079608f;
        __syncthreads();
        for (int r = bid; r < 2048 + 256; r += G) {
            if (r < 2048) {
                float v[8];
#pragma unroll
                for (int e = 0; e < 8; ++e) { const int k = tid * 8 + e, idx = (r * (k & 2047)) & 2047; v[e] = tab[k < 2048 ? idx : ((idx + 512) & 2047)]; }
                u32x4 o; o.x = pk2(v[0], v[1]); o.y = pk2(v[2], v[3]); o.z = pk2(v[4], v[5]); o.w = pk2(v[6], v[7]);
                *(u32x4*)((bf16_t*)(ws + WS_DFT) + (size_t)r * DFT_LD + tid * 8) = o;
            } else if (tid < 64) {
                const int np = r - 2048; const float sc = 2.8284271247461903f;
                float v[8];
#pragma unroll
                for (int e = 0; e < 8; ++e) { const int k = tid * 8 + e, idx = ((np * (k & 255)) & 255) * 8; v[e] = tab[k < 256 ? idx : ((idx + 512) & 2047)] * sc; }
                u32x4 o; o.x = pk2(v[0], v[1]); o.y = pk2(v[2], v[3]); o.z = pk2(v[4], v[5]); o.w = pk2(v[6], v[7]);
                *(u32x4*)((bf16_t*)(ws + WS_DFTC) + (size_t)np * DFTC_LD + tid * 8) = o;
            }
        }
        __syncthreads();
    }
    if (bid == G - 1) {
        float* rtab = (float*)(ws + WS_ROPE);
        for (int e = tid; e < 1024; e += 512) { const int pos = e >> 4, i = e & 15;
            const float inv = fast_exp2(-(float)i * (13.287712379549449f / 16.0f));
            const float tt = (float)pos * inv * 0.3183098861837907f;
            rtab[2 * e] = cospif(tt); rtab[2 * e + 1] = sinpif(tt); }
    }
}

struct EwRow { f32x4 x[4]; u32x2 y[4]; u32x2 y2[4]; };
__device__ __forceinline__ void ew_load(EwRow& r, const float* xin_lat, const float* xin_ctx, const bf16_t* Yp, const bf16_t* Y2p, int t, int lane) {
    const float* xr = t < TL ? xin_lat + (size_t)t * DM : xin_ctx + (size_t)(t - TL) * DM;
#pragma unroll
    for (int j = 0; j < 4; ++j) r.x[j] = *(const f32x4*)(xr + 4 * lane + 256 * j);
    if (Yp) {
#pragma unroll
        for (int j = 0; j < 4; ++j) r.y[j] = *(const u32x2*)(Yp + (size_t)t * DM + 4 * lane + 256 * j);
        if (t >= TL) {
#pragma unroll
            for (int j = 0; j < 4; ++j) r.y2[j] = *(const u32x2*)(Y2p + (size_t)(t - TL) * DM + 4 * lane + 256 * j);
        }
    }
}
__device__ __forceinline__ void ew_pass(const float* xin_lat, const float* xin_ctx, float* xout_lat, float* xout_ctx, const bf16_t* Yp, const bf16_t* Y2p, const float* gpost, float fac, const float* gate,
                                        bf16_t* Hp, const float* gpre, const float* shift, const float* scale, int nrows) {
    const int tid = otid(); const int wave = tid >> 6, lane = tid & 63;
    const int per = nrows / gridDim.x, tbeg = obid() * per + wave, tend = obid() * per + per;
    f32x4 vgp[4], vgt[4], vpre[4], vsh[4], vsc[4];
#pragma unroll
    for (int j = 0; j < 4; ++j) { vgp[j] = Yp ? *(const f32x4*)(gpost + 4 * lane + 256 * j) : (f32x4){0.f, 0.f, 0.f, 0.f}; vpre[j] = Hp ? *(const f32x4*)(gpre + 4 * lane + 256 * j) : (f32x4){0.f, 0.f, 0.f, 0.f};
        vgt[j] = vsh[j] = vsc[j] = (f32x4){0.f, 0.f, 0.f, 0.f}; }
    int bcur = -1;
    EwRow A, B;
    auto process = [&](EwRow& r, int t) {
        const bool lat = t < TL; const int b = lat ? (t >> 11) : 16;
        if (b != bcur) { bcur = b;
#pragma unroll
            for (int j = 0; j < 4; ++j) { const int cidx = 4 * lane + 256 * j;
                if (Yp) vgt[j] = *(const f32x4*)(gate + (size_t)b * NMODC + cidx) * fac;
                if (Hp) { vsh[j] = *(const f32x4*)(shift + (size_t)b * NMODC + cidx); vsc[j] = *(const f32x4*)(scale + (size_t)b * NMODC + cidx) + 1.0f; } } }
        if (Yp) {
            f32x4 y[4]; float ss = 0.f;
#pragma unroll
            for (int j = 0; j < 4; ++j) { const u32x2 w = r.y[j];
                y[j][0] = bflo(w.x); y[j][1] = bfhi(w.x); y[j][2] = bflo(w.y); y[j][3] = bfhi(w.y);
                if (!lat) { const u32x2 w2 = r.y2[j]; y[j][0] += bflo(w2.x); y[j][1] += bfhi(w2.x); y[j][2] += bflo(w2.y); y[j][3] += bfhi(w2.y); }
                ss += (y[j][0] * y[j][0] + y[j][1] * y[j][1]) + (y[j][2] * y[j][2] + y[j][3] * y[j][3]); }
            const float rstd = 1.0f / sqrtf(wave_sum(ss) * (1.0f / DM) + EPSV);
#pragma unroll
            for (int j = 0; j < 4; ++j) r.x[j] = r.x[j] + vgt[j] * (y[j] * rstd * vgp[j]);
        }
        float* xo = lat ? (xout_lat ? xout_lat + (size_t)t * DM : nullptr) : (xout_ctx ? xout_ctx + (size_t)(t - TL) * DM : nullptr);
        if (xo) {
#pragma unroll
            for (int j = 0; j < 4; ++j) *(f32x4*)(xo + 4 * lane + 256 * j) = r.x[j];
        }
        if (Hp) {
            float ss = 0.f;
#pragma unroll
            for (int j = 0; j < 4; ++j) ss += (r.x[j][0] * r.x[j][0] + r.x[j][1] * r.x[j][1]) + (r.x[j][2] * r.x[j][2] + r.x[j][3] * r.x[j][3]);
            const float rstd = 1.0f / sqrtf(wave_sum(ss) * (1.0f / DM) + EPSV);
#pragma unroll
            for (int j = 0; j < 4; ++j) { const f32x4 h = (r.x[j] * rstd * vpre[j]) * vsc[j] + vsh[j];
                u32x2 w; w.x = pk2(h[0], h[1]); w.y = pk2(h[2], h[3]);
                *(u32x2*)(Hp + (size_t)t * DM + 4 * lane + 256 * j) = w; }
        }
    };
    int t = tbeg;
    if (t < tend) ew_load(A, xin_lat, xin_ctx, Yp, Y2p, t, lane);
    while (t < tend) {
        const int tn = t + 8;
        if (tn < tend) ew_load(B, xin_lat, xin_ctx, Yp, Y2p, tn, lane);
        process(A, t);
        const int tnn = tn + 8;
        if (tnn < tend) ew_load(A, xin_lat, xin_ctx, Yp, Y2p, tnn, lane);
        if (tn < tend) process(B, tn);
        t = tnn;
    }
}

__device__ __forceinline__ void conv_item(CParams& p, LAS unsigned char* lds, int l, int s, int tb) {
    const int tid = otid(), wave = tid >> 6, lane = tid & 63;
    const bf16_t* PROJ = (const bf16_t*)(p.ws + WS_PROJ); bf16_t* YCAT = (bf16_t*)(p.ws + WS_YCAT);
    LAS float* sA = (LAS float*)lds;
    const int tokbase = s < 16 ? s * 2048 : TL + (s - 16) * 256, len = s < 16 ? 2048 : 256, t0 = tb * 64;
    for (int u = tid; u < 94 * 32; u += 512) {
        const int rr = u >> 5, c8 = (u & 31) * 8, tt = t0 - 15 + rr;
        float v[8];
        if (tt >= 0 && tt < len) {
            const bf16_t* rp = PROJ + (size_t)(tokbase + tt) * NP + c8;
            const u32x4 ua = *(const u32x4*)rp, ug = *(const u32x4*)(rp + 256);
            v[0] = bflo(ua.x) * sigmoid_f(bflo(ug.x)); v[1] = bfhi(ua.x) * sigmoid_f(bfhi(ug.x));
            v[2] = bflo(ua.y) * sigmoid_f(bflo(ug.y)); v[3] = bfhi(ua.y) * sigmoid_f(bfhi(ug.y));
            v[4] = bflo(ua.z) * sigmoid_f(bflo(ug.z)); v[5] = bfhi(ua.z) * sigmoid_f(bfhi(ug.z));
            v[6] = bflo(ua.w) * sigmoid_f(bflo(ug.w)); v[7] = bfhi(ua.w) * sigmoid_f(bfhi(ug.w));
        } else {
#pragma unroll
            for (int e = 0; e < 8; ++e) v[e] = 0.f;
        }
        *(LAS f32x4*)(sA + rr * 256 + c8) = (f32x4){v[0], v[1], v[2], v[3]};
        *(LAS f32x4*)(sA + rr * 256 + c8 + 4) = (f32x4){v[4], v[5], v[6], v[7]};
    }
    __syncthreads();
    const int ch = tid & 255, half = tid >> 8;
    float out[32];
    {
        float w[31];
#pragma unroll
        for (int j = 0; j < 31; ++j) w[j] = p.conv_w[((size_t)l * 31 + j) * 256 + ch];
        const float bias = p.conv_b[l * 256 + ch];
        const LAS float* ap = sA + (half * 32) * 256 + ch;
        float in[62];
#pragma unroll
        for (int i = 0; i < 62; ++i) in[i] = ap[i * 256];
#pragma unroll
        for (int q = 0; q < 32; ++q) {
            float acc = bias;
#pragma unroll
            for (int j = 0; j < 31; ++j) acc += in[q + j] * w[j];
            out[q] = acc;
        }
    }
    __syncthreads();
#pragma unroll
    for (int q = 0; q < 32; ++q) sA[(half * 32 + q) * 256 + ch] = out[q];
    __syncthreads();
    {
        const f32x4 lg = *(const f32x4*)(p.ln_g + l * 256 + 4 * lane), lb = *(const f32x4*)(p.ln_b + l * 256 + 4 * lane);
#pragma unroll
        for (int q = 0; q < 8; ++q) {
            const int tok = wave * 8 + q;
            const f32x4 v = *(const LAS f32x4*)(sA + tok * 256 + 4 * lane);
            const float mean = wave_sum((v[0] + v[1]) + (v[2] + v[3])) * (1.0f / 256.0f);
            const f32x4 d = v - mean;
            const float var = wave_sum((d[0] * d[0] + d[1] * d[1]) + (d[2] * d[2] + d[3] * d[3])) * (1.0f / 256.0f);
            const float rstd = 1.0f / sqrtf(var + EPSV);
            const f32x4 yn = d * rstd * lg + lb;
            u32x2 o; o.x = pk2(silu_f(yn[0]), silu_f(yn[1])); o.y = pk2(silu_f(yn[2]), silu_f(yn[3]));
            *(u32x2*)(YCAT + (size_t)(tokbase + t0 + tok) * YC_LD + 4 * lane) = o;
        }
    }
    __syncthreads();
}

struct AttnItem {
    int mode;
    int qtok0;
    int qcol0, qcol1, ocol0, ocol1;
    int kcol0, kcol1, vcol0, vcol1; int nslots;
    int nloc, loctok0;
    int ctxtok0;
    int r, rs;
    int q0, kp0;
    int has_sink; float sink0, sink1;
    int h0;
};
constexpr int KROW = 72;
constexpr int KV_BYTES = 64 * KROW * 2;
constexpr int ABUF_BYTES = 4 * KV_BYTES;
typedef short s16x4 __attribute__((ext_vector_type(4)));
template <int OFF> __device__ __forceinline__ s16x4 tr_read(unsigned addr) {
    s16x4 r; asm volatile("ds_read_b64_tr_b16 %0, %1 offset:%2" : "=&v"(r) : "v"(addr), "i"(OFF) : "memory"); return r;
}
template <int NKB>
__device__ __forceinline__ void attn_chunk(const LAS unsigned char* kt, const LAS unsigned char* vt, int kofs, const bf16x8 (&qf)[2], int fr, int fq,
                                           int mtype, int a0, const LAS float* bt, float& mrun, float& lsum, f32x4 (&o)[4]) {
    f32x4 sacc[NKB];
    const LAS unsigned char* kb_base = kt + ((kofs + fr) * KROW + 8 * fq) * 2;
#pragma unroll
    for (int kb = 0; kb < NKB; ++kb) {
        sacc[kb] = (f32x4){0.f, 0.f, 0.f, 0.f};
#pragma unroll
        for (int kk = 0; kk < 2; ++kk) {
            const bf16x8 a = *(const LAS bf16x8*)(kb_base + (16 * kb * KROW + 32 * kk) * 2);
            sacc[kb] = __builtin_amdgcn_mfma_f32_16x16x32_bf16(a, qf[kk], sacc[kb], 0, 0, 0);
        }
    }
    if (mtype == 1) {
        const int wsx = min(max(a0 - 8, 0), 48);
#pragma unroll
        for (int kb = 0; kb < NKB; ++kb)
#pragma unroll
            for (int j = 0; j < 4; ++j) { const int kc = kofs + 16 * kb + 4 * fq + j; const bool ok = (kc >= wsx) && (kc < wsx + 16);
                const int dc = min(max(kc - a0 + 15, 0), 30);
                sacc[kb][j] = ok ? (sacc[kb][j] + bt[dc]) * LOG2E : -1.0e30f; }
    } else if (mtype == 2) {
#pragma unroll
        for (int kb = 0; kb < NKB; ++kb)
#pragma unroll
            for (int j = 0; j < 4; ++j) { const int d = a0 + kofs + 16 * kb + 4 * fq + j; const bool ok = (d <= 128) && (d >= -128);
                sacc[kb][j] = ok ? sacc[kb][j] * LOG2E : -1.0e30f; }
    } else {
#pragma unroll
        for (int kb = 0; kb < NKB; ++kb) sacc[kb] = sacc[kb] * LOG2E;
    }
    float cm = sacc[0][0];
#pragma unroll
    for (int kb = 0; kb < NKB; ++kb)
#pragma unroll
        for (int j = 0; j < 4; ++j) cm = fmaxf(cm, sacc[kb][j]);
    cm = fmaxf(cm, __shfl_xor(cm, 16)); cm = fmaxf(cm, __shfl_xor(cm, 32));
    const float mnew = fmaxf(mrun, cm), alpha = fast_exp2(mrun - mnew);
    mrun = mnew;
    float ps = 0.f;
#pragma unroll
    for (int kb = 0; kb < NKB; ++kb)
#pragma unroll
        for (int j = 0; j < 4; ++j) { sacc[kb][j] = fast_exp2(sacc[kb][j] - mnew); ps += sacc[kb][j]; }
    lsum = lsum * alpha + ps;
#pragma unroll
    for (int db = 0; db < 4; ++db) o[db] = o[db] * alpha;
    const unsigned vaddr = (unsigned)(size_t)vt + (unsigned)(((kofs + 4 * fq + (fr >> 2)) * KROW + 4 * (fr & 3)) * 2);
#pragma unroll
    for (int grp = 0; grp < NKB / 2; ++grp) {
        union { bf16x8 v; unsigned u[4]; } pb;
        pb.u[0] = pk2(sacc[2 * grp][0], sacc[2 * grp][1]); pb.u[1] = pk2(sacc[2 * grp][2], sacc[2 * grp][3]);
        pb.u[2] = pk2(sacc[2 * grp + 1][0], sacc[2 * grp + 1][1]); pb.u[3] = pk2(sacc[2 * grp + 1][2], sacc[2 * grp + 1][3]);
        const unsigned va = vaddr + (unsigned)(grp * 32 * KROW * 2);
        const s16x4 l0 = tr_read<0>(va), h0 = tr_read<16 * KROW * 2>(va), l1 = tr_read<32>(va), h1 = tr_read<16 * KROW * 2 + 32>(va);
        const s16x4 l2 = tr_read<64>(va), h2 = tr_read<16 * KROW * 2 + 64>(va), l3 = tr_read<96>(va), h3 = tr_read<16 * KROW * 2 + 96>(va);
        asm volatile("s_waitcnt lgkmcnt(0)" ::: "memory"); __builtin_amdgcn_sched_barrier(0);
#define ATT_PK(L, H) (bf16x8){L[0], L[1], L[2], L[3], H[0], H[1], H[2], H[3]}
        o[0] = __builtin_amdgcn_mfma_f32_16x16x32_bf16(ATT_PK(l0, h0), pb.v, o[0], 0, 0, 0);
        o[1] = __builtin_amdgcn_mfma_f32_16x16x32_bf16(ATT_PK(l1, h1), pb.v, o[1], 0, 0, 0);
        o[2] = __builtin_amdgcn_mfma_f32_16x16x32_bf16(ATT_PK(l2, h2), pb.v, o[2], 0, 0, 0);
        o[3] = __builtin_amdgcn_mfma_f32_16x16x32_bf16(ATT_PK(l3, h3), pb.v, o[3], 0, 0, 0);
#undef ATT_PK
    }
}

__device__ __forceinline__ void attn_item(CParams& p, LAS unsigned char* lds, int l, const AttnItem& it) {
    const int tid = otid(), wave = tid >> 6, lane = tid & 63, g = wave >> 2, wq = wave & 3, fr = lane & 15, fq = lane >> 4;
    const bf16_t* PROJ = (const bf16_t*)(p.ws + WS_PROJ); bf16_t* YCAT = (bf16_t*)(p.ws + WS_YCAT);
    LAS float* sB = (LAS float*)(lds + 2 * ABUF_BYTES);
    const int slot = it.nslots == 2 ? g : 0;
    if (it.mode == 0) { for (int i = tid; i < 2 * 465; i += 512) sB[i] = p.nat_bias[(size_t)(l * 4 + it.h0) * 465 + i]; }
    bf16x8 qf[2];
    { const bf16_t* qp = PROJ + (size_t)(it.qtok0 + wq * 16 + fr) * NP + (g ? it.qcol1 : it.qcol0) + 8 * fq;
      qf[0] = *(const bf16x8*)qp; qf[1] = *(const bf16x8*)(qp + 32); }
    float mrun = -3.0e38f, lsum = 0.f;
    f32x4 o[4];
#pragma unroll
    for (int db = 0; db < 4; ++db) o[db] = (f32x4){0.f, 0.f, 0.f, 0.f};
    const int nchunks = 4 + it.nloc;
    const int srow = tid >> 3, sseg = tid & 7;
    u32x4 kreg[2], vreg[2];
    auto chunk_tok = [&](int c) { return c < 4 ? it.ctxtok0 + 64 * c : it.loctok0 + 64 * (c - 4); };
    auto gload = [&](int c) {
        const bf16_t* rp = PROJ + (size_t)(chunk_tok(c) + srow) * NP + 8 * sseg;
#pragma unroll
        for (int s = 0; s < 2; ++s) if (s < it.nslots) { kreg[s] = *(const u32x4*)(rp + (s ? it.kcol1 : it.kcol0)); vreg[s] = *(const u32x4*)(rp + (s ? it.vcol1 : it.vcol0)); }
    };
    auto lwrite = [&](int c) {
        LAS unsigned char* bufp = lds + (c & 1) * ABUF_BYTES + (srow * KROW + 8 * sseg) * 2;
#pragma unroll
        for (int s = 0; s < 2; ++s) if (s < it.nslots) { *(LAS u32x4*)(bufp + s * KV_BYTES) = kreg[s]; *(LAS u32x4*)(bufp + (2 + s) * KV_BYTES) = vreg[s]; }
    };
    gload(0); lwrite(0);
    if (nchunks > 1) gload(1);
    __syncthreads();
    const int qi = wq * 16 + fr;
    const int nat_kofs = min(max(16 * wq - 8, 0), 32);
    for (int c = 0; c < nchunks; ++c) {
        if (c + 1 < nchunks) lwrite(c + 1);
        if (c + 2 < nchunks) gload(c + 2);
        const LAS unsigned char* kt = lds + (c & 1) * ABUF_BYTES + slot * KV_BYTES;
        const LAS unsigned char* vt = kt + 2 * KV_BYTES;
        if (c >= 4 && it.mode == 0) {
            const int dr = (it.rs + (c - 4)) - it.r + 7;
            attn_chunk<2>(kt, vt, nat_kofs, qf, fr, fq, 1, qi, sB + g * 465 + dr * 31, mrun, lsum, o);
        } else if (c >= 4 && it.mode == 1) {
            attn_chunk<4>(kt, vt, 0, qf, fr, fq, 2, it.kp0 + 64 * (c - 4) - (it.q0 + qi), sB, mrun, lsum, o);
        } else {
            attn_chunk<4>(kt, vt, 0, qf, fr, fq, 0, 0, sB, mrun, lsum, o);
        }
        __syncthreads();
    }
    lsum += __shfl_xor(lsum, 16); lsum += __shfl_xor(lsum, 32);
    if (it.has_sink) lsum += fast_exp2((g ? it.sink1 : it.sink0) * LOG2E - mrun);
    const float inv = 1.0f / lsum;
    bf16_t* op = YCAT + (size_t)(it.qtok0 + wq * 16 + fr) * YC_LD + (g ? it.ocol1 : it.ocol0) + 4 * fq;
#pragma unroll
    for (int db = 0; db < 4; ++db) { u32x2 w; w.x = pk2(o[db][0] * inv, o[db][1] * inv); w.y = pk2(o[db][2] * inv, o[db][3] * inv); *(u32x2*)(op + 16 * db) = w; }
}

constexpr int C_UA = 0, C_QN = 512, C_KN = 768, C_VN = 1024, C_QS = 1280, C_KS = 1536, C_VS = 1664;

__device__ __forceinline__ void mix_items(CParams& p, LAS unsigned char* lds, int l, int sub) {
    const int n_attn = (l == 0) ? 2304 : 2048;
    const int n_conv = (l == 0) ? 512 + 64 : 512;
    const int start = (obid() + 128) % gridDim.x;
    for (int i = start; i < n_attn + n_conv; i += gridDim.x) {
        if (i >= n_attn) {
            if (!(sub & 4)) continue;
            const int ci = i - n_attn;
            if (ci < 512) conv_item(p, lds, l, ci >> 5, ci & 31);
            else { const int cj = ci - 512; conv_item(p, lds, l, 16 + (cj >> 2), cj & 3); }
            continue;
        }
        AttnItem it{};
        if (i < 1024) {
            const int b = i >> 6, r = (i >> 1) & 31, hp = i & 1;
            it.mode = 0; it.qtok0 = b * 2048 + r * 64; it.nslots = 2; it.h0 = 2 * hp;
            { const int h = 2 * hp; it.qcol0 = C_QN + 64 * h; it.kcol0 = C_KN + 64 * h; it.vcol0 = C_VN + 64 * h; it.ocol0 = 512 + 64 * h;
              it.qcol1 = it.qcol0 + 64; it.kcol1 = it.kcol0 + 64; it.vcol1 = it.vcol0 + 64; it.ocol1 = it.ocol0 + 64; }
            it.r = r; it.rs = min(max(r - 4, 0), 24); it.nloc = 8; it.loctok0 = b * 2048 + it.rs * 64; it.ctxtok0 = TL + b * 256;
        } else if (i < 2048) {
            const int k = i - 1024, b = k >> 6, qb = (k >> 1) & 31, kvh = k & 1;
            it.mode = 1; it.qtok0 = b * 2048 + qb * 64; it.nslots = 1;
            { const int h = 2 * kvh; it.qcol0 = C_QS + 64 * h; it.ocol0 = 768 + 64 * h; it.sink0 = p.sink[l * 4 + h]; it.sink1 = p.sink[l * 4 + h + 1];
              it.qcol1 = it.qcol0 + 64; it.ocol1 = it.ocol0 + 64; it.kcol0 = it.kcol1 = C_KS + 64 * kvh; it.vcol0 = it.vcol1 = C_VS + 64 * kvh; }
            it.has_sink = 1; it.q0 = qb * 64;
            const int ks = max(qb * 64 - 128, 0), ke = min(qb * 64 + 192, 2048);
            it.kp0 = ks; it.nloc = (ke - ks) >> 6; it.loctok0 = b * 2048 + ks; it.ctxtok0 = TL + b * 256;
        } else if (i < 2176) {
            const int k = i - 2048, b = k >> 3, qb = (k >> 1) & 3, hp = k & 1;
            it.mode = 2; it.qtok0 = TL + b * 256 + qb * 64; it.nslots = 2;
            { const int h = 2 * hp; it.qcol0 = C_QN + 64 * h; it.kcol0 = C_KN + 64 * h; it.vcol0 = C_VN + 64 * h; it.ocol0 = 512 + 64 * h;
              it.qcol1 = it.qcol0 + 64; it.kcol1 = it.kcol0 + 64; it.vcol1 = it.vcol0 + 64; it.ocol1 = it.ocol0 + 64; }
            it.nloc = 0; it.ctxtok0 = TL + b * 256;
        } else {
            const int k = i - 2176, b = k >> 3, qb = (k >> 1) & 3, kvh = k & 1;
            it.mode = 2; it.qtok0 = TL + b * 256 + qb * 64; it.nslots = 1;
            { const int h = 2 * kvh; it.qcol0 = C_QS + 64 * h; it.ocol0 = 768 + 64 * h; it.sink0 = p.sink[l * 4 + h]; it.sink1 = p.sink[l * 4 + h + 1];
              it.qcol1 = it.qcol0 + 64; it.ocol1 = it.ocol0 + 64; it.kcol0 = it.kcol1 = C_KS + 64 * kvh; it.vcol0 = it.vcol1 = C_VS + 64 * kvh; }
            it.has_sink = 1; it.nloc = 0; it.ctxtok0 = TL + b * 256;
        }
        if (sub & 2) attn_item(p, lds, l, it);
    }
}

constexpr int N_PHASES = 22;
#ifndef PHMASK
#define PHMASK 0xff
#endif

__device__ __forceinline__ void run_phase(CParams& p, LAS unsigned char* lds, int ph, int sub) {
    unsigned char* ws = p.ws;
    bf16_t* YH = (bf16_t*)(ws + WS_YH); bf16_t* U = (bf16_t*)(ws + WS_R1); bf16_t* PROJ = (bf16_t*)(ws + WS_PROJ); bf16_t* YCAT = (bf16_t*)(ws + WS_YCAT);
    float* XC = (float*)(ws + WS_XC); const float* MOD = (const float*)(ws + WS_MOD);
    const int G = gridDim.x, c = obid();
    if (ph == 0) { if constexpr ((PHMASK & 1) != 0) phase0(p, lds); return; }
    if (ph == 1) {
        if constexpr ((PHMASK & 2) == 0) return;
        ew_pass(p.x, p.ctx, nullptr, nullptr, nullptr, nullptr, nullptr, 0.f, nullptr, YH, p.norm_g, MOD, MOD + 1024, TA); return;
    }
    const int l = (ph - 2) / 10, k = (ph - 2) % 10;
    const float* MODL = MOD + (size_t)l * 17 * NMODC; const float* NG = p.norm_g + (size_t)l * 6 * DM;
    const int rows_late = (l == 0) ? TA : TL;
    switch (k) {
    case 0: case 7: {
        if constexpr ((PHMASK & 4) == 0) break;
        const int f = (k == 7), M = f ? rows_late : TA;
        pg8::Gemm g{YH, (const bf16_t*)(ws + WS_W13) + (size_t)(l * 2 + f) * 5632 * 1024, M, 5632, 1024, 1024, 1024};
        pg8::StaticOrder S; S.init(M, 5632, G, c); EpiSwiGLU E{U};
        pg8::gemm_phase<EpiSwiGLU, pg8::StaticOrder, true, true>(lds, g, S, E);
    } break;
    case 1: case 8: case 5: {
        if constexpr ((PHMASK & 8) == 0) break;
        const bool isout = (k == 5); const int f = (k == 8), M = (k == 1) ? TA : rows_late;
        const int Kd = isout ? YC_LD : FF;
        const bf16_t* Ap = isout ? YCAT : U;
        const bf16_t* Bp = isout ? (const bf16_t*)(ws + WS_WOUT) + (size_t)l * 1024 * YC_LD : (const bf16_t*)(ws + WS_W2T) + (size_t)(l * 2 + f) * 1024 * FF;
        for (int v = 0; v < (M == TA ? 3 : 1); ++v) {
            pg8::Gemm g = v == 0 ? pg8::Gemm{Ap, Bp, TL, 1024, Kd, Kd, Kd}
                                 : pg8::Gemm{Ap + (size_t)TL * Kd + (v - 1) * (Kd / 2), Bp + (v - 1) * (Kd / 2), TC, 1024, Kd / 2, Kd, Kd};
            pg8::StaticOrder S; S.init(g.M, 1024, G, v == 2 ? (c + G - 64) % G : c);
            EpiBf16Tile E{v == 0 ? YH : (v == 1 ? YH + (size_t)TL * DM : (bf16_t*)(ws + WS_Y2)), 1024, 0, 256};
            pg8::gemm_phase<EpiBf16Tile, pg8::StaticOrder, true, true>(lds, g, S, E);
        }
    } break;
    case 2: case 6: case 9: {
        if constexpr ((PHMASK & 2) == 0) break;
        const int gi = (k == 2) ? 2 : (k == 6 ? 5 : 8), ni = (k == 2) ? 1 : (k == 6 ? 3 : 5);
        const int nrows = (k == 2) ? TA : rows_late;
        const bool lastl = (k == 9 && l == 1);
        const float* gpre = (k == 2) ? NG + 2 * DM : (k == 6 ? NG + 4 * DM : p.norm_g + 6 * DM);
        const float* shift = (k == 2) ? MODL + 3 * 1024 : (k == 6 ? MODL + 6 * 1024 : MOD + 17 * NMODC);
        const float* scale = (k == 2) ? MODL + 4 * 1024 : (k == 6 ? MODL + 7 * 1024 : MOD + 17 * NMODC + 1024);
        float* outp = p.out;
        const bool first = (l == 0 && k == 2);
        ew_pass(first ? p.x : outp, first ? p.ctx : XC, outp, XC, YH, (const bf16_t*)(ws + WS_Y2), NG + ni * DM, (k == 6) ? 1.0f : 0.5f, MODL + gi * 1024, lastl ? nullptr : YH, gpre, shift, scale, nrows);
    } break;
    case 3: {
        if constexpr ((PHMASK & 16) == 0) break;
        const bf16_t* W = (const bf16_t*)(ws + WS_WIN) + (size_t)l * 2304 * 1024;
        { pg8::Gemm g{YH, W, TA, NP, 1024, 1024, 1024}; pg8::StaticOrder S; S.init(TA, NP, G, c); EpiWin E{PROJ, (const float*)(ws + WS_ROPE)};
          pg8::gemm_phase<EpiWin, pg8::StaticOrder, true, true>(lds, g, S, E); }
        { const int N = (l == 0) ? TA : TL; pg8::Gemm g{W + (size_t)1792 * 1024, YH, 512, N, 1024, 1024, 1024}; pg8::StaticOrder S; S.init(512, N, G, (c + 16) % G);
          EpiPQ E{(bf16_t*)(ws + WS_PQT), (bf16_t*)(ws + WS_PQTC)};
          pg8::gemm_phase<EpiPQ, pg8::StaticOrder, true, true>(lds, g, S, E); }
    } break;
    case 4: {
        if constexpr ((PHMASK & 32) == 0) break;
        if (sub & 1)
        for (int v = 0; v < ((l == 0) ? 4 : 2); ++v) {
            const int hs = v & 1, isc = v >> 1;
            const bf16_t* Ap = isc ? (const bf16_t*)(ws + WS_DFTC) + hs * 256 : (const bf16_t*)(ws + WS_DFT) + hs * 2048;
            const bf16_t* Bp = isc ? (const bf16_t*)(ws + WS_PQTC) + hs * 256 : (const bf16_t*)(ws + WS_PQT) + hs * 2048;
            pg8::Gemm g{Ap, Bp, isc ? 256 : 2048, 4096, isc ? 256 : 2048, isc ? DFTC_LD : DFT_LD, isc ? PQTC_LD : PQT_LD};
            pg8::StaticOrder S; S.init(g.M, g.N, G, isc ? (c + G - 16 * hs) % G : (c + G - 128 * hs) % G);
            EpiBf16Tile E{YCAT + (isc ? (size_t)TL * YC_LD : 0) + (hs ? 1024 : 256), YC_LD, isc ? 256 : 2048, 0};
            pg8::gemm_phase<EpiBf16Tile, pg8::StaticOrder, true, true>(lds, g, S, E);
        }
        if (sub & 6) mix_items(p, lds, l, sub);
    } break;
    }
}

__global__ void __launch_bounds__(512, 2) mega(Params p, int ph0, int ph1) {
    extern __shared__ __attribute__((aligned(16))) unsigned char lds_raw[];
    LAS unsigned char* lds = (LAS unsigned char*)lds_raw;
    cg::grid_group grid = cg::this_grid();
    if (ph1 < 0) grid.sync();
    volatile LAS unsigned* xst = (volatile LAS unsigned*)(lds + 131072);
    if (threadIdx.x < 4) xst[threadIdx.x] = 0u;
    __syncthreads();
    XcdBarrier xb = xcd_barrier_post((unsigned*)(p.ws + WS_BAR), xst);
#ifdef TPROBE
    unsigned long long tacc = 0, tprev = __builtin_amdgcn_s_memrealtime();
#endif
    for (int ph = ph0; ph < ph1; ++ph) {
        CParams* q = (CParams*)__builtin_amdgcn_kernarg_segment_ptr(); asm volatile("" : "+s"(q));
        run_phase(*q, lds, ph, 7);
#ifdef DUPK
        { const int kind = ph == 0 ? 10 : (ph == 1 ? 11 : (ph - 2) % 10);
          if ((DUPK >> kind) & 1) { xcd_barrier(xb); run_phase(*q, lds, ph, DUPSUB); } }
#endif
        if (ph + 1 < ph1) xcd_barrier(xb);
#ifdef TPROBE
        { const unsigned long long now = __builtin_amdgcn_s_memrealtime(); const int kind = ph == 0 ? 10 : (ph == 1 ? 11 : (ph - 2) % 10);
          if ((TPROBE >> kind) & 1) tacc += now - tprev; tprev = now; }
#endif
    }
#ifdef TPROBE
    if (blockIdx.x == 0 && threadIdx.x == 0) { const unsigned long long t0 = __builtin_amdgcn_s_memrealtime(); while (__builtin_amdgcn_s_memrealtime() - t0 < tacc) __builtin_amdgcn_s_sleep(8); }
#endif
#ifdef XSYNC
    for (int i = 0; i < XSYNC; ++i) xcd_barrier(xb);
#endif
}

#ifndef ONE_LAUNCH
#define ONE_LAUNCH 1
#endif

extern "C" void kernel_launch(void* const* d_in, const int* in_sizes, int n_in, void* d_out, int out_size, void* d_ws, size_t ws_size, hipStream_t stream) {
    static int grid = 0;
    if (grid == 0) {
        if (ws_size < WS_END) { fprintf(stderr, "kernel_launch: workspace too small: %zu < %zu\n", ws_size, (size_t)WS_END); grid = -1; return; }
        int dev = 0, cus = 0, per_cu = 0;
        hipGetDevice(&dev); hipDeviceGetAttribute(&cus, hipDeviceAttributeMultiprocessorCount, dev);
        hipFuncSetAttribute((const void*)mega, hipFuncAttributeMaxDynamicSharedMemorySize, LDS_BYTES);
        hipOccupancyMaxActiveBlocksPerMultiprocessor(&per_cu, (const void*)mega, 512, LDS_BYTES);
        if (per_cu < 1) { fprintf(stderr, "kernel_launch: occupancy query says %d blocks per CU\n", per_cu); per_cu = 1; }
        (void)hipGetLastError();
        grid = cus;
    }
    if (grid < 0) return;
    (void)hipMemsetAsync((unsigned char*)d_ws + WS_BAR, 0, 3456 * 4, stream);
    Params p{};
    p.x = (const float*)d_in[0]; p.c = (const float*)d_in[1]; p.ctx = (const float*)d_in[2]; p.c_ctx = (const float*)d_in[3];
    p.w_ada = (const float*)d_in[4]; p.b_ada = (const float*)d_in[5]; p.norm_g = (const float*)d_in[6];
    p.w1 = (const float*)d_in[7]; p.w3 = (const float*)d_in[8]; p.w2 = (const float*)d_in[9]; p.w_in = (const float*)d_in[10];
    p.conv_w = (const float*)d_in[11]; p.conv_b = (const float*)d_in[12]; p.ln_g = (const float*)d_in[13]; p.ln_b = (const float*)d_in[14];
    p.nat_bias = (const float*)d_in[15]; p.sink = (const float*)d_in[16]; p.w_out = (const float*)d_in[17];
    p.out = (float*)d_out; p.ws = (unsigned char*)d_ws;
#if ONE_LAUNCH
    int ph0 = 0, ph1 = N_PHASES;
    void* args[] = {&p, &ph0, &ph1};
    hipError_t e = hipLaunchCooperativeKernel((const void*)mega, dim3(grid), dim3(512), args, LDS_BYTES, stream);
    if (e != hipSuccess) fprintf(stderr, "cooperative launch failed: %s (grid %d)\n", hipGetErrorString(e), grid);
#else
    for (int ph = 0; ph < N_PHASES; ++ph) {
        int ph0 = ph, ph1 = ph + 1;
        void* args[] = {&p, &ph0, &ph1};
        hipError_t e = hipLaunchCooperativeKernel((const void*)mega, dim3(grid), dim3(512), args, LDS_BYTES, stream);
        if (e != hipSuccess) { fprintf(stderr, "launch %d failed: %s (grid %d)\n", ph, hipGetErrorString(e), grid); break; }
    }
#endif
}
```

```cpp
#include <hip/hip_runtime.h>
#include <hip/hip_cooperative_groups.h>
#include <cstdio>
#include <cstdint>
namespace cg = cooperative_groups;
#ifdef TSUB
#define TS_BEGIN(id) do { if ((TSUB) == (id) && threadIdx.x == 0) { *(volatile __attribute__((address_space(3))) unsigned long long*)(lds + 131080) -= __builtin_amdgcn_s_memrealtime(); } } while (0)
#define TS_END(id)   do { if ((TSUB) == (id) && threadIdx.x == 0) { *(volatile __attribute__((address_space(3))) unsigned long long*)(lds + 131080) += __builtin_amdgcn_s_memrealtime(); } } while (0)
#else
#define TS_BEGIN(id) do {} while (0)
#define TS_END(id) do {} while (0)
#endif
namespace pg8 {
#define PG8_LAS __attribute__((address_space(3)))
typedef unsigned short bf16_t;
typedef short bf16x8 __attribute__((ext_vector_type(8)));
typedef float f32x4 __attribute__((ext_vector_type(4)));
typedef unsigned u32x4 __attribute__((ext_vector_type(4)));
constexpr int BM = 256, BK = 64, HALF = 128, HTB = HALF * BK * 2  , STAGE_BYTES = 8 * HTB, NXCD = 8, WGM = 8;

__host__ __device__ __forceinline__ int lds_byte(int r, int c) { const int st = (r >> 4) * 2 + (c >> 5), rr = r & 15, cc = c & 31, ob = rr * 64 + cc * 2; return st * 1024 + (ob ^ (((ob >> 9) & 1) << 5)); }
__host__ __device__ __forceinline__ void stage_rc(int b, int& R, int& C) { const int st = b / 1024, sb = b % 1024, swz = sb ^ (((sb >> 9) & 1) << 5); R = (st >> 1) * 16 + swz / 64; C = (st & 1) * 32 + (swz % 64) / 2; }
__host__ __device__ __forceinline__ int perm32(int rho) { const int n = rho >> 4, i = rho & 15; return 8 * (i >> 2) + 4 * n + (i & 3); }

struct Unit { int pm, pn; };
struct Gemm { const bf16_t* A; const bf16_t* Bt; int M, N, K, lda, ldb; };

struct StaticOrder {
    int nM, nN, nwg, G, c;
    __host__ __device__ void init(int M, int N, int G_, int c_) { nM = M / BM; nN = N / BM; nwg = nM * nN; G = G_; c = c_; }
    __host__ __device__ bool next(int i, Unit& u) const {
        const long L = (long)i * G + c; if (L >= nwg) return false;
        int wgid = (int)L; { const int q = nwg / NXCD, r = nwg % NXCD, xcd = wgid % NXCD, off = wgid / NXCD; wgid = (xcd < r ? xcd * (q + 1) : r * (q + 1) + (xcd - r) * q) + off; }
        const int nig = WGM * nN, gid = wgid / nig, fm = gid * WGM, gsz = (nM - fm) < WGM ? (nM - fm) : WGM;
        u.pm = fm + ((wgid % nig) % gsz); u.pn = (wgid % nig) / gsz; return true;
    }
    __device__ __forceinline__ void a_ready(const Unit&) const {}
    __device__ __forceinline__ void done(const Unit&) const {}
};
__device__ __forceinline__ unsigned cvt_pk_bf16(float lo, float hi) { unsigned r; asm volatile("v_cvt_pk_bf16_f32 %0, %1, %2" : "=v"(r) : "v"(lo), "v"(hi)); return r; }
typedef float f32x2 __attribute__((ext_vector_type(2)));
template <class Epi, class Sched, bool ALIGN_EPI = false, bool SP2 = false>
__device__ __forceinline__ void gemm_phase(PG8_LAS unsigned char* lds, const Gemm g, const Sched& S, const Epi& E) {
    int tid_ = threadIdx.x; asm volatile("" : "+v"(tid_));
    const int tid = tid_, wid = __builtin_amdgcn_readfirstlane(tid >> 6), lane = tid & 63, wr = wid >> 2, wc = wid & 3, fr = lane & 15, fq = lane >> 4;
    const int K = g.K, nt = K / BK;
    unsigned voffA[2], voffB[2];
#pragma unroll
    for (int i = 0; i < 2; ++i) { int R, C; stage_rc(tid * 16 + i * 8192, R, C); const int Rb = Epi::PERM ? ((R & ~31) + perm32(R & 31)) : R;
        voffA[i] = (unsigned)(R * g.lda + C) * 2u; voffB[i] = (unsigned)(Rb * g.ldb + C) * 2u; }
    const size_t kstep = (size_t)(BK * 2);
    const size_t hstepA = (size_t)HALF * g.lda * 2, hstepB = (size_t)HALF * g.ldb * 2;
    const size_t tstepA = 2 * hstepA, tstepB = 2 * hstepB;
    const unsigned ldsw = (unsigned)wid * 1024u;
    const int aoff = lds_byte(wr * 64 + fr, fq * 8), boff = lds_byte(wc * 32 + fr, fq * 8);
#define PG8_SA(b, h) (((b) * 2 + (h)) * HTB)
#define PG8_SB(b, h) ((4 + (b) * 2 + (h)) * HTB)
#define PG8_STAGE(bufoff, gbase, voff) do { _Pragma("unroll") for (int _i = 0; _i < 2; ++_i) \
        __builtin_amdgcn_global_load_lds((const unsigned*)((const char*)(gbase) + (voff)[_i]), (PG8_LAS unsigned*)(lds + (bufoff) + ldsw + _i * 8192), 16, 0, 0); } while (0)
#define PG8_LDA(dst, b, h) do { _Pragma("unroll") for (int m = 0; m < 4; ++m) _Pragma("unroll") for (int k = 0; k < 2; ++k) dst[m][k] = *(const PG8_LAS bf16x8*)(lds + PG8_SA(b, h) + aoff + m * 2048 + k * 1024); } while (0)
#define PG8_LDB(dst, b, h) do { _Pragma("unroll") for (int n = 0; n < 2; ++n) _Pragma("unroll") for (int k = 0; k < 2; ++k) dst[n][k] = *(const PG8_LAS bf16x8*)(lds + PG8_SB(b, h) + boff + n * 2048 + k * 1024); } while (0)
#define PG8_MMA(ai, bj, At, Bt) do { __builtin_amdgcn_s_setprio(1); _Pragma("unroll") for (int m = 0; m < 4; ++m) _Pragma("unroll") for (int n = 0; n < 2; ++n) _Pragma("unroll") for (int k = 0; k < 2; ++k) \
        acc[ai][bj][m][n] = __builtin_amdgcn_mfma_f32_16x16x32_bf16(Bt[n][k], At[m][k], acc[ai][bj][m][n], 0, 0, 0); __builtin_amdgcn_s_setprio(0); } while (0)
#define PG8_WAIT_V(n) asm volatile("s_waitcnt vmcnt(" #n ")" ::: "memory")
#define PG8_WAIT_L(n) asm volatile("s_waitcnt lgkmcnt(" #n ")" ::: "memory")
#define PG8_BAR __builtin_amdgcn_s_barrier()
#define PG8_SCHED __builtin_amdgcn_sched_barrier(0)
    Unit cur, nxt; int ui = 0;
    if (!S.next(0, cur)) return;
    f32x4 acc[2][2][4][2];
#pragma unroll
    for (int a = 0; a < 2; ++a)
#pragma unroll
        for (int b = 0; b < 2; ++b)
#pragma unroll
            for (int m = 0; m < 4; ++m)
#pragma unroll
                for (int n = 0; n < 2; ++n) acc[a][b][m][n] = (f32x4){0.f, 0.f, 0.f, 0.f};
    bf16x8 At[4][2], B0[2][2], B1[2][2];
    const char* cA = (const char*)g.A + (size_t)cur.pm * tstepA; const char* cB = (const char*)g.Bt + (size_t)cur.pn * tstepB;
    S.a_ready(cur);
    if constexpr (SP2) {
        PG8_STAGE(PG8_SB(0, 0), cB, voffB); PG8_STAGE(PG8_SB(0, 1), cB + hstepB, voffB); PG8_STAGE(PG8_SA(0, 0), cA, voffA); PG8_STAGE(PG8_SA(0, 1), cA + hstepA, voffA);
        if (wr == 1) PG8_BAR;
        PG8_WAIT_V(2); PG8_BAR;
        PG8_STAGE(PG8_SB(1, 0), cB + kstep, voffB); PG8_STAGE(PG8_SA(1, 0), cA + kstep, voffA); PG8_STAGE(PG8_SB(1, 1), cB + hstepB + kstep, voffB);
        PG8_WAIT_V(6); PG8_BAR;
    } else {
        PG8_STAGE(PG8_SB(0, 0), cB, voffB); PG8_STAGE(PG8_SA(0, 0), cA, voffA); PG8_STAGE(PG8_SB(0, 1), cB + hstepB, voffB); PG8_STAGE(PG8_SA(0, 1), cA + hstepA, voffA);
        if (wr == 1) PG8_BAR;
        PG8_WAIT_V(4); PG8_BAR;
        PG8_STAGE(PG8_SB(1, 0), cB + kstep, voffB); PG8_STAGE(PG8_SA(1, 0), cA + kstep, voffA); PG8_STAGE(PG8_SB(1, 1), cB + hstepB + kstep, voffB);
        PG8_WAIT_V(6); PG8_BAR;
    }
    for (;;) {
        const bool has_next = S.next(ui + 1, nxt);
        const char* nA = has_next ? (const char*)g.A + (size_t)nxt.pm * tstepA : cA; const char* nB = has_next ? (const char*)g.Bt + (size_t)nxt.pn * tstepB : cB;
        for (int t = 0; t < nt; t += 2) {
            const bool last = (t == nt - 2);
            const char* a1 = cA + (size_t)(t + 1) * kstep;
            const char* a2 = last ? nA : cA + (size_t)(t + 2) * kstep; const char* b2 = last ? nB : cB + (size_t)(t + 2) * kstep;
            const char* a3 = a2 + kstep; const char* b3 = b2 + kstep;
            if (last && has_next) S.a_ready(nxt);
            if constexpr (SP2) {
            PG8_LDB(B0, 0, 0); PG8_LDB(B1, 0, 1); PG8_SCHED; PG8_LDA(At, 0, 0); PG8_STAGE(PG8_SA(1, 1), a1 + hstepA, voffA);
            PG8_WAIT_V(8); PG8_WAIT_L(0); PG8_BAR; PG8_MMA(0, 0, At, B0); PG8_MMA(0, 1, At, B1); PG8_BAR; PG8_SCHED;
            PG8_LDA(At, 0, 1); PG8_STAGE(PG8_SB(0, 0), b2, voffB); PG8_STAGE(PG8_SB(0, 1), b2 + hstepB, voffB); PG8_STAGE(PG8_SA(0, 0), a2, voffA);
            PG8_WAIT_V(8); PG8_WAIT_L(0); PG8_BAR; PG8_MMA(1, 0, At, B0); PG8_MMA(1, 1, At, B1); PG8_BAR; PG8_SCHED;
            PG8_LDB(B0, 1, 0); PG8_LDB(B1, 1, 1); PG8_SCHED; PG8_LDA(At, 1, 0); PG8_STAGE(PG8_SA(0, 1), a2 + hstepA, voffA);
            PG8_WAIT_V(8); PG8_WAIT_L(0); PG8_BAR; PG8_MMA(0, 0, At, B0); PG8_MMA(0, 1, At, B1); PG8_BAR; PG8_SCHED;
            PG8_LDA(At, 1, 1); PG8_STAGE(PG8_SB(1, 0), b3, voffB); PG8_STAGE(PG8_SB(1, 1), b3 + hstepB, voffB); PG8_STAGE(PG8_SA(1, 0), a3, voffA);
            PG8_WAIT_V(8); PG8_WAIT_L(0); PG8_BAR; PG8_MMA(1, 0, At, B0); PG8_MMA(1, 1, At, B1); PG8_BAR; PG8_SCHED;
            } else {
            PG8_LDB(B0, 0, 0); PG8_SCHED; PG8_LDA(At, 0, 0); PG8_STAGE(PG8_SA(1, 1), a1 + hstepA, voffA);
            PG8_WAIT_L(8); PG8_BAR; PG8_WAIT_L(0); PG8_MMA(0, 0, At, B0); PG8_BAR; PG8_SCHED;
            PG8_LDB(B1, 0, 1); PG8_STAGE(PG8_SB(0, 0), b2, voffB);
            PG8_BAR; PG8_WAIT_L(0); PG8_MMA(0, 1, At, B1); PG8_BAR;
            PG8_LDA(At, 0, 1); PG8_STAGE(PG8_SA(0, 0), a2, voffA);
            PG8_BAR; PG8_WAIT_L(0); PG8_MMA(1, 0, At, B0); PG8_BAR; PG8_SCHED;
            PG8_STAGE(PG8_SB(0, 1), b2 + hstepB, voffB);
            PG8_WAIT_V(6); PG8_BAR; PG8_MMA(1, 1, At, B1); PG8_BAR;
            PG8_LDB(B0, 1, 0); PG8_SCHED; PG8_LDA(At, 1, 0); PG8_STAGE(PG8_SA(0, 1), a2 + hstepA, voffA);
            PG8_WAIT_L(8); PG8_BAR; PG8_WAIT_L(0); PG8_MMA(0, 0, At, B0); PG8_BAR; PG8_SCHED;
            PG8_LDB(B1, 1, 1); PG8_STAGE(PG8_SB(1, 0), b3, voffB);
            PG8_BAR; PG8_WAIT_L(0); PG8_MMA(0, 1, At, B1); PG8_BAR;
            PG8_LDA(At, 1, 1); PG8_STAGE(PG8_SA(1, 0), a3, voffA);
            PG8_BAR; PG8_WAIT_L(0); PG8_MMA(1, 0, At, B0); PG8_BAR; PG8_SCHED;
            PG8_STAGE(PG8_SB(1, 1), b3 + hstepB, voffB);
            PG8_WAIT_V(6); PG8_BAR; PG8_MMA(1, 1, At, B1); PG8_BAR;
            }
        }
        if constexpr (ALIGN_EPI) { if (wr == 0) PG8_BAR; }
        TS_BEGIN(8);
        if constexpr (!Epi::AFTER_DRAIN) { E(acc, cur, wr, wc, fr, fq); S.done(cur); }
        TS_END(8);
        if (!has_next) break;
#pragma unroll
        for (int a = 0; a < 2; ++a)
#pragma unroll
            for (int b = 0; b < 2; ++b)
#pragma unroll
                for (int m = 0; m < 4; ++m)
#pragma unroll
                    for (int n = 0; n < 2; ++n) acc[a][b][m][n] = (f32x4){0.f, 0.f, 0.f, 0.f};
        cur = nxt; cA = nA; cB = nB; ++ui;
        if constexpr (ALIGN_EPI) { if (wr == 1) PG8_BAR; }
    }
    PG8_WAIT_V(0);
    if constexpr (!ALIGN_EPI) { if (wr == 0) PG8_BAR; }
    PG8_BAR;
    if constexpr (Epi::AFTER_DRAIN) { E.fused(acc, cur, wr, wc, fr, fq, lds, wid, lane); S.done(cur); }
#undef PG8_SA
#undef PG8_SB
#undef PG8_STAGE
#undef PG8_LDA
#undef PG8_LDB
#undef PG8_MMA
#undef PG8_WAIT_V
#undef PG8_WAIT_L
#undef PG8_BAR
#undef PG8_SCHED
}
}

#define LAS __attribute__((address_space(3)))
typedef unsigned short bf16_t;
typedef float f32x4 __attribute__((ext_vector_type(4)));
typedef float f32x2 __attribute__((ext_vector_type(2)));
typedef unsigned u32x4 __attribute__((ext_vector_type(4)));
typedef unsigned u32x2 __attribute__((ext_vector_type(2)));
typedef short bf16x8 __attribute__((ext_vector_type(8)));
typedef short bf16x4 __attribute__((ext_vector_type(4)));

constexpr int TL = 32768, TC = 4096, TA = 36864, DM = 1024, FF = 2816, NP = 1792, NMODC = 9216;
constexpr int YC_LD = 1280, DFT_LD = 4160, PQT_LD = 4160, DFTC_LD = 576, PQTC_LD = 576;
constexpr int LDS_BYTES = 131072 + 16;
#ifndef MIXMASK
#define MIXMASK 7
#endif

constexpr float EPSV = 1e-6f;
constexpr float LOG2E = 1.4426950408889634f;

constexpr size_t WS_XC   = 0;
constexpr size_t WS_YH   = WS_XC + (size_t)TC * DM * 4;
constexpr size_t WS_R1   = WS_YH + (size_t)TA * DM * 2;
constexpr size_t WS_PROJ = WS_R1;
constexpr size_t WS_PQT  = WS_PROJ + (size_t)TA * NP * 2;
constexpr size_t WS_PQTC = WS_PQT + (size_t)4096 * PQT_LD * 2;
constexpr size_t WS_YCAT = WS_PQTC + (size_t)4096 * PQTC_LD * 2;
constexpr size_t WS_R1END= WS_YCAT + (size_t)TA * YC_LD * 2;
constexpr size_t WS_W13  = WS_R1END;
constexpr size_t WS_W2T  = WS_W13 + (size_t)4 * 5632 * 1024 * 2;
constexpr size_t WS_WIN  = WS_W2T + (size_t)4 * 1024 * 2816 * 2;
constexpr size_t WS_WOUT = WS_WIN + (size_t)2 * 2304 * 1024 * 2;
constexpr size_t WS_DFT  = WS_WOUT + (size_t)2 * 1024 * YC_LD * 2;
constexpr size_t WS_DFTC = WS_DFT + (size_t)2048 * DFT_LD * 2;
constexpr size_t WS_MOD  = WS_DFTC + (size_t)256 * DFTC_LD * 2;
constexpr size_t WS_ROPE = WS_MOD + (size_t)2 * 17 * NMODC * 4;
constexpr size_t WS_BAR  = WS_ROPE + 64 * 16 * 2 * 4;
constexpr size_t WS_Y2   = WS_BAR + 3456 * 4;
constexpr size_t WS_END  = WS_Y2 + (size_t)TC * DM * 2;
static_assert((size_t)TA * FF * 2 <= WS_R1END - WS_R1, "U must fit in R1");

struct Params {
    const float *x, *c, *ctx, *c_ctx, *w_ada, *b_ada, *norm_g, *w1, *w3, *w2, *w_in, *conv_w, *conv_b, *ln_g, *ln_b, *nat_bias, *sink, *w_out;
    float* out; unsigned char* ws;
};
typedef const __attribute__((address_space(4))) Params CParams;

__device__ __forceinline__ unsigned pk2(float lo, float hi) { return pg8::cvt_pk_bf16(lo, hi); }
__device__ __forceinline__ float bflo(unsigned v) { return __uint_as_float(v << 16); }
__device__ __forceinline__ float bfhi(unsigned v) { return __uint_as_float(v & 0xffff0000u); }
__device__ __forceinline__ float wave_sum(float v) {
#pragma unroll
    for (int o = 1; o < 64; o <<= 1) v += __shfl_xor(v, o);
    return v;
}
__device__ __forceinline__ int otid() { int t = threadIdx.x; asm volatile("" : "+v"(t)); return t; }
__device__ __forceinline__ int obid() { int t = blockIdx.x; asm volatile("" : "+s"(t)); return t; }
__device__ __forceinline__ float xrow16_max(float x) {
    auto s = __builtin_amdgcn_permlane16_swap(__float_as_uint(x), __float_as_uint(x), false, false);
    x = fmaxf(__uint_as_float(s[0]), __uint_as_float(s[1]));
    auto t = __builtin_amdgcn_permlane32_swap(__float_as_uint(x), __float_as_uint(x), false, false);
    return fmaxf(__uint_as_float(t[0]), __uint_as_float(t[1]));
}
__device__ __forceinline__ float xrow16_sum(float x) {
    auto s = __builtin_amdgcn_permlane16_swap(__float_as_uint(x), __float_as_uint(x), false, false);
    x = __uint_as_float(s[0]) + __uint_as_float(s[1]);
    auto t = __builtin_amdgcn_permlane32_swap(__float_as_uint(x), __float_as_uint(x), false, false);
    return __uint_as_float(t[0]) + __uint_as_float(t[1]);
}
__device__ __forceinline__ float fast_exp2(float x) { return __builtin_amdgcn_exp2f(x); }
__device__ __forceinline__ float fast_rcp(float x) { return __builtin_amdgcn_rcpf(x); }
__device__ __forceinline__ float silu_f(float v) { return v * fast_rcp(1.0f + fast_exp2(-v * LOG2E)); }
__device__ __forceinline__ float sigmoid_f(float v) { return fast_rcp(1.0f + fast_exp2(-v * LOG2E)); }

#define XB_TMO      128
#define XB_XCNT(j)  (256  + 64 * (j))
#define XB_XSUB(j)  (1280 + 64 * (j))
#define XB_XGEN(j)  (2304 + 64 * (j))
#define XB_TOP      3328
#define XB_TOPGEN   3392
#define XCD_BAR_WORDS 3456
#define XB_SPIN_CAP (1u << 18)

__device__ __forceinline__ unsigned xb_ld(unsigned* p)              { return __hip_atomic_load(p, __ATOMIC_RELAXED, __HIP_MEMORY_SCOPE_AGENT); }
__device__ __forceinline__ unsigned xb_add(unsigned* p, unsigned v) { return __hip_atomic_fetch_add(p, v, __ATOMIC_RELAXED, __HIP_MEMORY_SCOPE_AGENT); }
__device__ __forceinline__ unsigned xb_xcc_id() { return (unsigned)__builtin_amdgcn_s_getreg((3 << 11) | 20) & 0xFu; }
#define XB_SPIN(cond, bar) do { unsigned _sp = 0; while (cond) { __builtin_amdgcn_s_sleep(1); \
    if ((++_sp & 255u) == 0u) { if (xb_ld(&(bar)[XB_TMO])) break; if (_sp > XB_SPIN_CAP) { atomicAdd(&(bar)[XB_TMO], 1u); break; } } } } while (0)

struct XcdBarrier {
    unsigned* bar; unsigned x;
    volatile LAS unsigned* st;
};

__device__ __forceinline__ XcdBarrier xcd_barrier_post(unsigned* bar, volatile LAS unsigned* st) {
    XcdBarrier b; b.bar = bar; b.x = xb_xcc_id(); b.st = st;
    if (threadIdx.x == 0) (void)xb_add(&bar[XB_XCNT(b.x)], 1u);
    return b;
}
__device__ __forceinline__ void xcd_barrier_complete(unsigned* bar, unsigned x, unsigned& nloc, unsigned& nx) {
    const unsigned G = gridDim.x * gridDim.y * gridDim.z;
    unsigned sum, cnt, mine, sp = 0u;
    for (;;) {
        sum = 0u; cnt = 0u; mine = 0u;
#pragma unroll
        for (unsigned j = 0; j < 16; ++j) { const unsigned c = xb_ld(&bar[XB_XCNT(j)]); sum += c; cnt += (c > 0u) ? 1u : 0u; mine = (j == x) ? c : mine; }
        if (sum == G) break;
        __builtin_amdgcn_s_sleep(1);
        if ((++sp & 255u) == 0u) { if (xb_ld(&bar[XB_TMO])) break; if (sp > XB_SPIN_CAP) { atomicAdd(&bar[XB_TMO], 1u); break; } }
    }
    nloc = mine > 0u ? mine : 1u; nx = cnt > 0u ? cnt : 1u;
}

__device__ __forceinline__ void xcd_barrier(const XcdBarrier& b) {
    asm volatile("s_waitcnt vmcnt(0)" ::: "memory");
    __syncthreads();
    if (threadIdx.x == 0) {
        unsigned* bar = b.bar;
        __builtin_amdgcn_s_waitcnt(0);
        unsigned nloc = b.st[0], nx = b.st[1];
        if (nloc == 0u) { xcd_barrier_complete(bar, b.x, nloc, nx); b.st[0] = nloc; b.st[1] = nx; }
        const unsigned old = xb_add(&bar[XB_XSUB(b.x)], 1u);
        const unsigned gen = old / nloc;
        if (old + 1u == (gen + 1u) * nloc) {
            __builtin_amdgcn_fence(__ATOMIC_RELEASE, "agent");
            asm volatile("s_waitcnt vmcnt(0)" ::: "memory");
            const unsigned og = xb_add(&bar[XB_TOP], 1u);
            const unsigned tg = og / nx;
            if (og + 1u == (tg + 1u) * nx) xb_add(&bar[XB_TOPGEN], 1u);
            else XB_SPIN(xb_ld(&bar[XB_TOPGEN]) == tg, bar);
            __builtin_amdgcn_fence(__ATOMIC_ACQUIRE, "agent");
            xb_add(&bar[XB_XGEN(b.x)], 1u);
            asm volatile("s_waitcnt vmcnt(0)" ::: "memory");
        } else {
            XB_SPIN(xb_ld(&bar[XB_XGEN(b.x)]) == gen, bar);
            __builtin_amdgcn_fence(__ATOMIC_ACQUIRE, "agent");
            asm volatile("s_waitcnt vmcnt(0)" ::: "memory");
        }
    }
    __syncthreads();
}


struct EpiSwiGLU {
    static constexpr bool PERM = true, AFTER_DRAIN = false;
    bf16_t* U;
    __device__ __forceinline__ void operator()(const f32x4 (&acc)[2][2][4][2], const pg8::Unit& u, int wr, int wc, int fr, int fq) const {
        const int row0 = u.pm * 256 + wr * 64 + fr, col0 = u.pn * 128 + wc * 32 + 8 * fq;
#pragma unroll
        for (int ai = 0; ai < 2; ++ai)
#pragma unroll
            for (int m = 0; m < 4; ++m) {
                bf16_t* rowp = U + (size_t)(row0 + ai * 128 + m * 16) * FF + col0;
                float v[8];
#pragma unroll
                for (int n = 0; n < 2; ++n)
#pragma unroll
                    for (int j = 0; j < 4; ++j) v[n * 4 + j] = silu_f(acc[ai][0][m][n][j]) * acc[ai][1][m][n][j];
                u32x4 w; w.x = pk2(v[0], v[1]); w.y = pk2(v[2], v[3]); w.z = pk2(v[4], v[5]); w.w = pk2(v[6], v[7]);
                *(u32x4*)rowp = w;
            }
    }
};
struct EpiBf16Tile {
    static constexpr bool PERM = true, AFTER_DRAIN = false;
    bf16_t* O; int ldc, row_pn, col_pn;
    __device__ __forceinline__ void operator()(const f32x4 (&acc)[2][2][4][2], const pg8::Unit& u, int wr, int wc, int fr, int fq) const {
        const int row0 = u.pm * 256 + u.pn * row_pn + wr * 64 + fr, col0 = u.pn * col_pn + wc * 32 + 8 * fq;
#pragma unroll
        for (int ai = 0; ai < 2; ++ai)
#pragma unroll
            for (int m = 0; m < 4; ++m) {
                bf16_t* rowp = O + (size_t)(row0 + ai * 128 + m * 16) * ldc + col0;
#pragma unroll
                for (int bj = 0; bj < 2; ++bj) {
                    const f32x4 v0 = acc[ai][bj][m][0], v1 = acc[ai][bj][m][1];
                    u32x4 w; w.x = pk2(v0[0], v0[1]); w.y = pk2(v0[2], v0[3]); w.z = pk2(v1[0], v1[1]); w.w = pk2(v1[2], v1[3]);
                    *(u32x4*)(rowp + bj * 128) = w;
                }
            }
    }
};
struct EpiPQ {
    static constexpr bool PERM = true, AFTER_DRAIN = false;
    bf16_t* PQT; bf16_t* PQTC;
    __device__ __forceinline__ void operator()(const f32x4 (&acc)[2][2][4][2], const pg8::Unit& u, int wr, int wc, int fr, int fq) const {
        const int cl = wc * 32 + 8 * fq;
#pragma unroll
        for (int ai = 0; ai < 2; ++ai)
#pragma unroll
            for (int m = 0; m < 4; ++m) {
                const int mp = u.pm * 256 + ai * 128 + wr * 64 + m * 16 + fr;
                const int g = mp >> 7, pq = (mp >> 6) & 1, cp = mp & 63;
                bf16_t* rowp;
                if (u.pn < 128) { const int b = u.pn >> 3, n0 = (u.pn & 7) * 256; rowp = PQT + (size_t)(b * 256 + g * 64 + cp) * PQT_LD + pq * 2048 + n0 + cl; }
                else { const int b = u.pn - 128; rowp = PQTC + (size_t)(b * 256 + g * 64 + cp) * PQTC_LD + pq * 256 + cl; }
#pragma unroll
                for (int bj = 0; bj < 2; ++bj) {
                    const f32x4 v0 = acc[ai][bj][m][0], v1 = acc[ai][bj][m][1];
                    u32x4 w; w.x = pk2(v0[0], v0[1]); w.y = pk2(v0[2], v0[3]); w.z = pk2(v1[0], v1[1]); w.w = pk2(v1[2], v1[3]);
                    *(u32x4*)(rowp + bj * 128) = w;
                }
            }
    }
};
struct EpiWin {
    static constexpr bool PERM = false, AFTER_DRAIN = false;
    bf16_t* P; const float* rope;
    __device__ __forceinline__ void operator()(const f32x4 (&acc)[2][2][4][2], const pg8::Unit& u, int wr, int wc, int fr, int fq) const {
        const int row0 = u.pm * 256 + wr * 64 + fr, col0 = u.pn * 256 + wc * 32 + 4 * fq;
        const float qs = (u.pn == 2 || u.pn == 5) ? 0.125f * LOG2E : 1.0f;
        const bool lat = u.pm < 128;
#pragma unroll
        for (int ai = 0; ai < 2; ++ai)
#pragma unroll
            for (int m = 0; m < 4; ++m) {
                const int r = row0 + ai * 128 + m * 16;
                bf16_t* rowp = P + (size_t)r * NP + col0;
                const int t = r & 2047;
                const int pos = (wc & 1) ? (t & 63) : (t >> 6);
#pragma unroll
                for (int bj = 0; bj < 2; ++bj) {
                    f32x4 v0 = acc[ai][bj][m][0], v1 = acc[ai][bj][m][1];
                    const bool dorope = lat && (u.pn == 5 || (u.pn == 6 && bj == 0));
                    if (dorope) {
                        const f32x4 cs0 = *(const f32x4*)(rope + (pos * 16 + 4 * fq) * 2), cs1 = *(const f32x4*)(rope + (pos * 16 + 4 * fq) * 2 + 4);
                        const float c0 = cs0[0], s0 = cs0[1], c1 = cs0[2], s1 = cs0[3], c2 = cs1[0], s2 = cs1[1], c3 = cs1[2], s3 = cs1[3];
                        f32x4 a, b;
                        a[0] = v0[0] * c0 - v1[0] * s0; b[0] = v0[0] * s0 + v1[0] * c0;
                        a[1] = v0[1] * c1 - v1[1] * s1; b[1] = v0[1] * s1 + v1[1] * c1;
                        a[2] = v0[2] * c2 - v1[2] * s2; b[2] = v0[2] * s2 + v1[2] * c2;
                        a[3] = v0[3] * c3 - v1[3] * s3; b[3] = v0[3] * s3 + v1[3] * c3;
                        v0 = a; v1 = b;
                    }
                    v0 = v0 * qs; v1 = v1 * qs;
                    u32x2 w0, w1; w0.x = pk2(v0[0], v0[1]); w0.y = pk2(v0[2], v0[3]); w1.x = pk2(v1[0], v1[1]); w1.y = pk2(v1[2], v1[3]);
                    *(u32x2*)(rowp + bj * 128) = w0; *(u32x2*)(rowp + bj * 128 + 16) = w1;
                }
            }
    }
};

struct TrItem { const float* src; bf16_t* dst; int ld_src, ld_dst; };
__device__ __forceinline__ TrItem tr_decode(CParams& p, int it) {
    constexpr int PER_L = 2 * 704 + 2 * 352 + 224 + 160;
    unsigned char* ws = p.ws;
    const int l = it / PER_L; int q = it % PER_L;
    const float* src; bf16_t* dst; int ld_src, ld_dst, col0, k0, r0;
    if (q < 2 * 704) { const int f = q / 704; q %= 704; const int rt = q >> 4, kt = q & 15, R0 = rt * 128, tile = R0 >> 8, bj = (R0 >> 7) & 1;
        src = (bj ? p.w3 : p.w1) + (size_t)(l * 2 + f) * 1024 * FF; ld_src = FF; col0 = 128 * tile; k0 = 64 * kt; dst = (bf16_t*)(ws + WS_W13) + (size_t)(l * 2 + f) * 5632 * 1024; r0 = R0; ld_dst = 1024; }
    else if (q < 2 * 704 + 2 * 352) { q -= 2 * 704; const int f = q / 352; q %= 352; const int rt = q / 44, kt = q % 44;
        src = p.w2 + (size_t)(l * 2 + f) * FF * 1024; ld_src = 1024; col0 = 128 * rt; k0 = 64 * kt; dst = (bf16_t*)(ws + WS_W2T) + (size_t)(l * 2 + f) * 1024 * FF; r0 = 128 * rt; ld_dst = FF; }
    else if (q < 2 * 704 + 2 * 352 + 224) { q -= 2 * 704 + 2 * 352; const int rt = q >> 4, kt = q & 15, R0 = rt * 128;
        src = p.w_in + (size_t)l * 1024 * 2048; ld_src = 2048; col0 = R0 < 512 ? R0 : R0 + 256; k0 = 64 * kt; dst = (bf16_t*)(ws + WS_WIN) + (size_t)l * 2304 * 1024; r0 = R0; ld_dst = 1024; }
    int ks = -1;
    if (q >= 2 * 704 + 2 * 352 + 224) { q -= 2 * 704 + 2 * 352 + 224; const int rt = q / 20, kt = q % 20;
        src = p.w_out + (size_t)l * 1024 * 1024; ld_src = 1024; col0 = 128 * rt; k0 = 64 * kt; ks = kt < 16 ? 64 * kt : 256 + 64 * (kt - 16); dst = (bf16_t*)(ws + WS_WOUT) + (size_t)l * 1024 * YC_LD; r0 = 128 * rt; ld_dst = YC_LD; }
    if (ks < 0) ks = k0;
    TrItem t; t.src = src + (size_t)ks * ld_src + col0; t.dst = dst + (size_t)r0 * ld_dst + k0; t.ld_src = ld_src; t.ld_dst = ld_dst; return t;
}

__device__ __forceinline__ void phase0(CParams& p, LAS unsigned char* lds) {
    const int tid = otid(), wave = tid >> 6, lane = tid & 63;
    unsigned char* ws = p.ws;
    const int bid = obid(), G = gridDim.x;
    TS_BEGIN(9);
    if (bid < 288) {
        LAS float* sS = (LAS float*)lds;
        LAS float* sR = sS + 17 * 1024;
        for (int i = tid; i < 17 * 1024; i += 512) { const float v = (i < 16384) ? p.c[i] : p.c_ctx[i - 16384]; sS[i] = v / (1.0f + __expf(-v)); }
        __syncthreads();
        for (int r = bid; r < 288; r += G) {
            const int l = r / 144, j0 = (r % 144) * 64, k0 = wave * 128;
            float acc[17];
#pragma unroll
            for (int q = 0; q < 17; ++q) acc[q] = 0.f;
            const float* wp = p.w_ada + ((size_t)l * 1024 + k0) * NMODC + j0 + lane;
#pragma unroll 1
            for (int kb = 0; kb < 128; kb += 16) {
                float wv[16];
#pragma unroll
                for (int kk = 0; kk < 16; ++kk) wv[kk] = wp[(size_t)(kb + kk) * NMODC];
#pragma unroll
                for (int kk = 0; kk < 16; ++kk)
#pragma unroll
                    for (int q = 0; q < 17; ++q) acc[q] += sS[q * 1024 + k0 + kb + kk] * wv[kk];
            }
#pragma unroll
            for (int q = 0; q < 17; ++q) sR[(wave * 17 + q) * 64 + lane] = acc[q];
            __syncthreads();
            float* MOD = (float*)(ws + WS_MOD);
            for (int o = tid; o < 17 * 64; o += 512) {
                const int q = o >> 6, ln = o & 63; float s = p.b_ada[l * NMODC + j0 + ln];
#pragma unroll
                for (int w = 0; w < 8; ++w) s += sR[(w * 17 + q) * 64 + ln];
                MOD[(size_t)(l * 17 + q) * NMODC + j0 + ln] = s;
            }
            __syncthreads();
        }
    }
    TS_END(9);
    TS_BEGIN(10);
    {
        constexpr int N_TR = 2 * (2 * 704 + 2 * 352 + 224 + 160);
        LAS float* t = (LAS float*)lds;
        const int lk = tid >> 5, lc = (tid & 31) * 4;
        const int sr = tid >> 2, sk = (tid & 3) * 16;
        int it = bid; f32x4 pre[4]; TrItem cur;
        if (it < N_TR) { cur = tr_decode(p, it);
#pragma unroll
            for (int i = 0; i < 4; ++i) pre[i] = *(const f32x4*)(cur.src + (size_t)(lk + 16 * i) * cur.ld_src + lc); }
        while (it < N_TR) {
#pragma unroll
            for (int i = 0; i < 4; ++i) { LAS float* d = t + (lk + 16 * i) * 129 + lc; d[0] = pre[i][0]; d[1] = pre[i][1]; d[2] = pre[i][2]; d[3] = pre[i][3]; }
            __syncthreads();
            bf16_t* dp = cur.dst + (size_t)sr * cur.ld_dst + sk;
            const int nxt = it + G;
            if (nxt < N_TR) { cur = tr_decode(p, nxt);
#pragma unroll
                for (int i = 0; i < 4; ++i) pre[i] = *(const f32x4*)(cur.src + (size_t)(lk + 16 * i) * cur.ld_src + lc); }
            { const LAS float* s = t + sk * 129 + sr;
              u32x4 o0, o1;
              o0.x = pk2(s[0 * 129], s[1 * 129]); o0.y = pk2(s[2 * 129], s[3 * 129]); o0.z = pk2(s[4 * 129], s[5 * 129]); o0.w = pk2(s[6 * 129], s[7 * 129]);
              o1.x = pk2(s[8 * 129], s[9 * 129]); o1.y = pk2(s[10 * 129], s[11 * 129]); o1.z = pk2(s[12 * 129], s[13 * 129]); o1.w = pk2(s[14 * 129], s[15 * 129]);
              *(u32x4*)dp = o0; *(u32x4*)(dp + 8) = o1; }
            __syncthreads();
            it = nxt;
        }
    }
    TS_END(10);
    TS_BEGIN(11);
    for (int r = bid; r < 256; r += G) {
        const int l = r >> 7, k0 = (r & 127) * 8;
        LAS float* sW = (LAS float*)lds;
        LAS float* sC = sW + 2048;
        for (int i = tid; i < 2048; i += 512) { const int kk = i >> 8, cc = i & 255; sW[i] = p.w_in[((size_t)l * 1024 + k0 + kk) * 2048 + 512 + cc]; }
        if (tid < 64) sC[tid] = cospif((float)tid * (1.0f / 32.0f));
        __syncthreads();
        const int g = tid >> 7, j = tid & 127, jj = j & 63, isS = j >> 6;
        float acc[8];
#pragma unroll
        for (int q = 0; q < 8; ++q) acc[q] = 0.f;
        for (int c = 0; c < 64; ++c) {
            const int mm = (c * jj) & 63; const float tv = sC[isS ? ((mm - 16) & 63) : mm];
#pragma unroll
            for (int q = 0; q < 8; ++q) acc[q] += sW[q * 256 + g * 64 + c] * tv;
        }
        u32x4 o; o.x = pk2(acc[0] * 0.125f, acc[1] * 0.125f); o.y = pk2(acc[2] * 0.125f, acc[3] * 0.125f); o.z = pk2(acc[4] * 0.125f, acc[5] * 0.125f); o.w = pk2(acc[6] * 0.125f, acc[7] * 0.125f);
        *(u32x4*)((bf16_t*)(ws + WS_WIN) + ((size_t)l * 2304 + 1792 + g * 128 + j) * 1024 + k0) = o;
        __syncthreads();
    }
    {
        LAS float* tab = (LAS float*)lds;
        for (int m = tid; m < 2048; m += 512) tab[m] = cospif((float)m * (1.0f / 1024.0f)) * 0.022097086912079608f;
        __syncthreads();
        for (int r = bid; r < 2048 + 256; r += G) {
            if (r < 2048) {
                float v[8];
#pragma unroll
                for (int e = 0; e < 8; ++e) { const int k = tid * 8 + e, idx = (r * (k & 2047)) & 2047; v[e] = tab[k < 2048 ? idx : ((idx + 512) & 2047)]; }
                u32x4 o; o.x = pk2(v[0], v[1]); o.y = pk2(v[2], v[3]); o.z = pk2(v[4], v[5]); o.w = pk2(v[6], v[7]);
                *(u32x4*)((bf16_t*)(ws + WS_DFT) + (size_t)r * DFT_LD + tid * 8) = o;
            } else if (tid < 64) {
                const int np = r - 2048; const float sc = 2.8284271247461903f;
                float v[8];
#pragma unroll
                for (int e = 0; e < 8; ++e) { const int k = tid * 8 + e, idx = ((np * (k & 255)) & 255) * 8; v[e] = tab[k < 256 ? idx : ((idx + 512) & 2047)] * sc; }
                u32x4 o; o.x = pk2(v[0], v[1]); o.y = pk2(v[2], v[3]); o.z = pk2(v[4], v[5]); o.w = pk2(v[6], v[7]);
                *(u32x4*)((bf16_t*)(ws + WS_DFTC) + (size_t)np * DFTC_LD + tid * 8) = o;
            }
        }
        __syncthreads();
    }
    TS_END(11);
    if (bid == G - 1) {
        float* rtab = (float*)(ws + WS_ROPE);
        for (int e = tid; e < 1024; e += 512) { const int pos = e >> 4, i = e & 15;
            const float inv = fast_exp2(-(float)i * (13.287712379549449f / 16.0f));
            const float tt = (float)pos * inv * 0.3183098861837907f;
            rtab[2 * e] = cospif(tt); rtab[2 * e + 1] = sinpif(tt); }
    }
}

struct EwRow { f32x4 x[4]; u32x2 y[4]; u32x2 y2[4]; };
__device__ __forceinline__ void ew_load(EwRow& r, const float* xin_lat, const float* xin_ctx, const bf16_t* Yp, const bf16_t* Y2p, int t, int lane) {
    const float* xr = t < TL ? xin_lat + (size_t)t * DM : xin_ctx + (size_t)(t - TL) * DM;
#pragma unroll
    for (int j = 0; j < 4; ++j) r.x[j] = *(const f32x4*)(xr + 4 * lane + 256 * j);
    if (Yp) {
#pragma unroll
        for (int j = 0; j < 4; ++j) r.y[j] = *(const u32x2*)(Yp + (size_t)t * DM + 4 * lane + 256 * j);
        if (t >= TL) {
#pragma unroll
            for (int j = 0; j < 4; ++j) r.y2[j] = *(const u32x2*)(Y2p + (size_t)(t - TL) * DM + 4 * lane + 256 * j);
        }
    }
}
__device__ __forceinline__ void ew_pass(const float* xin_lat, const float* xin_ctx, float* xout_lat, float* xout_ctx, const bf16_t* Yp, const bf16_t* Y2p, const float* gpost, float fac, const float* gate,
                                        bf16_t* Hp, const float* gpre, const float* shift, const float* scale, int nrows) {
    const int tid = otid(); const int wave = tid >> 6, lane = tid & 63;
    const int per = nrows / gridDim.x, tbeg = obid() * per + wave, tend = obid() * per + per;
    f32x4 vgp[4], vgt[4], vpre[4], vsh[4], vsc[4];
#pragma unroll
    for (int j = 0; j < 4; ++j) { vgp[j] = Yp ? *(const f32x4*)(gpost + 4 * lane + 256 * j) : (f32x4){0.f, 0.f, 0.f, 0.f}; vpre[j] = Hp ? *(const f32x4*)(gpre + 4 * lane + 256 * j) : (f32x4){0.f, 0.f, 0.f, 0.f};
        vgt[j] = vsh[j] = vsc[j] = (f32x4){0.f, 0.f, 0.f, 0.f}; }
    int bcur = -1;
    EwRow A, B;
    auto process = [&](EwRow& r, int t) {
        const bool lat = t < TL; const int b = lat ? (t >> 11) : 16;
        if (b != bcur) { bcur = b;
#pragma unroll
            for (int j = 0; j < 4; ++j) { const int cidx = 4 * lane + 256 * j;
                if (Yp) vgt[j] = *(const f32x4*)(gate + (size_t)b * NMODC + cidx) * fac;
                if (Hp) { vsh[j] = *(const f32x4*)(shift + (size_t)b * NMODC + cidx); vsc[j] = *(const f32x4*)(scale + (size_t)b * NMODC + cidx) + 1.0f; } } }
        if (Yp) {
            f32x4 y[4]; float ss = 0.f;
#pragma unroll
            for (int j = 0; j < 4; ++j) { const u32x2 w = r.y[j];
                y[j][0] = bflo(w.x); y[j][1] = bfhi(w.x); y[j][2] = bflo(w.y); y[j][3] = bfhi(w.y);
                if (!lat) { const u32x2 w2 = r.y2[j]; y[j][0] += bflo(w2.x); y[j][1] += bfhi(w2.x); y[j][2] += bflo(w2.y); y[j][3] += bfhi(w2.y); }
                ss += (y[j][0] * y[j][0] + y[j][1] * y[j][1]) + (y[j][2] * y[j][2] + y[j][3] * y[j][3]); }
            const float rstd = 1.0f / sqrtf(wave_sum(ss) * (1.0f / DM) + EPSV);
#pragma unroll
            for (int j = 0; j < 4; ++j) r.x[j] = r.x[j] + vgt[j] * (y[j] * rstd * vgp[j]);
        }
        float* xo = lat ? (xout_lat ? xout_lat + (size_t)t * DM : nullptr) : (xout_ctx ? xout_ctx + (size_t)(t - TL) * DM : nullptr);
        if (xo) {
#pragma unroll
            for (int j = 0; j < 4; ++j) *(f32x4*)(xo + 4 * lane + 256 * j) = r.x[j];
        }
        if (Hp) {
            float ss = 0.f;
#pragma unroll
            for (int j = 0; j < 4; ++j) ss += (r.x[j][0] * r.x[j][0] + r.x[j][1] * r.x[j][1]) + (r.x[j][2] * r.x[j][2] + r.x[j][3] * r.x[j][3]);
            const float rstd = 1.0f / sqrtf(wave_sum(ss) * (1.0f / DM) + EPSV);
#pragma unroll
            for (int j = 0; j < 4; ++j) { const f32x4 h = (r.x[j] * rstd * vpre[j]) * vsc[j] + vsh[j];
                u32x2 w; w.x = pk2(h[0], h[1]); w.y = pk2(h[2], h[3]);
                *(u32x2*)(Hp + (size_t)t * DM + 4 * lane + 256 * j) = w; }
        }
    };
    int t = tbeg;
    if (t < tend) ew_load(A, xin_lat, xin_ctx, Yp, Y2p, t, lane);
    while (t < tend) {
        const int tn = t + 8;
        if (tn < tend) ew_load(B, xin_lat, xin_ctx, Yp, Y2p, tn, lane);
        process(A, t);
        const int tnn = tn + 8;
        if (tnn < tend) ew_load(A, xin_lat, xin_ctx, Yp, Y2p, tnn, lane);
        if (tn < tend) process(B, tn);
        t = tnn;
    }
}

__device__ __forceinline__ void conv_item(CParams& p, LAS unsigned char* lds, int l, int s, int tb) {
    const int tid = otid(), wave = tid >> 6, lane = tid & 63;
    const bf16_t* PROJ = (const bf16_t*)(p.ws + WS_PROJ); bf16_t* YCAT = (bf16_t*)(p.ws + WS_YCAT);
    LAS float* sA = (LAS float*)lds;
    const int tokbase = s < 16 ? s * 2048 : TL + (s - 16) * 256, len = s < 16 ? 2048 : 256, t0 = tb * 64;
    {
        u32x4 ua[6], ug[6];
#pragma unroll
        for (int i = 0; i < 6; ++i) {
            const int u = tid + 512 * i, rr = u >> 5, c8 = (u & 31) * 8, tt = t0 - 15 + rr;
            ua[i] = (u32x4){0u, 0u, 0u, 0u}; ug[i] = (u32x4){0u, 0u, 0u, 0u};
            if (u < 94 * 32 && tt >= 0 && tt < len) { const bf16_t* rp = PROJ + (size_t)(tokbase + tt) * NP + c8; ua[i] = *(const u32x4*)rp; ug[i] = *(const u32x4*)(rp + 256); }
        }
#pragma unroll
        for (int i = 0; i < 6; ++i) {
            const int u = tid + 512 * i, rr = u >> 5, c8 = (u & 31) * 8;
            if (u < 94 * 32) {
                float v[8];
                v[0] = bflo(ua[i].x) * sigmoid_f(bflo(ug[i].x)); v[1] = bfhi(ua[i].x) * sigmoid_f(bfhi(ug[i].x));
                v[2] = bflo(ua[i].y) * sigmoid_f(bflo(ug[i].y)); v[3] = bfhi(ua[i].y) * sigmoid_f(bfhi(ug[i].y));
                v[4] = bflo(ua[i].z) * sigmoid_f(bflo(ug[i].z)); v[5] = bfhi(ua[i].z) * sigmoid_f(bfhi(ug[i].z));
                v[6] = bflo(ua[i].w) * sigmoid_f(bflo(ug[i].w)); v[7] = bfhi(ua[i].w) * sigmoid_f(bfhi(ug[i].w));
                *(LAS f32x4*)(sA + rr * 256 + c8) = (f32x4){v[0], v[1], v[2], v[3]};
                *(LAS f32x4*)(sA + rr * 256 + c8 + 4) = (f32x4){v[4], v[5], v[6], v[7]};
            }
        }
    }
    __syncthreads();
    TS_BEGIN(7);
    const int ch = tid & 255, half = tid >> 8;
    float out[32];
    {
        float w[31];
#pragma unroll
        for (int j = 0; j < 31; ++j) w[j] = p.conv_w[((size_t)l * 31 + j) * 256 + ch];
        const float bias = p.conv_b[l * 256 + ch];
        const LAS float* ap = sA + (half * 32) * 256 + ch;
        float in[62];
#pragma unroll
        for (int i = 0; i < 62; ++i) in[i] = ap[i * 256];
#pragma unroll
        for (int q = 0; q < 32; ++q) {
            float acc = bias;
#pragma unroll
            for (int j = 0; j < 31; ++j) acc += in[q + j] * w[j];
            out[q] = acc;
        }
    }
    TS_END(7);
    __syncthreads();
#pragma unroll
    for (int q = 0; q < 32; ++q) sA[(half * 32 + q) * 256 + ch] = out[q];
    __syncthreads();
    {
        const f32x4 lg = *(const f32x4*)(p.ln_g + l * 256 + 4 * lane), lb = *(const f32x4*)(p.ln_b + l * 256 + 4 * lane);
#pragma unroll
        for (int q = 0; q < 8; ++q) {
            const int tok = wave * 8 + q;
            const f32x4 v = *(const LAS f32x4*)(sA + tok * 256 + 4 * lane);
            const float mean = wave_sum((v[0] + v[1]) + (v[2] + v[3])) * (1.0f / 256.0f);
            const f32x4 d = v - mean;
            const float var = wave_sum((d[0] * d[0] + d[1] * d[1]) + (d[2] * d[2] + d[3] * d[3])) * (1.0f / 256.0f);
            const float rstd = 1.0f / sqrtf(var + EPSV);
            const f32x4 yn = d * rstd * lg + lb;
            u32x2 o; o.x = pk2(silu_f(yn[0]), silu_f(yn[1])); o.y = pk2(silu_f(yn[2]), silu_f(yn[3]));
            *(u32x2*)(YCAT + (size_t)(tokbase + t0 + tok) * YC_LD + 4 * lane) = o;
        }
    }
    __syncthreads();
}

struct AttnItem {
    int mode;
    int qtok0;
    int qcol0, qcol1, ocol0, ocol1;
    int kcol0, kcol1, vcol0, vcol1; int nslots;
    int nloc, loctok0;
    int ctxtok0;
    int r, rs;
    int q0, kp0;
    int has_sink; float sink0, sink1;
    int h0;
};
constexpr int KROW = 72;
constexpr int KV_BYTES = 64 * KROW * 2;
constexpr int ABUF_BYTES = 4 * KV_BYTES;
typedef short s16x4 __attribute__((ext_vector_type(4)));
template <int OFF> __device__ __forceinline__ s16x4 tr_read(unsigned addr) {
    s16x4 r; asm volatile("ds_read_b64_tr_b16 %0, %1 offset:%2" : "=&v"(r) : "v"(addr), "i"(OFF) : "memory"); return r;
}
template <int NKB>
__device__ __forceinline__ void attn_chunk(const LAS unsigned char* kt, const LAS unsigned char* vt, int kofs, const bf16x8 (&qf)[2], int fr, int fq,
                                           int mtype, int a0, const LAS float* bt, float& mrun, float& lsum, f32x4 (&o)[4]) {
    const unsigned vaddr = (unsigned)(size_t)vt + (unsigned)(((kofs + 4 * fq + (fr >> 2)) * KROW + 4 * (fr & 3)) * 2);
    s16x4 vl[NKB / 2][4], vh[NKB / 2][4];
#pragma unroll
    for (int grp = 0; grp < NKB / 2; ++grp) {
        const unsigned va = vaddr + (unsigned)(grp * 32 * KROW * 2);
        vl[grp][0] = tr_read<0>(va);  vh[grp][0] = tr_read<16 * KROW * 2>(va);
        vl[grp][1] = tr_read<32>(va); vh[grp][1] = tr_read<16 * KROW * 2 + 32>(va);
        vl[grp][2] = tr_read<64>(va); vh[grp][2] = tr_read<16 * KROW * 2 + 64>(va);
        vl[grp][3] = tr_read<96>(va); vh[grp][3] = tr_read<16 * KROW * 2 + 96>(va);
    }
    f32x4 sacc[NKB];
    const LAS unsigned char* kb_base = kt + ((kofs + fr) * KROW + 8 * fq) * 2;
#pragma unroll
    for (int kb = 0; kb < NKB; ++kb) {
        sacc[kb] = (f32x4){0.f, 0.f, 0.f, 0.f};
#pragma unroll
        for (int kk = 0; kk < 2; ++kk) {
            const bf16x8 a = *(const LAS bf16x8*)(kb_base + (16 * kb * KROW + 32 * kk) * 2);
            sacc[kb] = __builtin_amdgcn_mfma_f32_16x16x32_bf16(a, qf[kk], sacc[kb], 0, 0, 0);
        }
    }
    if (mtype == 1) {
        const int wsx = min(max(a0 - 8, 0), 48);
        const int lo = wsx - (kofs + 4 * fq);
        const LAS float* bl = bt + (kofs + 4 * fq - a0 + 63);
#pragma unroll
        for (int kb = 0; kb < NKB; ++kb)
#pragma unroll
            for (int j = 0; j < 4; ++j) { const bool ok = (unsigned)(16 * kb + j - lo) < 16u;
                sacc[kb][j] = ok ? sacc[kb][j] + bl[16 * kb + j] : -1.0e30f; }
    } else if (mtype == 2) {
        const int db = a0 + kofs + 4 * fq + 128;
#pragma unroll
        for (int kb = 0; kb < NKB; ++kb)
#pragma unroll
            for (int j = 0; j < 4; ++j) { const bool ok = (unsigned)(db + 16 * kb + j) <= 256u;
                sacc[kb][j] = ok ? sacc[kb][j] : -1.0e30f; }
    }
    float cm = sacc[0][0];
#pragma unroll
    for (int kb = 0; kb < NKB; ++kb)
#pragma unroll
        for (int j = 0; j < 4; ++j) cm = fmaxf(cm, sacc[kb][j]);
    cm = xrow16_max(cm);
    const float mnew = fmaxf(mrun, cm);
    if (__any(mnew > mrun)) {
        const float alpha = fast_exp2(mrun - mnew);
        lsum *= alpha;
#pragma unroll
        for (int db = 0; db < 4; ++db) o[db] = o[db] * alpha;
        mrun = mnew;
    }
    float ps = 0.f;
#pragma unroll
    for (int kb = 0; kb < NKB; ++kb)
#pragma unroll
        for (int j = 0; j < 4; ++j) { sacc[kb][j] = fast_exp2(sacc[kb][j] - mnew); ps += sacc[kb][j]; }
    lsum += ps;
    asm volatile("s_waitcnt lgkmcnt(0)" ::: "memory"); __builtin_amdgcn_sched_barrier(0);
#define ATT_PK(L, H) (bf16x8){L[0], L[1], L[2], L[3], H[0], H[1], H[2], H[3]}
#pragma unroll
    for (int grp = 0; grp < NKB / 2; ++grp) {
        union { bf16x8 v; unsigned u[4]; } pb;
        pb.u[0] = pk2(sacc[2 * grp][0], sacc[2 * grp][1]); pb.u[1] = pk2(sacc[2 * grp][2], sacc[2 * grp][3]);
        pb.u[2] = pk2(sacc[2 * grp + 1][0], sacc[2 * grp + 1][1]); pb.u[3] = pk2(sacc[2 * grp + 1][2], sacc[2 * grp + 1][3]);
#pragma unroll
        for (int db = 0; db < 4; ++db) o[db] = __builtin_amdgcn_mfma_f32_16x16x32_bf16(ATT_PK(vl[grp][db], vh[grp][db]), pb.v, o[db], 0, 0, 0);
    }
#undef ATT_PK
}

__device__ __forceinline__ void attn_item(CParams& p, LAS unsigned char* lds, int l, const AttnItem& it) {
    const int tid = otid(), wave = tid >> 6, lane = tid & 63, g = wave >> 2, wq = wave & 3, fr = lane & 15, fq = lane >> 4;
    const bf16_t* PROJ = (const bf16_t*)(p.ws + WS_PROJ); bf16_t* YCAT = (bf16_t*)(p.ws + WS_YCAT);
    LAS float* sB = (LAS float*)(lds + 2 * ABUF_BYTES);
    const int slot = it.nslots == 2 ? g : 0;
    if (it.mode == 0) { for (int i = tid; i < 2 * 15 * 128; i += 512) { const int h = i / 1920, rem = i % 1920, dr = rem >> 7, dc = (rem & 127) - 48;
            sB[i] = (dc >= 0 && dc < 31) ? p.nat_bias[(size_t)(l * 4 + it.h0 + h) * 465 + dr * 31 + dc] * LOG2E : 0.f; } }
    bf16x8 qf[2];
    { const bf16_t* qp = PROJ + (size_t)(it.qtok0 + wq * 16 + fr) * NP + (g ? it.qcol1 : it.qcol0) + 8 * fq;
      qf[0] = *(const bf16x8*)qp; qf[1] = *(const bf16x8*)(qp + 32); }
    float mrun = -3.0e38f, lsum = 0.f;
    f32x4 o[4];
#pragma unroll
    for (int db = 0; db < 4; ++db) o[db] = (f32x4){0.f, 0.f, 0.f, 0.f};
    const int nchunks = 4 + it.nloc;
    const int srow = tid >> 3, sseg = tid & 7;
    u32x4 kreg[2], vreg[2];
    auto chunk_tok = [&](int c) { return c < 4 ? it.ctxtok0 + 64 * c : it.loctok0 + 64 * (c - 4); };
    auto gload = [&](int c) {
        const bf16_t* rp = PROJ + (size_t)(chunk_tok(c) + srow) * NP + 8 * sseg;
#pragma unroll
        for (int s = 0; s < 2; ++s) if (s < it.nslots) { kreg[s] = *(const u32x4*)(rp + (s ? it.kcol1 : it.kcol0)); vreg[s] = *(const u32x4*)(rp + (s ? it.vcol1 : it.vcol0)); }
    };
    auto lwrite = [&](int c) {
        LAS unsigned char* bufp = lds + (c & 1) * ABUF_BYTES + (srow * KROW + 8 * sseg) * 2;
#pragma unroll
        for (int s = 0; s < 2; ++s) if (s < it.nslots) { *(LAS u32x4*)(bufp + s * KV_BYTES) = kreg[s]; *(LAS u32x4*)(bufp + (2 + s) * KV_BYTES) = vreg[s]; }
    };
    gload(0); lwrite(0);
    if (nchunks > 1) gload(1);
    __syncthreads();
    TS_BEGIN(5);
    const int qi = wq * 16 + fr;
    const int nat_kofs = min(max(16 * wq - 8, 0), 32);
    for (int c = 0; c < nchunks; ++c) {
        if (c + 1 < nchunks) lwrite(c + 1);
        if (c + 2 < nchunks) gload(c + 2);
        const LAS unsigned char* kt = lds + (c & 1) * ABUF_BYTES + slot * KV_BYTES;
        const LAS unsigned char* vt = kt + 2 * KV_BYTES;
        if (c >= 4 && it.mode == 0) {
            const int dr = (it.rs + (c - 4)) - it.r + 7;
            attn_chunk<2>(kt, vt, nat_kofs, qf, fr, fq, 1, qi, sB + g * 1920 + dr * 128, mrun, lsum, o);
        } else if (c >= 4 && it.mode == 1) {
            attn_chunk<4>(kt, vt, 0, qf, fr, fq, 2, it.kp0 + 64 * (c - 4) - (it.q0 + qi), sB, mrun, lsum, o);
        } else {
            attn_chunk<4>(kt, vt, 0, qf, fr, fq, 0, 0, sB, mrun, lsum, o);
        }
        __syncthreads();
    }
    TS_END(5);
    lsum = xrow16_sum(lsum);
    if (it.has_sink) lsum += fast_exp2((g ? it.sink1 : it.sink0) * LOG2E - mrun);
    const float inv = 1.0f / lsum;
    bf16_t* op = YCAT + (size_t)(it.qtok0 + wq * 16 + fr) * YC_LD + (g ? it.ocol1 : it.ocol0) + 4 * fq;
#pragma unroll
    for (int db = 0; db < 4; ++db) { u32x2 w; w.x = pk2(o[db][0] * inv, o[db][1] * inv); w.y = pk2(o[db][2] * inv, o[db][3] * inv); *(u32x2*)(op + 16 * db) = w; }
}

constexpr int C_UA = 0, C_QN = 512, C_KN = 768, C_VN = 1024, C_QS = 1280, C_KS = 1536, C_VS = 1664;

__device__ __forceinline__ void mix_items(CParams& p, LAS unsigned char* lds, int l, int sub) {
    const int n_attn = (l == 0) ? 2304 : 2048;
    const int n_conv = (l == 0) ? 512 + 64 : 512;
    const int start = (obid() + 128) % gridDim.x;
    for (int i = start; i < n_attn + n_conv; i += gridDim.x) {
        if (i >= n_attn) {
            if (!(sub & 4)) continue;
            const int ci = i - n_attn;
            TS_BEGIN(3);
            if (ci < 512) conv_item(p, lds, l, ci >> 5, ci & 31);
            else { const int cj = ci - 512; conv_item(p, lds, l, 16 + (cj >> 2), cj & 3); }
            TS_END(3);
            continue;
        }
        AttnItem it{};
        if (i < 1024) {
            const int b = i >> 6, r = (i >> 1) & 31, hp = i & 1;
            it.mode = 0; it.qtok0 = b * 2048 + r * 64; it.nslots = 2; it.h0 = 2 * hp;
            { const int h = 2 * hp; it.qcol0 = C_QN + 64 * h; it.kcol0 = C_KN + 64 * h; it.vcol0 = C_VN + 64 * h; it.ocol0 = 512 + 64 * h;
              it.qcol1 = it.qcol0 + 64; it.kcol1 = it.kcol0 + 64; it.vcol1 = it.vcol0 + 64; it.ocol1 = it.ocol0 + 64; }
            it.r = r; it.rs = min(max(r - 4, 0), 24); it.nloc = 8; it.loctok0 = b * 2048 + it.rs * 64; it.ctxtok0 = TL + b * 256;
        } else if (i < 2048) {
            const int k = i - 1024, b = k >> 6, qb = (k >> 1) & 31, kvh = k & 1;
            it.mode = 1; it.qtok0 = b * 2048 + qb * 64; it.nslots = 1;
            { const int h = 2 * kvh; it.qcol0 = C_QS + 64 * h; it.ocol0 = 768 + 64 * h; it.sink0 = p.sink[l * 4 + h]; it.sink1 = p.sink[l * 4 + h + 1];
              it.qcol1 = it.qcol0 + 64; it.ocol1 = it.ocol0 + 64; it.kcol0 = it.kcol1 = C_KS + 64 * kvh; it.vcol0 = it.vcol1 = C_VS + 64 * kvh; }
            it.has_sink = 1; it.q0 = qb * 64;
            const int ks = max(qb * 64 - 128, 0), ke = min(qb * 64 + 192, 2048);
            it.kp0 = ks; it.nloc = (ke - ks) >> 6; it.loctok0 = b * 2048 + ks; it.ctxtok0 = TL + b * 256;
        } else if (i < 2176) {
            const int k = i - 2048, b = k >> 3, qb = (k >> 1) & 3, hp = k & 1;
            it.mode = 2; it.qtok0 = TL + b * 256 + qb * 64; it.nslots = 2;
            { const int h = 2 * hp; it.qcol0 = C_QN + 64 * h; it.kcol0 = C_KN + 64 * h; it.vcol0 = C_VN + 64 * h; it.ocol0 = 512 + 64 * h;
              it.qcol1 = it.qcol0 + 64; it.kcol1 = it.kcol0 + 64; it.vcol1 = it.vcol0 + 64; it.ocol1 = it.ocol0 + 64; }
            it.nloc = 0; it.ctxtok0 = TL + b * 256;
        } else {
            const int k = i - 2176, b = k >> 3, qb = (k >> 1) & 3, kvh = k & 1;
            it.mode = 2; it.qtok0 = TL + b * 256 + qb * 64; it.nslots = 1;
            { const int h = 2 * kvh; it.qcol0 = C_QS + 64 * h; it.ocol0 = 768 + 64 * h; it.sink0 = p.sink[l * 4 + h]; it.sink1 = p.sink[l * 4 + h + 1];
              it.qcol1 = it.qcol0 + 64; it.ocol1 = it.ocol0 + 64; it.kcol0 = it.kcol1 = C_KS + 64 * kvh; it.vcol0 = it.vcol1 = C_VS + 64 * kvh; }
            it.has_sink = 1; it.nloc = 0; it.ctxtok0 = TL + b * 256;
        }
        TS_BEGIN(2);
        if (sub & 2) attn_item(p, lds, l, it);
        TS_END(2);
    }
}

constexpr int N_PHASES = 22;
#ifndef PHMASK
#define PHMASK 0xff
#endif

__device__ __forceinline__ void run_phase(CParams& p, LAS unsigned char* lds, int ph, int sub) {
    unsigned char* ws = p.ws;
    bf16_t* YH = (bf16_t*)(ws + WS_YH); bf16_t* U = (bf16_t*)(ws + WS_R1); bf16_t* PROJ = (bf16_t*)(ws + WS_PROJ); bf16_t* YCAT = (bf16_t*)(ws + WS_YCAT);
    float* XC = (float*)(ws + WS_XC); const float* MOD = (const float*)(ws + WS_MOD);
    const int G = gridDim.x, c = obid();
    if (ph == 0) { if constexpr ((PHMASK & 1) != 0) phase0(p, lds); return; }
    if (ph == 1) {
        if constexpr ((PHMASK & 2) == 0) return;
        ew_pass(p.x, p.ctx, nullptr, nullptr, nullptr, nullptr, nullptr, 0.f, nullptr, YH, p.norm_g, MOD, MOD + 1024, TA); return;
    }
    const int l = (ph - 2) / 10, k = (ph - 2) % 10;
    const float* MODL = MOD + (size_t)l * 17 * NMODC; const float* NG = p.norm_g + (size_t)l * 6 * DM;
    const int rows_late = (l == 0) ? TA : TL;
    switch (k) {
    case 0: case 7: {
        if constexpr ((PHMASK & 4) == 0) break;
        const int f = (k == 7), M = f ? rows_late : TA;
        pg8::Gemm g{YH, (const bf16_t*)(ws + WS_W13) + (size_t)(l * 2 + f) * 5632 * 1024, M, 5632, 1024, 1024, 1024};
        pg8::StaticOrder S; S.init(M, 5632, G, c); EpiSwiGLU E{U};
        pg8::gemm_phase<EpiSwiGLU, pg8::StaticOrder, true, true>(lds, g, S, E);
    } break;
    case 1: case 8: case 5: {
        if constexpr ((PHMASK & 8) == 0) break;
        const bool isout = (k == 5); const int f = (k == 8), M = (k == 1) ? TA : rows_late;
        const int Kd = isout ? YC_LD : FF;
        const bf16_t* Ap = isout ? YCAT : U;
        const bf16_t* Bp = isout ? (const bf16_t*)(ws + WS_WOUT) + (size_t)l * 1024 * YC_LD : (const bf16_t*)(ws + WS_W2T) + (size_t)(l * 2 + f) * 1024 * FF;
        for (int v = 0; v < (M == TA ? 3 : 1); ++v) {
            pg8::Gemm g = v == 0 ? pg8::Gemm{Ap, Bp, TL, 1024, Kd, Kd, Kd}
                                 : pg8::Gemm{Ap + (size_t)TL * Kd + (v - 1) * (Kd / 2), Bp + (v - 1) * (Kd / 2), TC, 1024, Kd / 2, Kd, Kd};
            pg8::StaticOrder S; S.init(g.M, 1024, G, v == 2 ? (c + G - 64) % G : c);
            EpiBf16Tile E{v == 0 ? YH : (v == 1 ? YH + (size_t)TL * DM : (bf16_t*)(ws + WS_Y2)), 1024, 0, 256};
            pg8::gemm_phase<EpiBf16Tile, pg8::StaticOrder, true, true>(lds, g, S, E);
        }
    } break;
    case 2: case 6: case 9: {
        if constexpr ((PHMASK & 2) == 0) break;
        const int gi = (k == 2) ? 2 : (k == 6 ? 5 : 8), ni = (k == 2) ? 1 : (k == 6 ? 3 : 5);
        const int nrows = (k == 2) ? TA : rows_late;
        const bool lastl = (k == 9 && l == 1);
        const float* gpre = (k == 2) ? NG + 2 * DM : (k == 6 ? NG + 4 * DM : p.norm_g + 6 * DM);
        const float* shift = (k == 2) ? MODL + 3 * 1024 : (k == 6 ? MODL + 6 * 1024 : MOD + 17 * NMODC);
        const float* scale = (k == 2) ? MODL + 4 * 1024 : (k == 6 ? MODL + 7 * 1024 : MOD + 17 * NMODC + 1024);
        float* outp = p.out;
        const bool first = (l == 0 && k == 2);
        ew_pass(first ? p.x : outp, first ? p.ctx : XC, outp, XC, YH, (const bf16_t*)(ws + WS_Y2), NG + ni * DM, (k == 6) ? 1.0f : 0.5f, MODL + gi * 1024, lastl ? nullptr : YH, gpre, shift, scale, nrows);
    } break;
    case 3: {
        if constexpr ((PHMASK & 16) == 0) break;
        const bf16_t* W = (const bf16_t*)(ws + WS_WIN) + (size_t)l * 2304 * 1024;
        { pg8::Gemm g{YH, W, TA, NP, 1024, 1024, 1024}; pg8::StaticOrder S; S.init(TA, NP, G, c); EpiWin E{PROJ, (const float*)(ws + WS_ROPE)};
          pg8::gemm_phase<EpiWin, pg8::StaticOrder, true, true>(lds, g, S, E); }
        { const int N = (l == 0) ? TA : TL; pg8::Gemm g{W + (size_t)1792 * 1024, YH, 512, N, 1024, 1024, 1024}; pg8::StaticOrder S; S.init(512, N, G, (c + 16) % G);
          EpiPQ E{(bf16_t*)(ws + WS_PQT), (bf16_t*)(ws + WS_PQTC)};
          pg8::gemm_phase<EpiPQ, pg8::StaticOrder, true, true>(lds, g, S, E); }
    } break;
    case 4: {
        if constexpr ((PHMASK & 32) == 0) break;
        TS_BEGIN(1);
        if (sub & 1)
        for (int v = 0; v < ((l == 0) ? 4 : 2); ++v) {
            const int hs = v & 1, isc = v >> 1;
            const bf16_t* Ap = isc ? (const bf16_t*)(ws + WS_DFTC) + hs * 256 : (const bf16_t*)(ws + WS_DFT) + hs * 2048;
            const bf16_t* Bp = isc ? (const bf16_t*)(ws + WS_PQTC) + hs * 256 : (const bf16_t*)(ws + WS_PQT) + hs * 2048;
            pg8::Gemm g{Ap, Bp, isc ? 256 : 2048, 4096, isc ? 256 : 2048, isc ? DFTC_LD : DFT_LD, isc ? PQTC_LD : PQT_LD};
            pg8::StaticOrder S; S.init(g.M, g.N, G, isc ? (c + G - 16 * hs) % G : (c + G - 128 * hs) % G);
            EpiBf16Tile E{YCAT + (isc ? (size_t)TL * YC_LD : 0) + (hs ? 1024 : 256), YC_LD, isc ? 256 : 2048, 0};
            pg8::gemm_phase<EpiBf16Tile, pg8::StaticOrder, true, true>(lds, g, S, E);
        }
        TS_END(1);
        if (sub & 6) mix_items(p, lds, l, sub);
    } break;
    }
}

__global__ void __launch_bounds__(512, 2) mega(Params p, int ph0, int ph1) {
    extern __shared__ __attribute__((aligned(16))) unsigned char lds_raw[];
    LAS unsigned char* lds = (LAS unsigned char*)lds_raw;
    cg::grid_group grid = cg::this_grid();
    if (ph1 < 0) grid.sync();
    volatile LAS unsigned* xst = (volatile LAS unsigned*)(lds + 131072);
    if (threadIdx.x < 4) xst[threadIdx.x] = 0u;
    __syncthreads();
    XcdBarrier xb = xcd_barrier_post((unsigned*)(p.ws + WS_BAR), xst);
#ifdef TPROBE
    unsigned long long tacc = 0, tprev = __builtin_amdgcn_s_memrealtime();
#endif
    for (int ph = ph0; ph < ph1; ++ph) {
        CParams* q = (CParams*)__builtin_amdgcn_kernarg_segment_ptr(); asm volatile("" : "+s"(q));
        run_phase(*q, lds, ph, 7);
#ifdef DUPK
        { const int kind = ph == 0 ? 10 : (ph == 1 ? 11 : (ph - 2) % 10);
          if ((DUPK >> kind) & 1) { xcd_barrier(xb); run_phase(*q, lds, ph, DUPSUB); } }
#endif
        if (ph + 1 < ph1) xcd_barrier(xb);
#ifdef TPROBE
        { const unsigned long long now = __builtin_amdgcn_s_memrealtime(); const int kind = ph == 0 ? 10 : (ph == 1 ? 11 : (ph - 2) % 10);
          if ((TPROBE >> kind) & 1) tacc += now - tprev; tprev = now; }
#endif
    }
#ifdef TPROBE
    if (blockIdx.x == 0 && threadIdx.x == 0) { const unsigned long long t0 = __builtin_amdgcn_s_memrealtime(); while (__builtin_amdgcn_s_memrealtime() - t0 < tacc) __builtin_amdgcn_s_sleep(8); }
#endif
#ifdef TSUB
    if (blockIdx.x == 0 && threadIdx.x == 0) { const unsigned long long tacc2 = *(volatile LAS unsigned long long*)(lds + 131080); const unsigned long long t0 = __builtin_amdgcn_s_memrealtime(); while (__builtin_amdgcn_s_memrealtime() - t0 < 4ull * tacc2) __builtin_amdgcn_s_sleep(8); }
#endif
#ifdef XSYNC
    for (int i = 0; i < XSYNC; ++i) xcd_barrier(xb);
#endif
}

#ifndef ONE_LAUNCH
#define ONE_LAUNCH 1
#endif

extern "C" void kernel_launch(void* const* d_in, const int* in_sizes, int n_in, void* d_out, int out_size, void* d_ws, size_t ws_size, hipStream_t stream) {
    static int grid = 0;
    if (grid == 0) {
        if (ws_size < WS_END) { fprintf(stderr, "kernel_launch: workspace too small: %zu < %zu\n", ws_size, (size_t)WS_END); grid = -1; return; }
        int dev = 0, cus = 0, per_cu = 0;
        hipGetDevice(&dev); hipDeviceGetAttribute(&cus, hipDeviceAttributeMultiprocessorCount, dev);
        hipFuncSetAttribute((const void*)mega, hipFuncAttributeMaxDynamicSharedMemorySize, LDS_BYTES);
        hipOccupancyMaxActiveBlocksPerMultiprocessor(&per_cu, (const void*)mega, 512, LDS_BYTES);
        if (per_cu < 1) { fprintf(stderr, "kernel_launch: occupancy query says %d blocks per CU\n", per_cu); per_cu = 1; }
        (void)hipGetLastError();
        grid = cus;
    }
    if (grid < 0) return;
    (void)hipMemsetAsync((unsigned char*)d_ws + WS_BAR, 0, 3456 * 4, stream);
    Params p{};
    p.x = (const float*)d_in[0]; p.c = (const float*)d_in[1]; p.ctx = (const float*)d_in[2]; p.c_ctx = (const float*)d_in[3];
    p.w_ada = (const float*)d_in[4]; p.b_ada = (const float*)d_in[5]; p.norm_g = (const float*)d_in[6];
    p.w1 = (const float*)d_in[7]; p.w3 = (const float*)d_in[8]; p.w2 = (const float*)d_in[9]; p.w_in = (const float*)d_in[10];
    p.conv_w = (const float*)d_in[11]; p.conv_b = (const float*)d_in[12]; p.ln_g = (const float*)d_in[13]; p.ln_b = (const float*)d_in[14];
    p.nat_bias = (const float*)d_in[15]; p.sink = (const float*)d_in[16]; p.w_out = (const float*)d_in[17];
    p.out = (float*)d_out; p.ws = (unsigned char*)d_ws;
#if ONE_LAUNCH
    int ph0 = 0, ph1 = N_PHASES;
    void* args[] = {&p, &ph0, &ph1};
    hipError_t e = hipLaunchCooperativeKernel((const void*)mega, dim3(grid), dim3(512), args, LDS_BYTES, stream);
    if (e != hipSuccess) fprintf(stderr, "cooperative launch failed: %s (grid %d)\n", hipGetErrorString(e), grid);
#else
    for (int ph = 0; ph < N_PHASES; ++ph) {
        int ph0 = ph, ph1 = ph + 1;
        void* args[] = {&p, &ph0, &ph1};
        hipError_t e = hipLaunchCooperativeKernel((const void*)mega, dim3(grid), dim3(512), args, LDS_BYTES, stream);
        if (e != hipSuccess) { fprintf(stderr, "launch %d failed: %s (grid %d)\n", ph, hipGetErrorString(e), grid); break; }
    }
#endif
}
```

```cpp
#include <hip/hip_runtime.h>
#include <hip/hip_cooperative_groups.h>
#include <cstdio>
#include <cstdint>
namespace cg = cooperative_groups;
#ifdef TSUB
#define TS_BEGIN(id) do { if ((TSUB) == (id) && threadIdx.x == 0) { *(volatile __attribute__((address_space(3))) unsigned long long*)(lds + 131080) -= __builtin_amdgcn_s_memrealtime(); } } while (0)
#define TS_END(id)   do { if ((TSUB) == (id) && threadIdx.x == 0) { *(volatile __attribute__((address_space(3))) unsigned long long*)(lds + 131080) += __builtin_amdgcn_s_memrealtime(); } } while (0)
#else
#define TS_BEGIN(id) do {} while (0)
#define TS_END(id) do {} while (0)
#endif
namespace pg8 {
#define PG8_LAS __attribute__((address_space(3)))
typedef unsigned short bf16_t;
typedef short bf16x8 __attribute__((ext_vector_type(8)));
typedef float f32x4 __attribute__((ext_vector_type(4)));
typedef unsigned u32x4 __attribute__((ext_vector_type(4)));
constexpr int BM = 256, BK = 64, HALF = 128, HTB = HALF * BK * 2  , STAGE_BYTES = 8 * HTB, NXCD = 8, WGM = 8;

__host__ __device__ __forceinline__ int lds_byte(int r, int c) { const int st = (r >> 4) * 2 + (c >> 5), rr = r & 15, cc = c & 31, ob = rr * 64 + cc * 2; return st * 1024 + (ob ^ (((ob >> 9) & 1) << 5)); }
__host__ __device__ __forceinline__ void stage_rc(int b, int& R, int& C) { const int st = b / 1024, sb = b % 1024, swz = sb ^ (((sb >> 9) & 1) << 5); R = (st >> 1) * 16 + swz / 64; C = (st & 1) * 32 + (swz % 64) / 2; }
__host__ __device__ __forceinline__ int perm32(int rho) { const int n = rho >> 4, i = rho & 15; return 8 * (i >> 2) + 4 * n + (i & 3); }

struct Unit { int pm, pn; };
struct Gemm { const bf16_t* A; const bf16_t* Bt; int M, N, K, lda, ldb; };

struct StaticOrder {
    int nM, nN, nwg, G, c;
    __host__ __device__ void init(int M, int N, int G_, int c_) { nM = M / BM; nN = N / BM; nwg = nM * nN; G = G_; c = c_; }
    __host__ __device__ bool next(int i, Unit& u) const {
        const long L = (long)i * G + c; if (L >= nwg) return false;
        int wgid = (int)L; { const int q = nwg / NXCD, r = nwg % NXCD, xcd = wgid % NXCD, off = wgid / NXCD; wgid = (xcd < r ? xcd * (q + 1) : r * (q + 1) + (xcd - r) * q) + off; }
        const int nig = WGM * nN, gid = wgid / nig, fm = gid * WGM, gsz = (nM - fm) < WGM ? (nM - fm) : WGM;
        u.pm = fm + ((wgid % nig) % gsz); u.pn = (wgid % nig) / gsz; return true;
    }
    __device__ __forceinline__ void a_ready(const Unit&) const {}
    __device__ __forceinline__ void done(const Unit&) const {}
};
__device__ __forceinline__ unsigned cvt_pk_bf16(float lo, float hi) { unsigned r; asm volatile("v_cvt_pk_bf16_f32 %0, %1, %2" : "=v"(r) : "v"(lo), "v"(hi)); return r; }
typedef float f32x2 __attribute__((ext_vector_type(2)));
template <class Epi, class Sched, bool ALIGN_EPI = false, bool SP2 = false>
__device__ __forceinline__ void gemm_phase(PG8_LAS unsigned char* lds, const Gemm g, const Sched& S, const Epi& E) {
    int tid_ = threadIdx.x; asm volatile("" : "+v"(tid_));
    const int tid = tid_, wid = __builtin_amdgcn_readfirstlane(tid >> 6), lane = tid & 63, wr = wid >> 2, wc = wid & 3, fr = lane & 15, fq = lane >> 4;
    const int K = g.K, nt = K / BK;
    unsigned voffA[2], voffB[2];
#pragma unroll
    for (int i = 0; i < 2; ++i) { int R, C; stage_rc(tid * 16 + i * 8192, R, C); const int Rb = Epi::PERM ? ((R & ~31) + perm32(R & 31)) : R;
        voffA[i] = (unsigned)(R * g.lda + C) * 2u; voffB[i] = (unsigned)(Rb * g.ldb + C) * 2u; }
    const size_t kstep = (size_t)(BK * 2);
    const size_t hstepA = (size_t)HALF * g.lda * 2, hstepB = (size_t)HALF * g.ldb * 2;
    const size_t tstepA = 2 * hstepA, tstepB = 2 * hstepB;
    const unsigned ldsw = (unsigned)wid * 1024u;
    const int aoff = lds_byte(wr * 64 + fr, fq * 8), boff = lds_byte(wc * 32 + fr, fq * 8);
#define PG8_SA(b, h) (((b) * 2 + (h)) * HTB)
#define PG8_SB(b, h) ((4 + (b) * 2 + (h)) * HTB)
#define PG8_STAGE(bufoff, gbase, voff) do { _Pragma("unroll") for (int _i = 0; _i < 2; ++_i) \
        __builtin_amdgcn_global_load_lds((const unsigned*)((const char*)(gbase) + (voff)[_i]), (PG8_LAS unsigned*)(lds + (bufoff) + ldsw + _i * 8192), 16, 0, 0); } while (0)
#define PG8_LDA(dst, b, h) do { _Pragma("unroll") for (int m = 0; m < 4; ++m) _Pragma("unroll") for (int k = 0; k < 2; ++k) dst[m][k] = *(const PG8_LAS bf16x8*)(lds + PG8_SA(b, h) + aoff + m * 2048 + k * 1024); } while (0)
#define PG8_LDB(dst, b, h) do { _Pragma("unroll") for (int n = 0; n < 2; ++n) _Pragma("unroll") for (int k = 0; k < 2; ++k) dst[n][k] = *(const PG8_LAS bf16x8*)(lds + PG8_SB(b, h) + boff + n * 2048 + k * 1024); } while (0)
#define PG8_MMA(ai, bj, At, Bt) do { __builtin_amdgcn_s_setprio(1); _Pragma("unroll") for (int m = 0; m < 4; ++m) _Pragma("unroll") for (int n = 0; n < 2; ++n) _Pragma("unroll") for (int k = 0; k < 2; ++k) \
        acc[ai][bj][m][n] = __builtin_amdgcn_mfma_f32_16x16x32_bf16(Bt[n][k], At[m][k], acc[ai][bj][m][n], 0, 0, 0); __builtin_amdgcn_s_setprio(0); } while (0)
#define PG8_WAIT_V(n) asm volatile("s_waitcnt vmcnt(" #n ")" ::: "memory")
#define PG8_WAIT_L(n) asm volatile("s_waitcnt lgkmcnt(" #n ")" ::: "memory")
#define PG8_BAR __builtin_amdgcn_s_barrier()
#define PG8_SCHED __builtin_amdgcn_sched_barrier(0)
    Unit cur, nxt; int ui = 0;
    if (!S.next(0, cur)) return;
    f32x4 acc[2][2][4][2];
#pragma unroll
    for (int a = 0; a < 2; ++a)
#pragma unroll
        for (int b = 0; b < 2; ++b)
#pragma unroll
            for (int m = 0; m < 4; ++m)
#pragma unroll
                for (int n = 0; n < 2; ++n) acc[a][b][m][n] = (f32x4){0.f, 0.f, 0.f, 0.f};
    bf16x8 At[4][2], B0[2][2], B1[2][2];
    const char* cA = (const char*)g.A + (size_t)cur.pm * tstepA; const char* cB = (const char*)g.Bt + (size_t)cur.pn * tstepB;
    S.a_ready(cur);
    if constexpr (SP2) {
        PG8_STAGE(PG8_SB(0, 0), cB, voffB); PG8_STAGE(PG8_SB(0, 1), cB + hstepB, voffB); PG8_STAGE(PG8_SA(0, 0), cA, voffA); PG8_STAGE(PG8_SA(0, 1), cA + hstepA, voffA);
        if (wr == 1) PG8_BAR;
        PG8_WAIT_V(2); PG8_BAR;
        PG8_STAGE(PG8_SB(1, 0), cB + kstep, voffB); PG8_STAGE(PG8_SA(1, 0), cA + kstep, voffA); PG8_STAGE(PG8_SB(1, 1), cB + hstepB + kstep, voffB);
        PG8_WAIT_V(6); PG8_BAR;
    } else {
        PG8_STAGE(PG8_SB(0, 0), cB, voffB); PG8_STAGE(PG8_SA(0, 0), cA, voffA); PG8_STAGE(PG8_SB(0, 1), cB + hstepB, voffB); PG8_STAGE(PG8_SA(0, 1), cA + hstepA, voffA);
        if (wr == 1) PG8_BAR;
        PG8_WAIT_V(4); PG8_BAR;
        PG8_STAGE(PG8_SB(1, 0), cB + kstep, voffB); PG8_STAGE(PG8_SA(1, 0), cA + kstep, voffA); PG8_STAGE(PG8_SB(1, 1), cB + hstepB + kstep, voffB);
        PG8_WAIT_V(6); PG8_BAR;
    }
    for (;;) {
        const bool has_next = S.next(ui + 1, nxt);
        const char* nA = has_next ? (const char*)g.A + (size_t)nxt.pm * tstepA : cA; const char* nB = has_next ? (const char*)g.Bt + (size_t)nxt.pn * tstepB : cB;
        for (int t = 0; t < nt; t += 2) {
            const bool last = (t == nt - 2);
            const char* a1 = cA + (size_t)(t + 1) * kstep;
            const char* a2 = last ? nA : cA + (size_t)(t + 2) * kstep; const char* b2 = last ? nB : cB + (size_t)(t + 2) * kstep;
            const char* a3 = a2 + kstep; const char* b3 = b2 + kstep;
            if (last && has_next) S.a_ready(nxt);
            if constexpr (SP2) {
            PG8_LDB(B0, 0, 0); PG8_LDB(B1, 0, 1); PG8_SCHED; PG8_LDA(At, 0, 0); PG8_STAGE(PG8_SA(1, 1), a1 + hstepA, voffA);
            PG8_WAIT_V(8); PG8_WAIT_L(0); PG8_BAR; PG8_MMA(0, 0, At, B0); PG8_MMA(0, 1, At, B1); PG8_BAR; PG8_SCHED;
            PG8_LDA(At, 0, 1); PG8_STAGE(PG8_SB(0, 0), b2, voffB); PG8_STAGE(PG8_SB(0, 1), b2 + hstepB, voffB); PG8_STAGE(PG8_SA(0, 0), a2, voffA);
            PG8_WAIT_V(8); PG8_WAIT_L(0); PG8_BAR; PG8_MMA(1, 0, At, B0); PG8_MMA(1, 1, At, B1); PG8_BAR; PG8_SCHED;
            PG8_LDB(B0, 1, 0); PG8_LDB(B1, 1, 1); PG8_SCHED; PG8_LDA(At, 1, 0); PG8_STAGE(PG8_SA(0, 1), a2 + hstepA, voffA);
            PG8_WAIT_V(8); PG8_WAIT_L(0); PG8_BAR; PG8_MMA(0, 0, At, B0); PG8_MMA(0, 1, At, B1); PG8_BAR; PG8_SCHED;
            PG8_LDA(At, 1, 1); PG8_STAGE(PG8_SB(1, 0), b3, voffB); PG8_STAGE(PG8_SB(1, 1), b3 + hstepB, voffB); PG8_STAGE(PG8_SA(1, 0), a3, voffA);
            PG8_WAIT_V(8); PG8_WAIT_L(0); PG8_BAR; PG8_MMA(1, 0, At, B0); PG8_MMA(1, 1, At, B1); PG8_BAR; PG8_SCHED;
            } else {
            PG8_LDB(B0, 0, 0); PG8_SCHED; PG8_LDA(At, 0, 0); PG8_STAGE(PG8_SA(1, 1), a1 + hstepA, voffA);
            PG8_WAIT_L(8); PG8_BAR; PG8_WAIT_L(0); PG8_MMA(0, 0, At, B0); PG8_BAR; PG8_SCHED;
            PG8_LDB(B1, 0, 1); PG8_STAGE(PG8_SB(0, 0), b2, voffB);
            PG8_BAR; PG8_WAIT_L(0); PG8_MMA(0, 1, At, B1); PG8_BAR;
            PG8_LDA(At, 0, 1); PG8_STAGE(PG8_SA(0, 0), a2, voffA);
            PG8_BAR; PG8_WAIT_L(0); PG8_MMA(1, 0, At, B0); PG8_BAR; PG8_SCHED;
            PG8_STAGE(PG8_SB(0, 1), b2 + hstepB, voffB);
            PG8_WAIT_V(6); PG8_BAR; PG8_MMA(1, 1, At, B1); PG8_BAR;
            PG8_LDB(B0, 1, 0); PG8_SCHED; PG8_LDA(At, 1, 0); PG8_STAGE(PG8_SA(0, 1), a2 + hstepA, voffA);
            PG8_WAIT_L(8); PG8_BAR; PG8_WAIT_L(0); PG8_MMA(0, 0, At, B0); PG8_BAR; PG8_SCHED;
            PG8_LDB(B1, 1, 1); PG8_STAGE(PG8_SB(1, 0), b3, voffB);
            PG8_BAR; PG8_WAIT_L(0); PG8_MMA(0, 1, At, B1); PG8_BAR;
            PG8_LDA(At, 1, 1); PG8_STAGE(PG8_SA(1, 0), a3, voffA);
            PG8_BAR; PG8_WAIT_L(0); PG8_MMA(1, 0, At, B0); PG8_BAR; PG8_SCHED;
            PG8_STAGE(PG8_SB(1, 1), b3 + hstepB, voffB);
            PG8_WAIT_V(6); PG8_BAR; PG8_MMA(1, 1, At, B1); PG8_BAR;
            }
        }
        if constexpr (ALIGN_EPI) { if (wr == 0) PG8_BAR; }
        TS_BEGIN(8);
        if constexpr (!Epi::AFTER_DRAIN) { E(acc, cur, wr, wc, fr, fq); S.done(cur); }
        TS_END(8);
        if (!has_next) break;
#pragma unroll
        for (int a = 0; a < 2; ++a)
#pragma unroll
            for (int b = 0; b < 2; ++b)
#pragma unroll
                for (int m = 0; m < 4; ++m)
#pragma unroll
                    for (int n = 0; n < 2; ++n) acc[a][b][m][n] = (f32x4){0.f, 0.f, 0.f, 0.f};
        cur = nxt; cA = nA; cB = nB; ++ui;
        if constexpr (ALIGN_EPI) { if (wr == 1) PG8_BAR; }
    }
    PG8_WAIT_V(0);
    if constexpr (!ALIGN_EPI) { if (wr == 0) PG8_BAR; }
    PG8_BAR;
    if constexpr (Epi::AFTER_DRAIN) { E.fused(acc, cur, wr, wc, fr, fq, lds, wid, lane); S.done(cur); }
#undef PG8_SA
#undef PG8_SB
#undef PG8_STAGE
#undef PG8_LDA
#undef PG8_LDB
#undef PG8_MMA
#undef PG8_WAIT_V
#undef PG8_WAIT_L
#undef PG8_BAR
#undef PG8_SCHED
}
}

#define LAS __attribute__((address_space(3)))
typedef unsigned short bf16_t;
typedef float f32x4 __attribute__((ext_vector_type(4)));
typedef float f32x2 __attribute__((ext_vector_type(2)));
typedef unsigned u32x4 __attribute__((ext_vector_type(4)));
typedef unsigned u32x2 __attribute__((ext_vector_type(2)));
typedef short bf16x8 __attribute__((ext_vector_type(8)));
typedef short bf16x4 __attribute__((ext_vector_type(4)));

constexpr int TL = 32768, TC = 4096, TA = 36864, DM = 1024, FF = 2816, NP = 1792, NMODC = 9216;
constexpr int YC_LD = 1280, DFT_LD = 4160, PQT_LD = 4160, DFTC_LD = 576, PQTC_LD = 576;
constexpr int LDS_BYTES = 131072 + 16;
#ifndef MIXMASK
#define MIXMASK 7
#endif

constexpr float EPSV = 1e-6f;
constexpr float LOG2E = 1.4426950408889634f;

constexpr size_t WS_XC   = 0;
constexpr size_t WS_YH   = WS_XC + (size_t)TC * DM * 4;
constexpr size_t WS_R1   = WS_YH + (size_t)TA * DM * 2;
constexpr size_t WS_PROJ = WS_R1;
constexpr size_t WS_PQT  = WS_PROJ + (size_t)TA * NP * 2;
constexpr size_t WS_PQTC = WS_PQT + (size_t)4096 * PQT_LD * 2;
constexpr size_t WS_YCAT = WS_PQTC + (size_t)4096 * PQTC_LD * 2;
constexpr size_t WS_R1END= WS_YCAT + (size_t)TA * YC_LD * 2;
constexpr size_t WS_W13  = WS_R1END;
constexpr size_t WS_W2T  = WS_W13 + (size_t)4 * 5632 * 1024 * 2;
constexpr size_t WS_WIN  = WS_W2T + (size_t)4 * 1024 * 2816 * 2;
constexpr size_t WS_WOUT = WS_WIN + (size_t)2 * 2304 * 1024 * 2;
constexpr size_t WS_DFT  = WS_WOUT + (size_t)2 * 1024 * YC_LD * 2;
constexpr size_t WS_DFTC = WS_DFT + (size_t)2048 * DFT_LD * 2;
constexpr size_t WS_MOD  = WS_DFTC + (size_t)256 * DFTC_LD * 2;
constexpr size_t WS_ROPE = WS_MOD + (size_t)2 * 17 * NMODC * 4;
constexpr size_t WS_BAR  = WS_ROPE + 64 * 16 * 2 * 4;
constexpr size_t WS_Y2   = WS_BAR + 3456 * 4;
constexpr size_t WS_END  = WS_Y2 + (size_t)TC * DM * 2;
static_assert((size_t)TA * FF * 2 <= WS_R1END - WS_R1, "U must fit in R1");

struct Params {
    const float *x, *c, *ctx, *c_ctx, *w_ada, *b_ada, *norm_g, *w1, *w3, *w2, *w_in, *conv_w, *conv_b, *ln_g, *ln_b, *nat_bias, *sink, *w_out;
    float* out; unsigned char* ws;
};
typedef const __attribute__((address_space(4))) Params CParams;

__device__ __forceinline__ unsigned pk2(float lo, float hi) { return pg8::cvt_pk_bf16(lo, hi); }
__device__ __forceinline__ float bflo(unsigned v) { return __uint_as_float(v << 16); }
__device__ __forceinline__ float bfhi(unsigned v) { return __uint_as_float(v & 0xffff0000u); }
__device__ __forceinline__ int otid() { int t = threadIdx.x; asm volatile("" : "+v"(t)); return t; }
__device__ __forceinline__ int obid() { int t = blockIdx.x; asm volatile("" : "+s"(t)); return t; }
__device__ __forceinline__ float xrow16_max(float x) {
    auto s = __builtin_amdgcn_permlane16_swap(__float_as_uint(x), __float_as_uint(x), false, false);
    x = fmaxf(__uint_as_float(s[0]), __uint_as_float(s[1]));
    auto t = __builtin_amdgcn_permlane32_swap(__float_as_uint(x), __float_as_uint(x), false, false);
    return fmaxf(__uint_as_float(t[0]), __uint_as_float(t[1]));
}
__device__ __forceinline__ float xrow16_sum(float x) {
    auto s = __builtin_amdgcn_permlane16_swap(__float_as_uint(x), __float_as_uint(x), false, false);
    x = __uint_as_float(s[0]) + __uint_as_float(s[1]);
    auto t = __builtin_amdgcn_permlane32_swap(__float_as_uint(x), __float_as_uint(x), false, false);
    return __uint_as_float(t[0]) + __uint_as_float(t[1]);
}
template <int CTRL> __device__ __forceinline__ float dpp_mov(float x) { return __builtin_bit_cast(float, __builtin_amdgcn_mov_dpp(__builtin_bit_cast(int, x), CTRL, 0xf, 0xf, true)); }
__device__ __forceinline__ float wave_sum(float v) {
    v += dpp_mov<0xB1>(v);
    v += dpp_mov<0x4E>(v);
    v += dpp_mov<0x141>(v);
    v += dpp_mov<0x128>(v);
    return xrow16_sum(v);
}
__device__ __forceinline__ float fast_exp2(float x) { return __builtin_amdgcn_exp2f(x); }
__device__ __forceinline__ float fast_rcp(float x) { return __builtin_amdgcn_rcpf(x); }
__device__ __forceinline__ float silu_f(float v) { return v * fast_rcp(1.0f + fast_exp2(-v * LOG2E)); }
__device__ __forceinline__ float sigmoid_f(float v) { return fast_rcp(1.0f + fast_exp2(-v * LOG2E)); }

#define XB_TMO      128
#define XB_XCNT(j)  (256  + 64 * (j))
#define XB_XSUB(j)  (1280 + 64 * (j))
#define XB_XGEN(j)  (2304 + 64 * (j))
#define XB_TOP      3328
#define XB_TOPGEN   3392
#define XCD_BAR_WORDS 3456
#define XB_SPIN_CAP (1u << 18)

__device__ __forceinline__ unsigned xb_ld(unsigned* p)              { return __hip_atomic_load(p, __ATOMIC_RELAXED, __HIP_MEMORY_SCOPE_AGENT); }
__device__ __forceinline__ unsigned xb_add(unsigned* p, unsigned v) { return __hip_atomic_fetch_add(p, v, __ATOMIC_RELAXED, __HIP_MEMORY_SCOPE_AGENT); }
__device__ __forceinline__ unsigned xb_xcc_id() { return (unsigned)__builtin_amdgcn_s_getreg((3 << 11) | 20) & 0xFu; }
#define XB_SPIN(cond, bar) do { unsigned _sp = 0; while (cond) { __builtin_amdgcn_s_sleep(1); \
    if ((++_sp & 255u) == 0u) { if (xb_ld(&(bar)[XB_TMO])) break; if (_sp > XB_SPIN_CAP) { atomicAdd(&(bar)[XB_TMO], 1u); break; } } } } while (0)

struct XcdBarrier {
    unsigned* bar; unsigned x;
    volatile LAS unsigned* st;
};

__device__ __forceinline__ XcdBarrier xcd_barrier_post(unsigned* bar, volatile LAS unsigned* st) {
    XcdBarrier b; b.bar = bar; b.x = xb_xcc_id(); b.st = st;
    if (threadIdx.x == 0) (void)xb_add(&bar[XB_XCNT(b.x)], 1u);
    return b;
}
__device__ __forceinline__ void xcd_barrier_complete(unsigned* bar, unsigned x, unsigned& nloc, unsigned& nx) {
    const unsigned G = gridDim.x * gridDim.y * gridDim.z;
    unsigned sum, cnt, mine, sp = 0u;
    for (;;) {
        sum = 0u; cnt = 0u; mine = 0u;
#pragma unroll
        for (unsigned j = 0; j < 16; ++j) { const unsigned c = xb_ld(&bar[XB_XCNT(j)]); sum += c; cnt += (c > 0u) ? 1u : 0u; mine = (j == x) ? c : mine; }
        if (sum == G) break;
        __builtin_amdgcn_s_sleep(1);
        if ((++sp & 255u) == 0u) { if (xb_ld(&bar[XB_TMO])) break; if (sp > XB_SPIN_CAP) { atomicAdd(&bar[XB_TMO], 1u); break; } }
    }
    nloc = mine > 0u ? mine : 1u; nx = cnt > 0u ? cnt : 1u;
}

__device__ __forceinline__ void xcd_barrier(const XcdBarrier& b) {
    asm volatile("s_waitcnt vmcnt(0)" ::: "memory");
    __syncthreads();
    if (threadIdx.x == 0) {
        unsigned* bar = b.bar;
        __builtin_amdgcn_s_waitcnt(0);
        unsigned nloc = b.st[0], nx = b.st[1];
        if (nloc == 0u) { xcd_barrier_complete(bar, b.x, nloc, nx); b.st[0] = nloc; b.st[1] = nx; }
        const unsigned old = xb_add(&bar[XB_XSUB(b.x)], 1u);
        const unsigned gen = old / nloc;
        if (old + 1u == (gen + 1u) * nloc) {
            __builtin_amdgcn_fence(__ATOMIC_RELEASE, "agent");
            asm volatile("s_waitcnt vmcnt(0)" ::: "memory");
            const unsigned og = xb_add(&bar[XB_TOP], 1u);
            const unsigned tg = og / nx;
            if (og + 1u == (tg + 1u) * nx) xb_add(&bar[XB_TOPGEN], 1u);
            else XB_SPIN(xb_ld(&bar[XB_TOPGEN]) == tg, bar);
            __builtin_amdgcn_fence(__ATOMIC_ACQUIRE, "agent");
            xb_add(&bar[XB_XGEN(b.x)], 1u);
            asm volatile("s_waitcnt vmcnt(0)" ::: "memory");
        } else {
            XB_SPIN(xb_ld(&bar[XB_XGEN(b.x)]) == gen, bar);
            __builtin_amdgcn_fence(__ATOMIC_ACQUIRE, "agent");
            asm volatile("s_waitcnt vmcnt(0)" ::: "memory");
        }
    }
    __syncthreads();
}


struct EpiSwiGLU {
    static constexpr bool PERM = true, AFTER_DRAIN = false;
    bf16_t* U;
    __device__ __forceinline__ void operator()(const f32x4 (&acc)[2][2][4][2], const pg8::Unit& u, int wr, int wc, int fr, int fq) const {
        const int row0 = u.pm * 256 + wr * 64 + fr, col0 = u.pn * 128 + wc * 32 + 8 * fq;
#pragma unroll
        for (int ai = 0; ai < 2; ++ai)
#pragma unroll
            for (int m = 0; m < 4; ++m) {
                bf16_t* rowp = U + (size_t)(row0 + ai * 128 + m * 16) * FF + col0;
                float v[8];
#pragma unroll
                for (int n = 0; n < 2; ++n)
#pragma unroll
                    for (int j = 0; j < 4; ++j) v[n * 4 + j] = silu_f(acc[ai][0][m][n][j]) * acc[ai][1][m][n][j];
                u32x4 w; w.x = pk2(v[0], v[1]); w.y = pk2(v[2], v[3]); w.z = pk2(v[4], v[5]); w.w = pk2(v[6], v[7]);
                *(u32x4*)rowp = w;
            }
    }
};
struct EpiBf16Tile {
    static constexpr bool PERM = true, AFTER_DRAIN = false;
    bf16_t* O; int ldc, row_pn, col_pn;
    __device__ __forceinline__ void operator()(const f32x4 (&acc)[2][2][4][2], const pg8::Unit& u, int wr, int wc, int fr, int fq) const {
        const int row0 = u.pm * 256 + u.pn * row_pn + wr * 64 + fr, col0 = u.pn * col_pn + wc * 32 + 8 * fq;
#pragma unroll
        for (int ai = 0; ai < 2; ++ai)
#pragma unroll
            for (int m = 0; m < 4; ++m) {
                bf16_t* rowp = O + (size_t)(row0 + ai * 128 + m * 16) * ldc + col0;
#pragma unroll
                for (int bj = 0; bj < 2; ++bj) {
                    const f32x4 v0 = acc[ai][bj][m][0], v1 = acc[ai][bj][m][1];
                    u32x4 w; w.x = pk2(v0[0], v0[1]); w.y = pk2(v0[2], v0[3]); w.z = pk2(v1[0], v1[1]); w.w = pk2(v1[2], v1[3]);
                    *(u32x4*)(rowp + bj * 128) = w;
                }
            }
    }
};
struct EpiPQ {
    static constexpr bool PERM = true, AFTER_DRAIN = false;
    bf16_t* PQT; bf16_t* PQTC;
    __device__ __forceinline__ void operator()(const f32x4 (&acc)[2][2][4][2], const pg8::Unit& u, int wr, int wc, int fr, int fq) const {
        const int cl = wc * 32 + 8 * fq;
#pragma unroll
        for (int ai = 0; ai < 2; ++ai)
#pragma unroll
            for (int m = 0; m < 4; ++m) {
                const int mp = u.pm * 256 + ai * 128 + wr * 64 + m * 16 + fr;
                const int g = mp >> 7, pq = (mp >> 6) & 1, cp = mp & 63;
                bf16_t* rowp;
                if (u.pn < 128) { const int b = u.pn >> 3, n0 = (u.pn & 7) * 256; rowp = PQT + (size_t)(b * 256 + g * 64 + cp) * PQT_LD + pq * 2048 + n0 + cl; }
                else { const int b = u.pn - 128; rowp = PQTC + (size_t)(b * 256 + g * 64 + cp) * PQTC_LD + pq * 256 + cl; }
#pragma unroll
                for (int bj = 0; bj < 2; ++bj) {
                    const f32x4 v0 = acc[ai][bj][m][0], v1 = acc[ai][bj][m][1];
                    u32x4 w; w.x = pk2(v0[0], v0[1]); w.y = pk2(v0[2], v0[3]); w.z = pk2(v1[0], v1[1]); w.w = pk2(v1[2], v1[3]);
                    *(u32x4*)(rowp + bj * 128) = w;
                }
            }
    }
};
struct EpiWin {
    static constexpr bool PERM = false, AFTER_DRAIN = false;
    bf16_t* P; const float* rope;
    __device__ __forceinline__ void operator()(const f32x4 (&acc)[2][2][4][2], const pg8::Unit& u, int wr, int wc, int fr, int fq) const {
        const int row0 = u.pm * 256 + wr * 64 + fr, col0 = u.pn * 256 + wc * 32 + 4 * fq;
        const float qs = (u.pn == 2 || u.pn == 5) ? 0.125f * LOG2E : 1.0f;
        const bool lat = u.pm < 128;
#pragma unroll
        for (int ai = 0; ai < 2; ++ai)
#pragma unroll
            for (int m = 0; m < 4; ++m) {
                const int r = row0 + ai * 128 + m * 16;
                bf16_t* rowp = P + (size_t)r * NP + col0;
                const int t = r & 2047;
                const int pos = (wc & 1) ? (t & 63) : (t >> 6);
#pragma unroll
                for (int bj = 0; bj < 2; ++bj) {
                    f32x4 v0 = acc[ai][bj][m][0], v1 = acc[ai][bj][m][1];
                    const bool dorope = lat && (u.pn == 5 || (u.pn == 6 && bj == 0));
                    if (dorope) {
                        const f32x4 cs0 = *(const f32x4*)(rope + (pos * 16 + 4 * fq) * 2), cs1 = *(const f32x4*)(rope + (pos * 16 + 4 * fq) * 2 + 4);
                        const float c0 = cs0[0], s0 = cs0[1], c1 = cs0[2], s1 = cs0[3], c2 = cs1[0], s2 = cs1[1], c3 = cs1[2], s3 = cs1[3];
                        f32x4 a, b;
                        a[0] = v0[0] * c0 - v1[0] * s0; b[0] = v0[0] * s0 + v1[0] * c0;
                        a[1] = v0[1] * c1 - v1[1] * s1; b[1] = v0[1] * s1 + v1[1] * c1;
                        a[2] = v0[2] * c2 - v1[2] * s2; b[2] = v0[2] * s2 + v1[2] * c2;
                        a[3] = v0[3] * c3 - v1[3] * s3; b[3] = v0[3] * s3 + v1[3] * c3;
                        v0 = a; v1 = b;
                    }
                    v0 = v0 * qs; v1 = v1 * qs;
                    u32x2 w0, w1; w0.x = pk2(v0[0], v0[1]); w0.y = pk2(v0[2], v0[3]); w1.x = pk2(v1[0], v1[1]); w1.y = pk2(v1[2], v1[3]);
                    *(u32x2*)(rowp + bj * 128) = w0; *(u32x2*)(rowp + bj * 128 + 16) = w1;
                }
            }
    }
};

struct TrItem { const float* src; bf16_t* dst; int ld_src, ld_dst; };
__device__ __forceinline__ TrItem tr_decode(CParams& p, int it) {
    constexpr int PER_L = 2 * 704 + 2 * 352 + 224 + 160;
    unsigned char* ws = p.ws;
    const int l = it / PER_L; int q = it % PER_L;
    const float* src; bf16_t* dst; int ld_src, ld_dst, col0, k0, r0;
    if (q < 2 * 704) { const int f = q / 704; q %= 704; const int rt = q >> 4, kt = q & 15, R0 = rt * 128, tile = R0 >> 8, bj = (R0 >> 7) & 1;
        src = (bj ? p.w3 : p.w1) + (size_t)(l * 2 + f) * 1024 * FF; ld_src = FF; col0 = 128 * tile; k0 = 64 * kt; dst = (bf16_t*)(ws + WS_W13) + (size_t)(l * 2 + f) * 5632 * 1024; r0 = R0; ld_dst = 1024; }
    else if (q < 2 * 704 + 2 * 352) { q -= 2 * 704; const int f = q / 352; q %= 352; const int rt = q / 44, kt = q % 44;
        src = p.w2 + (size_t)(l * 2 + f) * FF * 1024; ld_src = 1024; col0 = 128 * rt; k0 = 64 * kt; dst = (bf16_t*)(ws + WS_W2T) + (size_t)(l * 2 + f) * 1024 * FF; r0 = 128 * rt; ld_dst = FF; }
    else if (q < 2 * 704 + 2 * 352 + 224) { q -= 2 * 704 + 2 * 352; const int rt = q >> 4, kt = q & 15, R0 = rt * 128;
        src = p.w_in + (size_t)l * 1024 * 2048; ld_src = 2048; col0 = R0 < 512 ? R0 : R0 + 256; k0 = 64 * kt; dst = (bf16_t*)(ws + WS_WIN) + (size_t)l * 2304 * 1024; r0 = R0; ld_dst = 1024; }
    int ks = -1;
    if (q >= 2 * 704 + 2 * 352 + 224) { q -= 2 * 704 + 2 * 352 + 224; const int rt = q / 20, kt = q % 20;
        src = p.w_out + (size_t)l * 1024 * 1024; ld_src = 1024; col0 = 128 * rt; k0 = 64 * kt; ks = kt < 16 ? 64 * kt : 256 + 64 * (kt - 16); dst = (bf16_t*)(ws + WS_WOUT) + (size_t)l * 1024 * YC_LD; r0 = 128 * rt; ld_dst = YC_LD; }
    if (ks < 0) ks = k0;
    TrItem t; t.src = src + (size_t)ks * ld_src + col0; t.dst = dst + (size_t)r0 * ld_dst + k0; t.ld_src = ld_src; t.ld_dst = ld_dst; return t;
}

__device__ __forceinline__ void phase0(CParams& p, LAS unsigned char* lds) {
    const int tid = otid(), wave = tid >> 6, lane = tid & 63;
    unsigned char* ws = p.ws;
    const int bid = obid(), G = gridDim.x;
    TS_BEGIN(9);
    if (bid < 288) {
        LAS float* sS = (LAS float*)lds;
        LAS float* sR = sS + 17 * 1024;
        for (int i = tid; i < 17 * 1024; i += 512) { const float v = (i < 16384) ? p.c[i] : p.c_ctx[i - 16384]; sS[i] = v / (1.0f + __expf(-v)); }
        __syncthreads();
        for (int r = bid; r < 288; r += G) {
            const int l = r / 144, j0 = (r % 144) * 64, k0 = wave * 128;
            float acc[17];
#pragma unroll
            for (int q = 0; q < 17; ++q) acc[q] = 0.f;
            const float* wp = p.w_ada + ((size_t)l * 1024 + k0) * NMODC + j0 + lane;
            float wv[16];
#pragma unroll
            for (int kk = 0; kk < 16; ++kk) wv[kk] = wp[(size_t)kk * NMODC];
#pragma unroll 1
            for (int kb = 0; kb < 128; kb += 16) {
                float wn[16];
                const int kn = (kb + 16 < 128) ? kb + 16 : kb;
#pragma unroll
                for (int kk = 0; kk < 16; ++kk) wn[kk] = wp[(size_t)(kn + kk) * NMODC];
#pragma unroll 1
                for (int k4 = 0; k4 < 16; k4 += 4) {
                    const float w0 = k4 == 0 ? wv[0] : (k4 == 4 ? wv[4] : (k4 == 8 ? wv[8] : wv[12]));
                    const float w1 = k4 == 0 ? wv[1] : (k4 == 4 ? wv[5] : (k4 == 8 ? wv[9] : wv[13]));
                    const float w2 = k4 == 0 ? wv[2] : (k4 == 4 ? wv[6] : (k4 == 8 ? wv[10] : wv[14]));
                    const float w3 = k4 == 0 ? wv[3] : (k4 == 4 ? wv[7] : (k4 == 8 ? wv[11] : wv[15]));
#pragma unroll
                    for (int q = 0; q < 17; ++q) { const f32x4 sv = *(const LAS f32x4*)(sS + q * 1024 + k0 + kb + k4);
                        acc[q] += (sv[0] * w0 + sv[1] * w1) + (sv[2] * w2 + sv[3] * w3); }
                }
#pragma unroll
                for (int kk = 0; kk < 16; ++kk) wv[kk] = wn[kk];
            }
#pragma unroll
            for (int q = 0; q < 17; ++q) sR[(wave * 17 + q) * 64 + lane] = acc[q];
            __syncthreads();
            float* MOD = (float*)(ws + WS_MOD);
            for (int o = tid; o < 17 * 64; o += 512) {
                const int q = o >> 6, ln = o & 63; float s = p.b_ada[l * NMODC + j0 + ln];
#pragma unroll
                for (int w = 0; w < 8; ++w) s += sR[(w * 17 + q) * 64 + ln];
                MOD[(size_t)(l * 17 + q) * NMODC + j0 + ln] = s;
            }
            __syncthreads();
        }
    }
    TS_END(9);
    TS_BEGIN(10);
    {
        constexpr int N_TR = 2 * (2 * 704 + 2 * 352 + 224 + 160);
        LAS float* t = (LAS float*)lds;
        const int lk = tid >> 5, lc = (tid & 31) * 4;
        const int sr = tid >> 2, sk = (tid & 3) * 16;
        int it = bid; f32x4 pre[4]; TrItem cur;
        if (it < N_TR) { cur = tr_decode(p, it);
#pragma unroll
            for (int i = 0; i < 4; ++i) pre[i] = *(const f32x4*)(cur.src + (size_t)(lk + 16 * i) * cur.ld_src + lc); }
        while (it < N_TR) {
#pragma unroll
            for (int i = 0; i < 4; ++i) { LAS float* d = t + (lk + 16 * i) * 129 + lc; d[0] = pre[i][0]; d[1] = pre[i][1]; d[2] = pre[i][2]; d[3] = pre[i][3]; }
            __syncthreads();
            bf16_t* dp = cur.dst + (size_t)sr * cur.ld_dst + sk;
            const int nxt = it + G;
            if (nxt < N_TR) { cur = tr_decode(p, nxt);
#pragma unroll
                for (int i = 0; i < 4; ++i) pre[i] = *(const f32x4*)(cur.src + (size_t)(lk + 16 * i) * cur.ld_src + lc); }
            { const LAS float* s = t + sk * 129 + sr;
              u32x4 o0, o1;
              o0.x = pk2(s[0 * 129], s[1 * 129]); o0.y = pk2(s[2 * 129], s[3 * 129]); o0.z = pk2(s[4 * 129], s[5 * 129]); o0.w = pk2(s[6 * 129], s[7 * 129]);
              o1.x = pk2(s[8 * 129], s[9 * 129]); o1.y = pk2(s[10 * 129], s[11 * 129]); o1.z = pk2(s[12 * 129], s[13 * 129]); o1.w = pk2(s[14 * 129], s[15 * 129]);
              *(u32x4*)dp = o0; *(u32x4*)(dp + 8) = o1; }
            __syncthreads();
            it = nxt;
        }
    }
    TS_END(10);
    TS_BEGIN(11);
    for (int r = bid; r < 256; r += G) {
        const int l = r >> 7, k0 = (r & 127) * 8;
        LAS float* sW = (LAS float*)lds;
        LAS float* sC = sW + 2048;
        for (int i = tid; i < 2048; i += 512) { const int kk = i >> 8, cc = i & 255; sW[i] = p.w_in[((size_t)l * 1024 + k0 + kk) * 2048 + 512 + cc]; }
        if (tid < 64) sC[tid] = cospif((float)tid * (1.0f / 32.0f));
        __syncthreads();
        const int g = tid >> 7, j = tid & 127, jj = j & 63, isS = j >> 6;
        float acc[8];
#pragma unroll
        for (int q = 0; q < 8; ++q) acc[q] = 0.f;
        for (int c = 0; c < 64; ++c) {
            const int mm = (c * jj) & 63; const float tv = sC[isS ? ((mm - 16) & 63) : mm];
#pragma unroll
            for (int q = 0; q < 8; ++q) acc[q] += sW[q * 256 + g * 64 + c] * tv;
        }
        u32x4 o; o.x = pk2(acc[0] * 0.125f, acc[1] * 0.125f); o.y = pk2(acc[2] * 0.125f, acc[3] * 0.125f); o.z = pk2(acc[4] * 0.125f, acc[5] * 0.125f); o.w = pk2(acc[6] * 0.125f, acc[7] * 0.125f);
        *(u32x4*)((bf16_t*)(ws + WS_WIN) + ((size_t)l * 2304 + 1792 + g * 128 + j) * 1024 + k0) = o;
        __syncthreads();
    }
    {
        LAS float* tab = (LAS float*)lds;
        for (int m = tid; m < 2048; m += 512) tab[m] = cospif((float)m * (1.0f / 1024.0f)) * 0.022097086912079608f;
        __syncthreads();
        for (int r = bid; r < 2048 + 256; r += G) {
            if (r < 2048) {
                float v[8];
#pragma unroll
                for (int e = 0; e < 8; ++e) { const int k = tid * 8 + e, idx = (r * (k & 2047)) & 2047; v[e] = tab[k < 2048 ? idx : ((idx + 512) & 2047)]; }
                u32x4 o; o.x = pk2(v[0], v[1]); o.y = pk2(v[2], v[3]); o.z = pk2(v[4], v[5]); o.w = pk2(v[6], v[7]);
                *(u32x4*)((bf16_t*)(ws + WS_DFT) + (size_t)r * DFT_LD + tid * 8) = o;
            } else if (tid < 64) {
                const int np = r - 2048; const float sc = 2.8284271247461903f;
                float v[8];
#pragma unroll
                for (int e = 0; e < 8; ++e) { const int k = tid * 8 + e, idx = ((np * (k & 255)) & 255) * 8; v[e] = tab[k < 256 ? idx : ((idx + 512) & 2047)] * sc; }
                u32x4 o; o.x = pk2(v[0], v[1]); o.y = pk2(v[2], v[3]); o.z = pk2(v[4], v[5]); o.w = pk2(v[6], v[7]);
                *(u32x4*)((bf16_t*)(ws + WS_DFTC) + (size_t)np * DFTC_LD + tid * 8) = o;
            }
        }
        __syncthreads();
    }
    TS_END(11);
    if (bid == G - 1) {
        float* rtab = (float*)(ws + WS_ROPE);
        for (int e = tid; e < 1024; e += 512) { const int pos = e >> 4, i = e & 15;
            const float inv = fast_exp2(-(float)i * (13.287712379549449f / 16.0f));
            const float tt = (float)pos * inv * 0.3183098861837907f;
            rtab[2 * e] = cospif(tt); rtab[2 * e + 1] = sinpif(tt); }
    }
}

struct EwRow { f32x4 x[4]; u32x2 y[4]; u32x2 y2[4]; };
__device__ __forceinline__ void ew_load(EwRow& r, const float* xin_lat, const float* xin_ctx, const bf16_t* Yp, const bf16_t* Y2p, int t, int lane) {
    const float* xr = t < TL ? xin_lat + (size_t)t * DM : xin_ctx + (size_t)(t - TL) * DM;
#pragma unroll
    for (int j = 0; j < 4; ++j) r.x[j] = *(const f32x4*)(xr + 4 * lane + 256 * j);
    if (Yp) {
#pragma unroll
        for (int j = 0; j < 4; ++j) r.y[j] = *(const u32x2*)(Yp + (size_t)t * DM + 4 * lane + 256 * j);
        if (t >= TL) {
#pragma unroll
            for (int j = 0; j < 4; ++j) r.y2[j] = *(const u32x2*)(Y2p + (size_t)(t - TL) * DM + 4 * lane + 256 * j);
        }
    }
}
__device__ __forceinline__ void ew_pass(const float* xin_lat, const float* xin_ctx, float* xout_lat, float* xout_ctx, const bf16_t* Yp, const bf16_t* Y2p, const float* gpost, float fac, const float* gate,
                                        bf16_t* Hp, const float* gpre, const float* shift, const float* scale, int nrows) {
    const int tid = otid(); const int wave = tid >> 6, lane = tid & 63;
    const int per = nrows / gridDim.x, tbeg = obid() * per + wave, tend = obid() * per + per;
    f32x4 vgp[4], vgt[4], vpre[4], vsh[4], vsc[4];
#pragma unroll
    for (int j = 0; j < 4; ++j) { vgp[j] = Yp ? *(const f32x4*)(gpost + 4 * lane + 256 * j) : (f32x4){0.f, 0.f, 0.f, 0.f}; vpre[j] = Hp ? *(const f32x4*)(gpre + 4 * lane + 256 * j) : (f32x4){0.f, 0.f, 0.f, 0.f};
        vgt[j] = vsh[j] = vsc[j] = (f32x4){0.f, 0.f, 0.f, 0.f}; }
    int bcur = -1;
    EwRow A, B;
    auto process = [&](EwRow& r, int t) {
        const bool lat = t < TL; const int b = lat ? (t >> 11) : 16;
        if (b != bcur) { bcur = b;
#pragma unroll
            for (int j = 0; j < 4; ++j) { const int cidx = 4 * lane + 256 * j;
                if (Yp) vgt[j] = *(const f32x4*)(gate + (size_t)b * NMODC + cidx) * fac;
                if (Hp) { vsh[j] = *(const f32x4*)(shift + (size_t)b * NMODC + cidx); vsc[j] = *(const f32x4*)(scale + (size_t)b * NMODC + cidx) + 1.0f; } } }
        if (Yp) {
            f32x4 y[4]; float ss = 0.f;
#pragma unroll
            for (int j = 0; j < 4; ++j) { const u32x2 w = r.y[j];
                y[j][0] = bflo(w.x); y[j][1] = bfhi(w.x); y[j][2] = bflo(w.y); y[j][3] = bfhi(w.y);
                if (!lat) { const u32x2 w2 = r.y2[j]; y[j][0] += bflo(w2.x); y[j][1] += bfhi(w2.x); y[j][2] += bflo(w2.y); y[j][3] += bfhi(w2.y); }
                ss += (y[j][0] * y[j][0] + y[j][1] * y[j][1]) + (y[j][2] * y[j][2] + y[j][3] * y[j][3]); }
            const float rstd = 1.0f / sqrtf(wave_sum(ss) * (1.0f / DM) + EPSV);
#pragma unroll
            for (int j = 0; j < 4; ++j) r.x[j] = r.x[j] + vgt[j] * (y[j] * rstd * vgp[j]);
        }
        float* xo = lat ? (xout_lat ? xout_lat + (size_t)t * DM : nullptr) : (xout_ctx ? xout_ctx + (size_t)(t - TL) * DM : nullptr);
        if (xo) {
#pragma unroll
            for (int j = 0; j < 4; ++j) *(f32x4*)(xo + 4 * lane + 256 * j) = r.x[j];
        }
        if (Hp) {
            float ss = 0.f;
#pragma unroll
            for (int j = 0; j < 4; ++j) ss += (r.x[j][0] * r.x[j][0] + r.x[j][1] * r.x[j][1]) + (r.x[j][2] * r.x[j][2] + r.x[j][3] * r.x[j][3]);
            const float rstd = 1.0f / sqrtf(wave_sum(ss) * (1.0f / DM) + EPSV);
#pragma unroll
            for (int j = 0; j < 4; ++j) { const f32x4 h = (r.x[j] * rstd * vpre[j]) * vsc[j] + vsh[j];
                u32x2 w; w.x = pk2(h[0], h[1]); w.y = pk2(h[2], h[3]);
                *(u32x2*)(Hp + (size_t)t * DM + 4 * lane + 256 * j) = w; }
        }
    };
    int t = tbeg;
    if (t < tend) ew_load(A, xin_lat, xin_ctx, Yp, Y2p, t, lane);
    while (t < tend) {
        const int tn = t + 8;
        if (tn < tend) ew_load(B, xin_lat, xin_ctx, Yp, Y2p, tn, lane);
        process(A, t);
        const int tnn = tn + 8;
        if (tnn < tend) ew_load(A, xin_lat, xin_ctx, Yp, Y2p, tnn, lane);
        if (tn < tend) process(B, tn);
        t = tnn;
    }
}

__device__ __forceinline__ void conv_item(CParams& p, LAS unsigned char* lds, int l, int s, int tb) {
    const int tid = otid(), wave = tid >> 6, lane = tid & 63;
    const bf16_t* PROJ = (const bf16_t*)(p.ws + WS_PROJ); bf16_t* YCAT = (bf16_t*)(p.ws + WS_YCAT);
    LAS float* sA = (LAS float*)lds;
    const int tokbase = s < 16 ? s * 2048 : TL + (s - 16) * 256, len = s < 16 ? 2048 : 256, t0 = tb * 64;
    {
        u32x4 ua[6], ug[6];
#pragma unroll
        for (int i = 0; i < 6; ++i) {
            const int u = tid + 512 * i, rr = u >> 5, c8 = (u & 31) * 8, tt = t0 - 15 + rr;
            ua[i] = (u32x4){0u, 0u, 0u, 0u}; ug[i] = (u32x4){0u, 0u, 0u, 0u};
            if (u < 94 * 32 && tt >= 0 && tt < len) { const bf16_t* rp = PROJ + (size_t)(tokbase + tt) * NP + c8; ua[i] = *(const u32x4*)rp; ug[i] = *(const u32x4*)(rp + 256); }
        }
#pragma unroll
        for (int i = 0; i < 6; ++i) {
            const int u = tid + 512 * i, rr = u >> 5, c8 = (u & 31) * 8;
            if (u < 94 * 32) {
                float v[8];
                v[0] = bflo(ua[i].x) * sigmoid_f(bflo(ug[i].x)); v[1] = bfhi(ua[i].x) * sigmoid_f(bfhi(ug[i].x));
                v[2] = bflo(ua[i].y) * sigmoid_f(bflo(ug[i].y)); v[3] = bfhi(ua[i].y) * sigmoid_f(bfhi(ug[i].y));
                v[4] = bflo(ua[i].z) * sigmoid_f(bflo(ug[i].z)); v[5] = bfhi(ua[i].z) * sigmoid_f(bfhi(ug[i].z));
                v[6] = bflo(ua[i].w) * sigmoid_f(bflo(ug[i].w)); v[7] = bfhi(ua[i].w) * sigmoid_f(bfhi(ug[i].w));
                *(LAS f32x4*)(sA + rr * 256 + c8) = (f32x4){v[0], v[1], v[2], v[3]};
                *(LAS f32x4*)(sA + rr * 256 + c8 + 4) = (f32x4){v[4], v[5], v[6], v[7]};
            }
        }
    }
    __syncthreads();
    TS_BEGIN(7);
    const int cp = tid & 127, oc = tid >> 7;
    f32x2 out2[2][8];
    {
        f32x2 w2[31];
#pragma unroll
        for (int j = 0; j < 31; ++j) w2[j] = *(const f32x2*)(p.conv_w + ((size_t)l * 31 + j) * 256 + 2 * cp);
        const f32x2 bias2 = *(const f32x2*)(p.conv_b + l * 256 + 2 * cp);
#pragma unroll
        for (int ps = 0; ps < 2; ++ps) {
            const LAS float* ap = sA + ((oc * 2 + ps) * 8) * 256 + 2 * cp;
            f32x2 in2[38];
#pragma unroll
            for (int i = 0; i < 38; ++i) in2[i] = *(const LAS f32x2*)(ap + i * 256);
#pragma unroll
            for (int q = 0; q < 8; ++q) {
                f32x2 acc = bias2;
#pragma unroll
                for (int j = 0; j < 31; ++j) acc = in2[q + j] * w2[j] + acc;
                out2[ps][q] = acc;
            }
        }
    }
    TS_END(7);
    __syncthreads();
#pragma unroll
    for (int ps = 0; ps < 2; ++ps)
#pragma unroll
        for (int q = 0; q < 8; ++q) *(LAS f32x2*)(sA + ((oc * 2 + ps) * 8 + q) * 256 + 2 * cp) = out2[ps][q];
    __syncthreads();
    {
        const f32x4 lg = *(const f32x4*)(p.ln_g + l * 256 + 4 * lane), lb = *(const f32x4*)(p.ln_b + l * 256 + 4 * lane);
#pragma unroll
        for (int q = 0; q < 8; ++q) {
            const int tok = wave * 8 + q;
            const f32x4 v = *(const LAS f32x4*)(sA + tok * 256 + 4 * lane);
            const float mean = wave_sum((v[0] + v[1]) + (v[2] + v[3])) * (1.0f / 256.0f);
            const f32x4 d = v - mean;
            const float var = wave_sum((d[0] * d[0] + d[1] * d[1]) + (d[2] * d[2] + d[3] * d[3])) * (1.0f / 256.0f);
            const float rstd = 1.0f / sqrtf(var + EPSV);
            const f32x4 yn = d * rstd * lg + lb;
            u32x2 o; o.x = pk2(silu_f(yn[0]), silu_f(yn[1])); o.y = pk2(silu_f(yn[2]), silu_f(yn[3]));
            *(u32x2*)(YCAT + (size_t)(tokbase + t0 + tok) * YC_LD + 4 * lane) = o;
        }
    }
    __syncthreads();
}

struct AttnItem {
    int mode;
    int qtok0;
    int qcol0, qcol1, ocol0, ocol1;
    int kcol0, kcol1, vcol0, vcol1; int nslots;
    int nloc, loctok0;
    int ctxtok0;
    int r, rs;
    int q0, kp0;
    int has_sink; float sink0, sink1;
    int h0;
};
constexpr int KROW = 72;
constexpr int KV_BYTES = 64 * KROW * 2;
constexpr int ABUF_BYTES = 4 * KV_BYTES;
typedef short s16x4 __attribute__((ext_vector_type(4)));
template <int OFF> __device__ __forceinline__ s16x4 tr_read(unsigned addr) {
    s16x4 r; asm volatile("ds_read_b64_tr_b16 %0, %1 offset:%2" : "=&v"(r) : "v"(addr), "i"(OFF) : "memory"); return r;
}
template <int NKB>
__device__ __forceinline__ void attn_chunk(const LAS unsigned char* kt, const LAS unsigned char* vt, int kofs, const bf16x8 (&qf)[2], int fr, int fq,
                                           int mtype, int a0, const LAS float* bt, float& mrun, float& lsum, f32x4 (&o)[4]) {
    const unsigned vaddr = (unsigned)(size_t)vt + (unsigned)(((kofs + 4 * fq + (fr >> 2)) * KROW + 4 * (fr & 3)) * 2);
    s16x4 vl[NKB / 2][4], vh[NKB / 2][4];
#pragma unroll
    for (int grp = 0; grp < NKB / 2; ++grp) {
        const unsigned va = vaddr + (unsigned)(grp * 32 * KROW * 2);
        vl[grp][0] = tr_read<0>(va);  vh[grp][0] = tr_read<16 * KROW * 2>(va);
        vl[grp][1] = tr_read<32>(va); vh[grp][1] = tr_read<16 * KROW * 2 + 32>(va);
        vl[grp][2] = tr_read<64>(va); vh[grp][2] = tr_read<16 * KROW * 2 + 64>(va);
        vl[grp][3] = tr_read<96>(va); vh[grp][3] = tr_read<16 * KROW * 2 + 96>(va);
    }
    f32x4 sacc[NKB];
    const LAS unsigned char* kb_base = kt + ((kofs + fr) * KROW + 8 * fq) * 2;
#pragma unroll
    for (int kb = 0; kb < NKB; ++kb) {
        sacc[kb] = (f32x4){0.f, 0.f, 0.f, 0.f};
#pragma unroll
        for (int kk = 0; kk < 2; ++kk) {
            const bf16x8 a = *(const LAS bf16x8*)(kb_base + (16 * kb * KROW + 32 * kk) * 2);
            sacc[kb] = __builtin_amdgcn_mfma_f32_16x16x32_bf16(a, qf[kk], sacc[kb], 0, 0, 0);
        }
    }
    if (mtype == 1) {
        const int wsx = min(max(a0 - 8, 0), 48);
        const int lo = wsx - (kofs + 4 * fq);
        const LAS float* bl = bt + (kofs + 4 * fq - a0 + 63);
#pragma unroll
        for (int kb = 0; kb < NKB; ++kb)
#pragma unroll
            for (int j = 0; j < 4; ++j) { const bool ok = (unsigned)(16 * kb + j - lo) < 16u;
                sacc[kb][j] = ok ? sacc[kb][j] + bl[16 * kb + j] : -1.0e30f; }
    } else if (mtype == 2) {
        const int db = a0 + kofs + 4 * fq + 128;
#pragma unroll
        for (int kb = 0; kb < NKB; ++kb)
#pragma unroll
            for (int j = 0; j < 4; ++j) { const bool ok = (unsigned)(db + 16 * kb + j) <= 256u;
                sacc[kb][j] = ok ? sacc[kb][j] : -1.0e30f; }
    }
    float cm = sacc[0][0];
#pragma unroll
    for (int kb = 0; kb < NKB; ++kb)
#pragma unroll
        for (int j = 0; j < 4; ++j) cm = fmaxf(cm, sacc[kb][j]);
    cm = xrow16_max(cm);
    const float mnew = fmaxf(mrun, cm);
    if (__any(mnew > mrun)) {
        const float alpha = fast_exp2(mrun - mnew);
        lsum *= alpha;
#pragma unroll
        for (int db = 0; db < 4; ++db) o[db] = o[db] * alpha;
        mrun = mnew;
    }
    float ps = 0.f;
#pragma unroll
    for (int kb = 0; kb < NKB; ++kb)
#pragma unroll
        for (int j = 0; j < 4; ++j) { sacc[kb][j] = fast_exp2(sacc[kb][j] - mnew); ps += sacc[kb][j]; }
    lsum += ps;
    asm volatile("s_waitcnt lgkmcnt(0)" ::: "memory"); __builtin_amdgcn_sched_barrier(0);
#define ATT_PK(L, H) (bf16x8){L[0], L[1], L[2], L[3], H[0], H[1], H[2], H[3]}
#pragma unroll
    for (int grp = 0; grp < NKB / 2; ++grp) {
        union { bf16x8 v; unsigned u[4]; } pb;
        pb.u[0] = pk2(sacc[2 * grp][0], sacc[2 * grp][1]); pb.u[1] = pk2(sacc[2 * grp][2], sacc[2 * grp][3]);
        pb.u[2] = pk2(sacc[2 * grp + 1][0], sacc[2 * grp + 1][1]); pb.u[3] = pk2(sacc[2 * grp + 1][2], sacc[2 * grp + 1][3]);
#pragma unroll
        for (int db = 0; db < 4; ++db) o[db] = __builtin_amdgcn_mfma_f32_16x16x32_bf16(ATT_PK(vl[grp][db], vh[grp][db]), pb.v, o[db], 0, 0, 0);
    }
#undef ATT_PK
}

__device__ __forceinline__ void attn_item(CParams& p, LAS unsigned char* lds, int l, const AttnItem& it) {
    const int tid = otid(), wave = tid >> 6, lane = tid & 63, g = wave >> 2, wq = wave & 3, fr = lane & 15, fq = lane >> 4;
    const bf16_t* PROJ = (const bf16_t*)(p.ws + WS_PROJ); bf16_t* YCAT = (bf16_t*)(p.ws + WS_YCAT);
    LAS float* sB = (LAS float*)(lds + 2 * ABUF_BYTES);
    const int slot = it.nslots == 2 ? g : 0;
    if (it.mode == 0) { for (int i = tid; i < 2 * 15 * 128; i += 512) { const int h = i / 1920, rem = i % 1920, dr = rem >> 7, dc = (rem & 127) - 48;
            sB[i] = (dc >= 0 && dc < 31) ? p.nat_bias[(size_t)(l * 4 + it.h0 + h) * 465 + dr * 31 + dc] * LOG2E : 0.f; } }
    bf16x8 qf[2];
    { const bf16_t* qp = PROJ + (size_t)(it.qtok0 + wq * 16 + fr) * NP + (g ? it.qcol1 : it.qcol0) + 8 * fq;
      qf[0] = *(const bf16x8*)qp; qf[1] = *(const bf16x8*)(qp + 32); }
    float mrun = -3.0e38f, lsum = 0.f;
    f32x4 o[4];
#pragma unroll
    for (int db = 0; db < 4; ++db) o[db] = (f32x4){0.f, 0.f, 0.f, 0.f};
    const int nchunks = 4 + it.nloc;
    const int srow = tid >> 3, sseg = tid & 7;
    u32x4 kreg[2], vreg[2];
    auto chunk_tok = [&](int c) { return c < 4 ? it.ctxtok0 + 64 * c : it.loctok0 + 64 * (c - 4); };
    auto gload = [&](int c) {
        const bf16_t* rp = PROJ + (size_t)(chunk_tok(c) + srow) * NP + 8 * sseg;
#pragma unroll
        for (int s = 0; s < 2; ++s) if (s < it.nslots) { kreg[s] = *(const u32x4*)(rp + (s ? it.kcol1 : it.kcol0)); vreg[s] = *(const u32x4*)(rp + (s ? it.vcol1 : it.vcol0)); }
    };
    auto lwrite = [&](int c) {
        LAS unsigned char* bufp = lds + (c & 1) * ABUF_BYTES + (srow * KROW + 8 * sseg) * 2;
#pragma unroll
        for (int s = 0; s < 2; ++s) if (s < it.nslots) { *(LAS u32x4*)(bufp + s * KV_BYTES) = kreg[s]; *(LAS u32x4*)(bufp + (2 + s) * KV_BYTES) = vreg[s]; }
    };
    gload(0); lwrite(0);
    if (nchunks > 1) gload(1);
    __syncthreads();
    TS_BEGIN(5);
    const int qi = wq * 16 + fr;
    const int nat_kofs = min(max(16 * wq - 8, 0), 32);
    for (int c = 0; c < nchunks; ++c) {
        if (c + 1 < nchunks) lwrite(c + 1);
        if (c + 2 < nchunks) gload(c + 2);
        const LAS unsigned char* kt = lds + (c & 1) * ABUF_BYTES + slot * KV_BYTES;
        const LAS unsigned char* vt = kt + 2 * KV_BYTES;
        if (c >= 4 && it.mode == 0) {
            const int dr = (it.rs + (c - 4)) - it.r + 7;
            attn_chunk<2>(kt, vt, nat_kofs, qf, fr, fq, 1, qi, sB + g * 1920 + dr * 128, mrun, lsum, o);
        } else if (c >= 4 && it.mode == 1) {
            attn_chunk<4>(kt, vt, 0, qf, fr, fq, 2, it.kp0 + 64 * (c - 4) - (it.q0 + qi), sB, mrun, lsum, o);
        } else {
            attn_chunk<4>(kt, vt, 0, qf, fr, fq, 0, 0, sB, mrun, lsum, o);
        }
        __syncthreads();
    }
    TS_END(5);
    lsum = xrow16_sum(lsum);
    if (it.has_sink) lsum += fast_exp2((g ? it.sink1 : it.sink0) * LOG2E - mrun);
    const float inv = 1.0f / lsum;
    bf16_t* op = YCAT + (size_t)(it.qtok0 + wq * 16 + fr) * YC_LD + (g ? it.ocol1 : it.ocol0) + 4 * fq;
#pragma unroll
    for (int db = 0; db < 4; ++db) { u32x2 w; w.x = pk2(o[db][0] * inv, o[db][1] * inv); w.y = pk2(o[db][2] * inv, o[db][3] * inv); *(u32x2*)(op + 16 * db) = w; }
}

constexpr int C_UA = 0, C_QN = 512, C_KN = 768, C_VN = 1024, C_QS = 1280, C_KS = 1536, C_VS = 1664;

__device__ __forceinline__ void mix_items(CParams& p, LAS unsigned char* lds, int l, int sub) {
    const int n_attn = (l == 0) ? 2304 : 2048;
    const int n_conv = (l == 0) ? 512 + 64 : 512;
    const int start = (obid() + 128) % gridDim.x;
    for (int i = start; i < n_attn + n_conv; i += gridDim.x) {
        if (i >= n_attn) {
            if (!(sub & 4)) continue;
            const int ci = i - n_attn;
            TS_BEGIN(3);
            if (ci < 512) conv_item(p, lds, l, ci >> 5, ci & 31);
            else { const int cj = ci - 512; conv_item(p, lds, l, 16 + (cj >> 2), cj & 3); }
            TS_END(3);
            continue;
        }
        AttnItem it{};
        if (i < 1024) {
            const int b = i >> 6, r = (i >> 1) & 31, hp = i & 1;
            it.mode = 0; it.qtok0 = b * 2048 + r * 64; it.nslots = 2; it.h0 = 2 * hp;
            { const int h = 2 * hp; it.qcol0 = C_QN + 64 * h; it.kcol0 = C_KN + 64 * h; it.vcol0 = C_VN + 64 * h; it.ocol0 = 512 + 64 * h;
              it.qcol1 = it.qcol0 + 64; it.kcol1 = it.kcol0 + 64; it.vcol1 = it.vcol0 + 64; it.ocol1 = it.ocol0 + 64; }
            it.r = r; it.rs = min(max(r - 4, 0), 24); it.nloc = 8; it.loctok0 = b * 2048 + it.rs * 64; it.ctxtok0 = TL + b * 256;
        } else if (i < 2048) {
            const int k = i - 1024, b = k >> 6, qb = (k >> 1) & 31, kvh = k & 1;
            it.mode = 1; it.qtok0 = b * 2048 + qb * 64; it.nslots = 1;
            { const int h = 2 * kvh; it.qcol0 = C_QS + 64 * h; it.ocol0 = 768 + 64 * h; it.sink0 = p.sink[l * 4 + h]; it.sink1 = p.sink[l * 4 + h + 1];
              it.qcol1 = it.qcol0 + 64; it.ocol1 = it.ocol0 + 64; it.kcol0 = it.kcol1 = C_KS + 64 * kvh; it.vcol0 = it.vcol1 = C_VS + 64 * kvh; }
            it.has_sink = 1; it.q0 = qb * 64;
            const int ks = max(qb * 64 - 128, 0), ke = min(qb * 64 + 192, 2048);
            it.kp0 = ks; it.nloc = (ke - ks) >> 6; it.loctok0 = b * 2048 + ks; it.ctxtok0 = TL + b * 256;
        } else if (i < 2176) {
            const int k = i - 2048, b = k >> 3, qb = (k >> 1) & 3, hp = k & 1;
            it.mode = 2; it.qtok0 = TL + b * 256 + qb * 64; it.nslots = 2;
            { const int h = 2 * hp; it.qcol0 = C_QN + 64 * h; it.kcol0 = C_KN + 64 * h; it.vcol0 = C_VN + 64 * h; it.ocol0 = 512 + 64 * h;
              it.qcol1 = it.qcol0 + 64; it.kcol1 = it.kcol0 + 64; it.vcol1 = it.vcol0 + 64; it.ocol1 = it.ocol0 + 64; }
            it.nloc = 0; it.ctxtok0 = TL + b * 256;
        } else {
            const int k = i - 2176, b = k >> 3, qb = (k >> 1) & 3, kvh = k & 1;
            it.mode = 2; it.qtok0 = TL + b * 256 + qb * 64; it.nslots = 1;
            { const int h = 2 * kvh; it.qcol0 = C_QS + 64 * h; it.ocol0 = 768 + 64 * h; it.sink0 = p.sink[l * 4 + h]; it.sink1 = p.sink[l * 4 + h + 1];
              it.qcol1 = it.qcol0 + 64; it.ocol1 = it.ocol0 + 64; it.kcol0 = it.kcol1 = C_KS + 64 * kvh; it.vcol0 = it.vcol1 = C_VS + 64 * kvh; }
            it.has_sink = 1; it.nloc = 0; it.ctxtok0 = TL + b * 256;
        }
        TS_BEGIN(2);
        if (sub & 2) attn_item(p, lds, l, it);
        TS_END(2);
    }
}

constexpr int N_PHASES = 22;
#ifndef PHMASK
#define PHMASK 0xff
#endif

__device__ __forceinline__ void run_phase(CParams& p, LAS unsigned char* lds, int ph, int sub) {
    unsigned char* ws = p.ws;
    bf16_t* YH = (bf16_t*)(ws + WS_YH); bf16_t* U = (bf16_t*)(ws + WS_R1); bf16_t* PROJ = (bf16_t*)(ws + WS_PROJ); bf16_t* YCAT = (bf16_t*)(ws + WS_YCAT);
    float* XC = (float*)(ws + WS_XC); const float* MOD = (const float*)(ws + WS_MOD);
    const int G = gridDim.x, c = obid();
    if (ph == 0) { if constexpr ((PHMASK & 1) != 0) phase0(p, lds); return; }
    if (ph == 1) {
        if constexpr ((PHMASK & 2) == 0) return;
        ew_pass(p.x, p.ctx, nullptr, nullptr, nullptr, nullptr, nullptr, 0.f, nullptr, YH, p.norm_g, MOD, MOD + 1024, TA); return;
    }
    const int l = (ph - 2) / 10, k = (ph - 2) % 10;
    const float* MODL = MOD + (size_t)l * 17 * NMODC; const float* NG = p.norm_g + (size_t)l * 6 * DM;
    const int rows_late = (l == 0) ? TA : TL;
    switch (k) {
    case 0: case 7: {
        if constexpr ((PHMASK & 4) == 0) break;
        const int f = (k == 7), M = f ? rows_late : TA;
        pg8::Gemm g{YH, (const bf16_t*)(ws + WS_W13) + (size_t)(l * 2 + f) * 5632 * 1024, M, 5632, 1024, 1024, 1024};
        pg8::StaticOrder S; S.init(M, 5632, G, c); EpiSwiGLU E{U};
        pg8::gemm_phase<EpiSwiGLU, pg8::StaticOrder, true, true>(lds, g, S, E);
    } break;
    case 1: case 8: case 5: {
        if constexpr ((PHMASK & 8) == 0) break;
        const bool isout = (k == 5); const int f = (k == 8), M = (k == 1) ? TA : rows_late;
        const int Kd = isout ? YC_LD : FF;
        const bf16_t* Ap = isout ? YCAT : U;
        const bf16_t* Bp = isout ? (const bf16_t*)(ws + WS_WOUT) + (size_t)l * 1024 * YC_LD : (const bf16_t*)(ws + WS_W2T) + (size_t)(l * 2 + f) * 1024 * FF;
        for (int v = 0; v < (M == TA ? 3 : 1); ++v) {
            pg8::Gemm g = v == 0 ? pg8::Gemm{Ap, Bp, TL, 1024, Kd, Kd, Kd}
                                 : pg8::Gemm{Ap + (size_t)TL * Kd + (v - 1) * (Kd / 2), Bp + (v - 1) * (Kd / 2), TC, 1024, Kd / 2, Kd, Kd};
            pg8::StaticOrder S; S.init(g.M, 1024, G, v == 2 ? (c + G - 64) % G : c);
            EpiBf16Tile E{v == 0 ? YH : (v == 1 ? YH + (size_t)TL * DM : (bf16_t*)(ws + WS_Y2)), 1024, 0, 256};
            pg8::gemm_phase<EpiBf16Tile, pg8::StaticOrder, true, true>(lds, g, S, E);
        }
    } break;
    case 2: case 6: case 9: {
        if constexpr ((PHMASK & 2) == 0) break;
        const int gi = (k == 2) ? 2 : (k == 6 ? 5 : 8), ni = (k == 2) ? 1 : (k == 6 ? 3 : 5);
        const int nrows = (k == 2) ? TA : rows_late;
        const bool lastl = (k == 9 && l == 1);
        const float* gpre = (k == 2) ? NG + 2 * DM : (k == 6 ? NG + 4 * DM : p.norm_g + 6 * DM);
        const float* shift = (k == 2) ? MODL + 3 * 1024 : (k == 6 ? MODL + 6 * 1024 : MOD + 17 * NMODC);
        const float* scale = (k == 2) ? MODL + 4 * 1024 : (k == 6 ? MODL + 7 * 1024 : MOD + 17 * NMODC + 1024);
        float* outp = p.out;
        const bool first = (l == 0 && k == 2);
        ew_pass(first ? p.x : outp, first ? p.ctx : XC, outp, XC, YH, (const bf16_t*)(ws + WS_Y2), NG + ni * DM, (k == 6) ? 1.0f : 0.5f, MODL + gi * 1024, lastl ? nullptr : YH, gpre, shift, scale, nrows);
    } break;
    case 3: {
        if constexpr ((PHMASK & 16) == 0) break;
        const bf16_t* W = (const bf16_t*)(ws + WS_WIN) + (size_t)l * 2304 * 1024;
        { pg8::Gemm g{YH, W, TA, NP, 1024, 1024, 1024}; pg8::StaticOrder S; S.init(TA, NP, G, c); EpiWin E{PROJ, (const float*)(ws + WS_ROPE)};
          pg8::gemm_phase<EpiWin, pg8::StaticOrder, true, true>(lds, g, S, E); }
        { const int N = (l == 0) ? TA : TL; pg8::Gemm g{W + (size_t)1792 * 1024, YH, 512, N, 1024, 1024, 1024}; pg8::StaticOrder S; S.init(512, N, G, (c + 16) % G);
          EpiPQ E{(bf16_t*)(ws + WS_PQT), (bf16_t*)(ws + WS_PQTC)};
          pg8::gemm_phase<EpiPQ, pg8::StaticOrder, true, true>(lds, g, S, E); }
    } break;
    case 4: {
        if constexpr ((PHMASK & 32) == 0) break;
        TS_BEGIN(1);
        if (sub & 1)
        for (int v = 0; v < ((l == 0) ? 4 : 2); ++v) {
            const int hs = v & 1, isc = v >> 1;
            const bf16_t* Ap = isc ? (const bf16_t*)(ws + WS_DFTC) + hs * 256 : (const bf16_t*)(ws + WS_DFT) + hs * 2048;
            const bf16_t* Bp = isc ? (const bf16_t*)(ws + WS_PQTC) + hs * 256 : (const bf16_t*)(ws + WS_PQT) + hs * 2048;
            pg8::Gemm g{Ap, Bp, isc ? 256 : 2048, 4096, isc ? 256 : 2048, isc ? DFTC_LD : DFT_LD, isc ? PQTC_LD : PQT_LD};
            pg8::StaticOrder S; S.init(g.M, g.N, G, isc ? (c + G - 16 * hs) % G : (c + G - 128 * hs) % G);
            EpiBf16Tile E{YCAT + (isc ? (size_t)TL * YC_LD : 0) + (hs ? 1024 : 256), YC_LD, isc ? 256 : 2048, 0};
            pg8::gemm_phase<EpiBf16Tile, pg8::StaticOrder, true, true>(lds, g, S, E);
        }
        TS_END(1);
        if (sub & 6) mix_items(p, lds, l, sub);
    } break;
    }
}

__global__ void __launch_bounds__(512, 2) mega(Params p, int ph0, int ph1) {
    extern __shared__ __attribute__((aligned(16))) unsigned char lds_raw[];
    LAS unsigned char* lds = (LAS unsigned char*)lds_raw;
    cg::grid_group grid = cg::this_grid();
    if (ph1 < 0) grid.sync();
    volatile LAS unsigned* xst = (volatile LAS unsigned*)(lds + 131072);
    if (threadIdx.x < 4) xst[threadIdx.x] = 0u;
    __syncthreads();
    XcdBarrier xb = xcd_barrier_post((unsigned*)(p.ws + WS_BAR), xst);
#ifdef TPROBE
    unsigned long long tacc = 0, tprev = __builtin_amdgcn_s_memrealtime();
#endif
    for (int ph = ph0; ph < ph1; ++ph) {
        CParams* q = (CParams*)__builtin_amdgcn_kernarg_segment_ptr(); asm volatile("" : "+s"(q));
        run_phase(*q, lds, ph, 7);
#ifdef DUPK
        { const int kind = ph == 0 ? 10 : (ph == 1 ? 11 : (ph - 2) % 10);
          if ((DUPK >> kind) & 1) { xcd_barrier(xb); run_phase(*q, lds, ph, DUPSUB); } }
#endif
        if (ph + 1 < ph1) xcd_barrier(xb);
#ifdef TPROBE
        { const unsigned long long now = __builtin_amdgcn_s_memrealtime(); const int kind = ph == 0 ? 10 : (ph == 1 ? 11 : (ph - 2) % 10);
          if ((TPROBE >> kind) & 1) tacc += now - tprev; tprev = now; }
#endif
    }
#ifdef TPROBE
    if (blockIdx.x == 0 && threadIdx.x == 0) { const unsigned long long t0 = __builtin_amdgcn_s_memrealtime(); while (__builtin_amdgcn_s_memrealtime() - t0 < tacc) __builtin_amdgcn_s_sleep(8); }
#endif
#ifdef TSUB
    if (blockIdx.x == 0 && threadIdx.x == 0) { const unsigned long long tacc2 = *(volatile LAS unsigned long long*)(lds + 131080); const unsigned long long t0 = __builtin_amdgcn_s_memrealtime(); while (__builtin_amdgcn_s_memrealtime() - t0 < 4ull * tacc2) __builtin_amdgcn_s_sleep(8); }
#endif
#ifdef XSYNC
    for (int i = 0; i < XSYNC; ++i) xcd_barrier(xb);
#endif
}

#ifndef ONE_LAUNCH
#define ONE_LAUNCH 1
#endif

extern "C" void kernel_launch(void* const* d_in, const int* in_sizes, int n_in, void* d_out, int out_size, void* d_ws, size_t ws_size, hipStream_t stream) {
    static int grid = 0;
    if (grid == 0) {
        if (ws_size < WS_END) { fprintf(stderr, "kernel_launch: workspace too small: %zu < %zu\n", ws_size, (size_t)WS_END); grid = -1; return; }
        int dev = 0, cus = 0, per_cu = 0;
        hipGetDevice(&dev); hipDeviceGetAttribute(&cus, hipDeviceAttributeMultiprocessorCount, dev);
        hipFuncSetAttribute((const void*)mega, hipFuncAttributeMaxDynamicSharedMemorySize, LDS_BYTES);
        hipOccupancyMaxActiveBlocksPerMultiprocessor(&per_cu, (const void*)mega, 512, LDS_BYTES);
        if (per_cu < 1) { fprintf(stderr, "kernel_launch: occupancy query says %d blocks per CU\n", per_cu); per_cu = 1; }
        (void)hipGetLastError();
        grid = cus;
    }
    if (grid < 0) return;
    (void)hipMemsetAsync((unsigned char*)d_ws + WS_BAR, 0, 3456 * 4, stream);
    Params p{};
    p.x = (const float*)d_in[0]; p.c = (const float*)d_in[1]; p.ctx = (const float*)d_in[2]; p.c_ctx = (const float*)d_in[3];
    p.w_ada = (const float*)d_in[4]; p.b_ada = (const float*)d_in[5]; p.norm_g = (const float*)d_in[6];
    p.w1 = (const float*)d_in[7]; p.w3 = (const float*)d_in[8]; p.w2 = (const float*)d_in[9]; p.w_in = (const float*)d_in[10];
    p.conv_w = (const float*)d_in[11]; p.conv_b = (const float*)d_in[12]; p.ln_g = (const float*)d_in[13]; p.ln_b = (const float*)d_in[14];
    p.nat_bias = (const float*)d_in[15]; p.sink = (const float*)d_in[16]; p.w_out = (const float*)d_in[17];
    p.out = (float*)d_out; p.ws = (unsigned char*)d_ws;
#if ONE_LAUNCH
    int ph0 = 0, ph1 = N_PHASES;
    void* args[] = {&p, &ph0, &ph1};
    hipError_t e = hipLaunchCooperativeKernel((const void*)mega, dim3(grid), dim3(512), args, LDS_BYTES, stream);
    if (e != hipSuccess) fprintf(stderr, "cooperative launch failed: %s (grid %d)\n", hipGetErrorString(e), grid);
#else
    for (int ph = 0; ph < N_PHASES; ++ph) {
        int ph0 = ph, ph1 = ph + 1;
        void* args[] = {&p, &ph0, &ph1};
        hipError_t e = hipLaunchCooperativeKernel((const void*)mega, dim3(grid), dim3(512), args, LDS_BYTES, stream);
        if (e != hipSuccess) { fprintf(stderr, "launch %d failed: %s (grid %d)\n", ph, hipGetErrorString(e), grid); break; }
    }
#endif
}
```

```cpp
#include <hip/hip_runtime.h>
#include <hip/hip_cooperative_groups.h>
#include <cstdio>
#include <cstdint>
namespace cg = cooperative_groups;
#ifdef TSUB
#define TS_BEGIN(id) do { if ((TSUB) == (id) && threadIdx.x == 0) { *(volatile __attribute__((address_space(3))) unsigned long long*)(lds + 131080) -= __builtin_amdgcn_s_memrealtime(); } } while (0)
#define TS_END(id)   do { if ((TSUB) == (id) && threadIdx.x == 0) { *(volatile __attribute__((address_space(3))) unsigned long long*)(lds + 131080) += __builtin_amdgcn_s_memrealtime(); } } while (0)
#else
#define TS_BEGIN(id) do {} while (0)
#define TS_END(id) do {} while (0)
#endif
namespace pg8 {
#define PG8_LAS __attribute__((address_space(3)))
typedef unsigned short bf16_t;
typedef short bf16x8 __attribute__((ext_vector_type(8)));
typedef float f32x4 __attribute__((ext_vector_type(4)));
typedef unsigned u32x4 __attribute__((ext_vector_type(4)));
constexpr int BM = 256, BK = 64, HALF = 128, HTB = HALF * BK * 2  , STAGE_BYTES = 8 * HTB, NXCD = 8, WGM = 8;

__host__ __device__ __forceinline__ int lds_byte(int r, int c) { const int st = (r >> 4) * 2 + (c >> 5), rr = r & 15, cc = c & 31, ob = rr * 64 + cc * 2; return st * 1024 + (ob ^ (((ob >> 9) & 1) << 5)); }
__host__ __device__ __forceinline__ void stage_rc(int b, int& R, int& C) { const int st = b / 1024, sb = b % 1024, swz = sb ^ (((sb >> 9) & 1) << 5); R = (st >> 1) * 16 + swz / 64; C = (st & 1) * 32 + (swz % 64) / 2; }
__host__ __device__ __forceinline__ int perm32(int rho) { const int n = rho >> 4, i = rho & 15; return 8 * (i >> 2) + 4 * n + (i & 3); }

struct Unit { int pm, pn; };
struct Gemm { const bf16_t* A; const bf16_t* Bt; int M, N, K, lda, ldb; };

struct StaticOrder {
    int nM, nN, nwg, G, c;
    __host__ __device__ void init(int M, int N, int G_, int c_) { nM = M / BM; nN = N / BM; nwg = nM * nN; G = G_; c = c_; }
    __host__ __device__ bool next(int i, Unit& u) const {
        const long L = (long)i * G + c; if (L >= nwg) return false;
        int wgid = (int)L; { const int q = nwg / NXCD, r = nwg % NXCD, xcd = wgid % NXCD, off = wgid / NXCD; wgid = (xcd < r ? xcd * (q + 1) : r * (q + 1) + (xcd - r) * q) + off; }
        const int nig = WGM * nN, gid = wgid / nig, fm = gid * WGM, gsz = (nM - fm) < WGM ? (nM - fm) : WGM;
        u.pm = fm + ((wgid % nig) % gsz); u.pn = (wgid % nig) / gsz; return true;
    }
    __device__ __forceinline__ void a_ready(const Unit&) const {}
    __device__ __forceinline__ void done(const Unit&) const {}
};
__device__ __forceinline__ unsigned cvt_pk_bf16(float lo, float hi) { unsigned r; asm volatile("v_cvt_pk_bf16_f32 %0, %1, %2" : "=v"(r) : "v"(lo), "v"(hi)); return r; }
typedef float f32x2 __attribute__((ext_vector_type(2)));
template <class Epi, class Sched, bool ALIGN_EPI = false, bool SP2 = false>
__device__ __forceinline__ void gemm_phase(PG8_LAS unsigned char* lds, const Gemm g, const Sched& S, const Epi& E) {
    int tid_ = threadIdx.x; asm volatile("" : "+v"(tid_));
    const int tid = tid_, wid = __builtin_amdgcn_readfirstlane(tid >> 6), lane = tid & 63, wr = wid >> 2, wc = wid & 3, fr = lane & 15, fq = lane >> 4;
    const int K = g.K, nt = K / BK;
    unsigned voffA[2], voffB[2];
#pragma unroll
    for (int i = 0; i < 2; ++i) { int R, C; stage_rc(tid * 16 + i * 8192, R, C); const int Rb = Epi::PERM ? ((R & ~31) + perm32(R & 31)) : R;
        voffA[i] = (unsigned)(R * g.lda + C) * 2u; voffB[i] = (unsigned)(Rb * g.ldb + C) * 2u; }
    const size_t kstep = (size_t)(BK * 2);
    const size_t hstepA = (size_t)HALF * g.lda * 2, hstepB = (size_t)HALF * g.ldb * 2;
    const size_t tstepA = 2 * hstepA, tstepB = 2 * hstepB;
    const unsigned ldsw = (unsigned)wid * 1024u;
    const int aoff = lds_byte(wr * 64 + fr, fq * 8), boff = lds_byte(wc * 32 + fr, fq * 8);
#define PG8_SA(b, h) (((b) * 2 + (h)) * HTB)
#define PG8_SB(b, h) ((4 + (b) * 2 + (h)) * HTB)
#define PG8_STAGE(bufoff, gbase, voff) do { _Pragma("unroll") for (int _i = 0; _i < 2; ++_i) \
        __builtin_amdgcn_global_load_lds((const unsigned*)((const char*)(gbase) + (voff)[_i]), (PG8_LAS unsigned*)(lds + (bufoff) + ldsw + _i * 8192), 16, 0, 0); } while (0)
#define PG8_LDA(dst, b, h) do { _Pragma("unroll") for (int m = 0; m < 4; ++m) _Pragma("unroll") for (int k = 0; k < 2; ++k) dst[m][k] = *(const PG8_LAS bf16x8*)(lds + PG8_SA(b, h) + aoff + m * 2048 + k * 1024); } while (0)
#define PG8_LDB(dst, b, h) do { _Pragma("unroll") for (int n = 0; n < 2; ++n) _Pragma("unroll") for (int k = 0; k < 2; ++k) dst[n][k] = *(const PG8_LAS bf16x8*)(lds + PG8_SB(b, h) + boff + n * 2048 + k * 1024); } while (0)
#define PG8_MMA(ai, bj, At, Bt) do { __builtin_amdgcn_s_setprio(1); _Pragma("unroll") for (int m = 0; m < 4; ++m) _Pragma("unroll") for (int n = 0; n < 2; ++n) _Pragma("unroll") for (int k = 0; k < 2; ++k) \
        acc[ai][bj][m][n] = __builtin_amdgcn_mfma_f32_16x16x32_bf16(Bt[n][k], At[m][k], acc[ai][bj][m][n], 0, 0, 0); __builtin_amdgcn_s_setprio(0); } while (0)
#define PG8_WAIT_V(n) asm volatile("s_waitcnt vmcnt(" #n ")" ::: "memory")
#define PG8_WAIT_L(n) asm volatile("s_waitcnt lgkmcnt(" #n ")" ::: "memory")
#define PG8_BAR __builtin_amdgcn_s_barrier()
#define PG8_SCHED __builtin_amdgcn_sched_barrier(0)
    Unit cur, nxt; int ui = 0;
    if (!S.next(0, cur)) return;
    f32x4 acc[2][2][4][2];
#pragma unroll
    for (int a = 0; a < 2; ++a)
#pragma unroll
        for (int b = 0; b < 2; ++b)
#pragma unroll
            for (int m = 0; m < 4; ++m)
#pragma unroll
                for (int n = 0; n < 2; ++n) acc[a][b][m][n] = (f32x4){0.f, 0.f, 0.f, 0.f};
    bf16x8 At[4][2], B0[2][2], B1[2][2];
    const char* cA = (const char*)g.A + (size_t)cur.pm * tstepA; const char* cB = (const char*)g.Bt + (size_t)cur.pn * tstepB;
    S.a_ready(cur);
    if constexpr (SP2) {
        PG8_STAGE(PG8_SB(0, 0), cB, voffB); PG8_STAGE(PG8_SB(0, 1), cB + hstepB, voffB); PG8_STAGE(PG8_SA(0, 0), cA, voffA); PG8_STAGE(PG8_SA(0, 1), cA + hstepA, voffA);
        if (wr == 1) PG8_BAR;
        PG8_WAIT_V(2); PG8_BAR;
        PG8_STAGE(PG8_SB(1, 0), cB + kstep, voffB); PG8_STAGE(PG8_SA(1, 0), cA + kstep, voffA); PG8_STAGE(PG8_SB(1, 1), cB + hstepB + kstep, voffB);
        PG8_WAIT_V(6); PG8_BAR;
    } else {
        PG8_STAGE(PG8_SB(0, 0), cB, voffB); PG8_STAGE(PG8_SA(0, 0), cA, voffA); PG8_STAGE(PG8_SB(0, 1), cB + hstepB, voffB); PG8_STAGE(PG8_SA(0, 1), cA + hstepA, voffA);
        if (wr == 1) PG8_BAR;
        PG8_WAIT_V(4); PG8_BAR;
        PG8_STAGE(PG8_SB(1, 0), cB + kstep, voffB); PG8_STAGE(PG8_SA(1, 0), cA + kstep, voffA); PG8_STAGE(PG8_SB(1, 1), cB + hstepB + kstep, voffB);
        PG8_WAIT_V(6); PG8_BAR;
    }
    for (;;) {
        const bool has_next = S.next(ui + 1, nxt);
        const char* nA = has_next ? (const char*)g.A + (size_t)nxt.pm * tstepA : cA; const char* nB = has_next ? (const char*)g.Bt + (size_t)nxt.pn * tstepB : cB;
        for (int t = 0; t < nt; t += 2) {
            const bool last = (t == nt - 2);
            const char* a1 = cA + (size_t)(t + 1) * kstep;
            const char* a2 = last ? nA : cA + (size_t)(t + 2) * kstep; const char* b2 = last ? nB : cB + (size_t)(t + 2) * kstep;
            const char* a3 = a2 + kstep; const char* b3 = b2 + kstep;
            if (last && has_next) S.a_ready(nxt);
            if constexpr (SP2) {
            PG8_LDB(B0, 0, 0); PG8_LDB(B1, 0, 1); PG8_SCHED; PG8_LDA(At, 0, 0); PG8_STAGE(PG8_SA(1, 1), a1 + hstepA, voffA);
            PG8_WAIT_V(8); PG8_WAIT_L(0); PG8_BAR; PG8_MMA(0, 0, At, B0); PG8_MMA(0, 1, At, B1); PG8_BAR; PG8_SCHED;
            PG8_LDA(At, 0, 1); PG8_STAGE(PG8_SB(0, 0), b2, voffB); PG8_STAGE(PG8_SB(0, 1), b2 + hstepB, voffB); PG8_STAGE(PG8_SA(0, 0), a2, voffA);
            PG8_WAIT_V(8); PG8_WAIT_L(0); PG8_BAR; PG8_MMA(1, 0, At, B0); PG8_MMA(1, 1, At, B1); PG8_BAR; PG8_SCHED;
            PG8_LDB(B0, 1, 0); PG8_LDB(B1, 1, 1); PG8_SCHED; PG8_LDA(At, 1, 0); PG8_STAGE(PG8_SA(0, 1), a2 + hstepA, voffA);
            PG8_WAIT_V(8); PG8_WAIT_L(0); PG8_BAR; PG8_MMA(0, 0, At, B0); PG8_MMA(0, 1, At, B1); PG8_BAR; PG8_SCHED;
            PG8_LDA(At, 1, 1); PG8_STAGE(PG8_SB(1, 0), b3, voffB); PG8_STAGE(PG8_SB(1, 1), b3 + hstepB, voffB); PG8_STAGE(PG8_SA(1, 0), a3, voffA);
            PG8_WAIT_V(8); PG8_WAIT_L(0); PG8_BAR; PG8_MMA(1, 0, At, B0); PG8_MMA(1, 1, At, B1); PG8_BAR; PG8_SCHED;
            } else {
            PG8_LDB(B0, 0, 0); PG8_SCHED; PG8_LDA(At, 0, 0); PG8_STAGE(PG8_SA(1, 1), a1 + hstepA, voffA);
            PG8_WAIT_L(8); PG8_BAR; PG8_WAIT_L(0); PG8_MMA(0, 0, At, B0); PG8_BAR; PG8_SCHED;
            PG8_LDB(B1, 0, 1); PG8_STAGE(PG8_SB(0, 0), b2, voffB);
            PG8_BAR; PG8_WAIT_L(0); PG8_MMA(0, 1, At, B1); PG8_BAR;
            PG8_LDA(At, 0, 1); PG8_STAGE(PG8_SA(0, 0), a2, voffA);
            PG8_BAR; PG8_WAIT_L(0); PG8_MMA(1, 0, At, B0); PG8_BAR; PG8_SCHED;
            PG8_STAGE(PG8_SB(0, 1), b2 + hstepB, voffB);
            PG8_WAIT_V(6); PG8_BAR; PG8_MMA(1, 1, At, B1); PG8_BAR;
            PG8_LDB(B0, 1, 0); PG8_SCHED; PG8_LDA(At, 1, 0); PG8_STAGE(PG8_SA(0, 1), a2 + hstepA, voffA);
            PG8_WAIT_L(8); PG8_BAR; PG8_WAIT_L(0); PG8_MMA(0, 0, At, B0); PG8_BAR; PG8_SCHED;
            PG8_LDB(B1, 1, 1); PG8_STAGE(PG8_SB(1, 0), b3, voffB);
            PG8_BAR; PG8_WAIT_L(0); PG8_MMA(0, 1, At, B1); PG8_BAR;
            PG8_LDA(At, 1, 1); PG8_STAGE(PG8_SA(1, 0), a3, voffA);
            PG8_BAR; PG8_WAIT_L(0); PG8_MMA(1, 0, At, B0); PG8_BAR; PG8_SCHED;
            PG8_STAGE(PG8_SB(1, 1), b3 + hstepB, voffB);
            PG8_WAIT_V(6); PG8_BAR; PG8_MMA(1, 1, At, B1); PG8_BAR;
            }
        }
        if constexpr (ALIGN_EPI) { if (wr == 0) PG8_BAR; }
        TS_BEGIN(8);
        if constexpr (!Epi::AFTER_DRAIN) { E(acc, cur, wr, wc, fr, fq); S.done(cur); }
        TS_END(8);
        if (!has_next) break;
#pragma unroll
        for (int a = 0; a < 2; ++a)
#pragma unroll
            for (int b = 0; b < 2; ++b)
#pragma unroll
                for (int m = 0; m < 4; ++m)
#pragma unroll
                    for (int n = 0; n < 2; ++n) acc[a][b][m][n] = (f32x4){0.f, 0.f, 0.f, 0.f};
        cur = nxt; cA = nA; cB = nB; ++ui;
        if constexpr (ALIGN_EPI) { if (wr == 1) PG8_BAR; }
    }
    PG8_WAIT_V(0);
    if constexpr (!ALIGN_EPI) { if (wr == 0) PG8_BAR; }
    PG8_BAR;
    if constexpr (Epi::AFTER_DRAIN) { E.fused(acc, cur, wr, wc, fr, fq, lds, wid, lane); S.done(cur); }
#undef PG8_SA
#undef PG8_SB
#undef PG8_STAGE
#undef PG8_LDA
#undef PG8_LDB
#undef PG8_MMA
#undef PG8_WAIT_V
#undef PG8_WAIT_L
#undef PG8_BAR
#undef PG8_SCHED
}
}

#define LAS __attribute__((address_space(3)))
typedef unsigned short bf16_t;
typedef float f32x4 __attribute__((ext_vector_type(4)));
typedef float f32x2 __attribute__((ext_vector_type(2)));
typedef unsigned u32x4 __attribute__((ext_vector_type(4)));
typedef unsigned u32x2 __attribute__((ext_vector_type(2)));
typedef short bf16x8 __attribute__((ext_vector_type(8)));
typedef short bf16x4 __attribute__((ext_vector_type(4)));

constexpr int TL = 32768, TC = 4096, TA = 36864, DM = 1024, FF = 2816, NP = 1792, NMODC = 9216;
constexpr int YC_LD = 1280, DFT_LD = 4160, PQT_LD = 4160, DFTC_LD = 576, PQTC_LD = 576;
constexpr int LDS_BYTES = 131072 + 16;
#ifndef MIXMASK
#define MIXMASK 7
#endif

constexpr float EPSV = 1e-6f;
constexpr float LOG2E = 1.4426950408889634f;

constexpr size_t WS_XC   = 0;
constexpr size_t WS_YH   = WS_XC + (size_t)TC * DM * 4;
constexpr size_t WS_R1   = WS_YH + (size_t)TA * DM * 2;
constexpr size_t WS_PROJ = WS_R1;
constexpr size_t WS_PQT  = WS_PROJ + (size_t)TA * NP * 2;
constexpr size_t WS_PQTC = WS_PQT + (size_t)4096 * PQT_LD * 2;
constexpr size_t WS_YCAT = WS_PQTC + (size_t)4096 * PQTC_LD * 2;
constexpr size_t WS_R1END= WS_YCAT + (size_t)TA * YC_LD * 2;
constexpr size_t WS_W13  = WS_R1END;
constexpr size_t WS_W2T  = WS_W13 + (size_t)4 * 5632 * 1024 * 2;
constexpr size_t WS_WIN  = WS_W2T + (size_t)4 * 1024 * 2816 * 2;
constexpr size_t WS_WOUT = WS_WIN + (size_t)2 * 2304 * 1024 * 2;
constexpr size_t WS_DFT  = WS_WOUT + (size_t)2 * 1024 * YC_LD * 2;
constexpr size_t WS_DFTC = WS_DFT + (size_t)2048 * DFT_LD * 2;
constexpr size_t WS_MOD  = WS_DFTC + (size_t)256 * DFTC_LD * 2;
constexpr size_t WS_ROPE = WS_MOD + (size_t)2 * 17 * NMODC * 4;
constexpr size_t WS_BAR  = WS_ROPE + 64 * 16 * 2 * 4;
constexpr size_t WS_Y2   = WS_BAR + 3456 * 4;
constexpr size_t WS_END  = WS_Y2 + (size_t)TC * DM * 2;
static_assert((size_t)TA * FF * 2 <= WS_R1END - WS_R1, "U must fit in R1");

struct Params {
    const float *x, *c, *ctx, *c_ctx, *w_ada, *b_ada, *norm_g, *w1, *w3, *w2, *w_in, *conv_w, *conv_b, *ln_g, *ln_b, *nat_bias, *sink, *w_out;
    float* out; unsigned char* ws;
};
typedef const __attribute__((address_space(4))) Params CParams;

__device__ __forceinline__ unsigned pk2(float lo, float hi) { return pg8::cvt_pk_bf16(lo, hi); }
__device__ __forceinline__ float bflo(unsigned v) { return __uint_as_float(v << 16); }
__device__ __forceinline__ float bfhi(unsigned v) { return __uint_as_float(v & 0xffff0000u); }
__device__ __forceinline__ int otid() { int t = threadIdx.x; asm volatile("" : "+v"(t)); return t; }
__device__ __forceinline__ int obid() { int t = blockIdx.x; asm volatile("" : "+s"(t)); return t; }
__device__ __forceinline__ float xrow16_max(float x) {
    auto s = __builtin_amdgcn_permlane16_swap(__float_as_uint(x), __float_as_uint(x), false, false);
    x = fmaxf(__uint_as_float(s[0]), __uint_as_float(s[1]));
    auto t = __builtin_amdgcn_permlane32_swap(__float_as_uint(x), __float_as_uint(x), false, false);
    return fmaxf(__uint_as_float(t[0]), __uint_as_float(t[1]));
}
__device__ __forceinline__ float xrow16_sum(float x) {
    auto s = __builtin_amdgcn_permlane16_swap(__float_as_uint(x), __float_as_uint(x), false, false);
    x = __uint_as_float(s[0]) + __uint_as_float(s[1]);
    auto t = __builtin_amdgcn_permlane32_swap(__float_as_uint(x), __float_as_uint(x), false, false);
    return __uint_as_float(t[0]) + __uint_as_float(t[1]);
}
template <int CTRL> __device__ __forceinline__ float dpp_mov(float x) { return __builtin_bit_cast(float, __builtin_amdgcn_mov_dpp(__builtin_bit_cast(int, x), CTRL, 0xf, 0xf, true)); }
__device__ __forceinline__ float wave_sum(float v) {
    v += dpp_mov<0xB1>(v);
    v += dpp_mov<0x4E>(v);
    v += dpp_mov<0x141>(v);
    v += dpp_mov<0x128>(v);
    return xrow16_sum(v);
}
__device__ __forceinline__ float fast_exp2(float x) { return __builtin_amdgcn_exp2f(x); }
__device__ __forceinline__ float fast_rcp(float x) { return __builtin_amdgcn_rcpf(x); }
__device__ __forceinline__ float silu_f(float v) { return v * fast_rcp(1.0f + fast_exp2(-v * LOG2E)); }
__device__ __forceinline__ float sigmoid_f(float v) { return fast_rcp(1.0f + fast_exp2(-v * LOG2E)); }

#define XB_TMO      128
#define XB_XCNT(j)  (256  + 64 * (j))
#define XB_XSUB(j)  (1280 + 64 * (j))
#define XB_XGEN(j)  (2304 + 64 * (j))
#define XB_TOP      3328
#define XB_TOPGEN   3392
#define XCD_BAR_WORDS 3456
#define XB_SPIN_CAP (1u << 18)

__device__ __forceinline__ unsigned xb_ld(unsigned* p)              { return __hip_atomic_load(p, __ATOMIC_RELAXED, __HIP_MEMORY_SCOPE_AGENT); }
__device__ __forceinline__ unsigned xb_add(unsigned* p, unsigned v) { return __hip_atomic_fetch_add(p, v, __ATOMIC_RELAXED, __HIP_MEMORY_SCOPE_AGENT); }
__device__ __forceinline__ unsigned xb_xcc_id() { return (unsigned)__builtin_amdgcn_s_getreg((3 << 11) | 20) & 0xFu; }
#define XB_SPIN(cond, bar) do { unsigned _sp = 0; while (cond) { __builtin_amdgcn_s_sleep(1); \
    if ((++_sp & 255u) == 0u) { if (xb_ld(&(bar)[XB_TMO])) break; if (_sp > XB_SPIN_CAP) { atomicAdd(&(bar)[XB_TMO], 1u); break; } } } } while (0)

struct XcdBarrier {
    unsigned* bar; unsigned x;
    volatile LAS unsigned* st;
};

__device__ __forceinline__ XcdBarrier xcd_barrier_post(unsigned* bar, volatile LAS unsigned* st) {
    XcdBarrier b; b.bar = bar; b.x = xb_xcc_id(); b.st = st;
    if (threadIdx.x == 0) (void)xb_add(&bar[XB_XCNT(b.x)], 1u);
    return b;
}
__device__ __forceinline__ void xcd_barrier_complete(unsigned* bar, unsigned x, unsigned& nloc, unsigned& nx) {
    const unsigned G = gridDim.x * gridDim.y * gridDim.z;
    unsigned sum, cnt, mine, sp = 0u;
    for (;;) {
        sum = 0u; cnt = 0u; mine = 0u;
#pragma unroll
        for (unsigned j = 0; j < 16; ++j) { const unsigned c = xb_ld(&bar[XB_XCNT(j)]); sum += c; cnt += (c > 0u) ? 1u : 0u; mine = (j == x) ? c : mine; }
        if (sum == G) break;
        __builtin_amdgcn_s_sleep(1);
        if ((++sp & 255u) == 0u) { if (xb_ld(&bar[XB_TMO])) break; if (sp > XB_SPIN_CAP) { atomicAdd(&bar[XB_TMO], 1u); break; } }
    }
    nloc = mine > 0u ? mine : 1u; nx = cnt > 0u ? cnt : 1u;
}

__device__ __forceinline__ void xcd_barrier(const XcdBarrier& b) {
    asm volatile("s_waitcnt vmcnt(0)" ::: "memory");
    __syncthreads();
    if (threadIdx.x == 0) {
        unsigned* bar = b.bar;
        __builtin_amdgcn_s_waitcnt(0);
        unsigned nloc = b.st[0], nx = b.st[1];
        if (nloc == 0u) { xcd_barrier_complete(bar, b.x, nloc, nx); b.st[0] = nloc; b.st[1] = nx; }
        const unsigned old = xb_add(&bar[XB_XSUB(b.x)], 1u);
        const unsigned gen = old / nloc;
        if (old + 1u == (gen + 1u) * nloc) {
            __builtin_amdgcn_fence(__ATOMIC_RELEASE, "agent");
            asm volatile("s_waitcnt vmcnt(0)" ::: "memory");
            const unsigned og = xb_add(&bar[XB_TOP], 1u);
            const unsigned tg = og / nx;
            if (og + 1u == (tg + 1u) * nx) xb_add(&bar[XB_TOPGEN], 1u);
            else XB_SPIN(xb_ld(&bar[XB_TOPGEN]) == tg, bar);
            __builtin_amdgcn_fence(__ATOMIC_ACQUIRE, "agent");
            xb_add(&bar[XB_XGEN(b.x)], 1u);
            asm volatile("s_waitcnt vmcnt(0)" ::: "memory");
        } else {
            XB_SPIN(xb_ld(&bar[XB_XGEN(b.x)]) == gen, bar);
            __builtin_amdgcn_fence(__ATOMIC_ACQUIRE, "agent");
            asm volatile("s_waitcnt vmcnt(0)" ::: "memory");
        }
    }
    __syncthreads();
}


struct EpiSwiGLU {
    static constexpr bool PERM = true, AFTER_DRAIN = false;
    bf16_t* U;
    __device__ __forceinline__ void operator()(const f32x4 (&acc)[2][2][4][2], const pg8::Unit& u, int wr, int wc, int fr, int fq) const {
        const int row0 = u.pm * 256 + wr * 64 + fr, col0 = u.pn * 128 + wc * 32 + 8 * fq;
#pragma unroll
        for (int ai = 0; ai < 2; ++ai)
#pragma unroll
            for (int m = 0; m < 4; ++m) {
                bf16_t* rowp = U + (size_t)(row0 + ai * 128 + m * 16) * FF + col0;
                unsigned wv[4];
#pragma unroll
                for (int n = 0; n < 2; ++n)
#pragma unroll
                    for (int h = 0; h < 2; ++h) {
                        const f32x2 g2 = {acc[ai][0][m][n][2 * h], acc[ai][0][m][n][2 * h + 1]}, u2 = {acc[ai][1][m][n][2 * h], acc[ai][1][m][n][2 * h + 1]};
                        const f32x2 t = g2 * (-LOG2E);
                        f32x2 d; d.x = fast_exp2(t.x); d.y = fast_exp2(t.y);
                        d = d + 1.0f;
                        f32x2 r; r.x = fast_rcp(d.x); r.y = fast_rcp(d.y);
                        const f32x2 v = (g2 * u2) * r;
                        wv[n * 2 + h] = pk2(v.x, v.y);
                    }
                u32x4 w; w.x = wv[0]; w.y = wv[1]; w.z = wv[2]; w.w = wv[3];
                *(u32x4*)rowp = w;
            }
    }
};
struct EpiBf16Tile {
    static constexpr bool PERM = true, AFTER_DRAIN = false;
    bf16_t* O; int ldc, row_pn, col_pn;
    __device__ __forceinline__ void operator()(const f32x4 (&acc)[2][2][4][2], const pg8::Unit& u, int wr, int wc, int fr, int fq) const {
        const int row0 = u.pm * 256 + u.pn * row_pn + wr * 64 + fr, col0 = u.pn * col_pn + wc * 32 + 8 * fq;
#pragma unroll
        for (int ai = 0; ai < 2; ++ai)
#pragma unroll
            for (int m = 0; m < 4; ++m) {
                bf16_t* rowp = O + (size_t)(row0 + ai * 128 + m * 16) * ldc + col0;
#pragma unroll
                for (int bj = 0; bj < 2; ++bj) {
                    const f32x4 v0 = acc[ai][bj][m][0], v1 = acc[ai][bj][m][1];
                    u32x4 w; w.x = pk2(v0[0], v0[1]); w.y = pk2(v0[2], v0[3]); w.z = pk2(v1[0], v1[1]); w.w = pk2(v1[2], v1[3]);
                    *(u32x4*)(rowp + bj * 128) = w;
                }
            }
    }
};
struct EpiPQ {
    static constexpr bool PERM = true, AFTER_DRAIN = false;
    bf16_t* PQT; bf16_t* PQTC;
    __device__ __forceinline__ void operator()(const f32x4 (&acc)[2][2][4][2], const pg8::Unit& u, int wr, int wc, int fr, int fq) const {
        const int cl = wc * 32 + 8 * fq;
#pragma unroll
        for (int ai = 0; ai < 2; ++ai)
#pragma unroll
            for (int m = 0; m < 4; ++m) {
                const int mp = u.pm * 256 + ai * 128 + wr * 64 + m * 16 + fr;
                const int g = mp >> 7, pq = (mp >> 6) & 1, cp = mp & 63;
                bf16_t* rowp;
                if (u.pn < 128) { const int b = u.pn >> 3, n0 = (u.pn & 7) * 256; rowp = PQT + (size_t)(b * 256 + g * 64 + cp) * PQT_LD + pq * 2048 + n0 + cl; }
                else { const int b = u.pn - 128; rowp = PQTC + (size_t)(b * 256 + g * 64 + cp) * PQTC_LD + pq * 256 + cl; }
#pragma unroll
                for (int bj = 0; bj < 2; ++bj) {
                    const f32x4 v0 = acc[ai][bj][m][0], v1 = acc[ai][bj][m][1];
                    u32x4 w; w.x = pk2(v0[0], v0[1]); w.y = pk2(v0[2], v0[3]); w.z = pk2(v1[0], v1[1]); w.w = pk2(v1[2], v1[3]);
                    *(u32x4*)(rowp + bj * 128) = w;
                }
            }
    }
};
struct EpiWin {
    static constexpr bool PERM = false, AFTER_DRAIN = false;
    bf16_t* P; const float* rope;
    __device__ __forceinline__ void operator()(const f32x4 (&acc)[2][2][4][2], const pg8::Unit& u, int wr, int wc, int fr, int fq) const {
        const int row0 = u.pm * 256 + wr * 64 + fr, col0 = u.pn * 256 + wc * 32 + 4 * fq;
        const float qs = (u.pn == 2 || u.pn == 5) ? 0.125f * LOG2E : 1.0f;
        const bool lat = u.pm < 128;
#pragma unroll
        for (int ai = 0; ai < 2; ++ai)
#pragma unroll
            for (int m = 0; m < 4; ++m) {
                const int r = row0 + ai * 128 + m * 16;
                bf16_t* rowp = P + (size_t)r * NP + col0;
                const int t = r & 2047;
                const int pos = (wc & 1) ? (t & 63) : (t >> 6);
#pragma unroll
                for (int bj = 0; bj < 2; ++bj) {
                    f32x4 v0 = acc[ai][bj][m][0], v1 = acc[ai][bj][m][1];
                    const bool dorope = lat && (u.pn == 5 || (u.pn == 6 && bj == 0));
                    if (dorope) {
                        const f32x4 cs0 = *(const f32x4*)(rope + (pos * 16 + 4 * fq) * 2), cs1 = *(const f32x4*)(rope + (pos * 16 + 4 * fq) * 2 + 4);
                        const float c0 = cs0[0], s0 = cs0[1], c1 = cs0[2], s1 = cs0[3], c2 = cs1[0], s2 = cs1[1], c3 = cs1[2], s3 = cs1[3];
                        f32x4 a, b;
                        a[0] = v0[0] * c0 - v1[0] * s0; b[0] = v0[0] * s0 + v1[0] * c0;
                        a[1] = v0[1] * c1 - v1[1] * s1; b[1] = v0[1] * s1 + v1[1] * c1;
                        a[2] = v0[2] * c2 - v1[2] * s2; b[2] = v0[2] * s2 + v1[2] * c2;
                        a[3] = v0[3] * c3 - v1[3] * s3; b[3] = v0[3] * s3 + v1[3] * c3;
                        v0 = a; v1 = b;
                    }
                    v0 = v0 * qs; v1 = v1 * qs;
                    u32x2 w0, w1; w0.x = pk2(v0[0], v0[1]); w0.y = pk2(v0[2], v0[3]); w1.x = pk2(v1[0], v1[1]); w1.y = pk2(v1[2], v1[3]);
                    *(u32x2*)(rowp + bj * 128) = w0; *(u32x2*)(rowp + bj * 128 + 16) = w1;
                }
            }
    }
};

struct TrItem { const float* src; bf16_t* dst; int ld_src, ld_dst; };
__device__ __forceinline__ TrItem tr_decode(CParams& p, int it) {
    constexpr int PER_L = 2 * 704 + 2 * 352 + 224 + 160;
    unsigned char* ws = p.ws;
    const int l = it / PER_L; int q = it % PER_L;
    const float* src; bf16_t* dst; int ld_src, ld_dst, col0, k0, r0;
    if (q < 2 * 704) { const int f = q / 704; q %= 704; const int rt = q >> 4, kt = q & 15, R0 = rt * 128, tile = R0 >> 8, bj = (R0 >> 7) & 1;
        src = (bj ? p.w3 : p.w1) + (size_t)(l * 2 + f) * 1024 * FF; ld_src = FF; col0 = 128 * tile; k0 = 64 * kt; dst = (bf16_t*)(ws + WS_W13) + (size_t)(l * 2 + f) * 5632 * 1024; r0 = R0; ld_dst = 1024; }
    else if (q < 2 * 704 + 2 * 352) { q -= 2 * 704; const int f = q / 352; q %= 352; const int rt = q / 44, kt = q % 44;
        src = p.w2 + (size_t)(l * 2 + f) * FF * 1024; ld_src = 1024; col0 = 128 * rt; k0 = 64 * kt; dst = (bf16_t*)(ws + WS_W2T) + (size_t)(l * 2 + f) * 1024 * FF; r0 = 128 * rt; ld_dst = FF; }
    else if (q < 2 * 704 + 2 * 352 + 224) { q -= 2 * 704 + 2 * 352; const int rt = q >> 4, kt = q & 15, R0 = rt * 128;
        src = p.w_in + (size_t)l * 1024 * 2048; ld_src = 2048; col0 = R0 < 512 ? R0 : R0 + 256; k0 = 64 * kt; dst = (bf16_t*)(ws + WS_WIN) + (size_t)l * 2304 * 1024; r0 = R0; ld_dst = 1024; }
    int ks = -1;
    if (q >= 2 * 704 + 2 * 352 + 224) { q -= 2 * 704 + 2 * 352 + 224; const int rt = q / 20, kt = q % 20;
        src = p.w_out + (size_t)l * 1024 * 1024; ld_src = 1024; col0 = 128 * rt; k0 = 64 * kt; ks = kt < 16 ? 64 * kt : 256 + 64 * (kt - 16); dst = (bf16_t*)(ws + WS_WOUT) + (size_t)l * 1024 * YC_LD; r0 = 128 * rt; ld_dst = YC_LD; }
    if (ks < 0) ks = k0;
    TrItem t; t.src = src + (size_t)ks * ld_src + col0; t.dst = dst + (size_t)r0 * ld_dst + k0; t.ld_src = ld_src; t.ld_dst = ld_dst; return t;
}

__device__ __forceinline__ void phase0(CParams& p, LAS unsigned char* lds) {
    const int tid = otid(), wave = tid >> 6, lane = tid & 63;
    unsigned char* ws = p.ws;
    const int bid = obid(), G = gridDim.x;
    TS_BEGIN(9);
    if (bid < 288) {
        LAS float* sS = (LAS float*)lds;
        LAS float* sR = sS + 17 * 1024;
        for (int i = tid; i < 17 * 1024; i += 512) { const float v = (i < 16384) ? p.c[i] : p.c_ctx[i - 16384]; sS[i] = v / (1.0f + __expf(-v)); }
        __syncthreads();
        for (int r = bid; r < 288; r += G) {
            const int l = r / 144, j0 = (r % 144) * 64, k0 = wave * 128;
            float acc[17];
#pragma unroll
            for (int q = 0; q < 17; ++q) acc[q] = 0.f;
            const float* wp = p.w_ada + ((size_t)l * 1024 + k0) * NMODC + j0 + lane;
            float wv[16];
#pragma unroll
            for (int kk = 0; kk < 16; ++kk) wv[kk] = wp[(size_t)kk * NMODC];
#pragma unroll 1
            for (int kb = 0; kb < 128; kb += 16) {
                float wn[16];
                const int kn = (kb + 16 < 128) ? kb + 16 : kb;
#pragma unroll
                for (int kk = 0; kk < 16; ++kk) wn[kk] = wp[(size_t)(kn + kk) * NMODC];
#pragma unroll 1
                for (int k4 = 0; k4 < 16; k4 += 4) {
                    const float w0 = k4 == 0 ? wv[0] : (k4 == 4 ? wv[4] : (k4 == 8 ? wv[8] : wv[12]));
                    const float w1 = k4 == 0 ? wv[1] : (k4 == 4 ? wv[5] : (k4 == 8 ? wv[9] : wv[13]));
                    const float w2 = k4 == 0 ? wv[2] : (k4 == 4 ? wv[6] : (k4 == 8 ? wv[10] : wv[14]));
                    const float w3 = k4 == 0 ? wv[3] : (k4 == 4 ? wv[7] : (k4 == 8 ? wv[11] : wv[15]));
#pragma unroll
                    for (int q = 0; q < 17; ++q) { const f32x4 sv = *(const LAS f32x4*)(sS + q * 1024 + k0 + kb + k4);
                        acc[q] += (sv[0] * w0 + sv[1] * w1) + (sv[2] * w2 + sv[3] * w3); }
                }
#pragma unroll
                for (int kk = 0; kk < 16; ++kk) wv[kk] = wn[kk];
            }
#pragma unroll
            for (int q = 0; q < 17; ++q) sR[(wave * 17 + q) * 64 + lane] = acc[q];
            __syncthreads();
            float* MOD = (float*)(ws + WS_MOD);
            for (int o = tid; o < 17 * 64; o += 512) {
                const int q = o >> 6, ln = o & 63; float s = p.b_ada[l * NMODC + j0 + ln];
#pragma unroll
                for (int w = 0; w < 8; ++w) s += sR[(w * 17 + q) * 64 + ln];
                MOD[(size_t)(l * 17 + q) * NMODC + j0 + ln] = s;
            }
            __syncthreads();
        }
    }
    TS_END(9);
    TS_BEGIN(10);
    {
        constexpr int N_TR = 2 * (2 * 704 + 2 * 352 + 224 + 160);
        LAS float* t = (LAS float*)lds;
        const int lk = tid >> 5, lc = (tid & 31) * 4;
        const int sr = tid >> 2, sk = (tid & 3) * 16;
        const bool bal = (G == 256) && (N_TR == 4992);
        int it = bal ? (bid >= 32 ? (bid - 32) * 21 : 4704 + bid * 9) : bid;
        const int step = bal ? 1 : G, tr_end = bal ? it + (bid >= 32 ? 21 : 9) : N_TR;
        f32x4 pre[4]; TrItem cur;
        if (it < tr_end) { cur = tr_decode(p, it);
#pragma unroll
            for (int i = 0; i < 4; ++i) pre[i] = *(const f32x4*)(cur.src + (size_t)(lk + 16 * i) * cur.ld_src + lc); }
        while (it < tr_end) {
#pragma unroll
            for (int i = 0; i < 4; ++i) { LAS float* d = t + (lk + 16 * i) * 129 + lc; d[0] = pre[i][0]; d[1] = pre[i][1]; d[2] = pre[i][2]; d[3] = pre[i][3]; }
            __syncthreads();
            bf16_t* dp = cur.dst + (size_t)sr * cur.ld_dst + sk;
            const int nxt = it + step;
            if (nxt < tr_end) { cur = tr_decode(p, nxt);
#pragma unroll
                for (int i = 0; i < 4; ++i) pre[i] = *(const f32x4*)(cur.src + (size_t)(lk + 16 * i) * cur.ld_src + lc); }
            { const LAS float* s = t + sk * 129 + sr;
              u32x4 o0, o1;
              o0.x = pk2(s[0 * 129], s[1 * 129]); o0.y = pk2(s[2 * 129], s[3 * 129]); o0.z = pk2(s[4 * 129], s[5 * 129]); o0.w = pk2(s[6 * 129], s[7 * 129]);
              o1.x = pk2(s[8 * 129], s[9 * 129]); o1.y = pk2(s[10 * 129], s[11 * 129]); o1.z = pk2(s[12 * 129], s[13 * 129]); o1.w = pk2(s[14 * 129], s[15 * 129]);
              *(u32x4*)dp = o0; *(u32x4*)(dp + 8) = o1; }
            __syncthreads();
            it = nxt;
        }
    }
    TS_END(10);
    TS_BEGIN(11);
    for (int r = bid; r < 256; r += G) {
        const int l = r >> 7, k0 = (r & 127) * 8;
        LAS float* sW = (LAS float*)lds;
        LAS float* sC = sW + 2048;
        for (int i = tid; i < 2048; i += 512) { const int kk = i >> 8, cc = i & 255; sW[i] = p.w_in[((size_t)l * 1024 + k0 + kk) * 2048 + 512 + cc]; }
        if (tid < 64) sC[tid] = cospif((float)tid * (1.0f / 32.0f));
        __syncthreads();
        const int g = tid >> 7, j = tid & 127, jj = j & 63, isS = j >> 6;
        float acc[8];
#pragma unroll
        for (int q = 0; q < 8; ++q) acc[q] = 0.f;
        for (int c = 0; c < 64; ++c) {
            const int mm = (c * jj) & 63; const float tv = sC[isS ? ((mm - 16) & 63) : mm];
#pragma unroll
            for (int q = 0; q < 8; ++q) acc[q] += sW[q * 256 + g * 64 + c] * tv;
        }
        u32x4 o; o.x = pk2(acc[0] * 0.125f, acc[1] * 0.125f); o.y = pk2(acc[2] * 0.125f, acc[3] * 0.125f); o.z = pk2(acc[4] * 0.125f, acc[5] * 0.125f); o.w = pk2(acc[6] * 0.125f, acc[7] * 0.125f);
        *(u32x4*)((bf16_t*)(ws + WS_WIN) + ((size_t)l * 2304 + 1792 + g * 128 + j) * 1024 + k0) = o;
        __syncthreads();
    }
    {
        LAS float* tab = (LAS float*)lds;
        for (int m = tid; m < 2048; m += 512) tab[m] = cospif((float)m * (1.0f / 1024.0f)) * 0.022097086912079608f;
        __syncthreads();
        for (int r = bid; r < 2048 + 256; r += G) {
            if (r < 2048) {
                float v[8];
#pragma unroll
                for (int e = 0; e < 8; ++e) { const int k = tid * 8 + e, idx = (r * (k & 2047)) & 2047; v[e] = tab[k < 2048 ? idx : ((idx + 512) & 2047)]; }
                u32x4 o; o.x = pk2(v[0], v[1]); o.y = pk2(v[2], v[3]); o.z = pk2(v[4], v[5]); o.w = pk2(v[6], v[7]);
                *(u32x4*)((bf16_t*)(ws + WS_DFT) + (size_t)r * DFT_LD + tid * 8) = o;
            } else if (tid < 64) {
                const int np = r - 2048; const float sc = 2.8284271247461903f;
                float v[8];
#pragma unroll
                for (int e = 0; e < 8; ++e) { const int k = tid * 8 + e, idx = ((np * (k & 255)) & 255) * 8; v[e] = tab[k < 256 ? idx : ((idx + 512) & 2047)] * sc; }
                u32x4 o; o.x = pk2(v[0], v[1]); o.y = pk2(v[2], v[3]); o.z = pk2(v[4], v[5]); o.w = pk2(v[6], v[7]);
                *(u32x4*)((bf16_t*)(ws + WS_DFTC) + (size_t)np * DFTC_LD + tid * 8) = o;
            }
        }
        __syncthreads();
    }
    TS_END(11);
    if (bid == G - 1) {
        float* rtab = (float*)(ws + WS_ROPE);
        for (int e = tid; e < 1024; e += 512) { const int pos = e >> 4, i = e & 15;
            const float inv = fast_exp2(-(float)i * (13.287712379549449f / 16.0f));
            const float tt = (float)pos * inv * 0.3183098861837907f;
            rtab[2 * e] = cospif(tt); rtab[2 * e + 1] = sinpif(tt); }
    }
}

struct EwRow { f32x4 x[4]; u32x2 y[4]; u32x2 y2[4]; };
__device__ __forceinline__ void ew_load(EwRow& r, const float* xin_lat, const float* xin_ctx, const bf16_t* Yp, const bf16_t* Y2p, int t, int lane) {
    const float* xr = t < TL ? xin_lat + (size_t)t * DM : xin_ctx + (size_t)(t - TL) * DM;
#pragma unroll
    for (int j = 0; j < 4; ++j) r.x[j] = *(const f32x4*)(xr + 4 * lane + 256 * j);
    if (Yp) {
#pragma unroll
        for (int j = 0; j < 4; ++j) r.y[j] = *(const u32x2*)(Yp + (size_t)t * DM + 4 * lane + 256 * j);
        if (t >= TL) {
#pragma unroll
            for (int j = 0; j < 4; ++j) r.y2[j] = *(const u32x2*)(Y2p + (size_t)(t - TL) * DM + 4 * lane + 256 * j);
        }
    }
}
__device__ __forceinline__ void ew_pass(const float* xin_lat, const float* xin_ctx, float* xout_lat, float* xout_ctx, const bf16_t* Yp, const bf16_t* Y2p, const float* gpost, float fac, const float* gate,
                                        bf16_t* Hp, const float* gpre, const float* shift, const float* scale, int nrows) {
    const int tid = otid(); const int wave = tid >> 6, lane = tid & 63;
    const int per = nrows / gridDim.x, tbeg = obid() * per + wave, tend = obid() * per + per;
    f32x4 vgp[4], vgt[4], vpre[4], vsh[4], vsc[4];
#pragma unroll
    for (int j = 0; j < 4; ++j) { vgp[j] = Yp ? *(const f32x4*)(gpost + 4 * lane + 256 * j) : (f32x4){0.f, 0.f, 0.f, 0.f}; vpre[j] = Hp ? *(const f32x4*)(gpre + 4 * lane + 256 * j) : (f32x4){0.f, 0.f, 0.f, 0.f};
        vgt[j] = vsh[j] = vsc[j] = (f32x4){0.f, 0.f, 0.f, 0.f}; }
    int bcur = -1;
    EwRow A, B;
    auto process = [&](EwRow& r, int t) {
        const bool lat = t < TL; const int b = lat ? (t >> 11) : 16;
        if (b != bcur) { bcur = b;
#pragma unroll
            for (int j = 0; j < 4; ++j) { const int cidx = 4 * lane + 256 * j;
                if (Yp) vgt[j] = *(const f32x4*)(gate + (size_t)b * NMODC + cidx) * fac;
                if (Hp) { vsh[j] = *(const f32x4*)(shift + (size_t)b * NMODC + cidx); vsc[j] = *(const f32x4*)(scale + (size_t)b * NMODC + cidx) + 1.0f; } } }
        if (Yp) {
            f32x4 y[4]; float ss = 0.f;
#pragma unroll
            for (int j = 0; j < 4; ++j) { const u32x2 w = r.y[j];
                y[j][0] = bflo(w.x); y[j][1] = bfhi(w.x); y[j][2] = bflo(w.y); y[j][3] = bfhi(w.y);
                if (!lat) { const u32x2 w2 = r.y2[j]; y[j][0] += bflo(w2.x); y[j][1] += bfhi(w2.x); y[j][2] += bflo(w2.y); y[j][3] += bfhi(w2.y); }
                ss += (y[j][0] * y[j][0] + y[j][1] * y[j][1]) + (y[j][2] * y[j][2] + y[j][3] * y[j][3]); }
            const float rstd = 1.0f / sqrtf(wave_sum(ss) * (1.0f / DM) + EPSV);
#pragma unroll
            for (int j = 0; j < 4; ++j) r.x[j] = r.x[j] + vgt[j] * (y[j] * rstd * vgp[j]);
        }
        float* xo = lat ? (xout_lat ? xout_lat + (size_t)t * DM : nullptr) : (xout_ctx ? xout_ctx + (size_t)(t - TL) * DM : nullptr);
        if (xo) {
#pragma unroll
            for (int j = 0; j < 4; ++j) *(f32x4*)(xo + 4 * lane + 256 * j) = r.x[j];
        }
        if (Hp) {
            float ss = 0.f;
#pragma unroll
            for (int j = 0; j < 4; ++j) ss += (r.x[j][0] * r.x[j][0] + r.x[j][1] * r.x[j][1]) + (r.x[j][2] * r.x[j][2] + r.x[j][3] * r.x[j][3]);
            const float rstd = 1.0f / sqrtf(wave_sum(ss) * (1.0f / DM) + EPSV);
#pragma unroll
            for (int j = 0; j < 4; ++j) { const f32x4 h = (r.x[j] * rstd * vpre[j]) * vsc[j] + vsh[j];
                u32x2 w; w.x = pk2(h[0], h[1]); w.y = pk2(h[2], h[3]);
                *(u32x2*)(Hp + (size_t)t * DM + 4 * lane + 256 * j) = w; }
        }
    };
    int t = tbeg;
    if (t < tend) ew_load(A, xin_lat, xin_ctx, Yp, Y2p, t, lane);
    while (t < tend) {
        const int tn = t + 8;
        if (tn < tend) ew_load(B, xin_lat, xin_ctx, Yp, Y2p, tn, lane);
        process(A, t);
        const int tnn = tn + 8;
        if (tnn < tend) ew_load(A, xin_lat, xin_ctx, Yp, Y2p, tnn, lane);
        if (tn < tend) process(B, tn);
        t = tnn;
    }
}

__device__ __forceinline__ void conv_item(CParams& p, LAS unsigned char* lds, int l, int s, int tb) {
    const int tid = otid(), wave = tid >> 6, lane = tid & 63;
    const bf16_t* PROJ = (const bf16_t*)(p.ws + WS_PROJ); bf16_t* YCAT = (bf16_t*)(p.ws + WS_YCAT);
    LAS float* sA = (LAS float*)lds;
    const int tokbase = s < 16 ? s * 2048 : TL + (s - 16) * 256, len = s < 16 ? 2048 : 256, t0 = tb * 64;
    {
        u32x4 ua[6], ug[6];
#pragma unroll
        for (int i = 0; i < 6; ++i) {
            const int u = tid + 512 * i, rr = u >> 5, c8 = (u & 31) * 8, tt = t0 - 15 + rr;
            ua[i] = (u32x4){0u, 0u, 0u, 0u}; ug[i] = (u32x4){0u, 0u, 0u, 0u};
            if (u < 94 * 32 && tt >= 0 && tt < len) { const bf16_t* rp = PROJ + (size_t)(tokbase + tt) * NP + c8; ua[i] = *(const u32x4*)rp; ug[i] = *(const u32x4*)(rp + 256); }
        }
#pragma unroll
        for (int i = 0; i < 6; ++i) {
            const int u = tid + 512 * i, rr = u >> 5, c8 = (u & 31) * 8;
            if (u < 94 * 32) {
                float v[8];
                v[0] = bflo(ua[i].x) * sigmoid_f(bflo(ug[i].x)); v[1] = bfhi(ua[i].x) * sigmoid_f(bfhi(ug[i].x));
                v[2] = bflo(ua[i].y) * sigmoid_f(bflo(ug[i].y)); v[3] = bfhi(ua[i].y) * sigmoid_f(bfhi(ug[i].y));
                v[4] = bflo(ua[i].z) * sigmoid_f(bflo(ug[i].z)); v[5] = bfhi(ua[i].z) * sigmoid_f(bfhi(ug[i].z));
                v[6] = bflo(ua[i].w) * sigmoid_f(bflo(ug[i].w)); v[7] = bfhi(ua[i].w) * sigmoid_f(bfhi(ug[i].w));
                *(LAS f32x4*)(sA + rr * 256 + c8) = (f32x4){v[0], v[1], v[2], v[3]};
                *(LAS f32x4*)(sA + rr * 256 + c8 + 4) = (f32x4){v[4], v[5], v[6], v[7]};
            }
        }
    }
    __syncthreads();
    TS_BEGIN(7);
    const int cp = tid & 127, oc = tid >> 7;
    f32x2 out2[2][8];
    {
        f32x2 w2[31];
#pragma unroll
        for (int j = 0; j < 31; ++j) w2[j] = *(const f32x2*)(p.conv_w + ((size_t)l * 31 + j) * 256 + 2 * cp);
        const f32x2 bias2 = *(const f32x2*)(p.conv_b + l * 256 + 2 * cp);
#pragma unroll
        for (int ps = 0; ps < 2; ++ps) {
            const LAS float* ap = sA + ((oc * 2 + ps) * 8) * 256 + 2 * cp;
            f32x2 in2[38];
#pragma unroll
            for (int i = 0; i < 38; ++i) in2[i] = *(const LAS f32x2*)(ap + i * 256);
#pragma unroll
            for (int q = 0; q < 8; ++q) {
                f32x2 acc = bias2;
#pragma unroll
                for (int j = 0; j < 31; ++j) acc = in2[q + j] * w2[j] + acc;
                out2[ps][q] = acc;
            }
        }
    }
    TS_END(7);
    __syncthreads();
#pragma unroll
    for (int ps = 0; ps < 2; ++ps)
#pragma unroll
        for (int q = 0; q < 8; ++q) *(LAS f32x2*)(sA + ((oc * 2 + ps) * 8 + q) * 256 + 2 * cp) = out2[ps][q];
    __syncthreads();
    {
        const f32x4 lg = *(const f32x4*)(p.ln_g + l * 256 + 4 * lane), lb = *(const f32x4*)(p.ln_b + l * 256 + 4 * lane);
#pragma unroll
        for (int q = 0; q < 8; ++q) {
            const int tok = wave * 8 + q;
            const f32x4 v = *(const LAS f32x4*)(sA + tok * 256 + 4 * lane);
            const float mean = wave_sum((v[0] + v[1]) + (v[2] + v[3])) * (1.0f / 256.0f);
            const f32x4 d = v - mean;
            const float var = wave_sum((d[0] * d[0] + d[1] * d[1]) + (d[2] * d[2] + d[3] * d[3])) * (1.0f / 256.0f);
            const float rstd = 1.0f / sqrtf(var + EPSV);
            const f32x4 yn = d * rstd * lg + lb;
            u32x2 o; o.x = pk2(silu_f(yn[0]), silu_f(yn[1])); o.y = pk2(silu_f(yn[2]), silu_f(yn[3]));
            *(u32x2*)(YCAT + (size_t)(tokbase + t0 + tok) * YC_LD + 4 * lane) = o;
        }
    }
    __syncthreads();
}

struct AttnItem {
    int mode;
    int qtok0;
    int qcol0, qcol1, ocol0, ocol1;
    int kcol0, kcol1, vcol0, vcol1; int nslots;
    int nloc, loctok0;
    int ctxtok0;
    int r, rs;
    int q0, kp0;
    int has_sink; float sink0, sink1;
    int h0;
};
constexpr int KROW = 72;
constexpr int KV_BYTES = 64 * KROW * 2;
constexpr int ABUF_BYTES = 4 * KV_BYTES;
typedef short s16x4 __attribute__((ext_vector_type(4)));
template <int OFF> __device__ __forceinline__ s16x4 tr_read(unsigned addr) {
    s16x4 r; asm volatile("ds_read_b64_tr_b16 %0, %1 offset:%2" : "=&v"(r) : "v"(addr), "i"(OFF) : "memory"); return r;
}
template <int NKB>
__device__ __forceinline__ void attn_chunk(const LAS unsigned char* kt, const LAS unsigned char* vt, int kofs, const bf16x8 (&qf)[2], int fr, int fq,
                                           int mtype, int a0, const LAS float* bt, float& mrun, float& lsum, f32x4 (&o)[4]) {
    const unsigned vaddr = (unsigned)(size_t)vt + (unsigned)(((kofs + 4 * fq + (fr >> 2)) * KROW + 4 * (fr & 3)) * 2);
    s16x4 vl[NKB / 2][4], vh[NKB / 2][4];
#pragma unroll
    for (int grp = 0; grp < NKB / 2; ++grp) {
        const unsigned va = vaddr + (unsigned)(grp * 32 * KROW * 2);
        vl[grp][0] = tr_read<0>(va);  vh[grp][0] = tr_read<16 * KROW * 2>(va);
        vl[grp][1] = tr_read<32>(va); vh[grp][1] = tr_read<16 * KROW * 2 + 32>(va);
        vl[grp][2] = tr_read<64>(va); vh[grp][2] = tr_read<16 * KROW * 2 + 64>(va);
        vl[grp][3] = tr_read<96>(va); vh[grp][3] = tr_read<16 * KROW * 2 + 96>(va);
    }
    f32x4 sacc[NKB];
    const int kc0 = (fq ^ (((kofs + fr) >> 1) & 7)) * 16;
    const LAS unsigned char* krow = kt + (kofs + fr) * 128;
    const LAS unsigned char* kp0 = krow + kc0;
    const LAS unsigned char* kp1 = krow + (kc0 ^ 64);
#pragma unroll
    for (int kb = 0; kb < NKB; ++kb) {
        sacc[kb] = (f32x4){0.f, 0.f, 0.f, 0.f};
        const bf16x8 a0v = *(const LAS bf16x8*)(kp0 + 16 * kb * 128);
        const bf16x8 a1v = *(const LAS bf16x8*)(kp1 + 16 * kb * 128);
        sacc[kb] = __builtin_amdgcn_mfma_f32_16x16x32_bf16(a0v, qf[0], sacc[kb], 0, 0, 0);
        sacc[kb] = __builtin_amdgcn_mfma_f32_16x16x32_bf16(a1v, qf[1], sacc[kb], 0, 0, 0);
    }
    if (mtype == 1) {
        const int wsx = min(max(a0 - 8, 0), 48);
        const int lo = wsx - (kofs + 4 * fq);
        const LAS float* bl = bt + (kofs + 4 * fq - a0 + 63);
#pragma unroll
        for (int kb = 0; kb < NKB; ++kb)
#pragma unroll
            for (int j = 0; j < 4; ++j) { const bool ok = (unsigned)(16 * kb + j - lo) < 16u;
                sacc[kb][j] = ok ? sacc[kb][j] + bl[16 * kb + j] : -1.0e30f; }
    } else if (mtype == 2) {
        const int db = a0 + kofs + 4 * fq + 128;
#pragma unroll
        for (int kb = 0; kb < NKB; ++kb)
#pragma unroll
            for (int j = 0; j < 4; ++j) { const bool ok = (unsigned)(db + 16 * kb + j) <= 256u;
                sacc[kb][j] = ok ? sacc[kb][j] : -1.0e30f; }
    }
    float cm = sacc[0][0];
#pragma unroll
    for (int kb = 0; kb < NKB; ++kb)
#pragma unroll
        for (int j = 0; j < 4; ++j) cm = fmaxf(cm, sacc[kb][j]);
    cm = xrow16_max(cm);
    const float mnew = fmaxf(mrun, cm);
    if (__any(mnew > mrun)) {
        const float alpha = fast_exp2(mrun - mnew);
        lsum *= alpha;
#pragma unroll
        for (int db = 0; db < 4; ++db) o[db] = o[db] * alpha;
        mrun = mnew;
    }
    float ps = 0.f;
#pragma unroll
    for (int kb = 0; kb < NKB; ++kb)
#pragma unroll
        for (int j = 0; j < 4; ++j) { sacc[kb][j] = fast_exp2(sacc[kb][j] - mnew); ps += sacc[kb][j]; }
    lsum += ps;
    asm volatile("s_waitcnt lgkmcnt(0)" ::: "memory"); __builtin_amdgcn_sched_barrier(0);
#define ATT_PK(L, H) (bf16x8){L[0], L[1], L[2], L[3], H[0], H[1], H[2], H[3]}
#pragma unroll
    for (int grp = 0; grp < NKB / 2; ++grp) {
        union { bf16x8 v; unsigned u[4]; } pb;
        pb.u[0] = pk2(sacc[2 * grp][0], sacc[2 * grp][1]); pb.u[1] = pk2(sacc[2 * grp][2], sacc[2 * grp][3]);
        pb.u[2] = pk2(sacc[2 * grp + 1][0], sacc[2 * grp + 1][1]); pb.u[3] = pk2(sacc[2 * grp + 1][2], sacc[2 * grp + 1][3]);
#pragma unroll
        for (int db = 0; db < 4; ++db) o[db] = __builtin_amdgcn_mfma_f32_16x16x32_bf16(ATT_PK(vl[grp][db], vh[grp][db]), pb.v, o[db], 0, 0, 0);
    }
#undef ATT_PK
}

__device__ __forceinline__ void attn_item(CParams& p, LAS unsigned char* lds, int l, const AttnItem& it) {
    const int tid = otid(), wave = tid >> 6, lane = tid & 63, g = wave >> 2, wq = wave & 3, fr = lane & 15, fq = lane >> 4;
    const bf16_t* PROJ = (const bf16_t*)(p.ws + WS_PROJ); bf16_t* YCAT = (bf16_t*)(p.ws + WS_YCAT);
    LAS float* sB = (LAS float*)(lds + 2 * ABUF_BYTES);
    const int slot = it.nslots == 2 ? g : 0;
    if (it.mode == 0) { for (int i = tid; i < 2 * 15 * 128; i += 512) { const int h = i / 1920, rem = i % 1920, dr = rem >> 7, dc = (rem & 127) - 48;
            sB[i] = (dc >= 0 && dc < 31) ? p.nat_bias[(size_t)(l * 4 + it.h0 + h) * 465 + dr * 31 + dc] * LOG2E : 0.f; } }
    bf16x8 qf[2];
    { const bf16_t* qp = PROJ + (size_t)(it.qtok0 + wq * 16 + fr) * NP + (g ? it.qcol1 : it.qcol0) + 8 * fq;
      qf[0] = *(const bf16x8*)qp; qf[1] = *(const bf16x8*)(qp + 32); }
    float mrun = -3.0e38f, lsum = 0.f;
    f32x4 o[4];
#pragma unroll
    for (int db = 0; db < 4; ++db) o[db] = (f32x4){0.f, 0.f, 0.f, 0.f};
    const int nchunks = 4 + it.nloc;
    const int srow = tid >> 3, sseg = tid & 7;
    u32x4 kreg[2], vreg[2];
    auto chunk_tok = [&](int c) { return c < 4 ? it.ctxtok0 + 64 * c : it.loctok0 + 64 * (c - 4); };
    auto gload = [&](int c) {
        const bf16_t* rp = PROJ + (size_t)(chunk_tok(c) + srow) * NP + 8 * sseg;
#pragma unroll
        for (int s = 0; s < 2; ++s) if (s < it.nslots) { kreg[s] = *(const u32x4*)(rp + (s ? it.kcol1 : it.kcol0)); vreg[s] = *(const u32x4*)(rp + (s ? it.vcol1 : it.vcol0)); }
    };
    auto lwrite = [&](int c) {
        LAS unsigned char* bufk = lds + (c & 1) * ABUF_BYTES + srow * 128 + ((sseg ^ ((srow >> 1) & 7)) * 16);
        LAS unsigned char* bufv = lds + (c & 1) * ABUF_BYTES + 2 * KV_BYTES + (srow * KROW + 8 * sseg) * 2;
#pragma unroll
        for (int s = 0; s < 2; ++s) if (s < it.nslots) { *(LAS u32x4*)(bufk + s * KV_BYTES) = kreg[s]; *(LAS u32x4*)(bufv + s * KV_BYTES) = vreg[s]; }
    };
    gload(0); lwrite(0);
    if (nchunks > 1) gload(1);
    __syncthreads();
    TS_BEGIN(5);
    const int qi = wq * 16 + fr;
    const int nat_kofs = min(max(16 * wq - 8, 0), 32);
    for (int c = 0; c < nchunks; ++c) {
        if (c + 1 < nchunks) lwrite(c + 1);
        if (c + 2 < nchunks) gload(c + 2);
        const LAS unsigned char* kt = lds + (c & 1) * ABUF_BYTES + slot * KV_BYTES;
        const LAS unsigned char* vt = kt + 2 * KV_BYTES;
        if (c >= 4 && it.mode == 0) {
            const int dr = (it.rs + (c - 4)) - it.r + 7;
            attn_chunk<2>(kt, vt, nat_kofs, qf, fr, fq, 1, qi, sB + g * 1920 + dr * 128, mrun, lsum, o);
        } else if (c >= 4 && it.mode == 1) {
            attn_chunk<4>(kt, vt, 0, qf, fr, fq, 2, it.kp0 + 64 * (c - 4) - (it.q0 + qi), sB, mrun, lsum, o);
        } else {
            attn_chunk<4>(kt, vt, 0, qf, fr, fq, 0, 0, sB, mrun, lsum, o);
        }
        __syncthreads();
    }
    TS_END(5);
    lsum = xrow16_sum(lsum);
    if (it.has_sink) lsum += fast_exp2((g ? it.sink1 : it.sink0) * LOG2E - mrun);
    const float inv = 1.0f / lsum;
    bf16_t* op = YCAT + (size_t)(it.qtok0 + wq * 16 + fr) * YC_LD + (g ? it.ocol1 : it.ocol0) + 4 * fq;
#pragma unroll
    for (int db = 0; db < 4; ++db) { u32x2 w; w.x = pk2(o[db][0] * inv, o[db][1] * inv); w.y = pk2(o[db][2] * inv, o[db][3] * inv); *(u32x2*)(op + 16 * db) = w; }
}

constexpr int C_UA = 0, C_QN = 512, C_KN = 768, C_VN = 1024, C_QS = 1280, C_KS = 1536, C_VS = 1664;

__device__ __forceinline__ void mix_items(CParams& p, LAS unsigned char* lds, int l, int sub) {
    const int n_attn = (l == 0) ? 2304 : 2048;
    const int n_conv = (l == 0) ? 512 + 64 : 512;
    const int start = (obid() + 128) % gridDim.x;
    for (int i = start; i < n_attn + n_conv; i += gridDim.x) {
        if (i >= n_attn) {
            if (!(sub & 4)) continue;
            const int ci = i - n_attn;
            TS_BEGIN(3);
            if (ci < 512) conv_item(p, lds, l, ci >> 5, ci & 31);
            else { const int cj = ci - 512; conv_item(p, lds, l, 16 + (cj >> 2), cj & 3); }
            TS_END(3);
            continue;
        }
        AttnItem it{};
        if (i < 1024) {
            const int b = i >> 6, r = (i >> 1) & 31, hp = i & 1;
            it.mode = 0; it.qtok0 = b * 2048 + r * 64; it.nslots = 2; it.h0 = 2 * hp;
            { const int h = 2 * hp; it.qcol0 = C_QN + 64 * h; it.kcol0 = C_KN + 64 * h; it.vcol0 = C_VN + 64 * h; it.ocol0 = 512 + 64 * h;
              it.qcol1 = it.qcol0 + 64; it.kcol1 = it.kcol0 + 64; it.vcol1 = it.vcol0 + 64; it.ocol1 = it.ocol0 + 64; }
            it.r = r; it.rs = min(max(r - 4, 0), 24); it.nloc = 8; it.loctok0 = b * 2048 + it.rs * 64; it.ctxtok0 = TL + b * 256;
        } else if (i < 2048) {
            const int k = i - 1024, b = k >> 6, qb = (k >> 1) & 31, kvh = k & 1;
            it.mode = 1; it.qtok0 = b * 2048 + qb * 64; it.nslots = 1;
            { const int h = 2 * kvh; it.qcol0 = C_QS + 64 * h; it.ocol0 = 768 + 64 * h; it.sink0 = p.sink[l * 4 + h]; it.sink1 = p.sink[l * 4 + h + 1];
              it.qcol1 = it.qcol0 + 64; it.ocol1 = it.ocol0 + 64; it.kcol0 = it.kcol1 = C_KS + 64 * kvh; it.vcol0 = it.vcol1 = C_VS + 64 * kvh; }
            it.has_sink = 1; it.q0 = qb * 64;
            const int ks = max(qb * 64 - 128, 0), ke = min(qb * 64 + 192, 2048);
            it.kp0 = ks; it.nloc = (ke - ks) >> 6; it.loctok0 = b * 2048 + ks; it.ctxtok0 = TL + b * 256;
        } else if (i < 2176) {
            const int k = i - 2048, b = k >> 3, qb = (k >> 1) & 3, hp = k & 1;
            it.mode = 2; it.qtok0 = TL + b * 256 + qb * 64; it.nslots = 2;
            { const int h = 2 * hp; it.qcol0 = C_QN + 64 * h; it.kcol0 = C_KN + 64 * h; it.vcol0 = C_VN + 64 * h; it.ocol0 = 512 + 64 * h;
              it.qcol1 = it.qcol0 + 64; it.kcol1 = it.kcol0 + 64; it.vcol1 = it.vcol0 + 64; it.ocol1 = it.ocol0 + 64; }
            it.nloc = 0; it.ctxtok0 = TL + b * 256;
        } else {
            const int k = i - 2176, b = k >> 3, qb = (k >> 1) & 3, kvh = k & 1;
            it.mode = 2; it.qtok0 = TL + b * 256 + qb * 64; it.nslots = 1;
            { const int h = 2 * kvh; it.qcol0 = C_QS + 64 * h; it.ocol0 = 768 + 64 * h; it.sink0 = p.sink[l * 4 + h]; it.sink1 = p.sink[l * 4 + h + 1];
              it.qcol1 = it.qcol0 + 64; it.ocol1 = it.ocol0 + 64; it.kcol0 = it.kcol1 = C_KS + 64 * kvh; it.vcol0 = it.vcol1 = C_VS + 64 * kvh; }
            it.has_sink = 1; it.nloc = 0; it.ctxtok0 = TL + b * 256;
        }
        TS_BEGIN(2);
        if (sub & 2) attn_item(p, lds, l, it);
        TS_END(2);
    }
}

constexpr int N_PHASES = 22;
#ifndef PHMASK
#define PHMASK 0xff
#endif

__device__ __forceinline__ void run_phase(CParams& p, LAS unsigned char* lds, int ph, int sub) {
    unsigned char* ws = p.ws;
    bf16_t* YH = (bf16_t*)(ws + WS_YH); bf16_t* U = (bf16_t*)(ws + WS_R1); bf16_t* PROJ = (bf16_t*)(ws + WS_PROJ); bf16_t* YCAT = (bf16_t*)(ws + WS_YCAT);
    float* XC = (float*)(ws + WS_XC); const float* MOD = (const float*)(ws + WS_MOD);
    const int G = gridDim.x, c = obid();
    if (ph == 0) { if constexpr ((PHMASK & 1) != 0) phase0(p, lds); return; }
    if (ph == 1) {
        if constexpr ((PHMASK & 2) == 0) return;
        ew_pass(p.x, p.ctx, nullptr, nullptr, nullptr, nullptr, nullptr, 0.f, nullptr, YH, p.norm_g, MOD, MOD + 1024, TA); return;
    }
    const int l = (ph - 2) / 10, k = (ph - 2) % 10;
    const float* MODL = MOD + (size_t)l * 17 * NMODC; const float* NG = p.norm_g + (size_t)l * 6 * DM;
    const int rows_late = (l == 0) ? TA : TL;
    switch (k) {
    case 0: case 7: {
        if constexpr ((PHMASK & 4) == 0) break;
        const int f = (k == 7), M = f ? rows_late : TA;
        pg8::Gemm g{YH, (const bf16_t*)(ws + WS_W13) + (size_t)(l * 2 + f) * 5632 * 1024, M, 5632, 1024, 1024, 1024};
        pg8::StaticOrder S; S.init(M, 5632, G, c); EpiSwiGLU E{U};
        pg8::gemm_phase<EpiSwiGLU, pg8::StaticOrder, true, true>(lds, g, S, E);
    } break;
    case 1: case 8: case 5: {
        if constexpr ((PHMASK & 8) == 0) break;
        const bool isout = (k == 5); const int f = (k == 8), M = (k == 1) ? TA : rows_late;
        const int Kd = isout ? YC_LD : FF;
        const bf16_t* Ap = isout ? YCAT : U;
        const bf16_t* Bp = isout ? (const bf16_t*)(ws + WS_WOUT) + (size_t)l * 1024 * YC_LD : (const bf16_t*)(ws + WS_W2T) + (size_t)(l * 2 + f) * 1024 * FF;
        for (int v = 0; v < (M == TA ? 3 : 1); ++v) {
            pg8::Gemm g = v == 0 ? pg8::Gemm{Ap, Bp, TL, 1024, Kd, Kd, Kd}
                                 : pg8::Gemm{Ap + (size_t)TL * Kd + (v - 1) * (Kd / 2), Bp + (v - 1) * (Kd / 2), TC, 1024, Kd / 2, Kd, Kd};
            pg8::StaticOrder S; S.init(g.M, 1024, G, v == 2 ? (c + G - 64) % G : c);
            EpiBf16Tile E{v == 0 ? YH : (v == 1 ? YH + (size_t)TL * DM : (bf16_t*)(ws + WS_Y2)), 1024, 0, 256};
            pg8::gemm_phase<EpiBf16Tile, pg8::StaticOrder, true, true>(lds, g, S, E);
        }
    } break;
    case 2: case 6: case 9: {
        if constexpr ((PHMASK & 2) == 0) break;
        const int gi = (k == 2) ? 2 : (k == 6 ? 5 : 8), ni = (k == 2) ? 1 : (k == 6 ? 3 : 5);
        const int nrows = (k == 2) ? TA : rows_late;
        const bool lastl = (k == 9 && l == 1);
        const float* gpre = (k == 2) ? NG + 2 * DM : (k == 6 ? NG + 4 * DM : p.norm_g + 6 * DM);
        const float* shift = (k == 2) ? MODL + 3 * 1024 : (k == 6 ? MODL + 6 * 1024 : MOD + 17 * NMODC);
        const float* scale = (k == 2) ? MODL + 4 * 1024 : (k == 6 ? MODL + 7 * 1024 : MOD + 17 * NMODC + 1024);
        float* outp = p.out;
        const bool first = (l == 0 && k == 2);
        ew_pass(first ? p.x : outp, first ? p.ctx : XC, outp, XC, YH, (const bf16_t*)(ws + WS_Y2), NG + ni * DM, (k == 6) ? 1.0f : 0.5f, MODL + gi * 1024, lastl ? nullptr : YH, gpre, shift, scale, nrows);
    } break;
    case 3: {
        if constexpr ((PHMASK & 16) == 0) break;
        const bf16_t* W = (const bf16_t*)(ws + WS_WIN) + (size_t)l * 2304 * 1024;
        { pg8::Gemm g{YH, W, TA, NP, 1024, 1024, 1024}; pg8::StaticOrder S; S.init(TA, NP, G, c); EpiWin E{PROJ, (const float*)(ws + WS_ROPE)};
          pg8::gemm_phase<EpiWin, pg8::StaticOrder, true, true>(lds, g, S, E); }
        { const int N = (l == 0) ? TA : TL; pg8::Gemm g{W + (size_t)1792 * 1024, YH, 512, N, 1024, 1024, 1024}; pg8::StaticOrder S; S.init(512, N, G, (c + 16) % G);
          EpiPQ E{(bf16_t*)(ws + WS_PQT), (bf16_t*)(ws + WS_PQTC)};
          pg8::gemm_phase<EpiPQ, pg8::StaticOrder, true, true>(lds, g, S, E); }
    } break;
    case 4: {
        if constexpr ((PHMASK & 32) == 0) break;
        TS_BEGIN(1);
        if (sub & 1)
        for (int v = 0; v < ((l == 0) ? 4 : 2); ++v) {
            const int hs = v & 1, isc = v >> 1;
            const bf16_t* Ap = isc ? (const bf16_t*)(ws + WS_DFTC) + hs * 256 : (const bf16_t*)(ws + WS_DFT) + hs * 2048;
            const bf16_t* Bp = isc ? (const bf16_t*)(ws + WS_PQTC) + hs * 256 : (const bf16_t*)(ws + WS_PQT) + hs * 2048;
            pg8::Gemm g{Ap, Bp, isc ? 256 : 2048, 4096, isc ? 256 : 2048, isc ? DFTC_LD : DFT_LD, isc ? PQTC_LD : PQT_LD};
            pg8::StaticOrder S; S.init(g.M, g.N, G, isc ? (c + G - 16 * hs) % G : (c + G - 128 * hs) % G);
            EpiBf16Tile E{YCAT + (isc ? (size_t)TL * YC_LD : 0) + (hs ? 1024 : 256), YC_LD, isc ? 256 : 2048, 0};
            pg8::gemm_phase<EpiBf16Tile, pg8::StaticOrder, true, true>(lds, g, S, E);
        }
        TS_END(1);
        if (sub & 6) mix_items(p, lds, l, sub);
    } break;
    }
}

__global__ void __launch_bounds__(512, 2) mega(Params p, int ph0, int ph1) {
    extern __shared__ __attribute__((aligned(16))) unsigned char lds_raw[];
    LAS unsigned char* lds = (LAS unsigned char*)lds_raw;
    cg::grid_group grid = cg::this_grid();
    if (ph1 < 0) grid.sync();
    volatile LAS unsigned* xst = (volatile LAS unsigned*)(lds + 131072);
    if (threadIdx.x < 4) xst[threadIdx.x] = 0u;
    __syncthreads();
    XcdBarrier xb = xcd_barrier_post((unsigned*)(p.ws + WS_BAR), xst);
#ifdef TPROBE
    unsigned long long tacc = 0, tprev = __builtin_amdgcn_s_memrealtime();
#endif
    for (int ph = ph0; ph < ph1; ++ph) {
        CParams* q = (CParams*)__builtin_amdgcn_kernarg_segment_ptr(); asm volatile("" : "+s"(q));
        run_phase(*q, lds, ph, 7);
#ifdef DUPK
        { const int kind = ph == 0 ? 10 : (ph == 1 ? 11 : (ph - 2) % 10);
          if ((DUPK >> kind) & 1) { xcd_barrier(xb); run_phase(*q, lds, ph, DUPSUB); } }
#endif
        if (ph + 1 < ph1) xcd_barrier(xb);
#ifdef TPROBE
        { const unsigned long long now = __builtin_amdgcn_s_memrealtime(); const int kind = ph == 0 ? 10 : (ph == 1 ? 11 : (ph - 2) % 10);
          if ((TPROBE >> kind) & 1) tacc += now - tprev; tprev = now; }
#endif
    }
#ifdef TPROBE
    if (blockIdx.x == 0 && threadIdx.x == 0) { const unsigned long long t0 = __builtin_amdgcn_s_memrealtime(); while (__builtin_amdgcn_s_memrealtime() - t0 < tacc) __builtin_amdgcn_s_sleep(8); }
#endif
#ifdef TSUB
    if (blockIdx.x == 0 && threadIdx.x == 0) { const unsigned long long tacc2 = *(volatile LAS unsigned long long*)(lds + 131080); const unsigned long long t0 = __builtin_amdgcn_s_memrealtime(); while (__builtin_amdgcn_s_memrealtime() - t0 < 4ull * tacc2) __builtin_amdgcn_s_sleep(8); }
#endif
#ifdef XSYNC
    for (int i = 0; i < XSYNC; ++i) xcd_barrier(xb);
#endif
}

#ifndef ONE_LAUNCH
#define ONE_LAUNCH 1
#endif

extern "C" void kernel_launch(void* const* d_in, const int* in_sizes, int n_in, void* d_out, int out_size, void* d_ws, size_t ws_size, hipStream_t stream) {
    static int grid = 0;
    if (grid == 0) {
        if (ws_size < WS_END) { fprintf(stderr, "kernel_launch: workspace too small: %zu < %zu\n", ws_size, (size_t)WS_END); grid = -1; return; }
        int dev = 0, cus = 0, per_cu = 0;
        hipGetDevice(&dev); hipDeviceGetAttribute(&cus, hipDeviceAttributeMultiprocessorCount, dev);
        hipFuncSetAttribute((const void*)mega, hipFuncAttributeMaxDynamicSharedMemorySize, LDS_BYTES);
        hipOccupancyMaxActiveBlocksPerMultiprocessor(&per_cu, (const void*)mega, 512, LDS_BYTES);
        if (per_cu < 1) { fprintf(stderr, "kernel_launch: occupancy query says %d blocks per CU\n", per_cu); per_cu = 1; }
        (void)hipGetLastError();
        grid = cus;
    }
    if (grid < 0) return;
    (void)hipMemsetAsync((unsigned char*)d_ws + WS_BAR, 0, 3456 * 4, stream);
    Params p{};
    p.x = (const float*)d_in[0]; p.c = (const float*)d_in[1]; p.ctx = (const float*)d_in[2]; p.c_ctx = (const float*)d_in[3];
    p.w_ada = (const float*)d_in[4]; p.b_ada = (const float*)d_in[5]; p.norm_g = (const float*)d_in[6];
    p.w1 = (const float*)d_in[7]; p.w3 = (const float*)d_in[8]; p.w2 = (const float*)d_in[9]; p.w_in = (const float*)d_in[10];
    p.conv_w = (const float*)d_in[11]; p.conv_b = (const float*)d_in[12]; p.ln_g = (const float*)d_in[13]; p.ln_b = (const float*)d_in[14];
    p.nat_bias = (const float*)d_in[15]; p.sink = (const float*)d_in[16]; p.w_out = (const float*)d_in[17];
    p.out = (float*)d_out; p.ws = (unsigned char*)d_ws;
#if ONE_LAUNCH
    int ph0 = 0, ph1 = N_PHASES;
    void* args[] = {&p, &ph0, &ph1};
    hipError_t e = hipLaunchCooperativeKernel((const void*)mega, dim3(grid), dim3(512), args, LDS_BYTES, stream);
    if (e != hipSuccess) fprintf(stderr, "cooperative launch failed: %s (grid %d)\n", hipGetErrorString(e), grid);
#else
    for (int ph = 0; ph < N_PHASES; ++ph) {
        int ph0 = ph, ph1 = ph + 1;
        void* args[] = {&p, &ph0, &ph1};
        hipError_t e = hipLaunchCooperativeKernel((const void*)mega, dim3(grid), dim3(512), args, LDS_BYTES, stream);
        if (e != hipSuccess) { fprintf(stderr, "launch %d failed: %s (grid %d)\n", ph, hipGetErrorString(e), grid); break; }
    }
#endif
}
```

```cpp
#include <hip/hip_runtime.h>
#include <hip/hip_cooperative_groups.h>
#include <cstdio>
#include <cstdint>
namespace cg = cooperative_groups;
#ifdef TSUB
#define TS_BEGIN(id) do { if ((TSUB) == (id) && threadIdx.x == 0) { *(volatile __attribute__((address_space(3))) unsigned long long*)(lds + 131080) -= __builtin_amdgcn_s_memrealtime(); } } while (0)
#define TS_END(id)   do { if ((TSUB) == (id) && threadIdx.x == 0) { *(volatile __attribute__((address_space(3))) unsigned long long*)(lds + 131080) += __builtin_amdgcn_s_memrealtime(); } } while (0)
#else
#define TS_BEGIN(id) do {} while (0)
#define TS_END(id) do {} while (0)
#endif
namespace pg8 {
#define PG8_LAS __attribute__((address_space(3)))
typedef unsigned short bf16_t;
typedef short bf16x8 __attribute__((ext_vector_type(8)));
typedef float f32x4 __attribute__((ext_vector_type(4)));
typedef unsigned u32x4 __attribute__((ext_vector_type(4)));
constexpr int BM = 256, BK = 64, HALF = 128, HTB = HALF * BK * 2  , STAGE_BYTES = 8 * HTB, NXCD = 8, WGM = 8;

__host__ __device__ __forceinline__ int lds_byte(int r, int c) { const int st = (r >> 4) * 2 + (c >> 5), rr = r & 15, cc = c & 31, ob = rr * 64 + cc * 2; return st * 1024 + (ob ^ (((ob >> 9) & 1) << 5)); }
__host__ __device__ __forceinline__ void stage_rc(int b, int& R, int& C) { const int st = b / 1024, sb = b % 1024, swz = sb ^ (((sb >> 9) & 1) << 5); R = (st >> 1) * 16 + swz / 64; C = (st & 1) * 32 + (swz % 64) / 2; }
__host__ __device__ __forceinline__ int perm32(int rho) { const int n = rho >> 4, i = rho & 15; return 8 * (i >> 2) + 4 * n + (i & 3); }

struct Unit { int pm, pn; };
struct Gemm { const bf16_t* A; const bf16_t* Bt; int M, N, K, lda, ldb; };

struct StaticOrder {
    int nM, nN, nwg, G, c;
    __host__ __device__ void init(int M, int N, int G_, int c_) { nM = M / BM; nN = N / BM; nwg = nM * nN; G = G_; c = c_; }
    __host__ __device__ bool next(int i, Unit& u) const {
        const long L = (long)i * G + c; if (L >= nwg) return false;
        int wgid = (int)L; { const int q = nwg / NXCD, r = nwg % NXCD, xcd = wgid % NXCD, off = wgid / NXCD; wgid = (xcd < r ? xcd * (q + 1) : r * (q + 1) + (xcd - r) * q) + off; }
        const int nig = WGM * nN, gid = wgid / nig, fm = gid * WGM, gsz = (nM - fm) < WGM ? (nM - fm) : WGM;
        u.pm = fm + ((wgid % nig) % gsz); u.pn = (wgid % nig) / gsz; return true;
    }
    __device__ __forceinline__ void a_ready(const Unit&) const {}
    __device__ __forceinline__ void done(const Unit&) const {}
};
__device__ __forceinline__ unsigned cvt_pk_bf16(float lo, float hi) { unsigned r; asm volatile("v_cvt_pk_bf16_f32 %0, %1, %2" : "=v"(r) : "v"(lo), "v"(hi)); return r; }
typedef float f32x2 __attribute__((ext_vector_type(2)));
template <class Epi, class Sched, bool ALIGN_EPI = false, bool SP2 = false>
__device__ __forceinline__ void gemm_phase(PG8_LAS unsigned char* lds, const Gemm g, const Sched& S, const Epi& E) {
    int tid_ = threadIdx.x; asm volatile("" : "+v"(tid_));
    const int tid = tid_, wid = __builtin_amdgcn_readfirstlane(tid >> 6), lane = tid & 63, wr = wid >> 2, wc = wid & 3, fr = lane & 15, fq = lane >> 4;
    const int K = g.K, nt = K / BK;
    unsigned voffA[2], voffB[2];
#pragma unroll
    for (int i = 0; i < 2; ++i) { int R, C; stage_rc(tid * 16 + i * 8192, R, C); const int Rb = Epi::PERM ? ((R & ~31) + perm32(R & 31)) : R;
        voffA[i] = (unsigned)(R * g.lda + C) * 2u; voffB[i] = (unsigned)(Rb * g.ldb + C) * 2u; }
    const size_t kstep = (size_t)(BK * 2);
    const size_t hstepA = (size_t)HALF * g.lda * 2, hstepB = (size_t)HALF * g.ldb * 2;
    const size_t tstepA = 2 * hstepA, tstepB = 2 * hstepB;
    const unsigned ldsw = (unsigned)wid * 1024u;
    const int aoff = lds_byte(wr * 64 + fr, fq * 8), boff = lds_byte(wc * 32 + fr, fq * 8);
#define PG8_SA(b, h) (((b) * 2 + (h)) * HTB)
#define PG8_SB(b, h) ((4 + (b) * 2 + (h)) * HTB)
#define PG8_STAGE(bufoff, gbase, voff) do { _Pragma("unroll") for (int _i = 0; _i < 2; ++_i) \
        __builtin_amdgcn_global_load_lds((const unsigned*)((const char*)(gbase) + (voff)[_i]), (PG8_LAS unsigned*)(lds + (bufoff) + ldsw + _i * 8192), 16, 0, 0); } while (0)
#define PG8_LDA(dst, b, h) do { _Pragma("unroll") for (int m = 0; m < 4; ++m) _Pragma("unroll") for (int k = 0; k < 2; ++k) dst[m][k] = *(const PG8_LAS bf16x8*)(lds + PG8_SA(b, h) + aoff + m * 2048 + k * 1024); } while (0)
#define PG8_LDB(dst, b, h) do { _Pragma("unroll") for (int n = 0; n < 2; ++n) _Pragma("unroll") for (int k = 0; k < 2; ++k) dst[n][k] = *(const PG8_LAS bf16x8*)(lds + PG8_SB(b, h) + boff + n * 2048 + k * 1024); } while (0)
#define PG8_MMA(ai, bj, At, Bt) do { __builtin_amdgcn_s_setprio(1); _Pragma("unroll") for (int m = 0; m < 4; ++m) _Pragma("unroll") for (int n = 0; n < 2; ++n) _Pragma("unroll") for (int k = 0; k < 2; ++k) \
        acc[ai][bj][m][n] = __builtin_amdgcn_mfma_f32_16x16x32_bf16(Bt[n][k], At[m][k], acc[ai][bj][m][n], 0, 0, 0); __builtin_amdgcn_s_setprio(0); } while (0)
#define PG8_WAIT_V(n) asm volatile("s_waitcnt vmcnt(" #n ")" ::: "memory")
#define PG8_WAIT_L(n) asm volatile("s_waitcnt lgkmcnt(" #n ")" ::: "memory")
#define PG8_BAR __builtin_amdgcn_s_barrier()
#define PG8_SCHED __builtin_amdgcn_sched_barrier(0)
    Unit cur, nxt; int ui = 0;
    if (!S.next(0, cur)) return;
    f32x4 acc[2][2][4][2];
#pragma unroll
    for (int a = 0; a < 2; ++a)
#pragma unroll
        for (int b = 0; b < 2; ++b)
#pragma unroll
            for (int m = 0; m < 4; ++m)
#pragma unroll
                for (int n = 0; n < 2; ++n) acc[a][b][m][n] = (f32x4){0.f, 0.f, 0.f, 0.f};
    bf16x8 At[4][2], B0[2][2], B1[2][2];
    const char* cA = (const char*)g.A + (size_t)cur.pm * tstepA; const char* cB = (const char*)g.Bt + (size_t)cur.pn * tstepB;
    S.a_ready(cur);
    if constexpr (SP2) {
        PG8_STAGE(PG8_SB(0, 0), cB, voffB); PG8_STAGE(PG8_SB(0, 1), cB + hstepB, voffB); PG8_STAGE(PG8_SA(0, 0), cA, voffA); PG8_STAGE(PG8_SA(0, 1), cA + hstepA, voffA);
        if (wr == 1) PG8_BAR;
        PG8_WAIT_V(2); PG8_BAR;
        PG8_STAGE(PG8_SB(1, 0), cB + kstep, voffB); PG8_STAGE(PG8_SA(1, 0), cA + kstep, voffA); PG8_STAGE(PG8_SB(1, 1), cB + hstepB + kstep, voffB);
        PG8_WAIT_V(6); PG8_BAR;
    } else {
        PG8_STAGE(PG8_SB(0, 0), cB, voffB); PG8_STAGE(PG8_SA(0, 0), cA, voffA); PG8_STAGE(PG8_SB(0, 1), cB + hstepB, voffB); PG8_STAGE(PG8_SA(0, 1), cA + hstepA, voffA);
        if (wr == 1) PG8_BAR;
        PG8_WAIT_V(4); PG8_BAR;
        PG8_STAGE(PG8_SB(1, 0), cB + kstep, voffB); PG8_STAGE(PG8_SA(1, 0), cA + kstep, voffA); PG8_STAGE(PG8_SB(1, 1), cB + hstepB + kstep, voffB);
        PG8_WAIT_V(6); PG8_BAR;
    }
    for (;;) {
        const bool has_next = S.next(ui + 1, nxt);
        const char* nA = has_next ? (const char*)g.A + (size_t)nxt.pm * tstepA : cA; const char* nB = has_next ? (const char*)g.Bt + (size_t)nxt.pn * tstepB : cB;
        for (int t = 0; t < nt; t += 2) {
            const bool last = (t == nt - 2);
            const char* a1 = cA + (size_t)(t + 1) * kstep;
            const char* a2 = last ? nA : cA + (size_t)(t + 2) * kstep; const char* b2 = last ? nB : cB + (size_t)(t + 2) * kstep;
            const char* a3 = a2 + kstep; const char* b3 = b2 + kstep;
            if (last && has_next) S.a_ready(nxt);
            if constexpr (SP2) {
            PG8_LDB(B0, 0, 0); PG8_LDB(B1, 0, 1); PG8_SCHED; PG8_LDA(At, 0, 0); PG8_STAGE(PG8_SA(1, 1), a1 + hstepA, voffA);
            PG8_WAIT_V(8); PG8_WAIT_L(0); PG8_BAR; PG8_MMA(0, 0, At, B0); PG8_MMA(0, 1, At, B1); PG8_BAR; PG8_SCHED;
            PG8_LDA(At, 0, 1); PG8_STAGE(PG8_SB(0, 0), b2, voffB); PG8_STAGE(PG8_SB(0, 1), b2 + hstepB, voffB); PG8_STAGE(PG8_SA(0, 0), a2, voffA);
            PG8_WAIT_V(8); PG8_WAIT_L(0); PG8_BAR; PG8_MMA(1, 0, At, B0); PG8_MMA(1, 1, At, B1); PG8_BAR; PG8_SCHED;
            PG8_LDB(B0, 1, 0); PG8_LDB(B1, 1, 1); PG8_SCHED; PG8_LDA(At, 1, 0); PG8_STAGE(PG8_SA(0, 1), a2 + hstepA, voffA);
            PG8_WAIT_V(8); PG8_WAIT_L(0); PG8_BAR; PG8_MMA(0, 0, At, B0); PG8_MMA(0, 1, At, B1); PG8_BAR; PG8_SCHED;
            PG8_LDA(At, 1, 1); PG8_STAGE(PG8_SB(1, 0), b3, voffB); PG8_STAGE(PG8_SB(1, 1), b3 + hstepB, voffB); PG8_STAGE(PG8_SA(1, 0), a3, voffA);
            PG8_WAIT_V(8); PG8_WAIT_L(0); PG8_BAR; PG8_MMA(1, 0, At, B0); PG8_MMA(1, 1, At, B1); PG8_BAR; PG8_SCHED;
            } else {
            PG8_LDB(B0, 0, 0); PG8_SCHED; PG8_LDA(At, 0, 0); PG8_STAGE(PG8_SA(1, 1), a1 + hstepA, voffA);
            PG8_WAIT_L(8); PG8_BAR; PG8_WAIT_L(0); PG8_MMA(0, 0, At, B0); PG8_BAR; PG8_SCHED;
            PG8_LDB(B1, 0, 1); PG8_STAGE(PG8_SB(0, 0), b2, voffB);
            PG8_BAR; PG8_WAIT_L(0); PG8_MMA(0, 1, At, B1); PG8_BAR;
            PG8_LDA(At, 0, 1); PG8_STAGE(PG8_SA(0, 0), a2, voffA);
            PG8_BAR; PG8_WAIT_L(0); PG8_MMA(1, 0, At, B0); PG8_BAR; PG8_SCHED;
            PG8_STAGE(PG8_SB(0, 1), b2 + hstepB, voffB);
            PG8_WAIT_V(6); PG8_BAR; PG8_MMA(1, 1, At, B1); PG8_BAR;
            PG8_LDB(B0, 1, 0); PG8_SCHED; PG8_LDA(At, 1, 0); PG8_STAGE(PG8_SA(0, 1), a2 + hstepA, voffA);
            PG8_WAIT_L(8); PG8_BAR; PG8_WAIT_L(0); PG8_MMA(0, 0, At, B0); PG8_BAR; PG8_SCHED;
            PG8_LDB(B1, 1, 1); PG8_STAGE(PG8_SB(1, 0), b3, voffB);
            PG8_BAR; PG8_WAIT_L(0); PG8_MMA(0, 1, At, B1); PG8_BAR;
            PG8_LDA(At, 1, 1); PG8_STAGE(PG8_SA(1, 0), a3, voffA);
            PG8_BAR; PG8_WAIT_L(0); PG8_MMA(1, 0, At, B0); PG8_BAR; PG8_SCHED;
            PG8_STAGE(PG8_SB(1, 1), b3 + hstepB, voffB);
            PG8_WAIT_V(6); PG8_BAR; PG8_MMA(1, 1, At, B1); PG8_BAR;
            }
        }
        if constexpr (ALIGN_EPI) { if (wr == 0) PG8_BAR; }
        TS_BEGIN(8);
        if constexpr (!Epi::AFTER_DRAIN) { E(acc, cur, wr, wc, fr, fq); S.done(cur); }
        TS_END(8);
        if (!has_next) break;
#pragma unroll
        for (int a = 0; a < 2; ++a)
#pragma unroll
            for (int b = 0; b < 2; ++b)
#pragma unroll
                for (int m = 0; m < 4; ++m)
#pragma unroll
                    for (int n = 0; n < 2; ++n) acc[a][b][m][n] = (f32x4){0.f, 0.f, 0.f, 0.f};
        cur = nxt; cA = nA; cB = nB; ++ui;
        if constexpr (ALIGN_EPI) { if (wr == 1) PG8_BAR; }
    }
    PG8_WAIT_V(0);
    if constexpr (!ALIGN_EPI) { if (wr == 0) PG8_BAR; }
    PG8_BAR;
    if constexpr (Epi::AFTER_DRAIN) { E.fused(acc, cur, wr, wc, fr, fq, lds, wid, lane); S.done(cur); }
#undef PG8_SA
#undef PG8_SB
#undef PG8_STAGE
#undef PG8_LDA
#undef PG8_LDB
#undef PG8_MMA
#undef PG8_WAIT_V
#undef PG8_WAIT_L
#undef PG8_BAR
#undef PG8_SCHED
}
}

#define LAS __attribute__((address_space(3)))
typedef unsigned short bf16_t;
typedef float f32x4 __attribute__((ext_vector_type(4)));
typedef float f32x2 __attribute__((ext_vector_type(2)));
typedef unsigned u32x4 __attribute__((ext_vector_type(4)));
typedef unsigned u32x2 __attribute__((ext_vector_type(2)));
typedef short bf16x8 __attribute__((ext_vector_type(8)));
typedef short bf16x4 __attribute__((ext_vector_type(4)));

constexpr int TL = 32768, TC = 4096, TA = 36864, DM = 1024, FF = 2816, NP = 1792, NMODC = 9216;
constexpr int YC_LD = 1280, DFT_LD = 4160, PQT_LD = 4160, DFTC_LD = 576, PQTC_LD = 576;
constexpr int LDS_BYTES = 131072 + 16;
#ifndef MIXMASK
#define MIXMASK 7
#endif

constexpr float EPSV = 1e-6f;
constexpr float LOG2E = 1.4426950408889634f;

constexpr size_t WS_XC   = 0;
constexpr size_t WS_YH   = WS_XC + (size_t)TC * DM * 4;
constexpr size_t WS_R1   = WS_YH + (size_t)TA * DM * 2;
constexpr size_t WS_PROJ = WS_R1;
constexpr size_t WS_PQT  = WS_PROJ + (size_t)TA * NP * 2;
constexpr size_t WS_PQTC = WS_PQT + (size_t)4096 * PQT_LD * 2;
constexpr size_t WS_YCAT = WS_PQTC + (size_t)4096 * PQTC_LD * 2;
constexpr size_t WS_R1END= WS_YCAT + (size_t)TA * YC_LD * 2;
constexpr size_t WS_W13  = WS_R1END;
constexpr size_t WS_W2T  = WS_W13 + (size_t)4 * 5632 * 1024 * 2;
constexpr size_t WS_WIN  = WS_W2T + (size_t)4 * 1024 * 2816 * 2;
constexpr size_t WS_WOUT = WS_WIN + (size_t)2 * 2304 * 1024 * 2;
constexpr size_t WS_DFT  = WS_WOUT + (size_t)2 * 1024 * YC_LD * 2;
constexpr size_t WS_DFTC = WS_DFT + (size_t)2048 * DFT_LD * 2;
constexpr size_t WS_MOD  = WS_DFTC + (size_t)256 * DFTC_LD * 2;
constexpr size_t WS_ROPE = WS_MOD + (size_t)2 * 17 * NMODC * 4;
constexpr size_t WS_BAR  = WS_ROPE + 64 * 16 * 2 * 4;
constexpr size_t WS_Y2   = WS_BAR + 3456 * 4;
constexpr size_t WS_END  = WS_Y2 + (size_t)TC * DM * 2;
static_assert((size_t)TA * FF * 2 <= WS_R1END - WS_R1, "U must fit in R1");

struct Params {
    const float *x, *c, *ctx, *c_ctx, *w_ada, *b_ada, *norm_g, *w1, *w3, *w2, *w_in, *conv_w, *conv_b, *ln_g, *ln_b, *nat_bias, *sink, *w_out;
    float* out; unsigned char* ws;
};
typedef const __attribute__((address_space(4))) Params CParams;

__device__ __forceinline__ unsigned pk2(float lo, float hi) { return pg8::cvt_pk_bf16(lo, hi); }
__device__ __forceinline__ float bflo(unsigned v) { return __uint_as_float(v << 16); }
__device__ __forceinline__ float bfhi(unsigned v) { return __uint_as_float(v & 0xffff0000u); }
__device__ __forceinline__ int otid() { int t = threadIdx.x; asm volatile("" : "+v"(t)); return t; }
__device__ __forceinline__ int obid() { int t = blockIdx.x; asm volatile("" : "+s"(t)); return t; }
__device__ __forceinline__ float xrow16_max(float x) {
    auto s = __builtin_amdgcn_permlane16_swap(__float_as_uint(x), __float_as_uint(x), false, false);
    x = fmaxf(__uint_as_float(s[0]), __uint_as_float(s[1]));
    auto t = __builtin_amdgcn_permlane32_swap(__float_as_uint(x), __float_as_uint(x), false, false);
    return fmaxf(__uint_as_float(t[0]), __uint_as_float(t[1]));
}
__device__ __forceinline__ float xrow16_sum(float x) {
    auto s = __builtin_amdgcn_permlane16_swap(__float_as_uint(x), __float_as_uint(x), false, false);
    x = __uint_as_float(s[0]) + __uint_as_float(s[1]);
    auto t = __builtin_amdgcn_permlane32_swap(__float_as_uint(x), __float_as_uint(x), false, false);
    return __uint_as_float(t[0]) + __uint_as_float(t[1]);
}
template <int CTRL> __device__ __forceinline__ float dpp_mov(float x) { return __builtin_bit_cast(float, __builtin_amdgcn_mov_dpp(__builtin_bit_cast(int, x), CTRL, 0xf, 0xf, true)); }
__device__ __forceinline__ float wave_sum(float v) {
    v += dpp_mov<0xB1>(v);
    v += dpp_mov<0x4E>(v);
    v += dpp_mov<0x141>(v);
    v += dpp_mov<0x128>(v);
    return xrow16_sum(v);
}
__device__ __forceinline__ float fast_exp2(float x) { return __builtin_amdgcn_exp2f(x); }
__device__ __forceinline__ float fast_rcp(float x) { return __builtin_amdgcn_rcpf(x); }
__device__ __forceinline__ float silu_f(float v) { return v * fast_rcp(1.0f + fast_exp2(-v * LOG2E)); }
__device__ __forceinline__ float sigmoid_f(float v) { return fast_rcp(1.0f + fast_exp2(-v * LOG2E)); }

#define XB_TMO      128
#define XB_XCNT(j)  (256  + 64 * (j))
#define XB_XSUB(j)  (1280 + 64 * (j))
#define XB_XGEN(j)  (2304 + 64 * (j))
#define XB_TOP      3328
#define XB_TOPGEN   3392
#define XCD_BAR_WORDS 3456
#define XB_SPIN_CAP (1u << 18)

__device__ __forceinline__ unsigned xb_ld(unsigned* p)              { return __hip_atomic_load(p, __ATOMIC_RELAXED, __HIP_MEMORY_SCOPE_AGENT); }
__device__ __forceinline__ unsigned xb_add(unsigned* p, unsigned v) { return __hip_atomic_fetch_add(p, v, __ATOMIC_RELAXED, __HIP_MEMORY_SCOPE_AGENT); }
__device__ __forceinline__ unsigned xb_xcc_id() { return (unsigned)__builtin_amdgcn_s_getreg((3 << 11) | 20) & 0xFu; }
#define XB_SPIN(cond, bar) do { unsigned _sp = 0; while (cond) { __builtin_amdgcn_s_sleep(1); \
    if ((++_sp & 255u) == 0u) { if (xb_ld(&(bar)[XB_TMO])) break; if (_sp > XB_SPIN_CAP) { atomicAdd(&(bar)[XB_TMO], 1u); break; } } } } while (0)

struct XcdBarrier {
    unsigned* bar; unsigned x;
    volatile LAS unsigned* st;
};

__device__ __forceinline__ XcdBarrier xcd_barrier_post(unsigned* bar, volatile LAS unsigned* st) {
    XcdBarrier b; b.bar = bar; b.x = xb_xcc_id(); b.st = st;
    if (threadIdx.x == 0) (void)xb_add(&bar[XB_XCNT(b.x)], 1u);
    return b;
}
__device__ __forceinline__ void xcd_barrier_complete(unsigned* bar, unsigned x, unsigned& nloc, unsigned& nx) {
    const unsigned G = gridDim.x * gridDim.y * gridDim.z;
    unsigned sum, cnt, mine, sp = 0u;
    for (;;) {
        sum = 0u; cnt = 0u; mine = 0u;
#pragma unroll
        for (unsigned j = 0; j < 16; ++j) { const unsigned c = xb_ld(&bar[XB_XCNT(j)]); sum += c; cnt += (c > 0u) ? 1u : 0u; mine = (j == x) ? c : mine; }
        if (sum == G) break;
        __builtin_amdgcn_s_sleep(1);
        if ((++sp & 255u) == 0u) { if (xb_ld(&bar[XB_TMO])) break; if (sp > XB_SPIN_CAP) { atomicAdd(&bar[XB_TMO], 1u); break; } }
    }
    nloc = mine > 0u ? mine : 1u; nx = cnt > 0u ? cnt : 1u;
}

__device__ __forceinline__ void xcd_barrier(const XcdBarrier& b) {
    asm volatile("s_waitcnt vmcnt(0)" ::: "memory");
    __syncthreads();
    if (threadIdx.x == 0) {
        unsigned* bar = b.bar;
        __builtin_amdgcn_s_waitcnt(0);
        unsigned nloc = b.st[0], nx = b.st[1];
        if (nloc == 0u) { xcd_barrier_complete(bar, b.x, nloc, nx); b.st[0] = nloc; b.st[1] = nx; }
        const unsigned old = xb_add(&bar[XB_XSUB(b.x)], 1u);
        const unsigned gen = old / nloc;
        if (old + 1u == (gen + 1u) * nloc) {
            __builtin_amdgcn_fence(__ATOMIC_RELEASE, "agent");
            asm volatile("s_waitcnt vmcnt(0)" ::: "memory");
            const unsigned og = xb_add(&bar[XB_TOP], 1u);
            const unsigned tg = og / nx;
            if (og + 1u == (tg + 1u) * nx) xb_add(&bar[XB_TOPGEN], 1u);
            else XB_SPIN(xb_ld(&bar[XB_TOPGEN]) == tg, bar);
            __builtin_amdgcn_fence(__ATOMIC_ACQUIRE, "agent");
            xb_add(&bar[XB_XGEN(b.x)], 1u);
            asm volatile("s_waitcnt vmcnt(0)" ::: "memory");
        } else {
            XB_SPIN(xb_ld(&bar[XB_XGEN(b.x)]) == gen, bar);
            __builtin_amdgcn_fence(__ATOMIC_ACQUIRE, "agent");
            asm volatile("s_waitcnt vmcnt(0)" ::: "memory");
        }
    }
    __syncthreads();
}


struct EpiSwiGLU {
    static constexpr bool PERM = true, AFTER_DRAIN = false;
    bf16_t* U;
    __device__ __forceinline__ void operator()(const f32x4 (&acc)[2][2][4][2], const pg8::Unit& u, int wr, int wc, int fr, int fq) const {
        const int row0 = u.pm * 256 + wr * 64 + fr, col0 = u.pn * 128 + wc * 32 + 8 * fq;
#pragma unroll
        for (int ai = 0; ai < 2; ++ai)
#pragma unroll
            for (int m = 0; m < 4; ++m) {
                bf16_t* rowp = U + (size_t)(row0 + ai * 128 + m * 16) * FF + col0;
                unsigned wv[4];
#pragma unroll
                for (int n = 0; n < 2; ++n)
#pragma unroll
                    for (int h = 0; h < 2; ++h) {
                        const f32x2 g2 = {acc[ai][0][m][n][2 * h], acc[ai][0][m][n][2 * h + 1]}, u2 = {acc[ai][1][m][n][2 * h], acc[ai][1][m][n][2 * h + 1]};
                        const f32x2 t = g2 * (-LOG2E);
                        f32x2 d; d.x = fast_exp2(t.x); d.y = fast_exp2(t.y);
                        d = d + 1.0f;
                        f32x2 r; r.x = fast_rcp(d.x); r.y = fast_rcp(d.y);
                        const f32x2 v = (g2 * u2) * r;
                        wv[n * 2 + h] = pk2(v.x, v.y);
                    }
                u32x4 w; w.x = wv[0]; w.y = wv[1]; w.z = wv[2]; w.w = wv[3];
                *(u32x4*)rowp = w;
            }
    }
};
struct EpiBf16Tile {
    static constexpr bool PERM = true, AFTER_DRAIN = false;
    bf16_t* O; int ldc, row_pn, col_pn;
    __device__ __forceinline__ void operator()(const f32x4 (&acc)[2][2][4][2], const pg8::Unit& u, int wr, int wc, int fr, int fq) const {
        const int row0 = u.pm * 256 + u.pn * row_pn + wr * 64 + fr, col0 = u.pn * col_pn + wc * 32 + 8 * fq;
#pragma unroll
        for (int ai = 0; ai < 2; ++ai)
#pragma unroll
            for (int m = 0; m < 4; ++m) {
                bf16_t* rowp = O + (size_t)(row0 + ai * 128 + m * 16) * ldc + col0;
#pragma unroll
                for (int bj = 0; bj < 2; ++bj) {
                    const f32x4 v0 = acc[ai][bj][m][0], v1 = acc[ai][bj][m][1];
                    u32x4 w; w.x = pk2(v0[0], v0[1]); w.y = pk2(v0[2], v0[3]); w.z = pk2(v1[0], v1[1]); w.w = pk2(v1[2], v1[3]);
                    *(u32x4*)(rowp + bj * 128) = w;
                }
            }
    }
};
struct EpiPQ {
    static constexpr bool PERM = true, AFTER_DRAIN = false;
    bf16_t* PQT; bf16_t* PQTC;
    __device__ __forceinline__ void operator()(const f32x4 (&acc)[2][2][4][2], const pg8::Unit& u, int wr, int wc, int fr, int fq) const {
        const int cl = wc * 32 + 8 * fq;
#pragma unroll
        for (int ai = 0; ai < 2; ++ai)
#pragma unroll
            for (int m = 0; m < 4; ++m) {
                const int mp = u.pm * 256 + ai * 128 + wr * 64 + m * 16 + fr;
                const int g = mp >> 7, pq = (mp >> 6) & 1, cp = mp & 63;
                bf16_t* rowp;
                if (u.pn < 128) { const int b = u.pn >> 3, n0 = (u.pn & 7) * 256; rowp = PQT + (size_t)(b * 256 + g * 64 + cp) * PQT_LD + pq * 2048 + n0 + cl; }
                else { const int b = u.pn - 128; rowp = PQTC + (size_t)(b * 256 + g * 64 + cp) * PQTC_LD + pq * 256 + cl; }
#pragma unroll
                for (int bj = 0; bj < 2; ++bj) {
                    const f32x4 v0 = acc[ai][bj][m][0], v1 = acc[ai][bj][m][1];
                    u32x4 w; w.x = pk2(v0[0], v0[1]); w.y = pk2(v0[2], v0[3]); w.z = pk2(v1[0], v1[1]); w.w = pk2(v1[2], v1[3]);
                    *(u32x4*)(rowp + bj * 128) = w;
                }
            }
    }
};
struct EpiWin {
    static constexpr bool PERM = false, AFTER_DRAIN = false;
    bf16_t* P; const float* rope;
    __device__ __forceinline__ void operator()(const f32x4 (&acc)[2][2][4][2], const pg8::Unit& u, int wr, int wc, int fr, int fq) const {
        const int row0 = u.pm * 256 + wr * 64 + fr, col0 = u.pn * 256 + wc * 32 + 4 * fq;
        const float qs = (u.pn == 2 || u.pn == 5) ? 0.125f * LOG2E : 1.0f;
        const bool lat = u.pm < 128;
#pragma unroll
        for (int ai = 0; ai < 2; ++ai)
#pragma unroll
            for (int m = 0; m < 4; ++m) {
                const int r = row0 + ai * 128 + m * 16;
                bf16_t* rowp = P + (size_t)r * NP + col0;
                const int t = r & 2047;
                const int pos = (wc & 1) ? (t & 63) : (t >> 6);
#pragma unroll
                for (int bj = 0; bj < 2; ++bj) {
                    f32x4 v0 = acc[ai][bj][m][0], v1 = acc[ai][bj][m][1];
                    const bool dorope = lat && (u.pn == 5 || (u.pn == 6 && bj == 0));
                    if (dorope) {
                        const f32x4 cs0 = *(const f32x4*)(rope + (pos * 16 + 4 * fq) * 2), cs1 = *(const f32x4*)(rope + (pos * 16 + 4 * fq) * 2 + 4);
                        const float c0 = cs0[0], s0 = cs0[1], c1 = cs0[2], s1 = cs0[3], c2 = cs1[0], s2 = cs1[1], c3 = cs1[2], s3 = cs1[3];
                        f32x4 a, b;
                        a[0] = v0[0] * c0 - v1[0] * s0; b[0] = v0[0] * s0 + v1[0] * c0;
                        a[1] = v0[1] * c1 - v1[1] * s1; b[1] = v0[1] * s1 + v1[1] * c1;
                        a[2] = v0[2] * c2 - v1[2] * s2; b[2] = v0[2] * s2 + v1[2] * c2;
                        a[3] = v0[3] * c3 - v1[3] * s3; b[3] = v0[3] * s3 + v1[3] * c3;
                        v0 = a; v1 = b;
                    }
                    v0 = v0 * qs; v1 = v1 * qs;
                    u32x2 w0, w1; w0.x = pk2(v0[0], v0[1]); w0.y = pk2(v0[2], v0[3]); w1.x = pk2(v1[0], v1[1]); w1.y = pk2(v1[2], v1[3]);
                    *(u32x2*)(rowp + bj * 128) = w0; *(u32x2*)(rowp + bj * 128 + 16) = w1;
                }
            }
    }
};

struct TrItem { const float* src; bf16_t* dst; int ld_src, ld_dst; };
__device__ __forceinline__ TrItem tr_decode(CParams& p, int it) {
    constexpr int PER_L = 2 * 704 + 2 * 352 + 224 + 160;
    unsigned char* ws = p.ws;
    const int l = it / PER_L; int q = it % PER_L;
    const float* src; bf16_t* dst; int ld_src, ld_dst, col0, k0, r0;
    if (q < 2 * 704) { const int f = q / 704; q %= 704; const int rt = q >> 4, kt = q & 15, R0 = rt * 128, tile = R0 >> 8, bj = (R0 >> 7) & 1;
        src = (bj ? p.w3 : p.w1) + (size_t)(l * 2 + f) * 1024 * FF; ld_src = FF; col0 = 128 * tile; k0 = 64 * kt; dst = (bf16_t*)(ws + WS_W13) + (size_t)(l * 2 + f) * 5632 * 1024; r0 = R0; ld_dst = 1024; }
    else if (q < 2 * 704 + 2 * 352) { q -= 2 * 704; const int f = q / 352; q %= 352; const int rt = q / 44, kt = q % 44;
        src = p.w2 + (size_t)(l * 2 + f) * FF * 1024; ld_src = 1024; col0 = 128 * rt; k0 = 64 * kt; dst = (bf16_t*)(ws + WS_W2T) + (size_t)(l * 2 + f) * 1024 * FF; r0 = 128 * rt; ld_dst = FF; }
    else if (q < 2 * 704 + 2 * 352 + 224) { q -= 2 * 704 + 2 * 352; const int rt = q >> 4, kt = q & 15, R0 = rt * 128;
        src = p.w_in + (size_t)l * 1024 * 2048; ld_src = 2048; col0 = R0 < 512 ? R0 : R0 + 256; k0 = 64 * kt; dst = (bf16_t*)(ws + WS_WIN) + (size_t)l * 2304 * 1024; r0 = R0; ld_dst = 1024; }
    int ks = -1;
    if (q >= 2 * 704 + 2 * 352 + 224) { q -= 2 * 704 + 2 * 352 + 224; const int rt = q / 20, kt = q % 20;
        src = p.w_out + (size_t)l * 1024 * 1024; ld_src = 1024; col0 = 128 * rt; k0 = 64 * kt; ks = kt < 16 ? 64 * kt : 256 + 64 * (kt - 16); dst = (bf16_t*)(ws + WS_WOUT) + (size_t)l * 1024 * YC_LD; r0 = 128 * rt; ld_dst = YC_LD; }
    if (ks < 0) ks = k0;
    TrItem t; t.src = src + (size_t)ks * ld_src + col0; t.dst = dst + (size_t)r0 * ld_dst + k0; t.ld_src = ld_src; t.ld_dst = ld_dst; return t;
}

__device__ __forceinline__ void phase0(CParams& p, LAS unsigned char* lds) {
    const int tid = otid(), wave = tid >> 6, lane = tid & 63;
    unsigned char* ws = p.ws;
    const int bid = obid(), G = gridDim.x;
    TS_BEGIN(9);
    if (bid < 288) {
        LAS float* sS = (LAS float*)lds;
        LAS float* sR = sS + 17 * 1024;
        for (int i = tid; i < 17 * 1024; i += 512) { const float v = (i < 16384) ? p.c[i] : p.c_ctx[i - 16384]; sS[i] = v / (1.0f + __expf(-v)); }
        __syncthreads();
        for (int r = bid; r < 288; r += G) {
            const int l = r / 144, j0 = (r % 144) * 64, k0 = wave * 128;
            float acc[17];
#pragma unroll
            for (int q = 0; q < 17; ++q) acc[q] = 0.f;
            const float* wp = p.w_ada + ((size_t)l * 1024 + k0) * NMODC + j0 + lane;
            float wv[16];
#pragma unroll
            for (int kk = 0; kk < 16; ++kk) wv[kk] = __builtin_nontemporal_load(wp + (size_t)kk * NMODC);
#pragma unroll 1
            for (int kb = 0; kb < 128; kb += 16) {
                float wn[16];
                const int kn = (kb + 16 < 128) ? kb + 16 : kb;
#pragma unroll
                for (int kk = 0; kk < 16; ++kk) wn[kk] = __builtin_nontemporal_load(wp + (size_t)(kn + kk) * NMODC);
#pragma unroll 1
                for (int k4 = 0; k4 < 16; k4 += 4) {
                    const float w0 = k4 == 0 ? wv[0] : (k4 == 4 ? wv[4] : (k4 == 8 ? wv[8] : wv[12]));
                    const float w1 = k4 == 0 ? wv[1] : (k4 == 4 ? wv[5] : (k4 == 8 ? wv[9] : wv[13]));
                    const float w2 = k4 == 0 ? wv[2] : (k4 == 4 ? wv[6] : (k4 == 8 ? wv[10] : wv[14]));
                    const float w3 = k4 == 0 ? wv[3] : (k4 == 4 ? wv[7] : (k4 == 8 ? wv[11] : wv[15]));
#pragma unroll
                    for (int q = 0; q < 17; ++q) { const f32x4 sv = *(const LAS f32x4*)(sS + q * 1024 + k0 + kb + k4);
                        acc[q] += (sv[0] * w0 + sv[1] * w1) + (sv[2] * w2 + sv[3] * w3); }
                }
#pragma unroll
                for (int kk = 0; kk < 16; ++kk) wv[kk] = wn[kk];
            }
#pragma unroll
            for (int q = 0; q < 17; ++q) sR[(wave * 17 + q) * 64 + lane] = acc[q];
            __syncthreads();
            float* MOD = (float*)(ws + WS_MOD);
            for (int o = tid; o < 17 * 64; o += 512) {
                const int q = o >> 6, ln = o & 63; float s = p.b_ada[l * NMODC + j0 + ln];
#pragma unroll
                for (int w = 0; w < 8; ++w) s += sR[(w * 17 + q) * 64 + ln];
                MOD[(size_t)(l * 17 + q) * NMODC + j0 + ln] = s;
            }
            __syncthreads();
        }
    }
    TS_END(9);
    TS_BEGIN(10);
    {
        constexpr int N_TR = 2 * (2 * 704 + 2 * 352 + 224 + 160);
        LAS float* t = (LAS float*)lds;
        const int lk = tid >> 5, lc = (tid & 31) * 4;
        const int sr = tid >> 2, sk = (tid & 3) * 16;
        const bool bal = (G == 256) && (N_TR == 4992);
        int it = bal ? (bid >= 32 ? (bid - 32) * 21 : 4704 + bid * 9) : bid;
        const int step = bal ? 1 : G, tr_end = bal ? it + (bid >= 32 ? 21 : 9) : N_TR;
        f32x4 pre[4]; TrItem cur;
        if (it < tr_end) { cur = tr_decode(p, it);
#pragma unroll
            for (int i = 0; i < 4; ++i) pre[i] = __builtin_nontemporal_load((const f32x4*)(cur.src + (size_t)(lk + 16 * i) * cur.ld_src + lc)); }
        while (it < tr_end) {
#pragma unroll
            for (int i = 0; i < 4; ++i) { LAS float* d = t + (lk + 16 * i) * 129 + lc; d[0] = pre[i][0]; d[1] = pre[i][1]; d[2] = pre[i][2]; d[3] = pre[i][3]; }
            __syncthreads();
            bf16_t* dp = cur.dst + (size_t)sr * cur.ld_dst + sk;
            const int nxt = it + step;
            if (nxt < tr_end) { cur = tr_decode(p, nxt);
#pragma unroll
                for (int i = 0; i < 4; ++i) pre[i] = __builtin_nontemporal_load((const f32x4*)(cur.src + (size_t)(lk + 16 * i) * cur.ld_src + lc)); }
            { const LAS float* s = t + sk * 129 + sr;
              u32x4 o0, o1;
              o0.x = pk2(s[0 * 129], s[1 * 129]); o0.y = pk2(s[2 * 129], s[3 * 129]); o0.z = pk2(s[4 * 129], s[5 * 129]); o0.w = pk2(s[6 * 129], s[7 * 129]);
              o1.x = pk2(s[8 * 129], s[9 * 129]); o1.y = pk2(s[10 * 129], s[11 * 129]); o1.z = pk2(s[12 * 129], s[13 * 129]); o1.w = pk2(s[14 * 129], s[15 * 129]);
              *(u32x4*)dp = o0; *(u32x4*)(dp + 8) = o1; }
            __syncthreads();
            it = nxt;
        }
    }
    TS_END(10);
    TS_BEGIN(11);
    for (int r = bid; r < 256; r += G) {
        const int l = r >> 7, k0 = (r & 127) * 8;
        LAS float* sW = (LAS float*)lds;
        LAS float* sC = sW + 2048;
        for (int i = tid; i < 2048; i += 512) { const int kk = i >> 8, cc = i & 255; sW[i] = p.w_in[((size_t)l * 1024 + k0 + kk) * 2048 + 512 + cc]; }
        if (tid < 64) sC[tid] = cospif((float)tid * (1.0f / 32.0f));
        __syncthreads();
        const int g = tid >> 7, j = tid & 127, jj = j & 63, isS = j >> 6;
        float acc[8];
#pragma unroll
        for (int q = 0; q < 8; ++q) acc[q] = 0.f;
        for (int c = 0; c < 64; ++c) {
            const int mm = (c * jj) & 63; const float tv = sC[isS ? ((mm - 16) & 63) : mm];
#pragma unroll
            for (int q = 0; q < 8; ++q) acc[q] += sW[q * 256 + g * 64 + c] * tv;
        }
        u32x4 o; o.x = pk2(acc[0] * 0.125f, acc[1] * 0.125f); o.y = pk2(acc[2] * 0.125f, acc[3] * 0.125f); o.z = pk2(acc[4] * 0.125f, acc[5] * 0.125f); o.w = pk2(acc[6] * 0.125f, acc[7] * 0.125f);
        *(u32x4*)((bf16_t*)(ws + WS_WIN) + ((size_t)l * 2304 + 1792 + g * 128 + j) * 1024 + k0) = o;
        __syncthreads();
    }
    {
        LAS float* tab = (LAS float*)lds;
        for (int m = tid; m < 2048; m += 512) tab[m] = cospif((float)m * (1.0f / 1024.0f)) * 0.022097086912079608f;
        __syncthreads();
        for (int r = bid; r < 2048 + 256; r += G) {
            if (r < 2048) {
                float v[8];
#pragma unroll
                for (int e = 0; e < 8; ++e) { const int k = tid * 8 + e, idx = (r * (k & 2047)) & 2047; v[e] = tab[k < 2048 ? idx : ((idx + 512) & 2047)]; }
                u32x4 o; o.x = pk2(v[0], v[1]); o.y = pk2(v[2], v[3]); o.z = pk2(v[4], v[5]); o.w = pk2(v[6], v[7]);
                *(u32x4*)((bf16_t*)(ws + WS_DFT) + (size_t)r * DFT_LD + tid * 8) = o;
            } else if (tid < 64) {
                const int np = r - 2048; const float sc = 2.8284271247461903f;
                float v[8];
#pragma unroll
                for (int e = 0; e < 8; ++e) { const int k = tid * 8 + e, idx = ((np * (k & 255)) & 255) * 8; v[e] = tab[k < 256 ? idx : ((idx + 512) & 2047)] * sc; }
                u32x4 o; o.x = pk2(v[0], v[1]); o.y = pk2(v[2], v[3]); o.z = pk2(v[4], v[5]); o.w = pk2(v[6], v[7]);
                *(u32x4*)((bf16_t*)(ws + WS_DFTC) + (size_t)np * DFTC_LD + tid * 8) = o;
            }
        }
        __syncthreads();
    }
    TS_END(11);
    if (bid == G - 1) {
        float* rtab = (float*)(ws + WS_ROPE);
        for (int e = tid; e < 1024; e += 512) { const int pos = e >> 4, i = e & 15;
            const float inv = fast_exp2(-(float)i * (13.287712379549449f / 16.0f));
            const float tt = (float)pos * inv * 0.3183098861837907f;
            rtab[2 * e] = cospif(tt); rtab[2 * e + 1] = sinpif(tt); }
    }
}

struct EwRow { f32x4 x[4]; u32x2 y[4]; u32x2 y2[4]; };
__device__ __forceinline__ void ew_load(EwRow& r, const float* xin_lat, const float* xin_ctx, const bf16_t* Yp, const bf16_t* Y2p, int t, int lane) {
    const float* xr = t < TL ? xin_lat + (size_t)t * DM : xin_ctx + (size_t)(t - TL) * DM;
#pragma unroll
    for (int j = 0; j < 4; ++j) r.x[j] = __builtin_nontemporal_load((const f32x4*)(xr + 4 * lane + 256 * j));
    if (Yp) {
#pragma unroll
        for (int j = 0; j < 4; ++j) r.y[j] = __builtin_nontemporal_load((const u32x2*)(Yp + (size_t)t * DM + 4 * lane + 256 * j));
        if (t >= TL) {
#pragma unroll
            for (int j = 0; j < 4; ++j) r.y2[j] = __builtin_nontemporal_load((const u32x2*)(Y2p + (size_t)(t - TL) * DM + 4 * lane + 256 * j));
        }
    }
}
__device__ __forceinline__ void ew_pass(const float* xin_lat, const float* xin_ctx, float* xout_lat, float* xout_ctx, const bf16_t* Yp, const bf16_t* Y2p, const float* gpost, float fac, const float* gate,
                                        bf16_t* Hp, const float* gpre, const float* shift, const float* scale, int nrows) {
    const int tid = otid(); const int wave = tid >> 6, lane = tid & 63;
    const int per = nrows / gridDim.x, tbeg = obid() * per + wave, tend = obid() * per + per;
    f32x4 vgp[4], vgt[4], vpre[4], vsh[4], vsc[4];
#pragma unroll
    for (int j = 0; j < 4; ++j) { vgp[j] = Yp ? *(const f32x4*)(gpost + 4 * lane + 256 * j) : (f32x4){0.f, 0.f, 0.f, 0.f}; vpre[j] = Hp ? *(const f32x4*)(gpre + 4 * lane + 256 * j) : (f32x4){0.f, 0.f, 0.f, 0.f};
        vgt[j] = vsh[j] = vsc[j] = (f32x4){0.f, 0.f, 0.f, 0.f}; }
    int bcur = -1;
    EwRow A, B;
    auto process = [&](EwRow& r, int t) {
        const bool lat = t < TL; const int b = lat ? (t >> 11) : 16;
        if (b != bcur) { bcur = b;
#pragma unroll
            for (int j = 0; j < 4; ++j) { const int cidx = 4 * lane + 256 * j;
                if (Yp) vgt[j] = *(const f32x4*)(gate + (size_t)b * NMODC + cidx) * fac;
                if (Hp) { vsh[j] = *(const f32x4*)(shift + (size_t)b * NMODC + cidx); vsc[j] = *(const f32x4*)(scale + (size_t)b * NMODC + cidx) + 1.0f; } } }
        if (Yp) {
            f32x4 y[4]; float ss = 0.f;
#pragma unroll
            for (int j = 0; j < 4; ++j) { const u32x2 w = r.y[j];
                y[j][0] = bflo(w.x); y[j][1] = bfhi(w.x); y[j][2] = bflo(w.y); y[j][3] = bfhi(w.y);
                if (!lat) { const u32x2 w2 = r.y2[j]; y[j][0] += bflo(w2.x); y[j][1] += bfhi(w2.x); y[j][2] += bflo(w2.y); y[j][3] += bfhi(w2.y); }
                ss += (y[j][0] * y[j][0] + y[j][1] * y[j][1]) + (y[j][2] * y[j][2] + y[j][3] * y[j][3]); }
            const float rstd = 1.0f / sqrtf(wave_sum(ss) * (1.0f / DM) + EPSV);
#pragma unroll
            for (int j = 0; j < 4; ++j) r.x[j] = r.x[j] + vgt[j] * (y[j] * rstd * vgp[j]);
        }
        float* xo = lat ? (xout_lat ? xout_lat + (size_t)t * DM : nullptr) : (xout_ctx ? xout_ctx + (size_t)(t - TL) * DM : nullptr);
        if (xo) {
#pragma unroll
            for (int j = 0; j < 4; ++j) __builtin_nontemporal_store(r.x[j], (f32x4*)(xo + 4 * lane + 256 * j));
        }
        if (Hp) {
            float ss = 0.f;
#pragma unroll
            for (int j = 0; j < 4; ++j) ss += (r.x[j][0] * r.x[j][0] + r.x[j][1] * r.x[j][1]) + (r.x[j][2] * r.x[j][2] + r.x[j][3] * r.x[j][3]);
            const float rstd = 1.0f / sqrtf(wave_sum(ss) * (1.0f / DM) + EPSV);
#pragma unroll
            for (int j = 0; j < 4; ++j) { const f32x4 h = (r.x[j] * rstd * vpre[j]) * vsc[j] + vsh[j];
                u32x2 w; w.x = pk2(h[0], h[1]); w.y = pk2(h[2], h[3]);
                *(u32x2*)(Hp + (size_t)t * DM + 4 * lane + 256 * j) = w; }
        }
    };
    int t = tbeg;
    if (t < tend) ew_load(A, xin_lat, xin_ctx, Yp, Y2p, t, lane);
    while (t < tend) {
        const int tn = t + 8;
        if (tn < tend) ew_load(B, xin_lat, xin_ctx, Yp, Y2p, tn, lane);
        process(A, t);
        const int tnn = tn + 8;
        if (tnn < tend) ew_load(A, xin_lat, xin_ctx, Yp, Y2p, tnn, lane);
        if (tn < tend) process(B, tn);
        t = tnn;
    }
}

__device__ __forceinline__ void conv_item(CParams& p, LAS unsigned char* lds, int l, int s, int tb) {
    const int tid = otid(), wave = tid >> 6, lane = tid & 63;
    const bf16_t* PROJ = (const bf16_t*)(p.ws + WS_PROJ); bf16_t* YCAT = (bf16_t*)(p.ws + WS_YCAT);
    LAS float* sA = (LAS float*)lds;
    const int tokbase = s < 16 ? s * 2048 : TL + (s - 16) * 256, len = s < 16 ? 2048 : 256, t0 = tb * 64;
    {
        u32x4 ua[6], ug[6];
#pragma unroll
        for (int i = 0; i < 6; ++i) {
            const int u = tid + 512 * i, rr = u >> 5, c8 = (u & 31) * 8, tt = t0 - 15 + rr;
            ua[i] = (u32x4){0u, 0u, 0u, 0u}; ug[i] = (u32x4){0u, 0u, 0u, 0u};
            if (u < 94 * 32 && tt >= 0 && tt < len) { const bf16_t* rp = PROJ + (size_t)(tokbase + tt) * NP + c8; ua[i] = *(const u32x4*)rp; ug[i] = *(const u32x4*)(rp + 256); }
        }
#pragma unroll
        for (int i = 0; i < 6; ++i) {
            const int u = tid + 512 * i, rr = u >> 5, c8 = (u & 31) * 8;
            if (u < 94 * 32) {
                float v[8];
                v[0] = bflo(ua[i].x) * sigmoid_f(bflo(ug[i].x)); v[1] = bfhi(ua[i].x) * sigmoid_f(bfhi(ug[i].x));
                v[2] = bflo(ua[i].y) * sigmoid_f(bflo(ug[i].y)); v[3] = bfhi(ua[i].y) * sigmoid_f(bfhi(ug[i].y));
                v[4] = bflo(ua[i].z) * sigmoid_f(bflo(ug[i].z)); v[5] = bfhi(ua[i].z) * sigmoid_f(bfhi(ug[i].z));
                v[6] = bflo(ua[i].w) * sigmoid_f(bflo(ug[i].w)); v[7] = bfhi(ua[i].w) * sigmoid_f(bfhi(ug[i].w));
                *(LAS f32x4*)(sA + rr * 256 + c8) = (f32x4){v[0], v[1], v[2], v[3]};
                *(LAS f32x4*)(sA + rr * 256 + c8 + 4) = (f32x4){v[4], v[5], v[6], v[7]};
            }
        }
    }
    __syncthreads();
    TS_BEGIN(7);
    const int cp = tid & 127, oc = tid >> 7;
    f32x2 out2[2][8];
    {
        f32x2 w2[31];
#pragma unroll
        for (int j = 0; j < 31; ++j) w2[j] = *(const f32x2*)(p.conv_w + ((size_t)l * 31 + j) * 256 + 2 * cp);
        const f32x2 bias2 = *(const f32x2*)(p.conv_b + l * 256 + 2 * cp);
#pragma unroll
        for (int ps = 0; ps < 2; ++ps) {
            const LAS float* ap = sA + ((oc * 2 + ps) * 8) * 256 + 2 * cp;
            f32x2 in2[38];
#pragma unroll
            for (int i = 0; i < 38; ++i) in2[i] = *(const LAS f32x2*)(ap + i * 256);
#pragma unroll
            for (int q = 0; q < 8; ++q) {
                f32x2 acc = bias2;
#pragma unroll
                for (int j = 0; j < 31; ++j) acc = in2[q + j] * w2[j] + acc;
                out2[ps][q] = acc;
            }
        }
    }
    TS_END(7);
    __syncthreads();
#pragma unroll
    for (int ps = 0; ps < 2; ++ps)
#pragma unroll
        for (int q = 0; q < 8; ++q) *(LAS f32x2*)(sA + ((oc * 2 + ps) * 8 + q) * 256 + 2 * cp) = out2[ps][q];
    __syncthreads();
    {
        const f32x4 lg = *(const f32x4*)(p.ln_g + l * 256 + 4 * lane), lb = *(const f32x4*)(p.ln_b + l * 256 + 4 * lane);
#pragma unroll
        for (int q = 0; q < 8; ++q) {
            const int tok = wave * 8 + q;
            const f32x4 v = *(const LAS f32x4*)(sA + tok * 256 + 4 * lane);
            const float mean = wave_sum((v[0] + v[1]) + (v[2] + v[3])) * (1.0f / 256.0f);
            const f32x4 d = v - mean;
            const float var = wave_sum((d[0] * d[0] + d[1] * d[1]) + (d[2] * d[2] + d[3] * d[3])) * (1.0f / 256.0f);
            const float rstd = 1.0f / sqrtf(var + EPSV);
            const f32x4 yn = d * rstd * lg + lb;
            u32x2 o; o.x = pk2(silu_f(yn[0]), silu_f(yn[1])); o.y = pk2(silu_f(yn[2]), silu_f(yn[3]));
            *(u32x2*)(YCAT + (size_t)(tokbase + t0 + tok) * YC_LD + 4 * lane) = o;
        }
    }
    __syncthreads();
}

struct AttnItem {
    int mode;
    int qtok0;
    int qcol0, qcol1, ocol0, ocol1;
    int kcol0, kcol1, vcol0, vcol1; int nslots;
    int nloc, loctok0;
    int ctxtok0;
    int r, rs;
    int q0, kp0;
    int has_sink; float sink0, sink1;
    int h0;
};
constexpr int KROW = 72;
constexpr int KV_BYTES = 64 * KROW * 2;
constexpr int ABUF_BYTES = 4 * KV_BYTES;
typedef short s16x4 __attribute__((ext_vector_type(4)));
template <int OFF> __device__ __forceinline__ s16x4 tr_read(unsigned addr) {
    s16x4 r; asm volatile("ds_read_b64_tr_b16 %0, %1 offset:%2" : "=&v"(r) : "v"(addr), "i"(OFF) : "memory"); return r;
}
template <int NKB>
__device__ __forceinline__ void attn_chunk(const LAS unsigned char* kt, const LAS unsigned char* vt, int kofs, const bf16x8 (&qf)[2], int fr, int fq,
                                           int mtype, int a0, const LAS float* bt, float& mrun, float& lsum, f32x4 (&o)[4]) {
    const unsigned vaddr = (unsigned)(size_t)vt + (unsigned)(((kofs + 4 * fq + (fr >> 2)) * KROW + 4 * (fr & 3)) * 2);
    s16x4 vl[NKB / 2][4], vh[NKB / 2][4];
#pragma unroll
    for (int grp = 0; grp < NKB / 2; ++grp) {
        const unsigned va = vaddr + (unsigned)(grp * 32 * KROW * 2);
        vl[grp][0] = tr_read<0>(va);  vh[grp][0] = tr_read<16 * KROW * 2>(va);
        vl[grp][1] = tr_read<32>(va); vh[grp][1] = tr_read<16 * KROW * 2 + 32>(va);
        vl[grp][2] = tr_read<64>(va); vh[grp][2] = tr_read<16 * KROW * 2 + 64>(va);
        vl[grp][3] = tr_read<96>(va); vh[grp][3] = tr_read<16 * KROW * 2 + 96>(va);
    }
    f32x4 sacc[NKB];
    const int kc0 = (fq ^ (((kofs + fr) >> 1) & 7)) * 16;
    const LAS unsigned char* krow = kt + (kofs + fr) * 128;
    const LAS unsigned char* kp0 = krow + kc0;
    const LAS unsigned char* kp1 = krow + (kc0 ^ 64);
#pragma unroll
    for (int kb = 0; kb < NKB; ++kb) {
        sacc[kb] = (f32x4){0.f, 0.f, 0.f, 0.f};
        const bf16x8 a0v = *(const LAS bf16x8*)(kp0 + 16 * kb * 128);
        const bf16x8 a1v = *(const LAS bf16x8*)(kp1 + 16 * kb * 128);
        sacc[kb] = __builtin_amdgcn_mfma_f32_16x16x32_bf16(a0v, qf[0], sacc[kb], 0, 0, 0);
        sacc[kb] = __builtin_amdgcn_mfma_f32_16x16x32_bf16(a1v, qf[1], sacc[kb], 0, 0, 0);
    }
    if (mtype == 1) {
        const int wsx = min(max(a0 - 8, 0), 48);
        const int lo = wsx - (kofs + 4 * fq);
        const LAS float* bl = bt + (kofs + 4 * fq - a0 + 63);
#pragma unroll
        for (int kb = 0; kb < NKB; ++kb)
#pragma unroll
            for (int j = 0; j < 4; ++j) { const bool ok = (unsigned)(16 * kb + j - lo) < 16u;
                sacc[kb][j] = ok ? sacc[kb][j] + bl[16 * kb + j] : -1.0e30f; }
    } else if (mtype == 2) {
        const int db = a0 + kofs + 4 * fq + 128;
#pragma unroll
        for (int kb = 0; kb < NKB; ++kb)
#pragma unroll
            for (int j = 0; j < 4; ++j) { const bool ok = (unsigned)(db + 16 * kb + j) <= 256u;
                sacc[kb][j] = ok ? sacc[kb][j] : -1.0e30f; }
    }
    float cm = sacc[0][0];
#pragma unroll
    for (int kb = 0; kb < NKB; ++kb)
#pragma unroll
        for (int j = 0; j < 4; ++j) cm = fmaxf(cm, sacc[kb][j]);
    cm = xrow16_max(cm);
    const float mnew = fmaxf(mrun, cm);
    if (__any(mnew > mrun)) {
        const float alpha = fast_exp2(mrun - mnew);
        lsum *= alpha;
#pragma unroll
        for (int db = 0; db < 4; ++db) o[db] = o[db] * alpha;
        mrun = mnew;
    }
    float ps = 0.f;
#pragma unroll
    for (int kb = 0; kb < NKB; ++kb)
#pragma unroll
        for (int j = 0; j < 4; ++j) { sacc[kb][j] = fast_exp2(sacc[kb][j] - mnew); ps += sacc[kb][j]; }
    lsum += ps;
    asm volatile("s_waitcnt lgkmcnt(0)" ::: "memory"); __builtin_amdgcn_sched_barrier(0);
#define ATT_PK(L, H) (bf16x8){L[0], L[1], L[2], L[3], H[0], H[1], H[2], H[3]}
#pragma unroll
    for (int grp = 0; grp < NKB / 2; ++grp) {
        union { bf16x8 v; unsigned u[4]; } pb;
        pb.u[0] = pk2(sacc[2 * grp][0], sacc[2 * grp][1]); pb.u[1] = pk2(sacc[2 * grp][2], sacc[2 * grp][3]);
        pb.u[2] = pk2(sacc[2 * grp + 1][0], sacc[2 * grp + 1][1]); pb.u[3] = pk2(sacc[2 * grp + 1][2], sacc[2 * grp + 1][3]);
#pragma unroll
        for (int db = 0; db < 4; ++db) o[db] = __builtin_amdgcn_mfma_f32_16x16x32_bf16(ATT_PK(vl[grp][db], vh[grp][db]), pb.v, o[db], 0, 0, 0);
    }
#undef ATT_PK
}

__device__ __forceinline__ void attn_item(CParams& p, LAS unsigned char* lds, int l, const AttnItem& it) {
    const int tid = otid(), wave = tid >> 6, lane = tid & 63, g = wave >> 2, wq = wave & 3, fr = lane & 15, fq = lane >> 4;
    const bf16_t* PROJ = (const bf16_t*)(p.ws + WS_PROJ); bf16_t* YCAT = (bf16_t*)(p.ws + WS_YCAT);
    LAS float* sB = (LAS float*)(lds + 2 * ABUF_BYTES);
    const int slot = it.nslots == 2 ? g : 0;
    if (it.mode == 0) { for (int i = tid; i < 2 * 15 * 128; i += 512) { const int h = i / 1920, rem = i % 1920, dr = rem >> 7, dc = (rem & 127) - 48;
            sB[i] = (dc >= 0 && dc < 31) ? p.nat_bias[(size_t)(l * 4 + it.h0 + h) * 465 + dr * 31 + dc] * LOG2E : 0.f; } }
    bf16x8 qf[2];
    { const bf16_t* qp = PROJ + (size_t)(it.qtok0 + wq * 16 + fr) * NP + (g ? it.qcol1 : it.qcol0) + 8 * fq;
      qf[0] = *(const bf16x8*)qp; qf[1] = *(const bf16x8*)(qp + 32); }
    float mrun = -3.0e38f, lsum = 0.f;
    f32x4 o[4];
#pragma unroll
    for (int db = 0; db < 4; ++db) o[db] = (f32x4){0.f, 0.f, 0.f, 0.f};
    const int nchunks = 4 + it.nloc;
    const int srow = tid >> 3, sseg = tid & 7;
    u32x4 kreg[2], vreg[2];
    auto chunk_tok = [&](int c) { return c < 4 ? it.ctxtok0 + 64 * c : it.loctok0 + 64 * (c - 4); };
    auto gload = [&](int c) {
        const bf16_t* rp = PROJ + (size_t)(chunk_tok(c) + srow) * NP + 8 * sseg;
#pragma unroll
        for (int s = 0; s < 2; ++s) if (s < it.nslots) { kreg[s] = *(const u32x4*)(rp + (s ? it.kcol1 : it.kcol0)); vreg[s] = *(const u32x4*)(rp + (s ? it.vcol1 : it.vcol0)); }
    };
    auto lwrite = [&](int c) {
        LAS unsigned char* bufk = lds + (c & 1) * ABUF_BYTES + srow * 128 + ((sseg ^ ((srow >> 1) & 7)) * 16);
        LAS unsigned char* bufv = lds + (c & 1) * ABUF_BYTES + 2 * KV_BYTES + (srow * KROW + 8 * sseg) * 2;
#pragma unroll
        for (int s = 0; s < 2; ++s) if (s < it.nslots) { *(LAS u32x4*)(bufk + s * KV_BYTES) = kreg[s]; *(LAS u32x4*)(bufv + s * KV_BYTES) = vreg[s]; }
    };
    gload(0); lwrite(0);
    if (nchunks > 1) gload(1);
    __syncthreads();
    TS_BEGIN(5);
    const int qi = wq * 16 + fr;
    const int nat_kofs = min(max(16 * wq - 8, 0), 32);
    for (int c = 0; c < nchunks; ++c) {
        if (c + 1 < nchunks) lwrite(c + 1);
        if (c + 2 < nchunks) gload(c + 2);
        const LAS unsigned char* kt = lds + (c & 1) * ABUF_BYTES + slot * KV_BYTES;
        const LAS unsigned char* vt = kt + 2 * KV_BYTES;
        if (c >= 4 && it.mode == 0) {
            const int dr = (it.rs + (c - 4)) - it.r + 7;
            attn_chunk<2>(kt, vt, nat_kofs, qf, fr, fq, 1, qi, sB + g * 1920 + dr * 128, mrun, lsum, o);
        } else if (c >= 4 && it.mode == 1) {
            attn_chunk<4>(kt, vt, 0, qf, fr, fq, 2, it.kp0 + 64 * (c - 4) - (it.q0 + qi), sB, mrun, lsum, o);
        } else {
            attn_chunk<4>(kt, vt, 0, qf, fr, fq, 0, 0, sB, mrun, lsum, o);
        }
        __syncthreads();
    }
    TS_END(5);
    lsum = xrow16_sum(lsum);
    if (it.has_sink) lsum += fast_exp2((g ? it.sink1 : it.sink0) * LOG2E - mrun);
    const float inv = 1.0f / lsum;
    bf16_t* op = YCAT + (size_t)(it.qtok0 + wq * 16 + fr) * YC_LD + (g ? it.ocol1 : it.ocol0) + 4 * fq;
#pragma unroll
    for (int db = 0; db < 4; ++db) { u32x2 w; w.x = pk2(o[db][0] * inv, o[db][1] * inv); w.y = pk2(o[db][2] * inv, o[db][3] * inv); *(u32x2*)(op + 16 * db) = w; }
}

constexpr int C_UA = 0, C_QN = 512, C_KN = 768, C_VN = 1024, C_QS = 1280, C_KS = 1536, C_VS = 1664;

__device__ __forceinline__ void mix_items(CParams& p, LAS unsigned char* lds, int l, int sub) {
    const int n_attn = (l == 0) ? 2304 : 2048;
    const int n_conv = (l == 0) ? 512 + 64 : 512;
    const int start = (obid() + 128) % gridDim.x;
    for (int i = start; i < n_attn + n_conv; i += gridDim.x) {
        if (i >= n_attn) {
            if (!(sub & 4)) continue;
            const int ci = i - n_attn;
            TS_BEGIN(3);
            if (ci < 512) conv_item(p, lds, l, ci >> 5, ci & 31);
            else { const int cj = ci - 512; conv_item(p, lds, l, 16 + (cj >> 2), cj & 3); }
            TS_END(3);
            continue;
        }
        AttnItem it{};
        if (i < 1024) {
            const int b = i >> 6, r = (i >> 1) & 31, hp = i & 1;
            it.mode = 0; it.qtok0 = b * 2048 + r * 64; it.nslots = 2; it.h0 = 2 * hp;
            { const int h = 2 * hp; it.qcol0 = C_QN + 64 * h; it.kcol0 = C_KN + 64 * h; it.vcol0 = C_VN + 64 * h; it.ocol0 = 512 + 64 * h;
              it.qcol1 = it.qcol0 + 64; it.kcol1 = it.kcol0 + 64; it.vcol1 = it.vcol0 + 64; it.ocol1 = it.ocol0 + 64; }
            it.r = r; it.rs = min(max(r - 4, 0), 24); it.nloc = 8; it.loctok0 = b * 2048 + it.rs * 64; it.ctxtok0 = TL + b * 256;
        } else if (i < 2048) {
            const int k = i - 1024, b = k >> 6, qb = (k >> 1) & 31, kvh = k & 1;
            it.mode = 1; it.qtok0 = b * 2048 + qb * 64; it.nslots = 1;
            { const int h = 2 * kvh; it.qcol0 = C_QS + 64 * h; it.ocol0 = 768 + 64 * h; it.sink0 = p.sink[l * 4 + h]; it.sink1 = p.sink[l * 4 + h + 1];
              it.qcol1 = it.qcol0 + 64; it.ocol1 = it.ocol0 + 64; it.kcol0 = it.kcol1 = C_KS + 64 * kvh; it.vcol0 = it.vcol1 = C_VS + 64 * kvh; }
            it.has_sink = 1; it.q0 = qb * 64;
            const int ks = max(qb * 64 - 128, 0), ke = min(qb * 64 + 192, 2048);
            it.kp0 = ks; it.nloc = (ke - ks) >> 6; it.loctok0 = b * 2048 + ks; it.ctxtok0 = TL + b * 256;
        } else if (i < 2176) {
            const int k = i - 2048, b = k >> 3, qb = (k >> 1) & 3, hp = k & 1;
            it.mode = 2; it.qtok0 = TL + b * 256 + qb * 64; it.nslots = 2;
            { const int h = 2 * hp; it.qcol0 = C_QN + 64 * h; it.kcol0 = C_KN + 64 * h; it.vcol0 = C_VN + 64 * h; it.ocol0 = 512 + 64 * h;
              it.qcol1 = it.qcol0 + 64; it.kcol1 = it.kcol0 + 64; it.vcol1 = it.vcol0 + 64; it.ocol1 = it.ocol0 + 64; }
            it.nloc = 0; it.ctxtok0 = TL + b * 256;
        } else {
            const int k = i - 2176, b = k >> 3, qb = (k >> 1) & 3, kvh = k & 1;
            it.mode = 2; it.qtok0 = TL + b * 256 + qb * 64; it.nslots = 1;
            { const int h = 2 * kvh; it.qcol0 = C_QS + 64 * h; it.ocol0 = 768 + 64 * h; it.sink0 = p.sink[l * 4 + h]; it.sink1 = p.sink[l * 4 + h + 1];
              it.qcol1 = it.qcol0 + 64; it.ocol1 = it.ocol0 + 64; it.kcol0 = it.kcol1 = C_KS + 64 * kvh; it.vcol0 = it.vcol1 = C_VS + 64 * kvh; }
            it.has_sink = 1; it.nloc = 0; it.ctxtok0 = TL + b * 256;
        }
        TS_BEGIN(2);
        if (sub & 2) attn_item(p, lds, l, it);
        TS_END(2);
    }
}

constexpr int N_PHASES = 22;
#ifndef PHMASK
#define PHMASK 0xff
#endif

__device__ __forceinline__ void run_phase(CParams& p, LAS unsigned char* lds, int ph, int sub) {
    unsigned char* ws = p.ws;
    bf16_t* YH = (bf16_t*)(ws + WS_YH); bf16_t* U = (bf16_t*)(ws + WS_R1); bf16_t* PROJ = (bf16_t*)(ws + WS_PROJ); bf16_t* YCAT = (bf16_t*)(ws + WS_YCAT);
    float* XC = (float*)(ws + WS_XC); const float* MOD = (const float*)(ws + WS_MOD);
    const int G = gridDim.x, c = obid();
    if (ph == 0) { if constexpr ((PHMASK & 1) != 0) phase0(p, lds); return; }
    if (ph == 1) {
        if constexpr ((PHMASK & 2) == 0) return;
        ew_pass(p.x, p.ctx, nullptr, nullptr, nullptr, nullptr, nullptr, 0.f, nullptr, YH, p.norm_g, MOD, MOD + 1024, TA); return;
    }
    const int l = (ph - 2) / 10, k = (ph - 2) % 10;
    const float* MODL = MOD + (size_t)l * 17 * NMODC; const float* NG = p.norm_g + (size_t)l * 6 * DM;
    const int rows_late = (l == 0) ? TA : TL;
    switch (k) {
    case 0: case 7: {
        if constexpr ((PHMASK & 4) == 0) break;
        const int f = (k == 7), M = f ? rows_late : TA;
        pg8::Gemm g{YH, (const bf16_t*)(ws + WS_W13) + (size_t)(l * 2 + f) * 5632 * 1024, M, 5632, 1024, 1024, 1024};
        pg8::StaticOrder S; S.init(M, 5632, G, c); EpiSwiGLU E{U};
        pg8::gemm_phase<EpiSwiGLU, pg8::StaticOrder, true, true>(lds, g, S, E);
    } break;
    case 1: case 8: case 5: {
        if constexpr ((PHMASK & 8) == 0) break;
        const bool isout = (k == 5); const int f = (k == 8), M = (k == 1) ? TA : rows_late;
        const int Kd = isout ? YC_LD : FF;
        const bf16_t* Ap = isout ? YCAT : U;
        const bf16_t* Bp = isout ? (const bf16_t*)(ws + WS_WOUT) + (size_t)l * 1024 * YC_LD : (const bf16_t*)(ws + WS_W2T) + (size_t)(l * 2 + f) * 1024 * FF;
        for (int v = 0; v < (M == TA ? 3 : 1); ++v) {
            pg8::Gemm g = v == 0 ? pg8::Gemm{Ap, Bp, TL, 1024, Kd, Kd, Kd}
                                 : pg8::Gemm{Ap + (size_t)TL * Kd + (v - 1) * (Kd / 2), Bp + (v - 1) * (Kd / 2), TC, 1024, Kd / 2, Kd, Kd};
            pg8::StaticOrder S; S.init(g.M, 1024, G, v == 2 ? (c + G - 64) % G : c);
            EpiBf16Tile E{v == 0 ? YH : (v == 1 ? YH + (size_t)TL * DM : (bf16_t*)(ws + WS_Y2)), 1024, 0, 256};
            pg8::gemm_phase<EpiBf16Tile, pg8::StaticOrder, true, true>(lds, g, S, E);
        }
    } break;
    case 2: case 6: case 9: {
        if constexpr ((PHMASK & 2) == 0) break;
        const int gi = (k == 2) ? 2 : (k == 6 ? 5 : 8), ni = (k == 2) ? 1 : (k == 6 ? 3 : 5);
        const int nrows = (k == 2) ? TA : rows_late;
        const bool lastl = (k == 9 && l == 1);
        const float* gpre = (k == 2) ? NG + 2 * DM : (k == 6 ? NG + 4 * DM : p.norm_g + 6 * DM);
        const float* shift = (k == 2) ? MODL + 3 * 1024 : (k == 6 ? MODL + 6 * 1024 : MOD + 17 * NMODC);
        const float* scale = (k == 2) ? MODL + 4 * 1024 : (k == 6 ? MODL + 7 * 1024 : MOD + 17 * NMODC + 1024);
        float* outp = p.out;
        const bool first = (l == 0 && k == 2);
        ew_pass(first ? p.x : outp, first ? p.ctx : XC, outp, XC, YH, (const bf16_t*)(ws + WS_Y2), NG + ni * DM, (k == 6) ? 1.0f : 0.5f, MODL + gi * 1024, lastl ? nullptr : YH, gpre, shift, scale, nrows);
    } break;
    case 3: {
        if constexpr ((PHMASK & 16) == 0) break;
        const bf16_t* W = (const bf16_t*)(ws + WS_WIN) + (size_t)l * 2304 * 1024;
        { pg8::Gemm g{YH, W, TA, NP, 1024, 1024, 1024}; pg8::StaticOrder S; S.init(TA, NP, G, c); EpiWin E{PROJ, (const float*)(ws + WS_ROPE)};
          pg8::gemm_phase<EpiWin, pg8::StaticOrder, true, true>(lds, g, S, E); }
        { const int N = (l == 0) ? TA : TL; pg8::Gemm g{W + (size_t)1792 * 1024, YH, 512, N, 1024, 1024, 1024}; pg8::StaticOrder S; S.init(512, N, G, (c + 16) % G);
          EpiPQ E{(bf16_t*)(ws + WS_PQT), (bf16_t*)(ws + WS_PQTC)};
          pg8::gemm_phase<EpiPQ, pg8::StaticOrder, true, true>(lds, g, S, E); }
    } break;
    case 4: {
        if constexpr ((PHMASK & 32) == 0) break;
        TS_BEGIN(1);
        if (sub & 1)
        for (int v = 0; v < ((l == 0) ? 4 : 2); ++v) {
            const int hs = v & 1, isc = v >> 1;
            const bf16_t* Ap = isc ? (const bf16_t*)(ws + WS_DFTC) + hs * 256 : (const bf16_t*)(ws + WS_DFT) + hs * 2048;
            const bf16_t* Bp = isc ? (const bf16_t*)(ws + WS_PQTC) + hs * 256 : (const bf16_t*)(ws + WS_PQT) + hs * 2048;
            pg8::Gemm g{Ap, Bp, isc ? 256 : 2048, 4096, isc ? 256 : 2048, isc ? DFTC_LD : DFT_LD, isc ? PQTC_LD : PQT_LD};
            pg8::StaticOrder S; S.init(g.M, g.N, G, isc ? (c + G - 16 * hs) % G : (c + G - 128 * hs) % G);
            EpiBf16Tile E{YCAT + (isc ? (size_t)TL * YC_LD : 0) + (hs ? 1024 : 256), YC_LD, isc ? 256 : 2048, 0};
            pg8::gemm_phase<EpiBf16Tile, pg8::StaticOrder, true, true>(lds, g, S, E);
        }
        TS_END(1);
        if (sub & 6) mix_items(p, lds, l, sub);
    } break;
    }
}

__global__ void __launch_bounds__(512, 2) mega(Params p, int ph0, int ph1) {
    extern __shared__ __attribute__((aligned(16))) unsigned char lds_raw[];
    LAS unsigned char* lds = (LAS unsigned char*)lds_raw;
    cg::grid_group grid = cg::this_grid();
    if (ph1 < 0) grid.sync();
    volatile LAS unsigned* xst = (volatile LAS unsigned*)(lds + 131072);
    if (threadIdx.x < 4) xst[threadIdx.x] = 0u;
    __syncthreads();
    XcdBarrier xb = xcd_barrier_post((unsigned*)(p.ws + WS_BAR), xst);
#ifdef TPROBE
    unsigned long long tacc = 0, tprev = __builtin_amdgcn_s_memrealtime();
#endif
    for (int ph = ph0; ph < ph1; ++ph) {
        CParams* q = (CParams*)__builtin_amdgcn_kernarg_segment_ptr(); asm volatile("" : "+s"(q));
        run_phase(*q, lds, ph, 7);
#ifdef DUPK
        { const int kind = ph == 0 ? 10 : (ph == 1 ? 11 : (ph - 2) % 10);
          if ((DUPK >> kind) & 1) { xcd_barrier(xb); run_phase(*q, lds, ph, DUPSUB); } }
#endif
        if (ph + 1 < ph1) xcd_barrier(xb);
#ifdef TPROBE
        { const unsigned long long now = __builtin_amdgcn_s_memrealtime(); const int kind = ph == 0 ? 10 : (ph == 1 ? 11 : (ph - 2) % 10);
          if ((TPROBE >> kind) & 1) tacc += now - tprev; tprev = now; }
#endif
    }
#ifdef TPROBE
    if (blockIdx.x == 0 && threadIdx.x == 0) { const unsigned long long t0 = __builtin_amdgcn_s_memrealtime(); while (__builtin_amdgcn_s_memrealtime() - t0 < tacc) __builtin_amdgcn_s_sleep(8); }
#endif
#ifdef TSUB
    if (blockIdx.x == 0 && threadIdx.x == 0) { const unsigned long long tacc2 = *(volatile LAS unsigned long long*)(lds + 131080); const unsigned long long t0 = __builtin_amdgcn_s_memrealtime(); while (__builtin_amdgcn_s_memrealtime() - t0 < 4ull * tacc2) __builtin_amdgcn_s_sleep(8); }
#endif
#ifdef XSYNC
    for (int i = 0; i < XSYNC; ++i) xcd_barrier(xb);
#endif
}

#ifndef ONE_LAUNCH
#define ONE_LAUNCH 1
#endif

extern "C" void kernel_launch(void* const* d_in, const int* in_sizes, int n_in, void* d_out, int out_size, void* d_ws, size_t ws_size, hipStream_t stream) {
    static int grid = 0;
    if (grid == 0) {
        if (ws_size < WS_END) { fprintf(stderr, "kernel_launch: workspace too small: %zu < %zu\n", ws_size, (size_t)WS_END); grid = -1; return; }
        int dev = 0, cus = 0, per_cu = 0;
        hipGetDevice(&dev); hipDeviceGetAttribute(&cus, hipDeviceAttributeMultiprocessorCount, dev);
        hipFuncSetAttribute((const void*)mega, hipFuncAttributeMaxDynamicSharedMemorySize, LDS_BYTES);
        hipOccupancyMaxActiveBlocksPerMultiprocessor(&per_cu, (const void*)mega, 512, LDS_BYTES);
        if (per_cu < 1) { fprintf(stderr, "kernel_launch: occupancy query says %d blocks per CU\n", per_cu); per_cu = 1; }
        (void)hipGetLastError();
        grid = cus;
    }
    if (grid < 0) return;
    (void)hipMemsetAsync((unsigned char*)d_ws + WS_BAR, 0, 3456 * 4, stream);
    Params p{};
    p.x = (const float*)d_in[0]; p.c = (const float*)d_in[1]; p.ctx = (const float*)d_in[2]; p.c_ctx = (const float*)d_in[3];
    p.w_ada = (const float*)d_in[4]; p.b_ada = (const float*)d_in[5]; p.norm_g = (const float*)d_in[6];
    p.w1 = (const float*)d_in[7]; p.w3 = (const float*)d_in[8]; p.w2 = (const float*)d_in[9]; p.w_in = (const float*)d_in[10];
    p.conv_w = (const float*)d_in[11]; p.conv_b = (const float*)d_in[12]; p.ln_g = (const float*)d_in[13]; p.ln_b = (const float*)d_in[14];
    p.nat_bias = (const float*)d_in[15]; p.sink = (const float*)d_in[16]; p.w_out = (const float*)d_in[17];
    p.out = (float*)d_out; p.ws = (unsigned char*)d_ws;
#if ONE_LAUNCH
    int ph0 = 0, ph1 = N_PHASES;
    void* args[] = {&p, &ph0, &ph1};
    hipError_t e = hipLaunchCooperativeKernel((const void*)mega, dim3(grid), dim3(512), args, LDS_BYTES, stream);
    if (e != hipSuccess) fprintf(stderr, "cooperative launch failed: %s (grid %d)\n", hipGetErrorString(e), grid);
#else
    for (int ph = 0; ph < N_PHASES; ++ph) {
        int ph0 = ph, ph1 = ph + 1;
        void* args[] = {&p, &ph0, &ph1};
        hipError_t e = hipLaunchCooperativeKernel((const void*)mega, dim3(grid), dim3(512), args, LDS_BYTES, stream);
        if (e != hipSuccess) { fprintf(stderr, "launch %d failed: %s (grid %d)\n", ph, hipGetErrorString(e), grid); break; }
    }
#endif
}
```

```cpp
#include <hip/hip_runtime.h>
#include <hip/hip_cooperative_groups.h>
#include <cstdio>
#include <cstdint>
namespace cg = cooperative_groups;
#ifdef TSUB
#define TS_BEGIN(id) do { if ((TSUB) == (id) && threadIdx.x == 0) { *(volatile __attribute__((address_space(3))) unsigned long long*)(lds + 131080) -= __builtin_amdgcn_s_memrealtime(); } } while (0)
#define TS_END(id)   do { if ((TSUB) == (id) && threadIdx.x == 0) { *(volatile __attribute__((address_space(3))) unsigned long long*)(lds + 131080) += __builtin_amdgcn_s_memrealtime(); } } while (0)
#else
#define TS_BEGIN(id) do {} while (0)
#define TS_END(id) do {} while (0)
#endif
namespace pg8 {
#define PG8_LAS __attribute__((address_space(3)))
typedef unsigned short bf16_t;
typedef short bf16x8 __attribute__((ext_vector_type(8)));
typedef float f32x4 __attribute__((ext_vector_type(4)));
typedef unsigned u32x4 __attribute__((ext_vector_type(4)));
constexpr int BM = 256, BK = 64, HALF = 128, HTB = HALF * BK * 2  , STAGE_BYTES = 8 * HTB, NXCD = 8, WGM = 8;

__host__ __device__ __forceinline__ int lds_byte(int r, int c) { const int st = (r >> 4) * 2 + (c >> 5), rr = r & 15, cc = c & 31, ob = rr * 64 + cc * 2; return st * 1024 + (ob ^ (((ob >> 9) & 1) << 5)); }
__host__ __device__ __forceinline__ void stage_rc(int b, int& R, int& C) { const int st = b / 1024, sb = b % 1024, swz = sb ^ (((sb >> 9) & 1) << 5); R = (st >> 1) * 16 + swz / 64; C = (st & 1) * 32 + (swz % 64) / 2; }
__host__ __device__ __forceinline__ int perm32(int rho) { const int n = rho >> 4, i = rho & 15; return 8 * (i >> 2) + 4 * n + (i & 3); }

struct Unit { int pm, pn; };
struct Gemm { const bf16_t* A; const bf16_t* Bt; int M, N, K, lda, ldb; };

struct StaticOrder {
    int nM, nN, nwg, G, c;
    __host__ __device__ void init(int M, int N, int G_, int c_) { nM = M / BM; nN = N / BM; nwg = nM * nN; G = G_; c = c_; }
    __host__ __device__ bool next(int i, Unit& u) const {
        const long L = (long)i * G + c; if (L >= nwg) return false;
        int wgid = (int)L; { const int q = nwg / NXCD, r = nwg % NXCD, xcd = wgid % NXCD, off = wgid / NXCD; wgid = (xcd < r ? xcd * (q + 1) : r * (q + 1) + (xcd - r) * q) + off; }
        const int nig = WGM * nN, gid = wgid / nig, fm = gid * WGM, gsz = (nM - fm) < WGM ? (nM - fm) : WGM;
        u.pm = fm + ((wgid % nig) % gsz); u.pn = (wgid % nig) / gsz; return true;
    }
    __device__ __forceinline__ void a_ready(const Unit&) const {}
    __device__ __forceinline__ void done(const Unit&) const {}
};
__device__ __forceinline__ unsigned cvt_pk_bf16(float lo, float hi) { unsigned r; asm volatile("v_cvt_pk_bf16_f32 %0, %1, %2" : "=v"(r) : "v"(lo), "v"(hi)); return r; }
typedef float f32x2 __attribute__((ext_vector_type(2)));
template <class Epi, class Sched, bool ALIGN_EPI = false, bool SP2 = false>
__device__ __forceinline__ void gemm_phase(PG8_LAS unsigned char* lds, const Gemm g, const Sched& S, const Epi& E) {
    int tid_ = threadIdx.x; asm volatile("" : "+v"(tid_));
    const int tid = tid_, wid = __builtin_amdgcn_readfirstlane(tid >> 6), lane = tid & 63, wr = wid >> 2, wc = wid & 3, fr = lane & 15, fq = lane >> 4;
    const int K = g.K, nt = K / BK;
    unsigned voffA[2], voffB[2];
#pragma unroll
    for (int i = 0; i < 2; ++i) { int R, C; stage_rc(tid * 16 + i * 8192, R, C); const int Rb = Epi::PERM ? ((R & ~31) + perm32(R & 31)) : R;
        voffA[i] = (unsigned)(R * g.lda + C) * 2u; voffB[i] = (unsigned)(Rb * g.ldb + C) * 2u; }
    const size_t kstep = (size_t)(BK * 2);
    const size_t hstepA = (size_t)HALF * g.lda * 2, hstepB = (size_t)HALF * g.ldb * 2;
    const size_t tstepA = 2 * hstepA, tstepB = 2 * hstepB;
    const unsigned ldsw = (unsigned)wid * 1024u;
    const int aoff = lds_byte(wr * 64 + fr, fq * 8), boff = lds_byte(wc * 32 + fr, fq * 8);
#define PG8_SA(b, h) (((b) * 2 + (h)) * HTB)
#define PG8_SB(b, h) ((4 + (b) * 2 + (h)) * HTB)
#define PG8_STAGE(bufoff, gbase, voff) do { _Pragma("unroll") for (int _i = 0; _i < 2; ++_i) \
        __builtin_amdgcn_global_load_lds((const unsigned*)((const char*)(gbase) + (voff)[_i]), (PG8_LAS unsigned*)(lds + (bufoff) + ldsw + _i * 8192), 16, 0, 0); } while (0)
#define PG8_LDA(dst, b, h) do { _Pragma("unroll") for (int m = 0; m < 4; ++m) _Pragma("unroll") for (int k = 0; k < 2; ++k) dst[m][k] = *(const PG8_LAS bf16x8*)(lds + PG8_SA(b, h) + aoff + m * 2048 + k * 1024); } while (0)
#define PG8_LDB(dst, b, h) do { _Pragma("unroll") for (int n = 0; n < 2; ++n) _Pragma("unroll") for (int k = 0; k < 2; ++k) dst[n][k] = *(const PG8_LAS bf16x8*)(lds + PG8_SB(b, h) + boff + n * 2048 + k * 1024); } while (0)
#define PG8_MMA(ai, bj, At, Bt) do { __builtin_amdgcn_s_setprio(1); _Pragma("unroll") for (int m = 0; m < 4; ++m) _Pragma("unroll") for (int n = 0; n < 2; ++n) _Pragma("unroll") for (int k = 0; k < 2; ++k) \
        acc[ai][bj][m][n] = __builtin_amdgcn_mfma_f32_16x16x32_bf16(Bt[n][k], At[m][k], acc[ai][bj][m][n], 0, 0, 0); __builtin_amdgcn_s_setprio(0); } while (0)
#define PG8_WAIT_V(n) asm volatile("s_waitcnt vmcnt(" #n ")" ::: "memory")
#define PG8_WAIT_L(n) asm volatile("s_waitcnt lgkmcnt(" #n ")" ::: "memory")
#define PG8_BAR __builtin_amdgcn_s_barrier()
#define PG8_SCHED __builtin_amdgcn_sched_barrier(0)
    Unit cur, nxt; int ui = 0;
    if (!S.next(0, cur)) return;
    f32x4 acc[2][2][4][2];
#pragma unroll
    for (int a = 0; a < 2; ++a)
#pragma unroll
        for (int b = 0; b < 2; ++b)
#pragma unroll
            for (int m = 0; m < 4; ++m)
#pragma unroll
                for (int n = 0; n < 2; ++n) acc[a][b][m][n] = (f32x4){0.f, 0.f, 0.f, 0.f};
    bf16x8 At[4][2], B0[2][2], B1[2][2];
    const char* cA = (const char*)g.A + (size_t)cur.pm * tstepA; const char* cB = (const char*)g.Bt + (size_t)cur.pn * tstepB;
    S.a_ready(cur);
    if constexpr (SP2) {
        PG8_STAGE(PG8_SB(0, 0), cB, voffB); PG8_STAGE(PG8_SB(0, 1), cB + hstepB, voffB); PG8_STAGE(PG8_SA(0, 0), cA, voffA); PG8_STAGE(PG8_SA(0, 1), cA + hstepA, voffA);
        if (wr == 1) PG8_BAR;
        PG8_WAIT_V(2); PG8_BAR;
        PG8_STAGE(PG8_SB(1, 0), cB + kstep, voffB); PG8_STAGE(PG8_SA(1, 0), cA + kstep, voffA); PG8_STAGE(PG8_SB(1, 1), cB + hstepB + kstep, voffB);
        PG8_WAIT_V(6); PG8_BAR;
    } else {
        PG8_STAGE(PG8_SB(0, 0), cB, voffB); PG8_STAGE(PG8_SA(0, 0), cA, voffA); PG8_STAGE(PG8_SB(0, 1), cB + hstepB, voffB); PG8_STAGE(PG8_SA(0, 1), cA + hstepA, voffA);
        if (wr == 1) PG8_BAR;
        PG8_WAIT_V(4); PG8_BAR;
        PG8_STAGE(PG8_SB(1, 0), cB + kstep, voffB); PG8_STAGE(PG8_SA(1, 0), cA + kstep, voffA); PG8_STAGE(PG8_SB(1, 1), cB + hstepB + kstep, voffB);
        PG8_WAIT_V(6); PG8_BAR;
    }
    for (;;) {
        const bool has_next = S.next(ui + 1, nxt);
        const char* nA = has_next ? (const char*)g.A + (size_t)nxt.pm * tstepA : cA; const char* nB = has_next ? (const char*)g.Bt + (size_t)nxt.pn * tstepB : cB;
        for (int t = 0; t < nt; t += 2) {
            const bool last = (t == nt - 2);
            const char* a1 = cA + (size_t)(t + 1) * kstep;
            const char* a2 = last ? nA : cA + (size_t)(t + 2) * kstep; const char* b2 = last ? nB : cB + (size_t)(t + 2) * kstep;
            const char* a3 = a2 + kstep; const char* b3 = b2 + kstep;
            if (last && has_next) S.a_ready(nxt);
            if constexpr (SP2) {
            PG8_LDB(B0, 0, 0); PG8_LDB(B1, 0, 1); PG8_SCHED; PG8_LDA(At, 0, 0); PG8_STAGE(PG8_SA(1, 1), a1 + hstepA, voffA);
            PG8_WAIT_V(8); PG8_WAIT_L(0); PG8_BAR; PG8_MMA(0, 0, At, B0); PG8_MMA(0, 1, At, B1); PG8_BAR; PG8_SCHED;
            PG8_LDA(At, 0, 1); PG8_STAGE(PG8_SB(0, 0), b2, voffB); PG8_STAGE(PG8_SB(0, 1), b2 + hstepB, voffB); PG8_STAGE(PG8_SA(0, 0), a2, voffA);
            PG8_WAIT_V(8); PG8_WAIT_L(0); PG8_BAR; PG8_MMA(1, 0, At, B0); PG8_MMA(1, 1, At, B1); PG8_BAR; PG8_SCHED;
            PG8_LDB(B0, 1, 0); PG8_LDB(B1, 1, 1); PG8_SCHED; PG8_LDA(At, 1, 0); PG8_STAGE(PG8_SA(0, 1), a2 + hstepA, voffA);
            PG8_WAIT_V(8); PG8_WAIT_L(0); PG8_BAR; PG8_MMA(0, 0, At, B0); PG8_MMA(0, 1, At, B1); PG8_BAR; PG8_SCHED;
            PG8_LDA(At, 1, 1); PG8_STAGE(PG8_SB(1, 0), b3, voffB); PG8_STAGE(PG8_SB(1, 1), b3 + hstepB, voffB); PG8_STAGE(PG8_SA(1, 0), a3, voffA);
            PG8_WAIT_V(8); PG8_WAIT_L(0); PG8_BAR; PG8_MMA(1, 0, At, B0); PG8_MMA(1, 1, At, B1); PG8_BAR; PG8_SCHED;
            } else {
            PG8_LDB(B0, 0, 0); PG8_SCHED; PG8_LDA(At, 0, 0); PG8_STAGE(PG8_SA(1, 1), a1 + hstepA, voffA);
            PG8_WAIT_L(8); PG8_BAR; PG8_WAIT_L(0); PG8_MMA(0, 0, At, B0); PG8_BAR; PG8_SCHED;
            PG8_LDB(B1, 0, 1); PG8_STAGE(PG8_SB(0, 0), b2, voffB);
            PG8_BAR; PG8_WAIT_L(0); PG8_MMA(0, 1, At, B1); PG8_BAR;
            PG8_LDA(At, 0, 1); PG8_STAGE(PG8_SA(0, 0), a2, voffA);
            PG8_BAR; PG8_WAIT_L(0); PG8_MMA(1, 0, At, B0); PG8_BAR; PG8_SCHED;
            PG8_STAGE(PG8_SB(0, 1), b2 + hstepB, voffB);
            PG8_WAIT_V(6); PG8_BAR; PG8_MMA(1, 1, At, B1); PG8_BAR;
            PG8_LDB(B0, 1, 0); PG8_SCHED; PG8_LDA(At, 1, 0); PG8_STAGE(PG8_SA(0, 1), a2 + hstepA, voffA);
            PG8_WAIT_L(8); PG8_BAR; PG8_WAIT_L(0); PG8_MMA(0, 0, At, B0); PG8_BAR; PG8_SCHED;
            PG8_LDB(B1, 1, 1); PG8_STAGE(PG8_SB(1, 0), b3, voffB);
            PG8_BAR; PG8_WAIT_L(0); PG8_MMA(0, 1, At, B1); PG8_BAR;
            PG8_LDA(At, 1, 1); PG8_STAGE(PG8_SA(1, 0), a3, voffA);
            PG8_BAR; PG8_WAIT_L(0); PG8_MMA(1, 0, At, B0); PG8_BAR; PG8_SCHED;
            PG8_STAGE(PG8_SB(1, 1), b3 + hstepB, voffB);
            PG8_WAIT_V(6); PG8_BAR; PG8_MMA(1, 1, At, B1); PG8_BAR;
            }
        }
        if constexpr (ALIGN_EPI) { if (wr == 0) PG8_BAR; }
        TS_BEGIN(8);
        if constexpr (!Epi::AFTER_DRAIN) { E(acc, cur, wr, wc, fr, fq); S.done(cur); }
        TS_END(8);
        if (!has_next) break;
#pragma unroll
        for (int a = 0; a < 2; ++a)
#pragma unroll
            for (int b = 0; b < 2; ++b)
#pragma unroll
                for (int m = 0; m < 4; ++m)
#pragma unroll
                    for (int n = 0; n < 2; ++n) acc[a][b][m][n] = (f32x4){0.f, 0.f, 0.f, 0.f};
        cur = nxt; cA = nA; cB = nB; ++ui;
        if constexpr (ALIGN_EPI) { if (wr == 1) PG8_BAR; }
    }
    PG8_WAIT_V(0);
    if constexpr (!ALIGN_EPI) { if (wr == 0) PG8_BAR; }
    PG8_BAR;
    if constexpr (Epi::AFTER_DRAIN) { E.fused(acc, cur, wr, wc, fr, fq, lds, wid, lane); S.done(cur); }
#undef PG8_SA
#undef PG8_SB
#undef PG8_STAGE
#undef PG8_LDA
#undef PG8_LDB
#undef PG8_MMA
#undef PG8_WAIT_V
#undef PG8_WAIT_L
#undef PG8_BAR
#undef PG8_SCHED
}
}

#define LAS __attribute__((address_space(3)))
typedef unsigned short bf16_t;
typedef float f32x4 __attribute__((ext_vector_type(4)));
typedef float f32x2 __attribute__((ext_vector_type(2)));
typedef unsigned u32x4 __attribute__((ext_vector_type(4)));
typedef unsigned u32x2 __attribute__((ext_vector_type(2)));
typedef short bf16x8 __attribute__((ext_vector_type(8)));
typedef short bf16x4 __attribute__((ext_vector_type(4)));

constexpr int TL = 32768, TC = 4096, TA = 36864, DM = 1024, FF = 2816, NP = 1792, NMODC = 9216;
constexpr int YC_LD = 1280, DFT_LD = 4160, PQT_LD = 4160, DFTC_LD = 576, PQTC_LD = 576;
constexpr int LDS_BYTES = 131072 + 16;
#ifndef MIXMASK
#define MIXMASK 7
#endif

constexpr float EPSV = 1e-6f;
constexpr float LOG2E = 1.4426950408889634f;

constexpr size_t WS_XC   = 0;
constexpr size_t WS_YH   = WS_XC + (size_t)TC * DM * 4;
constexpr size_t WS_R1   = WS_YH + (size_t)TA * DM * 2;
constexpr size_t WS_PROJ = WS_R1;
constexpr size_t WS_PQT  = WS_PROJ + (size_t)TA * NP * 2;
constexpr size_t WS_PQTC = WS_PQT + (size_t)4096 * PQT_LD * 2;
constexpr size_t WS_YCAT = WS_PQTC + (size_t)4096 * PQTC_LD * 2;
constexpr size_t WS_R1END= WS_YCAT + (size_t)TA * YC_LD * 2;
constexpr size_t WS_W13  = WS_R1END;
constexpr size_t WS_W2T  = WS_W13 + (size_t)4 * 5632 * 1024 * 2;
constexpr size_t WS_WIN  = WS_W2T + (size_t)4 * 1024 * 2816 * 2;
constexpr size_t WS_WOUT = WS_WIN + (size_t)2 * 2304 * 1024 * 2;
constexpr size_t WS_DFT  = WS_WOUT + (size_t)2 * 1024 * YC_LD * 2;
constexpr size_t WS_DFTC = WS_DFT + (size_t)2048 * DFT_LD * 2;
constexpr size_t WS_MOD  = WS_DFTC + (size_t)256 * DFTC_LD * 2;
constexpr size_t WS_ROPE = WS_MOD + (size_t)2 * 17 * NMODC * 4;
constexpr size_t WS_BAR  = WS_ROPE + 64 * 16 * 2 * 4;
constexpr size_t WS_Y2   = WS_BAR + 3456 * 4;
constexpr size_t WS_END  = WS_Y2 + (size_t)TC * DM * 2;
static_assert((size_t)TA * FF * 2 <= WS_R1END - WS_R1, "U must fit in R1");

struct Params {
    const float *x, *c, *ctx, *c_ctx, *w_ada, *b_ada, *norm_g, *w1, *w3, *w2, *w_in, *conv_w, *conv_b, *ln_g, *ln_b, *nat_bias, *sink, *w_out;
    float* out; unsigned char* ws;
};
typedef const __attribute__((address_space(4))) Params CParams;

__device__ __forceinline__ unsigned pk2(float lo, float hi) { return pg8::cvt_pk_bf16(lo, hi); }
__device__ __forceinline__ float bflo(unsigned v) { return __uint_as_float(v << 16); }
__device__ __forceinline__ float bfhi(unsigned v) { return __uint_as_float(v & 0xffff0000u); }
__device__ __forceinline__ int otid() { int t = threadIdx.x; asm volatile("" : "+v"(t)); return t; }
__device__ __forceinline__ int obid() { int t = blockIdx.x; asm volatile("" : "+s"(t)); return t; }
__device__ __forceinline__ float xrow16_max(float x) {
    auto s = __builtin_amdgcn_permlane16_swap(__float_as_uint(x), __float_as_uint(x), false, false);
    x = fmaxf(__uint_as_float(s[0]), __uint_as_float(s[1]));
    auto t = __builtin_amdgcn_permlane32_swap(__float_as_uint(x), __float_as_uint(x), false, false);
    return fmaxf(__uint_as_float(t[0]), __uint_as_float(t[1]));
}
__device__ __forceinline__ float xrow16_sum(float x) {
    auto s = __builtin_amdgcn_permlane16_swap(__float_as_uint(x), __float_as_uint(x), false, false);
    x = __uint_as_float(s[0]) + __uint_as_float(s[1]);
    auto t = __builtin_amdgcn_permlane32_swap(__float_as_uint(x), __float_as_uint(x), false, false);
    return __uint_as_float(t[0]) + __uint_as_float(t[1]);
}
template <int CTRL> __device__ __forceinline__ float dpp_mov(float x) { return __builtin_bit_cast(float, __builtin_amdgcn_mov_dpp(__builtin_bit_cast(int, x), CTRL, 0xf, 0xf, true)); }
__device__ __forceinline__ float wave_sum(float v) {
    v += dpp_mov<0xB1>(v);
    v += dpp_mov<0x4E>(v);
    v += dpp_mov<0x141>(v);
    v += dpp_mov<0x128>(v);
    return xrow16_sum(v);
}
__device__ __forceinline__ float fast_exp2(float x) { return __builtin_amdgcn_exp2f(x); }
__device__ __forceinline__ float fast_rcp(float x) { return __builtin_amdgcn_rcpf(x); }
__device__ __forceinline__ float silu_f(float v) { return v * fast_rcp(1.0f + fast_exp2(-v * LOG2E)); }
__device__ __forceinline__ float sigmoid_f(float v) { return fast_rcp(1.0f + fast_exp2(-v * LOG2E)); }

#define XB_TMO      128
#define XB_XCNT(j)  (256  + 64 * (j))
#define XB_XSUB(j)  (1280 + 64 * (j))
#define XB_XGEN(j)  (2304 + 64 * (j))
#define XB_TOP      3328
#define XB_TOPGEN   3392
#define XCD_BAR_WORDS 3456
#define XB_SPIN_CAP (1u << 18)

__device__ __forceinline__ unsigned xb_ld(unsigned* p)              { return __hip_atomic_load(p, __ATOMIC_RELAXED, __HIP_MEMORY_SCOPE_AGENT); }
__device__ __forceinline__ unsigned xb_add(unsigned* p, unsigned v) { return __hip_atomic_fetch_add(p, v, __ATOMIC_RELAXED, __HIP_MEMORY_SCOPE_AGENT); }
__device__ __forceinline__ unsigned xb_xcc_id() { return (unsigned)__builtin_amdgcn_s_getreg((3 << 11) | 20) & 0xFu; }
#define XB_SPIN(cond, bar) do { unsigned _sp = 0; while (cond) { __builtin_amdgcn_s_sleep(1); \
    if ((++_sp & 255u) == 0u) { if (xb_ld(&(bar)[XB_TMO])) break; if (_sp > XB_SPIN_CAP) { atomicAdd(&(bar)[XB_TMO], 1u); break; } } } } while (0)

struct XcdBarrier {
    unsigned* bar; unsigned x;
    volatile LAS unsigned* st;
};

__device__ __forceinline__ XcdBarrier xcd_barrier_post(unsigned* bar, volatile LAS unsigned* st) {
    XcdBarrier b; b.bar = bar; b.x = xb_xcc_id(); b.st = st;
    if (threadIdx.x == 0) (void)xb_add(&bar[XB_XCNT(b.x)], 1u);
    return b;
}
__device__ __forceinline__ void xcd_barrier_complete(unsigned* bar, unsigned x, unsigned& nloc, unsigned& nx) {
    const unsigned G = gridDim.x * gridDim.y * gridDim.z;
    unsigned sum, cnt, mine, sp = 0u;
    for (;;) {
        sum = 0u; cnt = 0u; mine = 0u;
#pragma unroll
        for (unsigned j = 0; j < 16; ++j) { const unsigned c = xb_ld(&bar[XB_XCNT(j)]); sum += c; cnt += (c > 0u) ? 1u : 0u; mine = (j == x) ? c : mine; }
        if (sum == G) break;
        __builtin_amdgcn_s_sleep(1);
        if ((++sp & 255u) == 0u) { if (xb_ld(&bar[XB_TMO])) break; if (sp > XB_SPIN_CAP) { atomicAdd(&bar[XB_TMO], 1u); break; } }
    }
    nloc = mine > 0u ? mine : 1u; nx = cnt > 0u ? cnt : 1u;
}

__device__ __forceinline__ void xcd_barrier(const XcdBarrier& b) {
    asm volatile("s_waitcnt vmcnt(0)" ::: "memory");
    __syncthreads();
    if (threadIdx.x == 0) {
        unsigned* bar = b.bar;
        __builtin_amdgcn_s_waitcnt(0);
        unsigned nloc = b.st[0], nx = b.st[1];
        if (nloc == 0u) { xcd_barrier_complete(bar, b.x, nloc, nx); b.st[0] = nloc; b.st[1] = nx; }
        const unsigned old = xb_add(&bar[XB_XSUB(b.x)], 1u);
        const unsigned gen = old / nloc;
        if (old + 1u == (gen + 1u) * nloc) {
            __builtin_amdgcn_fence(__ATOMIC_RELEASE, "agent");
            asm volatile("s_waitcnt vmcnt(0)" ::: "memory");
            const unsigned og = xb_add(&bar[XB_TOP], 1u);
            const unsigned tg = og / nx;
            if (og + 1u == (tg + 1u) * nx) xb_add(&bar[XB_TOPGEN], 1u);
            else XB_SPIN(xb_ld(&bar[XB_TOPGEN]) == tg, bar);
            __builtin_amdgcn_fence(__ATOMIC_ACQUIRE, "agent");
            xb_add(&bar[XB_XGEN(b.x)], 1u);
            asm volatile("s_waitcnt vmcnt(0)" ::: "memory");
        } else {
            XB_SPIN(xb_ld(&bar[XB_XGEN(b.x)]) == gen, bar);
            __builtin_amdgcn_fence(__ATOMIC_ACQUIRE, "agent");
            asm volatile("s_waitcnt vmcnt(0)" ::: "memory");
        }
    }
    __syncthreads();
}


struct EpiSwiGLU {
    static constexpr bool PERM = true, AFTER_DRAIN = false;
    bf16_t* U;
    __device__ __forceinline__ void operator()(const f32x4 (&acc)[2][2][4][2], const pg8::Unit& u, int wr, int wc, int fr, int fq) const {
        const int row0 = u.pm * 256 + wr * 64 + fr, col0 = u.pn * 128 + wc * 32 + 8 * fq;
#pragma unroll
        for (int ai = 0; ai < 2; ++ai)
#pragma unroll
            for (int m = 0; m < 4; ++m) {
                bf16_t* rowp = U + (size_t)(row0 + ai * 128 + m * 16) * FF + col0;
                unsigned wv[4];
#pragma unroll
                for (int n = 0; n < 2; ++n)
#pragma unroll
                    for (int h = 0; h < 2; ++h) {
                        const f32x2 g2 = {acc[ai][0][m][n][2 * h], acc[ai][0][m][n][2 * h + 1]}, u2 = {acc[ai][1][m][n][2 * h], acc[ai][1][m][n][2 * h + 1]};
                        const f32x2 t = g2 * (-LOG2E);
                        f32x2 d; d.x = fast_exp2(t.x); d.y = fast_exp2(t.y);
                        d = d + 1.0f;
                        f32x2 r; r.x = fast_rcp(d.x); r.y = fast_rcp(d.y);
                        const f32x2 v = (g2 * u2) * r;
                        wv[n * 2 + h] = pk2(v.x, v.y);
                    }
                u32x4 w; w.x = wv[0]; w.y = wv[1]; w.z = wv[2]; w.w = wv[3];
                *(u32x4*)rowp = w;
            }
    }
};
struct EpiBf16Tile {
    static constexpr bool PERM = true, AFTER_DRAIN = false;
    bf16_t* O; int ldc, row_pn, col_pn;
    __device__ __forceinline__ void operator()(const f32x4 (&acc)[2][2][4][2], const pg8::Unit& u, int wr, int wc, int fr, int fq) const {
        const int row0 = u.pm * 256 + u.pn * row_pn + wr * 64 + fr, col0 = u.pn * col_pn + wc * 32 + 8 * fq;
#pragma unroll
        for (int ai = 0; ai < 2; ++ai)
#pragma unroll
            for (int m = 0; m < 4; ++m) {
                bf16_t* rowp = O + (size_t)(row0 + ai * 128 + m * 16) * ldc + col0;
#pragma unroll
                for (int bj = 0; bj < 2; ++bj) {
                    const f32x4 v0 = acc[ai][bj][m][0], v1 = acc[ai][bj][m][1];
                    u32x4 w; w.x = pk2(v0[0], v0[1]); w.y = pk2(v0[2], v0[3]); w.z = pk2(v1[0], v1[1]); w.w = pk2(v1[2], v1[3]);
                    *(u32x4*)(rowp + bj * 128) = w;
                }
            }
    }
};
struct EpiPQ {
    static constexpr bool PERM = true, AFTER_DRAIN = false;
    bf16_t* PQT; bf16_t* PQTC;
    __device__ __forceinline__ void operator()(const f32x4 (&acc)[2][2][4][2], const pg8::Unit& u, int wr, int wc, int fr, int fq) const {
        const int cl = wc * 32 + 8 * fq;
#pragma unroll
        for (int ai = 0; ai < 2; ++ai)
#pragma unroll
            for (int m = 0; m < 4; ++m) {
                const int mp = u.pm * 256 + ai * 128 + wr * 64 + m * 16 + fr;
                const int g = mp >> 7, pq = (mp >> 6) & 1, cp = mp & 63;
                bf16_t* rowp;
                if (u.pn < 128) { const int b = u.pn >> 3, n0 = (u.pn & 7) * 256; rowp = PQT + (size_t)(b * 256 + g * 64 + cp) * PQT_LD + pq * 2048 + n0 + cl; }
                else { const int b = u.pn - 128; rowp = PQTC + (size_t)(b * 256 + g * 64 + cp) * PQTC_LD + pq * 256 + cl; }
#pragma unroll
                for (int bj = 0; bj < 2; ++bj) {
                    const f32x4 v0 = acc[ai][bj][m][0], v1 = acc[ai][bj][m][1];
                    u32x4 w; w.x = pk2(v0[0], v0[1]); w.y = pk2(v0[2], v0[3]); w.z = pk2(v1[0], v1[1]); w.w = pk2(v1[2], v1[3]);
                    *(u32x4*)(rowp + bj * 128) = w;
                }
            }
    }
};
struct EpiWin {
    static constexpr bool PERM = false, AFTER_DRAIN = false;
    bf16_t* P; const float* rope;
    __device__ __forceinline__ void operator()(const f32x4 (&acc)[2][2][4][2], const pg8::Unit& u, int wr, int wc, int fr, int fq) const {
        const int row0 = u.pm * 256 + wr * 64 + fr, col0 = u.pn * 256 + wc * 32 + 4 * fq;
        const float qs = (u.pn == 2 || u.pn == 5) ? 0.125f * LOG2E : 1.0f;
        const bool lat = u.pm < 128;
#pragma unroll
        for (int ai = 0; ai < 2; ++ai)
#pragma unroll
            for (int m = 0; m < 4; ++m) {
                const int r = row0 + ai * 128 + m * 16;
                bf16_t* rowp = P + (size_t)r * NP + col0;
                const int t = r & 2047;
                const int pos = (wc & 1) ? (t & 63) : (t >> 6);
#pragma unroll
                for (int bj = 0; bj < 2; ++bj) {
                    f32x4 v0 = acc[ai][bj][m][0], v1 = acc[ai][bj][m][1];
                    const bool dorope = lat && (u.pn == 5 || (u.pn == 6 && bj == 0));
                    if (dorope) {
                        const f32x4 cs0 = *(const f32x4*)(rope + (pos * 16 + 4 * fq) * 2), cs1 = *(const f32x4*)(rope + (pos * 16 + 4 * fq) * 2 + 4);
                        const float c0 = cs0[0], s0 = cs0[1], c1 = cs0[2], s1 = cs0[3], c2 = cs1[0], s2 = cs1[1], c3 = cs1[2], s3 = cs1[3];
                        f32x4 a, b;
                        a[0] = v0[0] * c0 - v1[0] * s0; b[0] = v0[0] * s0 + v1[0] * c0;
                        a[1] = v0[1] * c1 - v1[1] * s1; b[1] = v0[1] * s1 + v1[1] * c1;
                        a[2] = v0[2] * c2 - v1[2] * s2; b[2] = v0[2] * s2 + v1[2] * c2;
                        a[3] = v0[3] * c3 - v1[3] * s3; b[3] = v0[3] * s3 + v1[3] * c3;
                        v0 = a; v1 = b;
                    }
                    v0 = v0 * qs; v1 = v1 * qs;
                    u32x2 w0, w1; w0.x = pk2(v0[0], v0[1]); w0.y = pk2(v0[2], v0[3]); w1.x = pk2(v1[0], v1[1]); w1.y = pk2(v1[2], v1[3]);
                    *(u32x2*)(rowp + bj * 128) = w0; *(u32x2*)(rowp + bj * 128 + 16) = w1;
                }
            }
    }
};

struct TrItem { const float* src; bf16_t* dst; int ld_src, ld_dst; };
__device__ __forceinline__ TrItem tr_decode(CParams& p, int it) {
    constexpr int PER_L = 2 * 704 + 2 * 352 + 224 + 160;
    unsigned char* ws = p.ws;
    const int l = it / PER_L; int q = it % PER_L;
    const float* src; bf16_t* dst; int ld_src, ld_dst, col0, k0, r0;
    if (q < 2 * 704) { const int f = q / 704; q %= 704; const int rt = q >> 4, kt = q & 15, R0 = rt * 128, tile = R0 >> 8, bj = (R0 >> 7) & 1;
        src = (bj ? p.w3 : p.w1) + (size_t)(l * 2 + f) * 1024 * FF; ld_src = FF; col0 = 128 * tile; k0 = 64 * kt; dst = (bf16_t*)(ws + WS_W13) + (size_t)(l * 2 + f) * 5632 * 1024; r0 = R0; ld_dst = 1024; }
    else if (q < 2 * 704 + 2 * 352) { q -= 2 * 704; const int f = q / 352; q %= 352; const int rt = q / 44, kt = q % 44;
        src = p.w2 + (size_t)(l * 2 + f) * FF * 1024; ld_src = 1024; col0 = 128 * rt; k0 = 64 * kt; dst = (bf16_t*)(ws + WS_W2T) + (size_t)(l * 2 + f) * 1024 * FF; r0 = 128 * rt; ld_dst = FF; }
    else if (q < 2 * 704 + 2 * 352 + 224) { q -= 2 * 704 + 2 * 352; const int rt = q >> 4, kt = q & 15, R0 = rt * 128;
        src = p.w_in + (size_t)l * 1024 * 2048; ld_src = 2048; col0 = R0 < 512 ? R0 : R0 + 256; k0 = 64 * kt; dst = (bf16_t*)(ws + WS_WIN) + (size_t)l * 2304 * 1024; r0 = R0; ld_dst = 1024; }
    int ks = -1;
    if (q >= 2 * 704 + 2 * 352 + 224) { q -= 2 * 704 + 2 * 352 + 224; const int rt = q / 20, kt = q % 20;
        src = p.w_out + (size_t)l * 1024 * 1024; ld_src = 1024; col0 = 128 * rt; k0 = 64 * kt; ks = kt < 16 ? 64 * kt : 256 + 64 * (kt - 16); dst = (bf16_t*)(ws + WS_WOUT) + (size_t)l * 1024 * YC_LD; r0 = 128 * rt; ld_dst = YC_LD; }
    if (ks < 0) ks = k0;
    TrItem t; t.src = src + (size_t)ks * ld_src + col0; t.dst = dst + (size_t)r0 * ld_dst + k0; t.ld_src = ld_src; t.ld_dst = ld_dst; return t;
}

__device__ __forceinline__ void phase0(CParams& p, LAS unsigned char* lds) {
    const int tid = otid(), wave = tid >> 6, lane = tid & 63;
    unsigned char* ws = p.ws;
    const int bid = obid(), G = gridDim.x;
    TS_BEGIN(9);
    if (bid < 288) {
        LAS float* sS = (LAS float*)lds;
        LAS float* sR = sS + 17 * 1024;
        for (int i = tid; i < 17 * 1024; i += 512) { const float v = (i < 16384) ? p.c[i] : p.c_ctx[i - 16384]; sS[i] = v / (1.0f + __expf(-v)); }
        __syncthreads();
        for (int r = bid; r < 288; r += G) {
            const int l = r / 144, j0 = (r % 144) * 64, k0 = wave * 128;
            float acc[17];
#pragma unroll
            for (int q = 0; q < 17; ++q) acc[q] = 0.f;
            const float* wp = p.w_ada + ((size_t)l * 1024 + k0) * NMODC + j0 + lane;
            float wv[16];
#pragma unroll
            for (int kk = 0; kk < 16; ++kk) wv[kk] = __builtin_nontemporal_load(wp + (size_t)kk * NMODC);
#pragma unroll 1
            for (int kb = 0; kb < 128; kb += 16) {
                float wn[16];
                const int kn = (kb + 16 < 128) ? kb + 16 : kb;
#pragma unroll
                for (int kk = 0; kk < 16; ++kk) wn[kk] = __builtin_nontemporal_load(wp + (size_t)(kn + kk) * NMODC);
#pragma unroll 1
                for (int k4 = 0; k4 < 16; k4 += 4) {
                    const float w0 = k4 == 0 ? wv[0] : (k4 == 4 ? wv[4] : (k4 == 8 ? wv[8] : wv[12]));
                    const float w1 = k4 == 0 ? wv[1] : (k4 == 4 ? wv[5] : (k4 == 8 ? wv[9] : wv[13]));
                    const float w2 = k4 == 0 ? wv[2] : (k4 == 4 ? wv[6] : (k4 == 8 ? wv[10] : wv[14]));
                    const float w3 = k4 == 0 ? wv[3] : (k4 == 4 ? wv[7] : (k4 == 8 ? wv[11] : wv[15]));
#pragma unroll
                    for (int q = 0; q < 17; ++q) { const f32x4 sv = *(const LAS f32x4*)(sS + q * 1024 + k0 + kb + k4);
                        acc[q] += (sv[0] * w0 + sv[1] * w1) + (sv[2] * w2 + sv[3] * w3); }
                }
#pragma unroll
                for (int kk = 0; kk < 16; ++kk) wv[kk] = wn[kk];
            }
#pragma unroll
            for (int q = 0; q < 17; ++q) sR[(wave * 17 + q) * 64 + lane] = acc[q];
            __syncthreads();
            float* MOD = (float*)(ws + WS_MOD);
            for (int o = tid; o < 17 * 64; o += 512) {
                const int q = o >> 6, ln = o & 63; float s = p.b_ada[l * NMODC + j0 + ln];
#pragma unroll
                for (int w = 0; w < 8; ++w) s += sR[(w * 17 + q) * 64 + ln];
                MOD[(size_t)(l * 17 + q) * NMODC + j0 + ln] = s;
            }
            __syncthreads();
        }
    }
    TS_END(9);
    TS_BEGIN(10);
    {
        constexpr int N_TR = 2 * (2 * 704 + 2 * 352 + 224 + 160);
        LAS float* t = (LAS float*)lds;
        const int lk = tid >> 5, lc = (tid & 31) * 4;
        const int sr = tid >> 2, sk = (tid & 3) * 16;
        const bool bal = (G == 256) && (N_TR == 4992);
        int it = bal ? (bid >= 32 ? (bid - 32) * 21 : 4704 + bid * 9) : bid;
        const int step = bal ? 1 : G, tr_end = bal ? it + (bid >= 32 ? 21 : 9) : N_TR;
        f32x4 pre[4]; TrItem cur;
        if (it < tr_end) { cur = tr_decode(p, it);
#pragma unroll
            for (int i = 0; i < 4; ++i) pre[i] = __builtin_nontemporal_load((const f32x4*)(cur.src + (size_t)(lk + 16 * i) * cur.ld_src + lc)); }
        while (it < tr_end) {
#pragma unroll
            for (int i = 0; i < 4; ++i) { LAS float* d = t + (lk + 16 * i) * 129 + lc; d[0] = pre[i][0]; d[1] = pre[i][1]; d[2] = pre[i][2]; d[3] = pre[i][3]; }
            __syncthreads();
            bf16_t* dp = cur.dst + (size_t)sr * cur.ld_dst + sk;
            const int nxt = it + step;
            if (nxt < tr_end) { cur = tr_decode(p, nxt);
#pragma unroll
                for (int i = 0; i < 4; ++i) pre[i] = __builtin_nontemporal_load((const f32x4*)(cur.src + (size_t)(lk + 16 * i) * cur.ld_src + lc)); }
            { const LAS float* s = t + sk * 129 + sr;
              u32x4 o0, o1;
              o0.x = pk2(s[0 * 129], s[1 * 129]); o0.y = pk2(s[2 * 129], s[3 * 129]); o0.z = pk2(s[4 * 129], s[5 * 129]); o0.w = pk2(s[6 * 129], s[7 * 129]);
              o1.x = pk2(s[8 * 129], s[9 * 129]); o1.y = pk2(s[10 * 129], s[11 * 129]); o1.z = pk2(s[12 * 129], s[13 * 129]); o1.w = pk2(s[14 * 129], s[15 * 129]);
              *(u32x4*)dp = o0; *(u32x4*)(dp + 8) = o1; }
            __syncthreads();
            it = nxt;
        }
    }
    TS_END(10);
    TS_BEGIN(11);
    for (int r = bid; r < 256; r += G) {
        const int l = r >> 7, k0 = (r & 127) * 8;
        LAS float* sW = (LAS float*)lds;
        LAS float* sC = sW + 2048;
        for (int i = tid; i < 2048; i += 512) { const int kk = i >> 8, cc = i & 255; sW[i] = p.w_in[((size_t)l * 1024 + k0 + kk) * 2048 + 512 + cc]; }
        if (tid < 64) sC[tid] = cospif((float)tid * (1.0f / 32.0f));
        __syncthreads();
        const int g = tid >> 7, j = tid & 127, jj = j & 63, isS = j >> 6;
        float acc[8];
#pragma unroll
        for (int q = 0; q < 8; ++q) acc[q] = 0.f;
        for (int c = 0; c < 64; ++c) {
            const int mm = (c * jj) & 63; const float tv = sC[isS ? ((mm - 16) & 63) : mm];
#pragma unroll
            for (int q = 0; q < 8; ++q) acc[q] += sW[q * 256 + g * 64 + c] * tv;
        }
        u32x4 o; o.x = pk2(acc[0] * 0.125f, acc[1] * 0.125f); o.y = pk2(acc[2] * 0.125f, acc[3] * 0.125f); o.z = pk2(acc[4] * 0.125f, acc[5] * 0.125f); o.w = pk2(acc[6] * 0.125f, acc[7] * 0.125f);
        *(u32x4*)((bf16_t*)(ws + WS_WIN) + ((size_t)l * 2304 + 1792 + g * 128 + j) * 1024 + k0) = o;
        __syncthreads();
    }
    {
        LAS float* tab = (LAS float*)lds;
        for (int m = tid; m < 2048; m += 512) tab[m] = cospif((float)m * (1.0f / 1024.0f)) * 0.022097086912079608f;
        __syncthreads();
        for (int r = bid; r < 2048 + 256; r += G) {
            if (r < 2048) {
                float v[8];
#pragma unroll
                for (int e = 0; e < 8; ++e) { const int k = tid * 8 + e, idx = (r * (k & 2047)) & 2047; v[e] = tab[k < 2048 ? idx : ((idx + 512) & 2047)]; }
                u32x4 o; o.x = pk2(v[0], v[1]); o.y = pk2(v[2], v[3]); o.z = pk2(v[4], v[5]); o.w = pk2(v[6], v[7]);
                *(u32x4*)((bf16_t*)(ws + WS_DFT) + (size_t)r * DFT_LD + tid * 8) = o;
            } else if (tid < 64) {
                const int np = r - 2048; const float sc = 2.8284271247461903f;
                float v[8];
#pragma unroll
                for (int e = 0; e < 8; ++e) { const int k = tid * 8 + e, idx = ((np * (k & 255)) & 255) * 8; v[e] = tab[k < 256 ? idx : ((idx + 512) & 2047)] * sc; }
                u32x4 o; o.x = pk2(v[0], v[1]); o.y = pk2(v[2], v[3]); o.z = pk2(v[4], v[5]); o.w = pk2(v[6], v[7]);
                *(u32x4*)((bf16_t*)(ws + WS_DFTC) + (size_t)np * DFTC_LD + tid * 8) = o;
            }
        }
        __syncthreads();
    }
    TS_END(11);
    if (bid == G - 1) {
        float* rtab = (float*)(ws + WS_ROPE);
        for (int e = tid; e < 1024; e += 512) { const int pos = e >> 4, i = e & 15;
            const float inv = fast_exp2(-(float)i * (13.287712379549449f / 16.0f));
            const float tt = (float)pos * inv * 0.3183098861837907f;
            rtab[2 * e] = cospif(tt); rtab[2 * e + 1] = sinpif(tt); }
    }
}

struct EwRow { f32x4 x[4]; u32x2 y[4]; u32x2 y2[4]; };
__device__ __forceinline__ void ew_load(EwRow& r, const float* xin_lat, const float* xin_ctx, const bf16_t* Yp, const bf16_t* Y2p, int t, int lane) {
    const float* xr = t < TL ? xin_lat + (size_t)t * DM : xin_ctx + (size_t)(t - TL) * DM;
#pragma unroll
    for (int j = 0; j < 4; ++j) r.x[j] = __builtin_nontemporal_load((const f32x4*)(xr + 4 * lane + 256 * j));
    if (Yp) {
#pragma unroll
        for (int j = 0; j < 4; ++j) r.y[j] = __builtin_nontemporal_load((const u32x2*)(Yp + (size_t)t * DM + 4 * lane + 256 * j));
        if (t >= TL) {
#pragma unroll
            for (int j = 0; j < 4; ++j) r.y2[j] = __builtin_nontemporal_load((const u32x2*)(Y2p + (size_t)(t - TL) * DM + 4 * lane + 256 * j));
        }
    }
}
__device__ __forceinline__ void ew_pass(const float* xin_lat, const float* xin_ctx, float* xout_lat, float* xout_ctx, const bf16_t* Yp, const bf16_t* Y2p, const float* gpost, float fac, const float* gate,
                                        bf16_t* Hp, const float* gpre, const float* shift, const float* scale, int nrows) {
    const int tid = otid(); const int wave = tid >> 6, lane = tid & 63;
    const int per = (nrows + (int)gridDim.x - 1) / (int)gridDim.x, tbeg = obid() * per + wave, tend = min(obid() * per + per, nrows);
    f32x4 vgp[4], vgt[4], vpre[4], vsh[4], vsc[4];
#pragma unroll
    for (int j = 0; j < 4; ++j) { vgp[j] = Yp ? *(const f32x4*)(gpost + 4 * lane + 256 * j) : (f32x4){0.f, 0.f, 0.f, 0.f}; vpre[j] = Hp ? *(const f32x4*)(gpre + 4 * lane + 256 * j) : (f32x4){0.f, 0.f, 0.f, 0.f};
        vgt[j] = vsh[j] = vsc[j] = (f32x4){0.f, 0.f, 0.f, 0.f}; }
    int bcur = -1;
    EwRow A, B;
    auto process = [&](EwRow& r, int t) {
        const bool lat = t < TL; const int b = lat ? (t >> 11) : 16;
        if (b != bcur) { bcur = b;
#pragma unroll
            for (int j = 0; j < 4; ++j) { const int cidx = 4 * lane + 256 * j;
                if (Yp) vgt[j] = *(const f32x4*)(gate + (size_t)b * NMODC + cidx) * fac;
                if (Hp) { vsh[j] = *(const f32x4*)(shift + (size_t)b * NMODC + cidx); vsc[j] = *(const f32x4*)(scale + (size_t)b * NMODC + cidx) + 1.0f; } } }
        if (Yp) {
            f32x4 y[4]; float ss = 0.f;
#pragma unroll
            for (int j = 0; j < 4; ++j) { const u32x2 w = r.y[j];
                y[j][0] = bflo(w.x); y[j][1] = bfhi(w.x); y[j][2] = bflo(w.y); y[j][3] = bfhi(w.y);
                if (!lat) { const u32x2 w2 = r.y2[j]; y[j][0] += bflo(w2.x); y[j][1] += bfhi(w2.x); y[j][2] += bflo(w2.y); y[j][3] += bfhi(w2.y); }
                ss += (y[j][0] * y[j][0] + y[j][1] * y[j][1]) + (y[j][2] * y[j][2] + y[j][3] * y[j][3]); }
            const float rstd = 1.0f / sqrtf(wave_sum(ss) * (1.0f / DM) + EPSV);
#pragma unroll
            for (int j = 0; j < 4; ++j) r.x[j] = r.x[j] + vgt[j] * (y[j] * rstd * vgp[j]);
        }
        float* xo = lat ? (xout_lat ? xout_lat + (size_t)t * DM : nullptr) : (xout_ctx ? xout_ctx + (size_t)(t - TL) * DM : nullptr);
        if (xo) {
#pragma unroll
            for (int j = 0; j < 4; ++j) __builtin_nontemporal_store(r.x[j], (f32x4*)(xo + 4 * lane + 256 * j));
        }
        if (Hp) {
            float ss = 0.f;
#pragma unroll
            for (int j = 0; j < 4; ++j) ss += (r.x[j][0] * r.x[j][0] + r.x[j][1] * r.x[j][1]) + (r.x[j][2] * r.x[j][2] + r.x[j][3] * r.x[j][3]);
            const float rstd = 1.0f / sqrtf(wave_sum(ss) * (1.0f / DM) + EPSV);
#pragma unroll
            for (int j = 0; j < 4; ++j) { const f32x4 h = (r.x[j] * rstd * vpre[j]) * vsc[j] + vsh[j];
                u32x2 w; w.x = pk2(h[0], h[1]); w.y = pk2(h[2], h[3]);
                *(u32x2*)(Hp + (size_t)t * DM + 4 * lane + 256 * j) = w; }
        }
    };
    int t = tbeg;
    if (t < tend) ew_load(A, xin_lat, xin_ctx, Yp, Y2p, t, lane);
    while (t < tend) {
        const int tn = t + 8;
        if (tn < tend) ew_load(B, xin_lat, xin_ctx, Yp, Y2p, tn, lane);
        process(A, t);
        const int tnn = tn + 8;
        if (tnn < tend) ew_load(A, xin_lat, xin_ctx, Yp, Y2p, tnn, lane);
        if (tn < tend) process(B, tn);
        t = tnn;
    }
}

__device__ __forceinline__ void conv_item(CParams& p, LAS unsigned char* lds, int l, int s, int tb) {
    const int tid = otid(), wave = tid >> 6, lane = tid & 63;
    const bf16_t* PROJ = (const bf16_t*)(p.ws + WS_PROJ); bf16_t* YCAT = (bf16_t*)(p.ws + WS_YCAT);
    LAS float* sA = (LAS float*)lds;
    const int tokbase = s < 16 ? s * 2048 : TL + (s - 16) * 256, len = s < 16 ? 2048 : 256, t0 = tb * 64;
    {
        u32x4 ua[6], ug[6];
#pragma unroll
        for (int i = 0; i < 6; ++i) {
            const int u = tid + 512 * i, rr = u >> 5, c8 = (u & 31) * 8, tt = t0 - 15 + rr;
            ua[i] = (u32x4){0u, 0u, 0u, 0u}; ug[i] = (u32x4){0u, 0u, 0u, 0u};
            if (u < 94 * 32 && tt >= 0 && tt < len) { const bf16_t* rp = PROJ + (size_t)(tokbase + tt) * NP + c8; ua[i] = *(const u32x4*)rp; ug[i] = *(const u32x4*)(rp + 256); }
        }
#pragma unroll
        for (int i = 0; i < 6; ++i) {
            const int u = tid + 512 * i, rr = u >> 5, c8 = (u & 31) * 8;
            if (u < 94 * 32) {
                float v[8];
                v[0] = bflo(ua[i].x) * sigmoid_f(bflo(ug[i].x)); v[1] = bfhi(ua[i].x) * sigmoid_f(bfhi(ug[i].x));
                v[2] = bflo(ua[i].y) * sigmoid_f(bflo(ug[i].y)); v[3] = bfhi(ua[i].y) * sigmoid_f(bfhi(ug[i].y));
                v[4] = bflo(ua[i].z) * sigmoid_f(bflo(ug[i].z)); v[5] = bfhi(ua[i].z) * sigmoid_f(bfhi(ug[i].z));
                v[6] = bflo(ua[i].w) * sigmoid_f(bflo(ug[i].w)); v[7] = bfhi(ua[i].w) * sigmoid_f(bfhi(ug[i].w));
                *(LAS f32x4*)(sA + rr * 256 + c8) = (f32x4){v[0], v[1], v[2], v[3]};
                *(LAS f32x4*)(sA + rr * 256 + c8 + 4) = (f32x4){v[4], v[5], v[6], v[7]};
            }
        }
    }
    __syncthreads();
    TS_BEGIN(7);
    const int cp = tid & 127, oc = tid >> 7;
    f32x2 out2[2][8];
    {
        f32x2 w2[31];
#pragma unroll
        for (int j = 0; j < 31; ++j) w2[j] = *(const f32x2*)(p.conv_w + ((size_t)l * 31 + j) * 256 + 2 * cp);
        const f32x2 bias2 = *(const f32x2*)(p.conv_b + l * 256 + 2 * cp);
#pragma unroll
        for (int ps = 0; ps < 2; ++ps) {
            const LAS float* ap = sA + ((oc * 2 + ps) * 8) * 256 + 2 * cp;
            f32x2 in2[38];
#pragma unroll
            for (int i = 0; i < 38; ++i) in2[i] = *(const LAS f32x2*)(ap + i * 256);
#pragma unroll
            for (int q = 0; q < 8; ++q) {
                f32x2 acc = bias2;
#pragma unroll
                for (int j = 0; j < 31; ++j) acc = in2[q + j] * w2[j] + acc;
                out2[ps][q] = acc;
            }
        }
    }
    TS_END(7);
    __syncthreads();
#pragma unroll
    for (int ps = 0; ps < 2; ++ps)
#pragma unroll
        for (int q = 0; q < 8; ++q) *(LAS f32x2*)(sA + ((oc * 2 + ps) * 8 + q) * 256 + 2 * cp) = out2[ps][q];
    __syncthreads();
    {
        const f32x4 lg = *(const f32x4*)(p.ln_g + l * 256 + 4 * lane), lb = *(const f32x4*)(p.ln_b + l * 256 + 4 * lane);
#pragma unroll
        for (int q = 0; q < 8; ++q) {
            const int tok = wave * 8 + q;
            const f32x4 v = *(const LAS f32x4*)(sA + tok * 256 + 4 * lane);
            const float mean = wave_sum((v[0] + v[1]) + (v[2] + v[3])) * (1.0f / 256.0f);
            const f32x4 d = v - mean;
            const float var = wave_sum((d[0] * d[0] + d[1] * d[1]) + (d[2] * d[2] + d[3] * d[3])) * (1.0f / 256.0f);
            const float rstd = 1.0f / sqrtf(var + EPSV);
            const f32x4 yn = d * rstd * lg + lb;
            u32x2 o; o.x = pk2(silu_f(yn[0]), silu_f(yn[1])); o.y = pk2(silu_f(yn[2]), silu_f(yn[3]));
            *(u32x2*)(YCAT + (size_t)(tokbase + t0 + tok) * YC_LD + 4 * lane) = o;
        }
    }
    __syncthreads();
}

struct AttnItem {
    int mode;
    int qtok0;
    int qcol0, qcol1, ocol0, ocol1;
    int kcol0, kcol1, vcol0, vcol1; int nslots;
    int nloc, loctok0;
    int ctxtok0;
    int r, rs;
    int q0, kp0;
    int has_sink; float sink0, sink1;
    int h0;
};
constexpr int KROW = 72;
constexpr int KV_BYTES = 64 * KROW * 2;
constexpr int ABUF_BYTES = 4 * KV_BYTES;
typedef short s16x4 __attribute__((ext_vector_type(4)));
template <int OFF> __device__ __forceinline__ s16x4 tr_read(unsigned addr) {
    s16x4 r; asm volatile("ds_read_b64_tr_b16 %0, %1 offset:%2" : "=&v"(r) : "v"(addr), "i"(OFF) : "memory"); return r;
}
template <int NKB>
__device__ __forceinline__ void attn_chunk(const LAS unsigned char* kt, const LAS unsigned char* vt, int kofs, const bf16x8 (&qf)[2], int fr, int fq,
                                           int mtype, int a0, const LAS float* bt, float& mrun, float& lsum, f32x4 (&o)[4]) {
    const unsigned vaddr = (unsigned)(size_t)vt + (unsigned)(((kofs + 4 * fq + (fr >> 2)) * KROW + 4 * (fr & 3)) * 2);
    s16x4 vl[NKB / 2][4], vh[NKB / 2][4];
#pragma unroll
    for (int grp = 0; grp < NKB / 2; ++grp) {
        const unsigned va = vaddr + (unsigned)(grp * 32 * KROW * 2);
        vl[grp][0] = tr_read<0>(va);  vh[grp][0] = tr_read<16 * KROW * 2>(va);
        vl[grp][1] = tr_read<32>(va); vh[grp][1] = tr_read<16 * KROW * 2 + 32>(va);
        vl[grp][2] = tr_read<64>(va); vh[grp][2] = tr_read<16 * KROW * 2 + 64>(va);
        vl[grp][3] = tr_read<96>(va); vh[grp][3] = tr_read<16 * KROW * 2 + 96>(va);
    }
    f32x4 sacc[NKB];
    const int kc0 = (fq ^ (((kofs + fr) >> 1) & 7)) * 16;
    const LAS unsigned char* krow = kt + (kofs + fr) * 128;
    const LAS unsigned char* kp0 = krow + kc0;
    const LAS unsigned char* kp1 = krow + (kc0 ^ 64);
#pragma unroll
    for (int kb = 0; kb < NKB; ++kb) {
        sacc[kb] = (f32x4){0.f, 0.f, 0.f, 0.f};
        const bf16x8 a0v = *(const LAS bf16x8*)(kp0 + 16 * kb * 128);
        const bf16x8 a1v = *(const LAS bf16x8*)(kp1 + 16 * kb * 128);
        sacc[kb] = __builtin_amdgcn_mfma_f32_16x16x32_bf16(a0v, qf[0], sacc[kb], 0, 0, 0);
        sacc[kb] = __builtin_amdgcn_mfma_f32_16x16x32_bf16(a1v, qf[1], sacc[kb], 0, 0, 0);
    }
    if (mtype == 1) {
        const int wsx = min(max(a0 - 8, 0), 48);
        const int lo = wsx - (kofs + 4 * fq);
        const LAS float* bl = bt + (kofs + 4 * fq - a0 + 63);
#pragma unroll
        for (int kb = 0; kb < NKB; ++kb)
#pragma unroll
            for (int j = 0; j < 4; ++j) { const bool ok = (unsigned)(16 * kb + j - lo) < 16u;
                sacc[kb][j] = ok ? sacc[kb][j] + bl[16 * kb + j] : -1.0e30f; }
    } else if (mtype == 2) {
        const int db = a0 + kofs + 4 * fq + 128;
#pragma unroll
        for (int kb = 0; kb < NKB; ++kb)
#pragma unroll
            for (int j = 0; j < 4; ++j) { const bool ok = (unsigned)(db + 16 * kb + j) <= 256u;
                sacc[kb][j] = ok ? sacc[kb][j] : -1.0e30f; }
    }
    float cm = sacc[0][0];
#pragma unroll
    for (int kb = 0; kb < NKB; ++kb)
#pragma unroll
        for (int j = 0; j < 4; ++j) cm = fmaxf(cm, sacc[kb][j]);
    cm = xrow16_max(cm);
    const float mnew = fmaxf(mrun, cm);
    if (__any(mnew > mrun)) {
        const float alpha = fast_exp2(mrun - mnew);
        lsum *= alpha;
#pragma unroll
        for (int db = 0; db < 4; ++db) o[db] = o[db] * alpha;
        mrun = mnew;
    }
    float ps = 0.f;
#pragma unroll
    for (int kb = 0; kb < NKB; ++kb)
#pragma unroll
        for (int j = 0; j < 4; ++j) { sacc[kb][j] = fast_exp2(sacc[kb][j] - mnew); ps += sacc[kb][j]; }
    lsum += ps;
    asm volatile("s_waitcnt lgkmcnt(0)" ::: "memory"); __builtin_amdgcn_sched_barrier(0);
#define ATT_PK(L, H) (bf16x8){L[0], L[1], L[2], L[3], H[0], H[1], H[2], H[3]}
#pragma unroll
    for (int grp = 0; grp < NKB / 2; ++grp) {
        union { bf16x8 v; unsigned u[4]; } pb;
        pb.u[0] = pk2(sacc[2 * grp][0], sacc[2 * grp][1]); pb.u[1] = pk2(sacc[2 * grp][2], sacc[2 * grp][3]);
        pb.u[2] = pk2(sacc[2 * grp + 1][0], sacc[2 * grp + 1][1]); pb.u[3] = pk2(sacc[2 * grp + 1][2], sacc[2 * grp + 1][3]);
#pragma unroll
        for (int db = 0; db < 4; ++db) o[db] = __builtin_amdgcn_mfma_f32_16x16x32_bf16(ATT_PK(vl[grp][db], vh[grp][db]), pb.v, o[db], 0, 0, 0);
    }
#undef ATT_PK
}

__device__ __forceinline__ void attn_item(CParams& p, LAS unsigned char* lds, int l, const AttnItem& it) {
    const int tid = otid(), wave = tid >> 6, lane = tid & 63, g = wave >> 2, wq = wave & 3, fr = lane & 15, fq = lane >> 4;
    const bf16_t* PROJ = (const bf16_t*)(p.ws + WS_PROJ); bf16_t* YCAT = (bf16_t*)(p.ws + WS_YCAT);
    LAS float* sB = (LAS float*)(lds + 2 * ABUF_BYTES);
    const int slot = it.nslots == 2 ? g : 0;
    if (it.mode == 0) { for (int i = tid; i < 2 * 15 * 128; i += 512) { const int h = i / 1920, rem = i % 1920, dr = rem >> 7, dc = (rem & 127) - 48;
            sB[i] = (dc >= 0 && dc < 31) ? p.nat_bias[(size_t)(l * 4 + it.h0 + h) * 465 + dr * 31 + dc] * LOG2E : 0.f; } }
    bf16x8 qf[2];
    { const bf16_t* qp = PROJ + (size_t)(it.qtok0 + wq * 16 + fr) * NP + (g ? it.qcol1 : it.qcol0) + 8 * fq;
      qf[0] = *(const bf16x8*)qp; qf[1] = *(const bf16x8*)(qp + 32); }
    float mrun = -3.0e38f, lsum = 0.f;
    f32x4 o[4];
#pragma unroll
    for (int db = 0; db < 4; ++db) o[db] = (f32x4){0.f, 0.f, 0.f, 0.f};
    const int nchunks = 4 + it.nloc;
    const int srow = tid >> 3, sseg = tid & 7;
    u32x4 kreg[2], vreg[2];
    auto chunk_tok = [&](int c) { return c < 4 ? it.ctxtok0 + 64 * c : it.loctok0 + 64 * (c - 4); };
    auto gload = [&](int c) {
        const bf16_t* rp = PROJ + (size_t)(chunk_tok(c) + srow) * NP + 8 * sseg;
#pragma unroll
        for (int s = 0; s < 2; ++s) if (s < it.nslots) { kreg[s] = *(const u32x4*)(rp + (s ? it.kcol1 : it.kcol0)); vreg[s] = *(const u32x4*)(rp + (s ? it.vcol1 : it.vcol0)); }
    };
    auto lwrite = [&](int c) {
        LAS unsigned char* bufk = lds + (c & 1) * ABUF_BYTES + srow * 128 + ((sseg ^ ((srow >> 1) & 7)) * 16);
        LAS unsigned char* bufv = lds + (c & 1) * ABUF_BYTES + 2 * KV_BYTES + (srow * KROW + 8 * sseg) * 2;
#pragma unroll
        for (int s = 0; s < 2; ++s) if (s < it.nslots) { *(LAS u32x4*)(bufk + s * KV_BYTES) = kreg[s]; *(LAS u32x4*)(bufv + s * KV_BYTES) = vreg[s]; }
    };
    gload(0); lwrite(0);
    if (nchunks > 1) gload(1);
    __syncthreads();
    TS_BEGIN(5);
    const int qi = wq * 16 + fr;
    const int nat_kofs = min(max(16 * wq - 8, 0), 32);
    for (int c = 0; c < nchunks; ++c) {
        if (c + 1 < nchunks) lwrite(c + 1);
        if (c + 2 < nchunks) gload(c + 2);
        const LAS unsigned char* kt = lds + (c & 1) * ABUF_BYTES + slot * KV_BYTES;
        const LAS unsigned char* vt = kt + 2 * KV_BYTES;
        if (c >= 4 && it.mode == 0) {
            const int dr = (it.rs + (c - 4)) - it.r + 7;
            attn_chunk<2>(kt, vt, nat_kofs, qf, fr, fq, 1, qi, sB + g * 1920 + dr * 128, mrun, lsum, o);
        } else if (c >= 4 && it.mode == 1) {
            attn_chunk<4>(kt, vt, 0, qf, fr, fq, 2, it.kp0 + 64 * (c - 4) - (it.q0 + qi), sB, mrun, lsum, o);
        } else {
            attn_chunk<4>(kt, vt, 0, qf, fr, fq, 0, 0, sB, mrun, lsum, o);
        }
        __syncthreads();
    }
    TS_END(5);
    lsum = xrow16_sum(lsum);
    if (it.has_sink) lsum += fast_exp2((g ? it.sink1 : it.sink0) * LOG2E - mrun);
    const float inv = 1.0f / lsum;
    bf16_t* op = YCAT + (size_t)(it.qtok0 + wq * 16 + fr) * YC_LD + (g ? it.ocol1 : it.ocol0) + 4 * fq;
#pragma unroll
    for (int db = 0; db < 4; ++db) { u32x2 w; w.x = pk2(o[db][0] * inv, o[db][1] * inv); w.y = pk2(o[db][2] * inv, o[db][3] * inv); *(u32x2*)(op + 16 * db) = w; }
}

constexpr int C_UA = 0, C_QN = 512, C_KN = 768, C_VN = 1024, C_QS = 1280, C_KS = 1536, C_VS = 1664;

__device__ __forceinline__ void mix_items(CParams& p, LAS unsigned char* lds, int l, int sub) {
    const int n_attn = (l == 0) ? 2304 : 2048;
    const int n_conv = (l == 0) ? 512 + 64 : 512;
    const int start = (obid() + 128) % gridDim.x;
    for (int i = start; i < n_attn + n_conv; i += gridDim.x) {
        if (i >= n_attn) {
            if (!(sub & 4)) continue;
            const int ci = i - n_attn;
            TS_BEGIN(3);
            if (ci < 512) conv_item(p, lds, l, ci >> 5, ci & 31);
            else { const int cj = ci - 512; conv_item(p, lds, l, 16 + (cj >> 2), cj & 3); }
            TS_END(3);
            continue;
        }
        AttnItem it{};
        if (i < 1024) {
            const int b = i >> 6, r = (i >> 1) & 31, hp = i & 1;
            it.mode = 0; it.qtok0 = b * 2048 + r * 64; it.nslots = 2; it.h0 = 2 * hp;
            { const int h = 2 * hp; it.qcol0 = C_QN + 64 * h; it.kcol0 = C_KN + 64 * h; it.vcol0 = C_VN + 64 * h; it.ocol0 = 512 + 64 * h;
              it.qcol1 = it.qcol0 + 64; it.kcol1 = it.kcol0 + 64; it.vcol1 = it.vcol0 + 64; it.ocol1 = it.ocol0 + 64; }
            it.r = r; it.rs = min(max(r - 4, 0), 24); it.nloc = 8; it.loctok0 = b * 2048 + it.rs * 64; it.ctxtok0 = TL + b * 256;
        } else if (i < 2048) {
            const int k = i - 1024, b = k >> 6, qb = (k >> 1) & 31, kvh = k & 1;
            it.mode = 1; it.qtok0 = b * 2048 + qb * 64; it.nslots = 1;
            { const int h = 2 * kvh; it.qcol0 = C_QS + 64 * h; it.ocol0 = 768 + 64 * h; it.sink0 = p.sink[l * 4 + h]; it.sink1 = p.sink[l * 4 + h + 1];
              it.qcol1 = it.qcol0 + 64; it.ocol1 = it.ocol0 + 64; it.kcol0 = it.kcol1 = C_KS + 64 * kvh; it.vcol0 = it.vcol1 = C_VS + 64 * kvh; }
            it.has_sink = 1; it.q0 = qb * 64;
            const int ks = max(qb * 64 - 128, 0), ke = min(qb * 64 + 192, 2048);
            it.kp0 = ks; it.nloc = (ke - ks) >> 6; it.loctok0 = b * 2048 + ks; it.ctxtok0 = TL + b * 256;
        } else if (i < 2176) {
            const int k = i - 2048, b = k >> 3, qb = (k >> 1) & 3, hp = k & 1;
            it.mode = 2; it.qtok0 = TL + b * 256 + qb * 64; it.nslots = 2;
            { const int h = 2 * hp; it.qcol0 = C_QN + 64 * h; it.kcol0 = C_KN + 64 * h; it.vcol0 = C_VN + 64 * h; it.ocol0 = 512 + 64 * h;
              it.qcol1 = it.qcol0 + 64; it.kcol1 = it.kcol0 + 64; it.vcol1 = it.vcol0 + 64; it.ocol1 = it.ocol0 + 64; }
            it.nloc = 0; it.ctxtok0 = TL + b * 256;
        } else {
            const int k = i - 2176, b = k >> 3, qb = (k >> 1) & 3, kvh = k & 1;
            it.mode = 2; it.qtok0 = TL + b * 256 + qb * 64; it.nslots = 1;
            { const int h = 2 * kvh; it.qcol0 = C_QS + 64 * h; it.ocol0 = 768 + 64 * h; it.sink0 = p.sink[l * 4 + h]; it.sink1 = p.sink[l * 4 + h + 1];
              it.qcol1 = it.qcol0 + 64; it.ocol1 = it.ocol0 + 64; it.kcol0 = it.kcol1 = C_KS + 64 * kvh; it.vcol0 = it.vcol1 = C_VS + 64 * kvh; }
            it.has_sink = 1; it.nloc = 0; it.ctxtok0 = TL + b * 256;
        }
        TS_BEGIN(2);
        if (sub & 2) attn_item(p, lds, l, it);
        TS_END(2);
    }
}

constexpr int N_PHASES = 22;
#ifndef PHMASK
#define PHMASK 0xff
#endif

__device__ __forceinline__ void run_phase(CParams& p, LAS unsigned char* lds, int ph, int sub) {
    unsigned char* ws = p.ws;
    bf16_t* YH = (bf16_t*)(ws + WS_YH); bf16_t* U = (bf16_t*)(ws + WS_R1); bf16_t* PROJ = (bf16_t*)(ws + WS_PROJ); bf16_t* YCAT = (bf16_t*)(ws + WS_YCAT);
    float* XC = (float*)(ws + WS_XC); const float* MOD = (const float*)(ws + WS_MOD);
    const int G = gridDim.x, c = obid();
    if (ph == 0) { if constexpr ((PHMASK & 1) != 0) phase0(p, lds); return; }
    if (ph == 1) {
        if constexpr ((PHMASK & 2) == 0) return;
        ew_pass(p.x, p.ctx, nullptr, nullptr, nullptr, nullptr, nullptr, 0.f, nullptr, YH, p.norm_g, MOD, MOD + 1024, TA); return;
    }
    const int l = (ph - 2) / 10, k = (ph - 2) % 10;
    const float* MODL = MOD + (size_t)l * 17 * NMODC; const float* NG = p.norm_g + (size_t)l * 6 * DM;
    const int rows_late = (l == 0) ? TA : TL;
    switch (k) {
    case 0: case 7: {
        if constexpr ((PHMASK & 4) == 0) break;
        const int f = (k == 7), M = f ? rows_late : TA;
        pg8::Gemm g{YH, (const bf16_t*)(ws + WS_W13) + (size_t)(l * 2 + f) * 5632 * 1024, M, 5632, 1024, 1024, 1024};
        pg8::StaticOrder S; S.init(M, 5632, G, c); EpiSwiGLU E{U};
        pg8::gemm_phase<EpiSwiGLU, pg8::StaticOrder, true, true>(lds, g, S, E);
    } break;
    case 1: case 8: case 5: {
        if constexpr ((PHMASK & 8) == 0) break;
        const bool isout = (k == 5); const int f = (k == 8), M = (k == 1) ? TA : rows_late;
        const int Kd = isout ? YC_LD : FF;
        const bf16_t* Ap = isout ? YCAT : U;
        const bf16_t* Bp = isout ? (const bf16_t*)(ws + WS_WOUT) + (size_t)l * 1024 * YC_LD : (const bf16_t*)(ws + WS_W2T) + (size_t)(l * 2 + f) * 1024 * FF;
        for (int v = 0; v < (M == TA ? 3 : 1); ++v) {
            pg8::Gemm g = v == 0 ? pg8::Gemm{Ap, Bp, TL, 1024, Kd, Kd, Kd}
                                 : pg8::Gemm{Ap + (size_t)TL * Kd + (v - 1) * (Kd / 2), Bp + (v - 1) * (Kd / 2), TC, 1024, Kd / 2, Kd, Kd};
            pg8::StaticOrder S; S.init(g.M, 1024, G, v == 2 ? (c + G - 64) % G : c);
            EpiBf16Tile E{v == 0 ? YH : (v == 1 ? YH + (size_t)TL * DM : (bf16_t*)(ws + WS_Y2)), 1024, 0, 256};
            pg8::gemm_phase<EpiBf16Tile, pg8::StaticOrder, true, true>(lds, g, S, E);
        }
    } break;
    case 2: case 6: case 9: {
        if constexpr ((PHMASK & 2) == 0) break;
        const int gi = (k == 2) ? 2 : (k == 6 ? 5 : 8), ni = (k == 2) ? 1 : (k == 6 ? 3 : 5);
        const int nrows = (k == 2) ? TA : rows_late;
        const bool lastl = (k == 9 && l == 1);
        const float* gpre = (k == 2) ? NG + 2 * DM : (k == 6 ? NG + 4 * DM : p.norm_g + 6 * DM);
        const float* shift = (k == 2) ? MODL + 3 * 1024 : (k == 6 ? MODL + 6 * 1024 : MOD + 17 * NMODC);
        const float* scale = (k == 2) ? MODL + 4 * 1024 : (k == 6 ? MODL + 7 * 1024 : MOD + 17 * NMODC + 1024);
        float* outp = p.out;
        const bool first = (l == 0 && k == 2);
        ew_pass(first ? p.x : outp, first ? p.ctx : XC, outp, XC, YH, (const bf16_t*)(ws + WS_Y2), NG + ni * DM, (k == 6) ? 1.0f : 0.5f, MODL + gi * 1024, lastl ? nullptr : YH, gpre, shift, scale, nrows);
    } break;
    case 3: {
        if constexpr ((PHMASK & 16) == 0) break;
        const bf16_t* W = (const bf16_t*)(ws + WS_WIN) + (size_t)l * 2304 * 1024;
        { pg8::Gemm g{YH, W, TA, NP, 1024, 1024, 1024}; pg8::StaticOrder S; S.init(TA, NP, G, c); EpiWin E{PROJ, (const float*)(ws + WS_ROPE)};
          pg8::gemm_phase<EpiWin, pg8::StaticOrder, true, true>(lds, g, S, E); }
        { const int N = (l == 0) ? TA : TL; pg8::Gemm g{W + (size_t)1792 * 1024, YH, 512, N, 1024, 1024, 1024}; pg8::StaticOrder S; S.init(512, N, G, (c + 16) % G);
          EpiPQ E{(bf16_t*)(ws + WS_PQT), (bf16_t*)(ws + WS_PQTC)};
          pg8::gemm_phase<EpiPQ, pg8::StaticOrder, true, true>(lds, g, S, E); }
    } break;
    case 4: {
        if constexpr ((PHMASK & 32) == 0) break;
        TS_BEGIN(1);
        if (sub & 1)
        for (int v = 0; v < ((l == 0) ? 4 : 2); ++v) {
            const int hs = v & 1, isc = v >> 1;
            const bf16_t* Ap = isc ? (const bf16_t*)(ws + WS_DFTC) + hs * 256 : (const bf16_t*)(ws + WS_DFT) + hs * 2048;
            const bf16_t* Bp = isc ? (const bf16_t*)(ws + WS_PQTC) + hs * 256 : (const bf16_t*)(ws + WS_PQT) + hs * 2048;
            pg8::Gemm g{Ap, Bp, isc ? 256 : 2048, 4096, isc ? 256 : 2048, isc ? DFTC_LD : DFT_LD, isc ? PQTC_LD : PQT_LD};
            pg8::StaticOrder S; S.init(g.M, g.N, G, isc ? (c + G - 16 * hs) % G : (c + G - 128 * hs) % G);
            EpiBf16Tile E{YCAT + (isc ? (size_t)TL * YC_LD : 0) + (hs ? 1024 : 256), YC_LD, isc ? 256 : 2048, 0};
            pg8::gemm_phase<EpiBf16Tile, pg8::StaticOrder, true, true>(lds, g, S, E);
        }
        TS_END(1);
        if (sub & 6) mix_items(p, lds, l, sub);
    } break;
    }
}

__global__ void __launch_bounds__(512, 2) mega(Params p, int ph0, int ph1) {
    extern __shared__ __attribute__((aligned(16))) unsigned char lds_raw[];
    LAS unsigned char* lds = (LAS unsigned char*)lds_raw;
    cg::grid_group grid = cg::this_grid();
    if (ph1 < 0) grid.sync();
    volatile LAS unsigned* xst = (volatile LAS unsigned*)(lds + 131072);
    if (threadIdx.x < 4) xst[threadIdx.x] = 0u;
    __syncthreads();
    XcdBarrier xb = xcd_barrier_post((unsigned*)(p.ws + WS_BAR), xst);
#ifdef TPROBE
    unsigned long long tacc = 0, tprev = __builtin_amdgcn_s_memrealtime();
#endif
    for (int ph = ph0; ph < ph1; ++ph) {
        CParams* q = (CParams*)__builtin_amdgcn_kernarg_segment_ptr(); asm volatile("" : "+s"(q));
        run_phase(*q, lds, ph, 7);
#ifdef DUPK
        { const int kind = ph == 0 ? 10 : (ph == 1 ? 11 : (ph - 2) % 10);
          if ((DUPK >> kind) & 1) { xcd_barrier(xb); run_phase(*q, lds, ph, DUPSUB); } }
#endif
        if (ph + 1 < ph1) xcd_barrier(xb);
#ifdef TPROBE
        { const unsigned long long now = __builtin_amdgcn_s_memrealtime(); const int kind = ph == 0 ? 10 : (ph == 1 ? 11 : (ph - 2) % 10);
          if ((TPROBE >> kind) & 1) tacc += now - tprev; tprev = now; }
#endif
    }
#ifdef TPROBE
    if (blockIdx.x == 0 && threadIdx.x == 0) { const unsigned long long t0 = __builtin_amdgcn_s_memrealtime(); while (__builtin_amdgcn_s_memrealtime() - t0 < tacc) __builtin_amdgcn_s_sleep(8); }
#endif
#ifdef TSUB
    if (blockIdx.x == 0 && threadIdx.x == 0) { const unsigned long long tacc2 = *(volatile LAS unsigned long long*)(lds + 131080); const unsigned long long t0 = __builtin_amdgcn_s_memrealtime(); while (__builtin_amdgcn_s_memrealtime() - t0 < 4ull * tacc2) __builtin_amdgcn_s_sleep(8); }
#endif
#ifdef XSYNC
    for (int i = 0; i < XSYNC; ++i) xcd_barrier(xb);
#endif
}

#ifndef ONE_LAUNCH
#define ONE_LAUNCH 1
#endif

extern "C" void kernel_launch(void* const* d_in, const int* in_sizes, int n_in, void* d_out, int out_size, void* d_ws, size_t ws_size, hipStream_t stream) {
    static int grid = 0;
    if (grid == 0) {
        if (ws_size < WS_END) { fprintf(stderr, "kernel_launch: workspace too small: %zu < %zu\n", ws_size, (size_t)WS_END); grid = -1; return; }
        int dev = 0, cus = 0, per_cu = 0;
        hipGetDevice(&dev); hipDeviceGetAttribute(&cus, hipDeviceAttributeMultiprocessorCount, dev);
        hipFuncSetAttribute((const void*)mega, hipFuncAttributeMaxDynamicSharedMemorySize, LDS_BYTES);
        hipOccupancyMaxActiveBlocksPerMultiprocessor(&per_cu, (const void*)mega, 512, LDS_BYTES);
        if (per_cu < 1) { fprintf(stderr, "kernel_launch: occupancy query says %d blocks per CU\n", per_cu); per_cu = 1; }
        (void)hipGetLastError();
        grid = cus;
    }
    if (grid < 0) return;
    (void)hipMemsetAsync((unsigned char*)d_ws + WS_BAR, 0, 3456 * 4, stream);
    Params p{};
    p.x = (const float*)d_in[0]; p.c = (const float*)d_in[1]; p.ctx = (const float*)d_in[2]; p.c_ctx = (const float*)d_in[3];
    p.w_ada = (const float*)d_in[4]; p.b_ada = (const float*)d_in[5]; p.norm_g = (const float*)d_in[6];
    p.w1 = (const float*)d_in[7]; p.w3 = (const float*)d_in[8]; p.w2 = (const float*)d_in[9]; p.w_in = (const float*)d_in[10];
    p.conv_w = (const float*)d_in[11]; p.conv_b = (const float*)d_in[12]; p.ln_g = (const float*)d_in[13]; p.ln_b = (const float*)d_in[14];
    p.nat_bias = (const float*)d_in[15]; p.sink = (const float*)d_in[16]; p.w_out = (const float*)d_in[17];
    p.out = (float*)d_out; p.ws = (unsigned char*)d_ws;
#if ONE_LAUNCH
    int ph0 = 0, ph1 = N_PHASES;
    void* args[] = {&p, &ph0, &ph1};
    hipError_t e = hipLaunchCooperativeKernel((const void*)mega, dim3(grid), dim3(512), args, LDS_BYTES, stream);
    if (e != hipSuccess) fprintf(stderr, "cooperative launch failed: %s (grid %d)\n", hipGetErrorString(e), grid);
#else
    for (int ph = 0; ph < N_PHASES; ++ph) {
        int ph0 = ph, ph1 = ph + 1;
        void* args[] = {&p, &ph0, &ph1};
        hipError_t e = hipLaunchCooperativeKernel((const void*)mega, dim3(grid), dim3(512), args, LDS_BYTES, stream);
        if (e != hipSuccess) { fprintf(stderr, "launch %d failed: %s (grid %d)\n", ph, hipGetErrorString(e), grid); break; }
    }
#endif
}
```

```cpp
#include <hip/hip_runtime.h>
#include <hip/hip_cooperative_groups.h>
#include <cstdio>
#include <cstdint>
namespace cg = cooperative_groups;
#ifdef TSUB
#define TS_BEGIN(id) do { if ((TSUB) == (id) && threadIdx.x == 0) { *(volatile __attribute__((address_space(3))) unsigned long long*)(lds + 131080) -= __builtin_amdgcn_s_memrealtime(); } } while (0)
#define TS_END(id)   do { if ((TSUB) == (id) && threadIdx.x == 0) { *(volatile __attribute__((address_space(3))) unsigned long long*)(lds + 131080) += __builtin_amdgcn_s_memrealtime(); } } while (0)
#else
#define TS_BEGIN(id) do {} while (0)
#define TS_END(id) do {} while (0)
#endif
namespace pg8 {
#define PG8_LAS __attribute__((address_space(3)))
typedef unsigned short bf16_t;
typedef short bf16x8 __attribute__((ext_vector_type(8)));
typedef float f32x4 __attribute__((ext_vector_type(4)));
typedef unsigned u32x4 __attribute__((ext_vector_type(4)));
constexpr int BM = 256, BK = 64, HALF = 128, HTB = HALF * BK * 2  , STAGE_BYTES = 8 * HTB, NXCD = 8, WGM = 8;

__host__ __device__ __forceinline__ int lds_byte(int r, int c) { const int st = (r >> 4) * 2 + (c >> 5), rr = r & 15, cc = c & 31, ob = rr * 64 + cc * 2; return st * 1024 + (ob ^ (((ob >> 9) & 1) << 5)); }
__host__ __device__ __forceinline__ void stage_rc(int b, int& R, int& C) { const int st = b / 1024, sb = b % 1024, swz = sb ^ (((sb >> 9) & 1) << 5); R = (st >> 1) * 16 + swz / 64; C = (st & 1) * 32 + (swz % 64) / 2; }
__host__ __device__ __forceinline__ int perm32(int rho) { const int n = rho >> 4, i = rho & 15; return 8 * (i >> 2) + 4 * n + (i & 3); }

struct Unit { int pm, pn; };
struct Gemm { const bf16_t* A; const bf16_t* Bt; int M, N, K, lda, ldb; };

struct StaticOrder {
    int nM, nN, nwg, G, c;
    __host__ __device__ void init(int M, int N, int G_, int c_) { nM = M / BM; nN = N / BM; nwg = nM * nN; G = G_; c = c_; }
    __host__ __device__ bool next(int i, Unit& u) const {
        const long L = (long)i * G + c; if (L >= nwg) return false;
        int wgid = (int)L; { const int q = nwg / NXCD, r = nwg % NXCD, xcd = wgid % NXCD, off = wgid / NXCD; wgid = (xcd < r ? xcd * (q + 1) : r * (q + 1) + (xcd - r) * q) + off; }
        const int nig = WGM * nN, gid = wgid / nig, fm = gid * WGM, gsz = (nM - fm) < WGM ? (nM - fm) : WGM;
        u.pm = fm + ((wgid % nig) % gsz); u.pn = (wgid % nig) / gsz; return true;
    }
    __device__ __forceinline__ void a_ready(const Unit&) const {}
    __device__ __forceinline__ void done(const Unit&) const {}
};
__device__ __forceinline__ unsigned cvt_pk_bf16(float lo, float hi) { unsigned r; asm volatile("v_cvt_pk_bf16_f32 %0, %1, %2" : "=v"(r) : "v"(lo), "v"(hi)); return r; }
typedef float f32x2 __attribute__((ext_vector_type(2)));
template <class Epi, class Sched, bool ALIGN_EPI = false, bool SP2 = false>
__device__ __forceinline__ void gemm_phase(PG8_LAS unsigned char* lds, const Gemm g, const Sched& S, const Epi& E) {
    int tid_ = threadIdx.x; asm volatile("" : "+v"(tid_));
    const int tid = tid_, wid = __builtin_amdgcn_readfirstlane(tid >> 6), lane = tid & 63, wr = wid >> 2, wc = wid & 3, fr = lane & 15, fq = lane >> 4;
    const int K = g.K, nt = K / BK;
    unsigned voffA[2], voffB[2];
#pragma unroll
    for (int i = 0; i < 2; ++i) { int R, C; stage_rc(tid * 16 + i * 8192, R, C); const int Rb = Epi::PERM ? ((R & ~31) + perm32(R & 31)) : R;
        voffA[i] = (unsigned)(R * g.lda + C) * 2u; voffB[i] = (unsigned)(Rb * g.ldb + C) * 2u; }
    const size_t kstep = (size_t)(BK * 2);
    const size_t hstepA = (size_t)HALF * g.lda * 2, hstepB = (size_t)HALF * g.ldb * 2;
    const size_t tstepA = 2 * hstepA, tstepB = 2 * hstepB;
    const unsigned ldsw = (unsigned)wid * 1024u;
    const int aoff = lds_byte(wr * 64 + fr, fq * 8), boff = lds_byte(wc * 32 + fr, fq * 8);
#define PG8_SA(b, h) (((b) * 2 + (h)) * HTB)
#define PG8_SB(b, h) ((4 + (b) * 2 + (h)) * HTB)
#define PG8_STAGE(bufoff, gbase, voff) do { _Pragma("unroll") for (int _i = 0; _i < 2; ++_i) \
        __builtin_amdgcn_global_load_lds((const unsigned*)((const char*)(gbase) + (voff)[_i]), (PG8_LAS unsigned*)(lds + (bufoff) + ldsw + _i * 8192), 16, 0, 0); } while (0)
#define PG8_LDA(dst, b, h) do { _Pragma("unroll") for (int m = 0; m < 4; ++m) _Pragma("unroll") for (int k = 0; k < 2; ++k) dst[m][k] = *(const PG8_LAS bf16x8*)(lds + PG8_SA(b, h) + aoff + m * 2048 + k * 1024); } while (0)
#define PG8_LDB(dst, b, h) do { _Pragma("unroll") for (int n = 0; n < 2; ++n) _Pragma("unroll") for (int k = 0; k < 2; ++k) dst[n][k] = *(const PG8_LAS bf16x8*)(lds + PG8_SB(b, h) + boff + n * 2048 + k * 1024); } while (0)
#define PG8_MMA(ai, bj, At, Bt) do { __builtin_amdgcn_s_setprio(1); _Pragma("unroll") for (int m = 0; m < 4; ++m) _Pragma("unroll") for (int n = 0; n < 2; ++n) _Pragma("unroll") for (int k = 0; k < 2; ++k) \
        acc[ai][bj][m][n] = __builtin_amdgcn_mfma_f32_16x16x32_bf16(Bt[n][k], At[m][k], acc[ai][bj][m][n], 0, 0, 0); __builtin_amdgcn_s_setprio(0); } while (0)
#define PG8_WAIT_V(n) asm volatile("s_waitcnt vmcnt(" #n ")" ::: "memory")
#define PG8_WAIT_L(n) asm volatile("s_waitcnt lgkmcnt(" #n ")" ::: "memory")
#define PG8_BAR __builtin_amdgcn_s_barrier()
#define PG8_SCHED __builtin_amdgcn_sched_barrier(0)
    Unit cur, nxt; int ui = 0;
    if (!S.next(0, cur)) return;
    f32x4 acc[2][2][4][2];
#pragma unroll
    for (int a = 0; a < 2; ++a)
#pragma unroll
        for (int b = 0; b < 2; ++b)
#pragma unroll
            for (int m = 0; m < 4; ++m)
#pragma unroll
                for (int n = 0; n < 2; ++n) acc[a][b][m][n] = (f32x4){0.f, 0.f, 0.f, 0.f};
    bf16x8 At[4][2], B0[2][2], B1[2][2];
    const char* cA = (const char*)g.A + (size_t)cur.pm * tstepA; const char* cB = (const char*)g.Bt + (size_t)cur.pn * tstepB;
    S.a_ready(cur);
    if constexpr (SP2) {
        PG8_STAGE(PG8_SB(0, 0), cB, voffB); PG8_STAGE(PG8_SB(0, 1), cB + hstepB, voffB); PG8_STAGE(PG8_SA(0, 0), cA, voffA); PG8_STAGE(PG8_SA(0, 1), cA + hstepA, voffA);
        if (wr == 1) PG8_BAR;
        PG8_WAIT_V(2); PG8_BAR;
        PG8_STAGE(PG8_SB(1, 0), cB + kstep, voffB); PG8_STAGE(PG8_SA(1, 0), cA + kstep, voffA); PG8_STAGE(PG8_SB(1, 1), cB + hstepB + kstep, voffB);
        PG8_WAIT_V(6); PG8_BAR;
    } else {
        PG8_STAGE(PG8_SB(0, 0), cB, voffB); PG8_STAGE(PG8_SA(0, 0), cA, voffA); PG8_STAGE(PG8_SB(0, 1), cB + hstepB, voffB); PG8_STAGE(PG8_SA(0, 1), cA + hstepA, voffA);
        if (wr == 1) PG8_BAR;
        PG8_WAIT_V(4); PG8_BAR;
        PG8_STAGE(PG8_SB(1, 0), cB + kstep, voffB); PG8_STAGE(PG8_SA(1, 0), cA + kstep, voffA); PG8_STAGE(PG8_SB(1, 1), cB + hstepB + kstep, voffB);
        PG8_WAIT_V(6); PG8_BAR;
    }
    for (;;) {
        const bool has_next = S.next(ui + 1, nxt);
        const char* nA = has_next ? (const char*)g.A + (size_t)nxt.pm * tstepA : cA; const char* nB = has_next ? (const char*)g.Bt + (size_t)nxt.pn * tstepB : cB;
        for (int t = 0; t < nt; t += 2) {
            const bool last = (t == nt - 2);
            const char* a1 = cA + (size_t)(t + 1) * kstep;
            const char* a2 = last ? nA : cA + (size_t)(t + 2) * kstep; const char* b2 = last ? nB : cB + (size_t)(t + 2) * kstep;
            const char* a3 = a2 + kstep; const char* b3 = b2 + kstep;
            if (last && has_next) S.a_ready(nxt);
            if constexpr (SP2) {
            PG8_LDB(B0, 0, 0); PG8_LDB(B1, 0, 1); PG8_SCHED; PG8_LDA(At, 0, 0); PG8_STAGE(PG8_SA(1, 1), a1 + hstepA, voffA);
            PG8_WAIT_V(8); PG8_WAIT_L(0); PG8_BAR; PG8_MMA(0, 0, At, B0); PG8_MMA(0, 1, At, B1); PG8_BAR; PG8_SCHED;
            PG8_LDA(At, 0, 1); PG8_STAGE(PG8_SB(0, 0), b2, voffB); PG8_STAGE(PG8_SB(0, 1), b2 + hstepB, voffB); PG8_STAGE(PG8_SA(0, 0), a2, voffA);
            PG8_WAIT_V(8); PG8_WAIT_L(0); PG8_BAR; PG8_MMA(1, 0, At, B0); PG8_MMA(1, 1, At, B1); PG8_BAR; PG8_SCHED;
            PG8_LDB(B0, 1, 0); PG8_LDB(B1, 1, 1); PG8_SCHED; PG8_LDA(At, 1, 0); PG8_STAGE(PG8_SA(0, 1), a2 + hstepA, voffA);
            PG8_WAIT_V(8); PG8_WAIT_L(0); PG8_BAR; PG8_MMA(0, 0, At, B0); PG8_MMA(0, 1, At, B1); PG8_BAR; PG8_SCHED;
            PG8_LDA(At, 1, 1); PG8_STAGE(PG8_SB(1, 0), b3, voffB); PG8_STAGE(PG8_SB(1, 1), b3 + hstepB, voffB); PG8_STAGE(PG8_SA(1, 0), a3, voffA);
            PG8_WAIT_V(8); PG8_WAIT_L(0); PG8_BAR; PG8_MMA(1, 0, At, B0); PG8_MMA(1, 1, At, B1); PG8_BAR; PG8_SCHED;
            } else {
            PG8_LDB(B0, 0, 0); PG8_SCHED; PG8_LDA(At, 0, 0); PG8_STAGE(PG8_SA(1, 1), a1 + hstepA, voffA);
            PG8_WAIT_L(8); PG8_BAR; PG8_WAIT_L(0); PG8_MMA(0, 0, At, B0); PG8_BAR; PG8_SCHED;
            PG8_LDB(B1, 0, 1); PG8_STAGE(PG8_SB(0, 0), b2, voffB);
            PG8_BAR; PG8_WAIT_L(0); PG8_MMA(0, 1, At, B1); PG8_BAR;
            PG8_LDA(At, 0, 1); PG8_STAGE(PG8_SA(0, 0), a2, voffA);
            PG8_BAR; PG8_WAIT_L(0); PG8_MMA(1, 0, At, B0); PG8_BAR; PG8_SCHED;
            PG8_STAGE(PG8_SB(0, 1), b2 + hstepB, voffB);
            PG8_WAIT_V(6); PG8_BAR; PG8_MMA(1, 1, At, B1); PG8_BAR;
            PG8_LDB(B0, 1, 0); PG8_SCHED; PG8_LDA(At, 1, 0); PG8_STAGE(PG8_SA(0, 1), a2 + hstepA, voffA);
            PG8_WAIT_L(8); PG8_BAR; PG8_WAIT_L(0); PG8_MMA(0, 0, At, B0); PG8_BAR; PG8_SCHED;
            PG8_LDB(B1, 1, 1); PG8_STAGE(PG8_SB(1, 0), b3, voffB);
            PG8_BAR; PG8_WAIT_L(0); PG8_MMA(0, 1, At, B1); PG8_BAR;
            PG8_LDA(At, 1, 1); PG8_STAGE(PG8_SA(1, 0), a3, voffA);
            PG8_BAR; PG8_WAIT_L(0); PG8_MMA(1, 0, At, B0); PG8_BAR; PG8_SCHED;
            PG8_STAGE(PG8_SB(1, 1), b3 + hstepB, voffB);
            PG8_WAIT_V(6); PG8_BAR; PG8_MMA(1, 1, At, B1); PG8_BAR;
            }
        }
        if constexpr (ALIGN_EPI) { if (wr == 0) PG8_BAR; }
        TS_BEGIN(8);
        if constexpr (!Epi::AFTER_DRAIN) { E(acc, cur, wr, wc, fr, fq); S.done(cur); }
        TS_END(8);
        if (!has_next) break;
#pragma unroll
        for (int a = 0; a < 2; ++a)
#pragma unroll
            for (int b = 0; b < 2; ++b)
#pragma unroll
                for (int m = 0; m < 4; ++m)
#pragma unroll
                    for (int n = 0; n < 2; ++n) acc[a][b][m][n] = (f32x4){0.f, 0.f, 0.f, 0.f};
        cur = nxt; cA = nA; cB = nB; ++ui;
        if constexpr (ALIGN_EPI) { if (wr == 1) PG8_BAR; }
    }
    PG8_WAIT_V(0);
    if constexpr (!ALIGN_EPI) { if (wr == 0) PG8_BAR; }
    PG8_BAR;
    if constexpr (Epi::AFTER_DRAIN) { E.fused(acc, cur, wr, wc, fr, fq, lds, wid, lane); S.done(cur); }
#undef PG8_SA
#undef PG8_SB
#undef PG8_STAGE
#undef PG8_LDA
#undef PG8_LDB
#undef PG8_MMA
#undef PG8_WAIT_V
#undef PG8_WAIT_L
#undef PG8_BAR
#undef PG8_SCHED
}
}

#define LAS __attribute__((address_space(3)))
typedef unsigned short bf16_t;
typedef float f32x4 __attribute__((ext_vector_type(4)));
typedef float f32x2 __attribute__((ext_vector_type(2)));
typedef unsigned u32x4 __attribute__((ext_vector_type(4)));
typedef unsigned u32x2 __attribute__((ext_vector_type(2)));
typedef short bf16x8 __attribute__((ext_vector_type(8)));
typedef short bf16x4 __attribute__((ext_vector_type(4)));

constexpr int TL = 32768, TC = 4096, TA = 36864, DM = 1024, FF = 2816, NP = 1792, NMODC = 9216;
constexpr int YC_LD = 1280, DFT_LD = 4160, PQT_LD = 4160, DFTC_LD = 576, PQTC_LD = 576;
constexpr int LDS_BYTES = 131072 + 16;
#ifndef MIXMASK
#define MIXMASK 7
#endif

constexpr float EPSV = 1e-6f;
constexpr float LOG2E = 1.4426950408889634f;

constexpr size_t WS_XC   = 0;
constexpr size_t WS_YH   = WS_XC + (size_t)TA * DM * 2;
constexpr size_t WS_R1   = WS_YH + (size_t)TA * DM * 2;
constexpr size_t WS_PROJ = WS_R1;
constexpr size_t WS_PQT  = WS_PROJ + (size_t)TA * NP * 2;
constexpr size_t WS_PQTC = WS_PQT + (size_t)4096 * PQT_LD * 2;
constexpr size_t WS_YCAT = WS_PQTC + (size_t)4096 * PQTC_LD * 2;
constexpr size_t WS_R1END= WS_YCAT + (size_t)TA * YC_LD * 2;
constexpr size_t WS_W13  = WS_R1END;
constexpr size_t WS_W2T  = WS_W13 + (size_t)4 * 5632 * 1024 * 2;
constexpr size_t WS_WIN  = WS_W2T + (size_t)4 * 1024 * 2816 * 2;
constexpr size_t WS_WOUT = WS_WIN + (size_t)2 * 2304 * 1024 * 2;
constexpr size_t WS_DFT  = WS_WOUT + (size_t)2 * 1024 * YC_LD * 2;
constexpr size_t WS_DFTC = WS_DFT + (size_t)2048 * DFT_LD * 2;
constexpr size_t WS_MOD  = WS_DFTC + (size_t)256 * DFTC_LD * 2;
constexpr size_t WS_ROPE = WS_MOD + (size_t)2 * 17 * NMODC * 4;
constexpr size_t WS_BAR  = WS_ROPE + 64 * 16 * 2 * 4;
constexpr size_t WS_Y2   = WS_BAR + 3456 * 4;
constexpr size_t WS_END  = WS_Y2 + (size_t)TC * DM * 2;
static_assert(WS_END <= (size_t)536870912, "workspace budget (4 x the largest tensor)");
static_assert((size_t)TA * FF * 2 <= WS_R1END - WS_R1, "U must fit in R1");

struct Params {
    const float *x, *c, *ctx, *c_ctx, *w_ada, *b_ada, *norm_g, *w1, *w3, *w2, *w_in, *conv_w, *conv_b, *ln_g, *ln_b, *nat_bias, *sink, *w_out;
    float* out; unsigned char* ws;
};
typedef const __attribute__((address_space(4))) Params CParams;

__device__ __forceinline__ unsigned pk2(float lo, float hi) { return pg8::cvt_pk_bf16(lo, hi); }
__device__ __forceinline__ float bflo(unsigned v) { return __uint_as_float(v << 16); }
__device__ __forceinline__ float bfhi(unsigned v) { return __uint_as_float(v & 0xffff0000u); }
__device__ __forceinline__ int otid() { int t = threadIdx.x; asm volatile("" : "+v"(t)); return t; }
__device__ __forceinline__ int obid() { int t = blockIdx.x; asm volatile("" : "+s"(t)); return t; }
__device__ __forceinline__ float xrow16_max(float x) {
    auto s = __builtin_amdgcn_permlane16_swap(__float_as_uint(x), __float_as_uint(x), false, false);
    x = fmaxf(__uint_as_float(s[0]), __uint_as_float(s[1]));
    auto t = __builtin_amdgcn_permlane32_swap(__float_as_uint(x), __float_as_uint(x), false, false);
    return fmaxf(__uint_as_float(t[0]), __uint_as_float(t[1]));
}
__device__ __forceinline__ float xrow16_sum(float x) {
    auto s = __builtin_amdgcn_permlane16_swap(__float_as_uint(x), __float_as_uint(x), false, false);
    x = __uint_as_float(s[0]) + __uint_as_float(s[1]);
    auto t = __builtin_amdgcn_permlane32_swap(__float_as_uint(x), __float_as_uint(x), false, false);
    return __uint_as_float(t[0]) + __uint_as_float(t[1]);
}
template <int CTRL> __device__ __forceinline__ float dpp_mov(float x) { return __builtin_bit_cast(float, __builtin_amdgcn_mov_dpp(__builtin_bit_cast(int, x), CTRL, 0xf, 0xf, true)); }
__device__ __forceinline__ float wave_sum(float v) {
    v += dpp_mov<0xB1>(v);
    v += dpp_mov<0x4E>(v);
    v += dpp_mov<0x141>(v);
    v += dpp_mov<0x128>(v);
    return xrow16_sum(v);
}
__device__ __forceinline__ float fast_exp2(float x) { return __builtin_amdgcn_exp2f(x); }
__device__ __forceinline__ float fast_rcp(float x) { return __builtin_amdgcn_rcpf(x); }
__device__ __forceinline__ float silu_f(float v) { return v * fast_rcp(1.0f + fast_exp2(-v * LOG2E)); }
__device__ __forceinline__ float sigmoid_f(float v) { return fast_rcp(1.0f + fast_exp2(-v * LOG2E)); }

#define XB_TMO      128
#define XB_XCNT(j)  (256  + 64 * (j))
#define XB_XSUB(j)  (1280 + 64 * (j))
#define XB_XGEN(j)  (2304 + 64 * (j))
#define XB_TOP      3328
#define XB_TOPGEN   3392
#define XCD_BAR_WORDS 3456
#define XB_SPIN_CAP (1u << 18)

__device__ __forceinline__ unsigned xb_ld(unsigned* p)              { return __hip_atomic_load(p, __ATOMIC_RELAXED, __HIP_MEMORY_SCOPE_AGENT); }
__device__ __forceinline__ unsigned xb_add(unsigned* p, unsigned v) { return __hip_atomic_fetch_add(p, v, __ATOMIC_RELAXED, __HIP_MEMORY_SCOPE_AGENT); }
__device__ __forceinline__ unsigned xb_xcc_id() { return (unsigned)__builtin_amdgcn_s_getreg((3 << 11) | 20) & 0xFu; }
#define XB_SPIN(cond, bar) do { unsigned _sp = 0; while (cond) { __builtin_amdgcn_s_sleep(1); \
    if ((++_sp & 255u) == 0u) { if (xb_ld(&(bar)[XB_TMO])) break; if (_sp > XB_SPIN_CAP) { atomicAdd(&(bar)[XB_TMO], 1u); break; } } } } while (0)

struct XcdBarrier {
    unsigned* bar; unsigned x;
    volatile LAS unsigned* st;
};

__device__ __forceinline__ XcdBarrier xcd_barrier_post(unsigned* bar, volatile LAS unsigned* st) {
    XcdBarrier b; b.bar = bar; b.x = xb_xcc_id(); b.st = st;
    if (threadIdx.x == 0) (void)xb_add(&bar[XB_XCNT(b.x)], 1u);
    return b;
}
__device__ __forceinline__ void xcd_barrier_complete(unsigned* bar, unsigned x, unsigned& nloc, unsigned& nx) {
    const unsigned G = gridDim.x * gridDim.y * gridDim.z;
    unsigned sum, cnt, mine, sp = 0u;
    for (;;) {
        sum = 0u; cnt = 0u; mine = 0u;
#pragma unroll
        for (unsigned j = 0; j < 16; ++j) { const unsigned c = xb_ld(&bar[XB_XCNT(j)]); sum += c; cnt += (c > 0u) ? 1u : 0u; mine = (j == x) ? c : mine; }
        if (sum == G) break;
        __builtin_amdgcn_s_sleep(1);
        if ((++sp & 255u) == 0u) { if (xb_ld(&bar[XB_TMO])) break; if (sp > XB_SPIN_CAP) { atomicAdd(&bar[XB_TMO], 1u); break; } }
    }
    nloc = mine > 0u ? mine : 1u; nx = cnt > 0u ? cnt : 1u;
}

__device__ __forceinline__ void xcd_barrier(const XcdBarrier& b) {
    asm volatile("s_waitcnt vmcnt(0)" ::: "memory");
    __syncthreads();
    if (threadIdx.x == 0) {
        unsigned* bar = b.bar;
        __builtin_amdgcn_s_waitcnt(0);
        unsigned nloc = b.st[0], nx = b.st[1];
        if (nloc == 0u) { xcd_barrier_complete(bar, b.x, nloc, nx); b.st[0] = nloc; b.st[1] = nx; }
        const unsigned old = xb_add(&bar[XB_XSUB(b.x)], 1u);
        const unsigned gen = old / nloc;
        if (old + 1u == (gen + 1u) * nloc) {
            __builtin_amdgcn_fence(__ATOMIC_RELEASE, "agent");
            asm volatile("s_waitcnt vmcnt(0)" ::: "memory");
            const unsigned og = xb_add(&bar[XB_TOP], 1u);
            const unsigned tg = og / nx;
            if (og + 1u == (tg + 1u) * nx) xb_add(&bar[XB_TOPGEN], 1u);
            else XB_SPIN(xb_ld(&bar[XB_TOPGEN]) == tg, bar);
            __builtin_amdgcn_fence(__ATOMIC_ACQUIRE, "agent");
            xb_add(&bar[XB_XGEN(b.x)], 1u);
            asm volatile("s_waitcnt vmcnt(0)" ::: "memory");
        } else {
            XB_SPIN(xb_ld(&bar[XB_XGEN(b.x)]) == gen, bar);
            __builtin_amdgcn_fence(__ATOMIC_ACQUIRE, "agent");
            asm volatile("s_waitcnt vmcnt(0)" ::: "memory");
        }
    }
    __syncthreads();
}


struct EpiSwiGLU {
    static constexpr bool PERM = true, AFTER_DRAIN = false;
    bf16_t* U;
    __device__ __forceinline__ void operator()(const f32x4 (&acc)[2][2][4][2], const pg8::Unit& u, int wr, int wc, int fr, int fq) const {
        const int row0 = u.pm * 256 + wr * 64 + fr, col0 = u.pn * 128 + wc * 32 + 8 * fq;
#pragma unroll
        for (int ai = 0; ai < 2; ++ai)
#pragma unroll
            for (int m = 0; m < 4; ++m) {
                bf16_t* rowp = U + (size_t)(row0 + ai * 128 + m * 16) * FF + col0;
                unsigned wv[4];
#pragma unroll
                for (int n = 0; n < 2; ++n)
#pragma unroll
                    for (int h = 0; h < 2; ++h) {
                        const f32x2 g2 = {acc[ai][0][m][n][2 * h], acc[ai][0][m][n][2 * h + 1]}, u2 = {acc[ai][1][m][n][2 * h], acc[ai][1][m][n][2 * h + 1]};
                        const f32x2 t = g2 * (-LOG2E);
                        f32x2 d; d.x = fast_exp2(t.x); d.y = fast_exp2(t.y);
                        d = d + 1.0f;
                        f32x2 r; r.x = fast_rcp(d.x); r.y = fast_rcp(d.y);
                        const f32x2 v = (g2 * u2) * r;
                        wv[n * 2 + h] = pk2(v.x, v.y);
                    }
                u32x4 w; w.x = wv[0]; w.y = wv[1]; w.z = wv[2]; w.w = wv[3];
                *(u32x4*)rowp = w;
            }
    }
};
struct EpiBf16Tile {
    static constexpr bool PERM = true, AFTER_DRAIN = false;
    bf16_t* O; int ldc, row_pn, col_pn;
    __device__ __forceinline__ void operator()(const f32x4 (&acc)[2][2][4][2], const pg8::Unit& u, int wr, int wc, int fr, int fq) const {
        const int row0 = u.pm * 256 + u.pn * row_pn + wr * 64 + fr, col0 = u.pn * col_pn + wc * 32 + 8 * fq;
#pragma unroll
        for (int ai = 0; ai < 2; ++ai)
#pragma unroll
            for (int m = 0; m < 4; ++m) {
                bf16_t* rowp = O + (size_t)(row0 + ai * 128 + m * 16) * ldc + col0;
#pragma unroll
                for (int bj = 0; bj < 2; ++bj) {
                    const f32x4 v0 = acc[ai][bj][m][0], v1 = acc[ai][bj][m][1];
                    u32x4 w; w.x = pk2(v0[0], v0[1]); w.y = pk2(v0[2], v0[3]); w.z = pk2(v1[0], v1[1]); w.w = pk2(v1[2], v1[3]);
                    *(u32x4*)(rowp + bj * 128) = w;
                }
            }
    }
};
struct EpiPQ {
    static constexpr bool PERM = true, AFTER_DRAIN = false;
    bf16_t* PQT; bf16_t* PQTC;
    __device__ __forceinline__ void operator()(const f32x4 (&acc)[2][2][4][2], const pg8::Unit& u, int wr, int wc, int fr, int fq) const {
        const int cl = wc * 32 + 8 * fq;
#pragma unroll
        for (int ai = 0; ai < 2; ++ai)
#pragma unroll
            for (int m = 0; m < 4; ++m) {
                const int mp = u.pm * 256 + ai * 128 + wr * 64 + m * 16 + fr;
                const int g = mp >> 7, pq = (mp >> 6) & 1, cp = mp & 63;
                bf16_t* rowp;
                if (u.pn < 128) { const int b = u.pn >> 3, n0 = (u.pn & 7) * 256; rowp = PQT + (size_t)(b * 256 + g * 64 + cp) * PQT_LD + pq * 2048 + n0 + cl; }
                else { const int b = u.pn - 128; rowp = PQTC + (size_t)(b * 256 + g * 64 + cp) * PQTC_LD + pq * 256 + cl; }
#pragma unroll
                for (int bj = 0; bj < 2; ++bj) {
                    const f32x4 v0 = acc[ai][bj][m][0], v1 = acc[ai][bj][m][1];
                    u32x4 w; w.x = pk2(v0[0], v0[1]); w.y = pk2(v0[2], v0[3]); w.z = pk2(v1[0], v1[1]); w.w = pk2(v1[2], v1[3]);
                    *(u32x4*)(rowp + bj * 128) = w;
                }
            }
    }
};
struct EpiWin {
    static constexpr bool PERM = false, AFTER_DRAIN = false;
    bf16_t* P; const float* rope;
    __device__ __forceinline__ void operator()(const f32x4 (&acc)[2][2][4][2], const pg8::Unit& u, int wr, int wc, int fr, int fq) const {
        const int row0 = u.pm * 256 + wr * 64 + fr, col0 = u.pn * 256 + wc * 32 + 4 * fq;
        const float qs = (u.pn == 2 || u.pn == 5) ? 0.125f * LOG2E : 1.0f;
        const bool lat = u.pm < 128;
#pragma unroll
        for (int ai = 0; ai < 2; ++ai)
#pragma unroll
            for (int m = 0; m < 4; ++m) {
                const int r = row0 + ai * 128 + m * 16;
                bf16_t* rowp = P + (size_t)r * NP + col0;
                const int t = r & 2047;
                const int pos = (wc & 1) ? (t & 63) : (t >> 6);
#pragma unroll
                for (int bj = 0; bj < 2; ++bj) {
                    f32x4 v0 = acc[ai][bj][m][0], v1 = acc[ai][bj][m][1];
                    const bool dorope = lat && (u.pn == 5 || (u.pn == 6 && bj == 0));
                    if (dorope) {
                        const f32x4 cs0 = *(const f32x4*)(rope + (pos * 16 + 4 * fq) * 2), cs1 = *(const f32x4*)(rope + (pos * 16 + 4 * fq) * 2 + 4);
                        const float c0 = cs0[0], s0 = cs0[1], c1 = cs0[2], s1 = cs0[3], c2 = cs1[0], s2 = cs1[1], c3 = cs1[2], s3 = cs1[3];
                        f32x4 a, b;
                        a[0] = v0[0] * c0 - v1[0] * s0; b[0] = v0[0] * s0 + v1[0] * c0;
                        a[1] = v0[1] * c1 - v1[1] * s1; b[1] = v0[1] * s1 + v1[1] * c1;
                        a[2] = v0[2] * c2 - v1[2] * s2; b[2] = v0[2] * s2 + v1[2] * c2;
                        a[3] = v0[3] * c3 - v1[3] * s3; b[3] = v0[3] * s3 + v1[3] * c3;
                        v0 = a; v1 = b;
                    }
                    v0 = v0 * qs; v1 = v1 * qs;
                    u32x2 w0, w1; w0.x = pk2(v0[0], v0[1]); w0.y = pk2(v0[2], v0[3]); w1.x = pk2(v1[0], v1[1]); w1.y = pk2(v1[2], v1[3]);
                    *(u32x2*)(rowp + bj * 128) = w0; *(u32x2*)(rowp + bj * 128 + 16) = w1;
                }
            }
    }
};

struct TrItem { const float* src; bf16_t* dst; int ld_src, ld_dst; };
__device__ __forceinline__ TrItem tr_decode(CParams& p, int it) {
    constexpr int PER_L = 2 * 704 + 2 * 352 + 224 + 160;
    unsigned char* ws = p.ws;
    const int l = it / PER_L; int q = it % PER_L;
    const float* src; bf16_t* dst; int ld_src, ld_dst, col0, k0, r0;
    if (q < 2 * 704) { const int f = q / 704; q %= 704; const int rt = q >> 4, kt = q & 15, R0 = rt * 128, tile = R0 >> 8, bj = (R0 >> 7) & 1;
        src = (bj ? p.w3 : p.w1) + (size_t)(l * 2 + f) * 1024 * FF; ld_src = FF; col0 = 128 * tile; k0 = 64 * kt; dst = (bf16_t*)(ws + WS_W13) + (size_t)(l * 2 + f) * 5632 * 1024; r0 = R0; ld_dst = 1024; }
    else if (q < 2 * 704 + 2 * 352) { q -= 2 * 704; const int f = q / 352; q %= 352; const int rt = q / 44, kt = q % 44;
        src = p.w2 + (size_t)(l * 2 + f) * FF * 1024; ld_src = 1024; col0 = 128 * rt; k0 = 64 * kt; dst = (bf16_t*)(ws + WS_W2T) + (size_t)(l * 2 + f) * 1024 * FF; r0 = 128 * rt; ld_dst = FF; }
    else if (q < 2 * 704 + 2 * 352 + 224) { q -= 2 * 704 + 2 * 352; const int rt = q >> 4, kt = q & 15, R0 = rt * 128;
        src = p.w_in + (size_t)l * 1024 * 2048; ld_src = 2048; col0 = R0 < 512 ? R0 : R0 + 256; k0 = 64 * kt; dst = (bf16_t*)(ws + WS_WIN) + (size_t)l * 2304 * 1024; r0 = R0; ld_dst = 1024; }
    int ks = -1;
    if (q >= 2 * 704 + 2 * 352 + 224) { q -= 2 * 704 + 2 * 352 + 224; const int rt = q / 20, kt = q % 20;
        src = p.w_out + (size_t)l * 1024 * 1024; ld_src = 1024; col0 = 128 * rt; k0 = 64 * kt; ks = kt < 16 ? 64 * kt : 256 + 64 * (kt - 16); dst = (bf16_t*)(ws + WS_WOUT) + (size_t)l * 1024 * YC_LD; r0 = 128 * rt; ld_dst = YC_LD; }
    if (ks < 0) ks = k0;
    TrItem t; t.src = src + (size_t)ks * ld_src + col0; t.dst = dst + (size_t)r0 * ld_dst + k0; t.ld_src = ld_src; t.ld_dst = ld_dst; return t;
}

__device__ __forceinline__ void phase0(CParams& p, LAS unsigned char* lds) {
    const int tid = otid(), wave = tid >> 6, lane = tid & 63;
    unsigned char* ws = p.ws;
    const int bid = obid(), G = gridDim.x;
    TS_BEGIN(9);
    if (bid < 288) {
        LAS float* sS = (LAS float*)lds;
        LAS float* sR = sS + 17 * 1024;
        for (int i = tid; i < 17 * 1024; i += 512) { const float v = (i < 16384) ? p.c[i] : p.c_ctx[i - 16384]; sS[i] = v / (1.0f + __expf(-v)); }
        __syncthreads();
        for (int r = bid; r < 288; r += G) {
            const int l = r / 144, j0 = (r % 144) * 64, k0 = wave * 128;
            float acc[17];
#pragma unroll
            for (int q = 0; q < 17; ++q) acc[q] = 0.f;
            const float* wp = p.w_ada + ((size_t)l * 1024 + k0) * NMODC + j0 + lane;
            float wv[16];
#pragma unroll
            for (int kk = 0; kk < 16; ++kk) wv[kk] = __builtin_nontemporal_load(wp + (size_t)kk * NMODC);
#pragma unroll 1
            for (int kb = 0; kb < 128; kb += 16) {
                float wn[16];
                const int kn = (kb + 16 < 128) ? kb + 16 : kb;
#pragma unroll
                for (int kk = 0; kk < 16; ++kk) wn[kk] = __builtin_nontemporal_load(wp + (size_t)(kn + kk) * NMODC);
#pragma unroll 1
                for (int k4 = 0; k4 < 16; k4 += 4) {
                    const float w0 = k4 == 0 ? wv[0] : (k4 == 4 ? wv[4] : (k4 == 8 ? wv[8] : wv[12]));
                    const float w1 = k4 == 0 ? wv[1] : (k4 == 4 ? wv[5] : (k4 == 8 ? wv[9] : wv[13]));
                    const float w2 = k4 == 0 ? wv[2] : (k4 == 4 ? wv[6] : (k4 == 8 ? wv[10] : wv[14]));
                    const float w3 = k4 == 0 ? wv[3] : (k4 == 4 ? wv[7] : (k4 == 8 ? wv[11] : wv[15]));
#pragma unroll
                    for (int q = 0; q < 17; ++q) { const f32x4 sv = *(const LAS f32x4*)(sS + q * 1024 + k0 + kb + k4);
                        acc[q] += (sv[0] * w0 + sv[1] * w1) + (sv[2] * w2 + sv[3] * w3); }
                }
#pragma unroll
                for (int kk = 0; kk < 16; ++kk) wv[kk] = wn[kk];
            }
#pragma unroll
            for (int q = 0; q < 17; ++q) sR[(wave * 17 + q) * 64 + lane] = acc[q];
            __syncthreads();
            float* MOD = (float*)(ws + WS_MOD);
            for (int o = tid; o < 17 * 64; o += 512) {
                const int q = o >> 6, ln = o & 63; float s = p.b_ada[l * NMODC + j0 + ln];
#pragma unroll
                for (int w = 0; w < 8; ++w) s += sR[(w * 17 + q) * 64 + ln];
                MOD[(size_t)(l * 17 + q) * NMODC + j0 + ln] = s;
            }
            __syncthreads();
        }
    }
    TS_END(9);
    TS_BEGIN(10);
    {
        constexpr int N_TR = 2 * (2 * 704 + 2 * 352 + 224 + 160);
        LAS float* t = (LAS float*)lds;
        const int lk = tid >> 5, lc = (tid & 31) * 4;
        const int sr = tid >> 2, sk = (tid & 3) * 16;
        const bool bal = (G == 256) && (N_TR == 4992);
        int it = bal ? (bid >= 32 ? (bid - 32) * 21 : 4704 + bid * 9) : bid;
        const int step = bal ? 1 : G, tr_end = bal ? it + (bid >= 32 ? 21 : 9) : N_TR;
        f32x4 pre[4]; TrItem cur;
        if (it < tr_end) { cur = tr_decode(p, it);
#pragma unroll
            for (int i = 0; i < 4; ++i) pre[i] = __builtin_nontemporal_load((const f32x4*)(cur.src + (size_t)(lk + 16 * i) * cur.ld_src + lc)); }
        while (it < tr_end) {
#pragma unroll
            for (int i = 0; i < 4; ++i) { LAS float* d = t + (lk + 16 * i) * 129 + lc; d[0] = pre[i][0]; d[1] = pre[i][1]; d[2] = pre[i][2]; d[3] = pre[i][3]; }
            __syncthreads();
            bf16_t* dp = cur.dst + (size_t)sr * cur.ld_dst + sk;
            const int nxt = it + step;
            if (nxt < tr_end) { cur = tr_decode(p, nxt);
#pragma unroll
                for (int i = 0; i < 4; ++i) pre[i] = __builtin_nontemporal_load((const f32x4*)(cur.src + (size_t)(lk + 16 * i) * cur.ld_src + lc)); }
            { const LAS float* s = t + sk * 129 + sr;
              u32x4 o0, o1;
              o0.x = pk2(s[0 * 129], s[1 * 129]); o0.y = pk2(s[2 * 129], s[3 * 129]); o0.z = pk2(s[4 * 129], s[5 * 129]); o0.w = pk2(s[6 * 129], s[7 * 129]);
              o1.x = pk2(s[8 * 129], s[9 * 129]); o1.y = pk2(s[10 * 129], s[11 * 129]); o1.z = pk2(s[12 * 129], s[13 * 129]); o1.w = pk2(s[14 * 129], s[15 * 129]);
              *(u32x4*)dp = o0; *(u32x4*)(dp + 8) = o1; }
            __syncthreads();
            it = nxt;
        }
    }
    TS_END(10);
    TS_BEGIN(11);
    for (int r = bid; r < 256; r += G) {
        const int l = r >> 7, k0 = (r & 127) * 8;
        LAS float* sW = (LAS float*)lds;
        LAS float* sC = sW + 2048;
        for (int i = tid; i < 2048; i += 512) { const int kk = i >> 8, cc = i & 255; sW[i] = p.w_in[((size_t)l * 1024 + k0 + kk) * 2048 + 512 + cc]; }
        if (tid < 64) sC[tid] = cospif((float)tid * (1.0f / 32.0f));
        __syncthreads();
        const int g = tid >> 7, j = tid & 127, jj = j & 63, isS = j >> 6;
        float acc[8];
#pragma unroll
        for (int q = 0; q < 8; ++q) acc[q] = 0.f;
        for (int c = 0; c < 64; ++c) {
            const int mm = (c * jj) & 63; const float tv = sC[isS ? ((mm - 16) & 63) : mm];
#pragma unroll
            for (int q = 0; q < 8; ++q) acc[q] += sW[q * 256 + g * 64 + c] * tv;
        }
        u32x4 o; o.x = pk2(acc[0] * 0.125f, acc[1] * 0.125f); o.y = pk2(acc[2] * 0.125f, acc[3] * 0.125f); o.z = pk2(acc[4] * 0.125f, acc[5] * 0.125f); o.w = pk2(acc[6] * 0.125f, acc[7] * 0.125f);
        *(u32x4*)((bf16_t*)(ws + WS_WIN) + ((size_t)l * 2304 + 1792 + g * 128 + j) * 1024 + k0) = o;
        __syncthreads();
    }
    {
        LAS float* tab = (LAS float*)lds;
        for (int m = tid; m < 2048; m += 512) tab[m] = cospif((float)m * (1.0f / 1024.0f)) * 0.022097086912079608f;
        __syncthreads();
        for (int r = bid; r < 2048 + 256; r += G) {
            if (r < 2048) {
                float v[8];
#pragma unroll
                for (int e = 0; e < 8; ++e) { const int k = tid * 8 + e, idx = (r * (k & 2047)) & 2047; v[e] = tab[k < 2048 ? idx : ((idx + 512) & 2047)]; }
                u32x4 o; o.x = pk2(v[0], v[1]); o.y = pk2(v[2], v[3]); o.z = pk2(v[4], v[5]); o.w = pk2(v[6], v[7]);
                *(u32x4*)((bf16_t*)(ws + WS_DFT) + (size_t)r * DFT_LD + tid * 8) = o;
            } else if (tid < 64) {
                const int np = r - 2048; const float sc = 2.8284271247461903f;
                float v[8];
#pragma unroll
                for (int e = 0; e < 8; ++e) { const int k = tid * 8 + e, idx = ((np * (k & 255)) & 255) * 8; v[e] = tab[k < 256 ? idx : ((idx + 512) & 2047)] * sc; }
                u32x4 o; o.x = pk2(v[0], v[1]); o.y = pk2(v[2], v[3]); o.z = pk2(v[4], v[5]); o.w = pk2(v[6], v[7]);
                *(u32x4*)((bf16_t*)(ws + WS_DFTC) + (size_t)np * DFTC_LD + tid * 8) = o;
            }
        }
        __syncthreads();
    }
    TS_END(11);
    if (bid == G - 1) {
        float* rtab = (float*)(ws + WS_ROPE);
        for (int e = tid; e < 1024; e += 512) { const int pos = e >> 4, i = e & 15;
            const float inv = fast_exp2(-(float)i * (13.287712379549449f / 16.0f));
            const float tt = (float)pos * inv * 0.3183098861837907f;
            rtab[2 * e] = cospif(tt); rtab[2 * e + 1] = sinpif(tt); }
    }
}

struct EwRow { f32x4 x[4]; u32x2 xb[4]; u32x2 y[4]; u32x2 y2[4]; };
__device__ __forceinline__ void ew_load(EwRow& r, const float* xin_lat, const float* xin_ctx, const bf16_t* xin_bf, const bf16_t* Yp, const bf16_t* Y2p, int t, int lane) {
    if (xin_bf) {
#pragma unroll
        for (int j = 0; j < 4; ++j) r.xb[j] = __builtin_nontemporal_load((const u32x2*)(xin_bf + (size_t)t * DM + 4 * lane + 256 * j));
    } else {
        const float* xr = t < TL ? xin_lat + (size_t)t * DM : xin_ctx + (size_t)(t - TL) * DM;
#pragma unroll
        for (int j = 0; j < 4; ++j) r.x[j] = __builtin_nontemporal_load((const f32x4*)(xr + 4 * lane + 256 * j));
    }
    if (Yp) {
#pragma unroll
        for (int j = 0; j < 4; ++j) r.y[j] = __builtin_nontemporal_load((const u32x2*)(Yp + (size_t)t * DM + 4 * lane + 256 * j));
        if (t >= TL) {
#pragma unroll
            for (int j = 0; j < 4; ++j) r.y2[j] = __builtin_nontemporal_load((const u32x2*)(Y2p + (size_t)(t - TL) * DM + 4 * lane + 256 * j));
        }
    }
}
__device__ __forceinline__ void ew_pass(const float* xin_lat, const float* xin_ctx, const bf16_t* xin_bf, bf16_t* xout_bf, float* xout_f32, const bf16_t* Yp, const bf16_t* Y2p, const float* gpost, float fac, const float* gate,
                                        bf16_t* Hp, const float* gpre, const float* shift, const float* scale, int nrows) {
    const int tid = otid(); const int wave = tid >> 6, lane = tid & 63;
    const int per = (nrows + (int)gridDim.x - 1) / (int)gridDim.x, tbeg = obid() * per + wave, tend = min(obid() * per + per, nrows);
    f32x4 vgp[4], vgt[4], vpre[4], vsh[4], vsc[4];
#pragma unroll
    for (int j = 0; j < 4; ++j) { vgp[j] = Yp ? *(const f32x4*)(gpost + 4 * lane + 256 * j) : (f32x4){0.f, 0.f, 0.f, 0.f}; vpre[j] = Hp ? *(const f32x4*)(gpre + 4 * lane + 256 * j) : (f32x4){0.f, 0.f, 0.f, 0.f};
        vgt[j] = vsh[j] = vsc[j] = (f32x4){0.f, 0.f, 0.f, 0.f}; }
    int bcur = -1;
    EwRow A, B;
    auto process = [&](EwRow& r, int t) {
        const bool lat = t < TL; const int b = lat ? (t >> 11) : 16;
        if (xin_bf) {
#pragma unroll
            for (int j = 0; j < 4; ++j) { const u32x2 w = r.xb[j]; r.x[j][0] = bflo(w.x); r.x[j][1] = bfhi(w.x); r.x[j][2] = bflo(w.y); r.x[j][3] = bfhi(w.y); }
        }
        if (b != bcur) { bcur = b;
#pragma unroll
            for (int j = 0; j < 4; ++j) { const int cidx = 4 * lane + 256 * j;
                if (Yp) vgt[j] = *(const f32x4*)(gate + (size_t)b * NMODC + cidx) * fac;
                if (Hp) { vsh[j] = *(const f32x4*)(shift + (size_t)b * NMODC + cidx); vsc[j] = *(const f32x4*)(scale + (size_t)b * NMODC + cidx) + 1.0f; } } }
        if (Yp) {
            f32x4 y[4]; float ss = 0.f;
#pragma unroll
            for (int j = 0; j < 4; ++j) { const u32x2 w = r.y[j];
                y[j][0] = bflo(w.x); y[j][1] = bfhi(w.x); y[j][2] = bflo(w.y); y[j][3] = bfhi(w.y);
                if (!lat) { const u32x2 w2 = r.y2[j]; y[j][0] += bflo(w2.x); y[j][1] += bfhi(w2.x); y[j][2] += bflo(w2.y); y[j][3] += bfhi(w2.y); }
                ss += (y[j][0] * y[j][0] + y[j][1] * y[j][1]) + (y[j][2] * y[j][2] + y[j][3] * y[j][3]); }
            const float rstd = 1.0f / sqrtf(wave_sum(ss) * (1.0f / DM) + EPSV);
#pragma unroll
            for (int j = 0; j < 4; ++j) r.x[j] = r.x[j] + vgt[j] * (y[j] * rstd * vgp[j]);
        }
        if (xout_f32) {
            float* xo = xout_f32 + (size_t)t * DM;
#pragma unroll
            for (int j = 0; j < 4; ++j) __builtin_nontemporal_store(r.x[j], (f32x4*)(xo + 4 * lane + 256 * j));
        } else if (xout_bf) {
#pragma unroll
            for (int j = 0; j < 4; ++j) { u32x2 w; w.x = pk2(r.x[j][0], r.x[j][1]); w.y = pk2(r.x[j][2], r.x[j][3]);
                __builtin_nontemporal_store(w, (u32x2*)(xout_bf + (size_t)t * DM + 4 * lane + 256 * j));
                r.x[j][0] = bflo(w.x); r.x[j][1] = bfhi(w.x); r.x[j][2] = bflo(w.y); r.x[j][3] = bfhi(w.y); }
        }
        if (Hp) {
            float ss = 0.f;
#pragma unroll
            for (int j = 0; j < 4; ++j) ss += (r.x[j][0] * r.x[j][0] + r.x[j][1] * r.x[j][1]) + (r.x[j][2] * r.x[j][2] + r.x[j][3] * r.x[j][3]);
            const float rstd = 1.0f / sqrtf(wave_sum(ss) * (1.0f / DM) + EPSV);
#pragma unroll
            for (int j = 0; j < 4; ++j) { const f32x4 h = (r.x[j] * rstd * vpre[j]) * vsc[j] + vsh[j];
                u32x2 w; w.x = pk2(h[0], h[1]); w.y = pk2(h[2], h[3]);
                *(u32x2*)(Hp + (size_t)t * DM + 4 * lane + 256 * j) = w; }
        }
    };
    int t = tbeg;
    if (t < tend) ew_load(A, xin_lat, xin_ctx, xin_bf, Yp, Y2p, t, lane);
    while (t < tend) {
        const int tn = t + 8;
        if (tn < tend) ew_load(B, xin_lat, xin_ctx, xin_bf, Yp, Y2p, tn, lane);
        process(A, t);
        const int tnn = tn + 8;
        if (tnn < tend) ew_load(A, xin_lat, xin_ctx, xin_bf, Yp, Y2p, tnn, lane);
        if (tn < tend) process(B, tn);
        t = tnn;
    }
}

__device__ __forceinline__ void conv_item(CParams& p, LAS unsigned char* lds, int l, int s, int tb) {
    const int tid = otid(), wave = tid >> 6, lane = tid & 63;
    const bf16_t* PROJ = (const bf16_t*)(p.ws + WS_PROJ); bf16_t* YCAT = (bf16_t*)(p.ws + WS_YCAT);
    LAS float* sA = (LAS float*)lds;
    const int tokbase = s < 16 ? s * 2048 : TL + (s - 16) * 256, len = s < 16 ? 2048 : 256, t0 = tb * 64;
    {
        u32x4 ua[6], ug[6];
#pragma unroll
        for (int i = 0; i < 6; ++i) {
            const int u = tid + 512 * i, rr = u >> 5, c8 = (u & 31) * 8, tt = t0 - 15 + rr;
            ua[i] = (u32x4){0u, 0u, 0u, 0u}; ug[i] = (u32x4){0u, 0u, 0u, 0u};
            if (u < 94 * 32 && tt >= 0 && tt < len) { const bf16_t* rp = PROJ + (size_t)(tokbase + tt) * NP + c8; ua[i] = *(const u32x4*)rp; ug[i] = *(const u32x4*)(rp + 256); }
        }
#pragma unroll
        for (int i = 0; i < 6; ++i) {
            const int u = tid + 512 * i, rr = u >> 5, c8 = (u & 31) * 8;
            if (u < 94 * 32) {
                float v[8];
                v[0] = bflo(ua[i].x) * sigmoid_f(bflo(ug[i].x)); v[1] = bfhi(ua[i].x) * sigmoid_f(bfhi(ug[i].x));
                v[2] = bflo(ua[i].y) * sigmoid_f(bflo(ug[i].y)); v[3] = bfhi(ua[i].y) * sigmoid_f(bfhi(ug[i].y));
                v[4] = bflo(ua[i].z) * sigmoid_f(bflo(ug[i].z)); v[5] = bfhi(ua[i].z) * sigmoid_f(bfhi(ug[i].z));
                v[6] = bflo(ua[i].w) * sigmoid_f(bflo(ug[i].w)); v[7] = bfhi(ua[i].w) * sigmoid_f(bfhi(ug[i].w));
                *(LAS f32x4*)(sA + rr * 256 + c8) = (f32x4){v[0], v[1], v[2], v[3]};
                *(LAS f32x4*)(sA + rr * 256 + c8 + 4) = (f32x4){v[4], v[5], v[6], v[7]};
            }
        }
    }
    __syncthreads();
    TS_BEGIN(7);
    const int cp = tid & 127, oc = tid >> 7;
    f32x2 out2[2][8];
    {
        f32x2 w2[31];
#pragma unroll
        for (int j = 0; j < 31; ++j) w2[j] = *(const f32x2*)(p.conv_w + ((size_t)l * 31 + j) * 256 + 2 * cp);
        const f32x2 bias2 = *(const f32x2*)(p.conv_b + l * 256 + 2 * cp);
#pragma unroll
        for (int ps = 0; ps < 2; ++ps) {
            const LAS float* ap = sA + ((oc * 2 + ps) * 8) * 256 + 2 * cp;
            f32x2 in2[38];
#pragma unroll
            for (int i = 0; i < 38; ++i) in2[i] = *(const LAS f32x2*)(ap + i * 256);
#pragma unroll
            for (int q = 0; q < 8; ++q) {
                f32x2 acc = bias2;
#pragma unroll
                for (int j = 0; j < 31; ++j) acc = in2[q + j] * w2[j] + acc;
                out2[ps][q] = acc;
            }
        }
    }
    TS_END(7);
    __syncthreads();
#pragma unroll
    for (int ps = 0; ps < 2; ++ps)
#pragma unroll
        for (int q = 0; q < 8; ++q) *(LAS f32x2*)(sA + ((oc * 2 + ps) * 8 + q) * 256 + 2 * cp) = out2[ps][q];
    __syncthreads();
    {
        const f32x4 lg = *(const f32x4*)(p.ln_g + l * 256 + 4 * lane), lb = *(const f32x4*)(p.ln_b + l * 256 + 4 * lane);
#pragma unroll
        for (int q = 0; q < 8; ++q) {
            const int tok = wave * 8 + q;
            const f32x4 v = *(const LAS f32x4*)(sA + tok * 256 + 4 * lane);
            const float mean = wave_sum((v[0] + v[1]) + (v[2] + v[3])) * (1.0f / 256.0f);
            const f32x4 d = v - mean;
            const float var = wave_sum((d[0] * d[0] + d[1] * d[1]) + (d[2] * d[2] + d[3] * d[3])) * (1.0f / 256.0f);
            const float rstd = 1.0f / sqrtf(var + EPSV);
            const f32x4 yn = d * rstd * lg + lb;
            u32x2 o; o.x = pk2(silu_f(yn[0]), silu_f(yn[1])); o.y = pk2(silu_f(yn[2]), silu_f(yn[3]));
            *(u32x2*)(YCAT + (size_t)(tokbase + t0 + tok) * YC_LD + 4 * lane) = o;
        }
    }
    __syncthreads();
}

struct AttnItem {
    int mode;
    int qtok0;
    int qcol0, qcol1, ocol0, ocol1;
    int kcol0, kcol1, vcol0, vcol1; int nslots;
    int nloc, loctok0;
    int ctxtok0;
    int r, rs;
    int q0, kp0;
    int has_sink; float sink0, sink1;
    int h0;
};
constexpr int KROW = 72;
constexpr int KV_BYTES = 64 * KROW * 2;
constexpr int ABUF_BYTES = 4 * KV_BYTES;
typedef short s16x4 __attribute__((ext_vector_type(4)));
template <int OFF> __device__ __forceinline__ s16x4 tr_read(unsigned addr) {
    s16x4 r; asm volatile("ds_read_b64_tr_b16 %0, %1 offset:%2" : "=&v"(r) : "v"(addr), "i"(OFF) : "memory"); return r;
}
template <int NKB>
__device__ __forceinline__ void attn_chunk(const LAS unsigned char* kt, const LAS unsigned char* vt, int kofs, const bf16x8 (&qf)[2], int fr, int fq,
                                           int mtype, int a0, const LAS float* bt, float& mrun, float& lsum, f32x4 (&o)[4]) {
    const unsigned vaddr = (unsigned)(size_t)vt + (unsigned)(((kofs + 4 * fq + (fr >> 2)) * KROW + 4 * (fr & 3)) * 2);
    s16x4 vl[NKB / 2][4], vh[NKB / 2][4];
#pragma unroll
    for (int grp = 0; grp < NKB / 2; ++grp) {
        const unsigned va = vaddr + (unsigned)(grp * 32 * KROW * 2);
        vl[grp][0] = tr_read<0>(va);  vh[grp][0] = tr_read<16 * KROW * 2>(va);
        vl[grp][1] = tr_read<32>(va); vh[grp][1] = tr_read<16 * KROW * 2 + 32>(va);
        vl[grp][2] = tr_read<64>(va); vh[grp][2] = tr_read<16 * KROW * 2 + 64>(va);
        vl[grp][3] = tr_read<96>(va); vh[grp][3] = tr_read<16 * KROW * 2 + 96>(va);
    }
    f32x4 sacc[NKB];
    const int kc0 = (fq ^ (((kofs + fr) >> 1) & 7)) * 16;
    const LAS unsigned char* krow = kt + (kofs + fr) * 128;
    const LAS unsigned char* kp0 = krow + kc0;
    const LAS unsigned char* kp1 = krow + (kc0 ^ 64);
#pragma unroll
    for (int kb = 0; kb < NKB; ++kb) {
        sacc[kb] = (f32x4){0.f, 0.f, 0.f, 0.f};
        const bf16x8 a0v = *(const LAS bf16x8*)(kp0 + 16 * kb * 128);
        const bf16x8 a1v = *(const LAS bf16x8*)(kp1 + 16 * kb * 128);
        sacc[kb] = __builtin_amdgcn_mfma_f32_16x16x32_bf16(a0v, qf[0], sacc[kb], 0, 0, 0);
        sacc[kb] = __builtin_amdgcn_mfma_f32_16x16x32_bf16(a1v, qf[1], sacc[kb], 0, 0, 0);
    }
    if (mtype == 1) {
        const int wsx = min(max(a0 - 8, 0), 48);
        const int lo = wsx - (kofs + 4 * fq);
        const LAS float* bl = bt + (kofs + 4 * fq - a0 + 63);
#pragma unroll
        for (int kb = 0; kb < NKB; ++kb)
#pragma unroll
            for (int j = 0; j < 4; ++j) { const bool ok = (unsigned)(16 * kb + j - lo) < 16u;
                sacc[kb][j] = ok ? sacc[kb][j] + bl[16 * kb + j] : -1.0e30f; }
    } else if (mtype == 2) {
        const int db = a0 + kofs + 4 * fq + 128;
#pragma unroll
        for (int kb = 0; kb < NKB; ++kb)
#pragma unroll
            for (int j = 0; j < 4; ++j) { const bool ok = (unsigned)(db + 16 * kb + j) <= 256u;
                sacc[kb][j] = ok ? sacc[kb][j] : -1.0e30f; }
    }
    float cm = sacc[0][0];
#pragma unroll
    for (int kb = 0; kb < NKB; ++kb)
#pragma unroll
        for (int j = 0; j < 4; ++j) cm = fmaxf(cm, sacc[kb][j]);
    cm = xrow16_max(cm);
    const float mnew = fmaxf(mrun, cm);
    if (__any(mnew > mrun)) {
        const float alpha = fast_exp2(mrun - mnew);
        lsum *= alpha;
#pragma unroll
        for (int db = 0; db < 4; ++db) o[db] = o[db] * alpha;
        mrun = mnew;
    }
    float ps = 0.f;
#pragma unroll
    for (int kb = 0; kb < NKB; ++kb)
#pragma unroll
        for (int j = 0; j < 4; ++j) { sacc[kb][j] = fast_exp2(sacc[kb][j] - mnew); ps += sacc[kb][j]; }
    lsum += ps;
    asm volatile("s_waitcnt lgkmcnt(0)" ::: "memory"); __builtin_amdgcn_sched_barrier(0);
#define ATT_PK(L, H) (bf16x8){L[0], L[1], L[2], L[3], H[0], H[1], H[2], H[3]}
#pragma unroll
    for (int grp = 0; grp < NKB / 2; ++grp) {
        union { bf16x8 v; unsigned u[4]; } pb;
        pb.u[0] = pk2(sacc[2 * grp][0], sacc[2 * grp][1]); pb.u[1] = pk2(sacc[2 * grp][2], sacc[2 * grp][3]);
        pb.u[2] = pk2(sacc[2 * grp + 1][0], sacc[2 * grp + 1][1]); pb.u[3] = pk2(sacc[2 * grp + 1][2], sacc[2 * grp + 1][3]);
#pragma unroll
        for (int db = 0; db < 4; ++db) o[db] = __builtin_amdgcn_mfma_f32_16x16x32_bf16(ATT_PK(vl[grp][db], vh[grp][db]), pb.v, o[db], 0, 0, 0);
    }
#undef ATT_PK
}

__device__ __forceinline__ void attn_item(CParams& p, LAS unsigned char* lds, int l, const AttnItem& it) {
    const int tid = otid(), wave = tid >> 6, lane = tid & 63, g = wave >> 2, wq = wave & 3, fr = lane & 15, fq = lane >> 4;
    const bf16_t* PROJ = (const bf16_t*)(p.ws + WS_PROJ); bf16_t* YCAT = (bf16_t*)(p.ws + WS_YCAT);
    LAS float* sB = (LAS float*)(lds + 2 * ABUF_BYTES);
    const int slot = it.nslots == 2 ? g : 0;
    if (it.mode == 0) { for (int i = tid; i < 2 * 15 * 128; i += 512) { const int h = i / 1920, rem = i % 1920, dr = rem >> 7, dc = (rem & 127) - 48;
            sB[i] = (dc >= 0 && dc < 31) ? p.nat_bias[(size_t)(l * 4 + it.h0 + h) * 465 + dr * 31 + dc] * LOG2E : 0.f; } }
    bf16x8 qf[2];
    { const bf16_t* qp = PROJ + (size_t)(it.qtok0 + wq * 16 + fr) * NP + (g ? it.qcol1 : it.qcol0) + 8 * fq;
      qf[0] = *(const bf16x8*)qp; qf[1] = *(const bf16x8*)(qp + 32); }
    float mrun = -3.0e38f, lsum = 0.f;
    f32x4 o[4];
#pragma unroll
    for (int db = 0; db < 4; ++db) o[db] = (f32x4){0.f, 0.f, 0.f, 0.f};
    const int nchunks = 4 + it.nloc;
    const int srow = tid >> 3, sseg = tid & 7;
    u32x4 kreg[2], vreg[2];
    auto chunk_tok = [&](int c) { return c < 4 ? it.ctxtok0 + 64 * c : it.loctok0 + 64 * (c - 4); };
    auto gload = [&](int c) {
        const bf16_t* rp = PROJ + (size_t)(chunk_tok(c) + srow) * NP + 8 * sseg;
#pragma unroll
        for (int s = 0; s < 2; ++s) if (s < it.nslots) { kreg[s] = *(const u32x4*)(rp + (s ? it.kcol1 : it.kcol0)); vreg[s] = *(const u32x4*)(rp + (s ? it.vcol1 : it.vcol0)); }
    };
    auto lwrite = [&](int c) {
        LAS unsigned char* bufk = lds + (c & 1) * ABUF_BYTES + srow * 128 + ((sseg ^ ((srow >> 1) & 7)) * 16);
        LAS unsigned char* bufv = lds + (c & 1) * ABUF_BYTES + 2 * KV_BYTES + (srow * KROW + 8 * sseg) * 2;
#pragma unroll
        for (int s = 0; s < 2; ++s) if (s < it.nslots) { *(LAS u32x4*)(bufk + s * KV_BYTES) = kreg[s]; *(LAS u32x4*)(bufv + s * KV_BYTES) = vreg[s]; }
    };
    gload(0); lwrite(0);
    if (nchunks > 1) gload(1);
    __syncthreads();
    TS_BEGIN(5);
    const int qi = wq * 16 + fr;
    const int nat_kofs = min(max(16 * wq - 8, 0), 32);
    for (int c = 0; c < nchunks; ++c) {
        if (c + 1 < nchunks) lwrite(c + 1);
        if (c + 2 < nchunks) gload(c + 2);
        const LAS unsigned char* kt = lds + (c & 1) * ABUF_BYTES + slot * KV_BYTES;
        const LAS unsigned char* vt = kt + 2 * KV_BYTES;
        if (c >= 4 && it.mode == 0) {
            const int dr = (it.rs + (c - 4)) - it.r + 7;
            attn_chunk<2>(kt, vt, nat_kofs, qf, fr, fq, 1, qi, sB + g * 1920 + dr * 128, mrun, lsum, o);
        } else if (c >= 4 && it.mode == 1) {
            attn_chunk<4>(kt, vt, 0, qf, fr, fq, 2, it.kp0 + 64 * (c - 4) - (it.q0 + qi), sB, mrun, lsum, o);
        } else {
            attn_chunk<4>(kt, vt, 0, qf, fr, fq, 0, 0, sB, mrun, lsum, o);
        }
        __syncthreads();
    }
    TS_END(5);
    lsum = xrow16_sum(lsum);
    if (it.has_sink) lsum += fast_exp2((g ? it.sink1 : it.sink0) * LOG2E - mrun);
    const float inv = 1.0f / lsum;
    bf16_t* op = YCAT + (size_t)(it.qtok0 + wq * 16 + fr) * YC_LD + (g ? it.ocol1 : it.ocol0) + 4 * fq;
#pragma unroll
    for (int db = 0; db < 4; ++db) { u32x2 w; w.x = pk2(o[db][0] * inv, o[db][1] * inv); w.y = pk2(o[db][2] * inv, o[db][3] * inv); *(u32x2*)(op + 16 * db) = w; }
}

constexpr int C_UA = 0, C_QN = 512, C_KN = 768, C_VN = 1024, C_QS = 1280, C_KS = 1536, C_VS = 1664;

__device__ __forceinline__ void mix_items(CParams& p, LAS unsigned char* lds, int l, int sub) {
    const int n_attn = (l == 0) ? 2304 : 2048;
    const int n_conv = (l == 0) ? 512 + 64 : 512;
    const int start = (obid() + 128) % gridDim.x;
    for (int i = start; i < n_attn + n_conv; i += gridDim.x) {
        if (i >= n_attn) {
            if (!(sub & 4)) continue;
            const int ci = i - n_attn;
            TS_BEGIN(3);
            if (ci < 512) conv_item(p, lds, l, ci >> 5, ci & 31);
            else { const int cj = ci - 512; conv_item(p, lds, l, 16 + (cj >> 2), cj & 3); }
            TS_END(3);
            continue;
        }
        AttnItem it{};
        if (i < 1024) {
            const int b = i >> 6, r = (i >> 1) & 31, hp = i & 1;
            it.mode = 0; it.qtok0 = b * 2048 + r * 64; it.nslots = 2; it.h0 = 2 * hp;
            { const int h = 2 * hp; it.qcol0 = C_QN + 64 * h; it.kcol0 = C_KN + 64 * h; it.vcol0 = C_VN + 64 * h; it.ocol0 = 512 + 64 * h;
              it.qcol1 = it.qcol0 + 64; it.kcol1 = it.kcol0 + 64; it.vcol1 = it.vcol0 + 64; it.ocol1 = it.ocol0 + 64; }
            it.r = r; it.rs = min(max(r - 4, 0), 24); it.nloc = 8; it.loctok0 = b * 2048 + it.rs * 64; it.ctxtok0 = TL + b * 256;
        } else if (i < 2048) {
            const int k = i - 1024, b = k >> 6, qb = (k >> 1) & 31, kvh = k & 1;
            it.mode = 1; it.qtok0 = b * 2048 + qb * 64; it.nslots = 1;
            { const int h = 2 * kvh; it.qcol0 = C_QS + 64 * h; it.ocol0 = 768 + 64 * h; it.sink0 = p.sink[l * 4 + h]; it.sink1 = p.sink[l * 4 + h + 1];
              it.qcol1 = it.qcol0 + 64; it.ocol1 = it.ocol0 + 64; it.kcol0 = it.kcol1 = C_KS + 64 * kvh; it.vcol0 = it.vcol1 = C_VS + 64 * kvh; }
            it.has_sink = 1; it.q0 = qb * 64;
            const int ks = max(qb * 64 - 128, 0), ke = min(qb * 64 + 192, 2048);
            it.kp0 = ks; it.nloc = (ke - ks) >> 6; it.loctok0 = b * 2048 + ks; it.ctxtok0 = TL + b * 256;
        } else if (i < 2176) {
            const int k = i - 2048, b = k >> 3, qb = (k >> 1) & 3, hp = k & 1;
            it.mode = 2; it.qtok0 = TL + b * 256 + qb * 64; it.nslots = 2;
            { const int h = 2 * hp; it.qcol0 = C_QN + 64 * h; it.kcol0 = C_KN + 64 * h; it.vcol0 = C_VN + 64 * h; it.ocol0 = 512 + 64 * h;
              it.qcol1 = it.qcol0 + 64; it.kcol1 = it.kcol0 + 64; it.vcol1 = it.vcol0 + 64; it.ocol1 = it.ocol0 + 64; }
            it.nloc = 0; it.ctxtok0 = TL + b * 256;
        } else {
            const int k = i - 2176, b = k >> 3, qb = (k >> 1) & 3, kvh = k & 1;
            it.mode = 2; it.qtok0 = TL + b * 256 + qb * 64; it.nslots = 1;
            { const int h = 2 * kvh; it.qcol0 = C_QS + 64 * h; it.ocol0 = 768 + 64 * h; it.sink0 = p.sink[l * 4 + h]; it.sink1 = p.sink[l * 4 + h + 1];
              it.qcol1 = it.qcol0 + 64; it.ocol1 = it.ocol0 + 64; it.kcol0 = it.kcol1 = C_KS + 64 * kvh; it.vcol0 = it.vcol1 = C_VS + 64 * kvh; }
            it.has_sink = 1; it.nloc = 0; it.ctxtok0 = TL + b * 256;
        }
        TS_BEGIN(2);
        if (sub & 2) attn_item(p, lds, l, it);
        TS_END(2);
    }
}

constexpr int N_PHASES = 22;
#ifndef PHMASK
#define PHMASK 0xff
#endif

__device__ __forceinline__ void run_phase(CParams& p, LAS unsigned char* lds, int ph, int sub) {
    unsigned char* ws = p.ws;
    bf16_t* YH = (bf16_t*)(ws + WS_YH); bf16_t* U = (bf16_t*)(ws + WS_R1); bf16_t* PROJ = (bf16_t*)(ws + WS_PROJ); bf16_t* YCAT = (bf16_t*)(ws + WS_YCAT);
    const float* MOD = (const float*)(ws + WS_MOD);
    const int G = gridDim.x, c = obid();
    if (ph == 0) { if constexpr ((PHMASK & 1) != 0) phase0(p, lds); return; }
    if (ph == 1) {
        if constexpr ((PHMASK & 2) == 0) return;
        ew_pass(p.x, p.ctx, nullptr, nullptr, nullptr, nullptr, nullptr, nullptr, 0.f, nullptr, YH, p.norm_g, MOD, MOD + 1024, TA); return;
    }
    const int l = (ph - 2) / 10, k = (ph - 2) % 10;
    const float* MODL = MOD + (size_t)l * 17 * NMODC; const float* NG = p.norm_g + (size_t)l * 6 * DM;
    const int rows_late = (l == 0) ? TA : TL;
    switch (k) {
    case 0: case 7: {
        if constexpr ((PHMASK & 4) == 0) break;
        const int f = (k == 7), M = f ? rows_late : TA;
        pg8::Gemm g{YH, (const bf16_t*)(ws + WS_W13) + (size_t)(l * 2 + f) * 5632 * 1024, M, 5632, 1024, 1024, 1024};
        pg8::StaticOrder S; S.init(M, 5632, G, c); EpiSwiGLU E{U};
        pg8::gemm_phase<EpiSwiGLU, pg8::StaticOrder, true, true>(lds, g, S, E);
    } break;
    case 1: case 8: case 5: {
        if constexpr ((PHMASK & 8) == 0) break;
        const bool isout = (k == 5); const int f = (k == 8), M = (k == 1) ? TA : rows_late;
        const int Kd = isout ? YC_LD : FF;
        const bf16_t* Ap = isout ? YCAT : U;
        const bf16_t* Bp = isout ? (const bf16_t*)(ws + WS_WOUT) + (size_t)l * 1024 * YC_LD : (const bf16_t*)(ws + WS_W2T) + (size_t)(l * 2 + f) * 1024 * FF;
        for (int v = 0; v < (M == TA ? 3 : 1); ++v) {
            pg8::Gemm g = v == 0 ? pg8::Gemm{Ap, Bp, TL, 1024, Kd, Kd, Kd}
                                 : pg8::Gemm{Ap + (size_t)TL * Kd + (v - 1) * (Kd / 2), Bp + (v - 1) * (Kd / 2), TC, 1024, Kd / 2, Kd, Kd};
            pg8::StaticOrder S; S.init(g.M, 1024, G, v == 2 ? (c + G - 64) % G : c);
            EpiBf16Tile E{v == 0 ? YH : (v == 1 ? YH + (size_t)TL * DM : (bf16_t*)(ws + WS_Y2)), 1024, 0, 256};
            pg8::gemm_phase<EpiBf16Tile, pg8::StaticOrder, true, true>(lds, g, S, E);
        }
    } break;
    case 2: case 6: case 9: {
        if constexpr ((PHMASK & 2) == 0) break;
        const int gi = (k == 2) ? 2 : (k == 6 ? 5 : 8), ni = (k == 2) ? 1 : (k == 6 ? 3 : 5);
        const int nrows = (k == 2) ? TA : rows_late;
        const bool lastl = (k == 9 && l == 1);
        const float* gpre = (k == 2) ? NG + 2 * DM : (k == 6 ? NG + 4 * DM : p.norm_g + 6 * DM);
        const float* shift = (k == 2) ? MODL + 3 * 1024 : (k == 6 ? MODL + 6 * 1024 : MOD + 17 * NMODC);
        const float* scale = (k == 2) ? MODL + 4 * 1024 : (k == 6 ? MODL + 7 * 1024 : MOD + 17 * NMODC + 1024);
        float* outp = p.out;
        const bool first = (l == 0 && k == 2);
        bf16_t* XS = (bf16_t*)(ws + WS_XC);
        ew_pass(p.x, p.ctx, first ? (const bf16_t*)nullptr : (const bf16_t*)XS, lastl ? (bf16_t*)nullptr : XS, lastl ? outp : (float*)nullptr, YH, (const bf16_t*)(ws + WS_Y2), NG + ni * DM, (k == 6) ? 1.0f : 0.5f, MODL + gi * 1024, lastl ? nullptr : YH, gpre, shift, scale, nrows);
    } break;
    case 3: {
        if constexpr ((PHMASK & 16) == 0) break;
        const bf16_t* W = (const bf16_t*)(ws + WS_WIN) + (size_t)l * 2304 * 1024;
        { pg8::Gemm g{YH, W, TA, NP, 1024, 1024, 1024}; pg8::StaticOrder S; S.init(TA, NP, G, c); EpiWin E{PROJ, (const float*)(ws + WS_ROPE)};
          pg8::gemm_phase<EpiWin, pg8::StaticOrder, true, true>(lds, g, S, E); }
        { const int N = (l == 0) ? TA : TL; pg8::Gemm g{W + (size_t)1792 * 1024, YH, 512, N, 1024, 1024, 1024}; pg8::StaticOrder S; S.init(512, N, G, (c + 16) % G);
          EpiPQ E{(bf16_t*)(ws + WS_PQT), (bf16_t*)(ws + WS_PQTC)};
          pg8::gemm_phase<EpiPQ, pg8::StaticOrder, true, true>(lds, g, S, E); }
    } break;
    case 4: {
        if constexpr ((PHMASK & 32) == 0) break;
        TS_BEGIN(1);
        if (sub & 1)
        for (int v = 0; v < ((l == 0) ? 4 : 2); ++v) {
            const int hs = v & 1, isc = v >> 1;
            const bf16_t* Ap = isc ? (const bf16_t*)(ws + WS_DFTC) + hs * 256 : (const bf16_t*)(ws + WS_DFT) + hs * 2048;
            const bf16_t* Bp = isc ? (const bf16_t*)(ws + WS_PQTC) + hs * 256 : (const bf16_t*)(ws + WS_PQT) + hs * 2048;
            pg8::Gemm g{Ap, Bp, isc ? 256 : 2048, 4096, isc ? 256 : 2048, isc ? DFTC_LD : DFT_LD, isc ? PQTC_LD : PQT_LD};
            pg8::StaticOrder S; S.init(g.M, g.N, G, isc ? (c + G - 16 * hs) % G : (c + G - 128 * hs) % G);
            EpiBf16Tile E{YCAT + (isc ? (size_t)TL * YC_LD : 0) + (hs ? 1024 : 256), YC_LD, isc ? 256 : 2048, 0};
            pg8::gemm_phase<EpiBf16Tile, pg8::StaticOrder, true, true>(lds, g, S, E);
        }
        TS_END(1);
        if (sub & 6) mix_items(p, lds, l, sub);
    } break;
    }
}

__global__ void __launch_bounds__(512, 2) mega(Params p, int ph0, int ph1) {
    extern __shared__ __attribute__((aligned(16))) unsigned char lds_raw[];
    LAS unsigned char* lds = (LAS unsigned char*)lds_raw;
    cg::grid_group grid = cg::this_grid();
    if (ph1 < 0) grid.sync();
    volatile LAS unsigned* xst = (volatile LAS unsigned*)(lds + 131072);
    if (threadIdx.x < 4) xst[threadIdx.x] = 0u;
    __syncthreads();
    XcdBarrier xb = xcd_barrier_post((unsigned*)(p.ws + WS_BAR), xst);
#ifdef TPROBE
    unsigned long long tacc = 0, tprev = __builtin_amdgcn_s_memrealtime();
#endif
    for (int ph = ph0; ph < ph1; ++ph) {
        CParams* q = (CParams*)__builtin_amdgcn_kernarg_segment_ptr(); asm volatile("" : "+s"(q));
        run_phase(*q, lds, ph, 7);
#ifdef DUPK
        { const int kind = ph == 0 ? 10 : (ph == 1 ? 11 : (ph - 2) % 10);
          if ((DUPK >> kind) & 1) { xcd_barrier(xb); run_phase(*q, lds, ph, DUPSUB); } }
#endif
        if (ph + 1 < ph1) xcd_barrier(xb);
#ifdef TPROBE
        { const unsigned long long now = __builtin_amdgcn_s_memrealtime(); const int kind = ph == 0 ? 10 : (ph == 1 ? 11 : (ph - 2) % 10);
          if ((TPROBE >> kind) & 1) tacc += now - tprev; tprev = now; }
#endif
    }
#ifdef TPROBE
    if (blockIdx.x == 0 && threadIdx.x == 0) { const unsigned long long t0 = __builtin_amdgcn_s_memrealtime(); while (__builtin_amdgcn_s_memrealtime() - t0 < tacc) __builtin_amdgcn_s_sleep(8); }
#endif
#ifdef TSUB
    if (blockIdx.x == 0 && threadIdx.x == 0) { const unsigned long long tacc2 = *(volatile LAS unsigned long long*)(lds + 131080); const unsigned long long t0 = __builtin_amdgcn_s_memrealtime(); while (__builtin_amdgcn_s_memrealtime() - t0 < 4ull * tacc2) __builtin_amdgcn_s_sleep(8); }
#endif
#ifdef XSYNC
    for (int i = 0; i < XSYNC; ++i) xcd_barrier(xb);
#endif
}

#ifndef ONE_LAUNCH
#define ONE_LAUNCH 1
#endif

extern "C" void kernel_launch(void* const* d_in, const int* in_sizes, int n_in, void* d_out, int out_size, void* d_ws, size_t ws_size, hipStream_t stream) {
    static int grid = 0;
    if (grid == 0) {
        if (ws_size < WS_END) { fprintf(stderr, "kernel_launch: workspace too small: %zu < %zu\n", ws_size, (size_t)WS_END); grid = -1; return; }
        int dev = 0, cus = 0, per_cu = 0;
        hipGetDevice(&dev); hipDeviceGetAttribute(&cus, hipDeviceAttributeMultiprocessorCount, dev);
        hipFuncSetAttribute((const void*)mega, hipFuncAttributeMaxDynamicSharedMemorySize, LDS_BYTES);
        hipOccupancyMaxActiveBlocksPerMultiprocessor(&per_cu, (const void*)mega, 512, LDS_BYTES);
        if (per_cu < 1) { fprintf(stderr, "kernel_launch: occupancy query says %d blocks per CU\n", per_cu); per_cu = 1; }
        (void)hipGetLastError();
        grid = cus;
    }
    if (grid < 0) return;
    (void)hipMemsetAsync((unsigned char*)d_ws + WS_BAR, 0, 3456 * 4, stream);
    Params p{};
    p.x = (const float*)d_in[0]; p.c = (const float*)d_in[1]; p.ctx = (const float*)d_in[2]; p.c_ctx = (const float*)d_in[3];
    p.w_ada = (const float*)d_in[4]; p.b_ada = (const float*)d_in[5]; p.norm_g = (const float*)d_in[6];
    p.w1 = (const float*)d_in[7]; p.w3 = (const float*)d_in[8]; p.w2 = (const float*)d_in[9]; p.w_in = (const float*)d_in[10];
    p.conv_w = (const float*)d_in[11]; p.conv_b = (const float*)d_in[12]; p.ln_g = (const float*)d_in[13]; p.ln_b = (const float*)d_in[14];
    p.nat_bias = (const float*)d_in[15]; p.sink = (const float*)d_in[16]; p.w_out = (const float*)d_in[17];
    p.out = (float*)d_out; p.ws = (unsigned char*)d_ws;
#if ONE_LAUNCH
    int ph0 = 0, ph1 = N_PHASES;
    void* args[] = {&p, &ph0, &ph1};
    hipError_t e = hipLaunchCooperativeKernel((const void*)mega, dim3(grid), dim3(512), args, LDS_BYTES, stream);
    if (e != hipSuccess) fprintf(stderr, "cooperative launch failed: %s (grid %d)\n", hipGetErrorString(e), grid);
#else
    for (int ph = 0; ph < N_PHASES; ++ph) {
        int ph0 = ph, ph1 = ph + 1;
        void* args[] = {&p, &ph0, &ph1};
        hipError_t e = hipLaunchCooperativeKernel((const void*)mega, dim3(grid), dim3(512), args, LDS_BYTES, stream);
        if (e != hipSuccess) { fprintf(stderr, "launch %d failed: %s (grid %d)\n", ph, hipGetErrorString(e), grid); break; }
    }
#endif
}
```

```cpp
#include <hip/hip_runtime.h>
#include <hip/hip_cooperative_groups.h>
#include <cstdio>
#include <cstdint>
namespace cg = cooperative_groups;
#ifdef TSUB
#define TS_BEGIN(id) do { if ((TSUB) == (id) && threadIdx.x == 0) { *(volatile __attribute__((address_space(3))) unsigned long long*)(lds + 131080) -= __builtin_amdgcn_s_memrealtime(); } } while (0)
#define TS_END(id)   do { if ((TSUB) == (id) && threadIdx.x == 0) { *(volatile __attribute__((address_space(3))) unsigned long long*)(lds + 131080) += __builtin_amdgcn_s_memrealtime(); } } while (0)
#else
#define TS_BEGIN(id) do {} while (0)
#define TS_END(id) do {} while (0)
#endif
namespace pg8 {
#define PG8_LAS __attribute__((address_space(3)))
typedef unsigned short bf16_t;
typedef short bf16x8 __attribute__((ext_vector_type(8)));
typedef float f32x4 __attribute__((ext_vector_type(4)));
typedef unsigned u32x4 __attribute__((ext_vector_type(4)));
constexpr int BM = 256, BK = 64, HALF = 128, HTB = HALF * BK * 2  , STAGE_BYTES = 8 * HTB, NXCD = 8, WGM = 8;

__host__ __device__ __forceinline__ int lds_byte(int r, int c) { const int st = (r >> 4) * 2 + (c >> 5), rr = r & 15, cc = c & 31, ob = rr * 64 + cc * 2; return st * 1024 + (ob ^ (((ob >> 9) & 1) << 5)); }
__host__ __device__ __forceinline__ void stage_rc(int b, int& R, int& C) { const int st = b / 1024, sb = b % 1024, swz = sb ^ (((sb >> 9) & 1) << 5); R = (st >> 1) * 16 + swz / 64; C = (st & 1) * 32 + (swz % 64) / 2; }
__host__ __device__ __forceinline__ int perm32(int rho) { const int n = rho >> 4, i = rho & 15; return 8 * (i >> 2) + 4 * n + (i & 3); }

struct Unit { int pm, pn; };
struct Gemm { const bf16_t* A; const bf16_t* Bt; int M, N, K, lda, ldb; };

struct StaticOrder {
    int nM, nN, nwg, G, c;
    __host__ __device__ void init(int M, int N, int G_, int c_) { nM = M / BM; nN = N / BM; nwg = nM * nN; G = G_; c = c_; }
    __host__ __device__ bool next(int i, Unit& u) const {
        const long L = (long)i * G + c; if (L >= nwg) return false;
        int wgid = (int)L; { const int q = nwg / NXCD, r = nwg % NXCD, xcd = wgid % NXCD, off = wgid / NXCD; wgid = (xcd < r ? xcd * (q + 1) : r * (q + 1) + (xcd - r) * q) + off; }
        const int nig = WGM * nN, gid = wgid / nig, fm = gid * WGM, gsz = (nM - fm) < WGM ? (nM - fm) : WGM;
        u.pm = fm + ((wgid % nig) % gsz); u.pn = (wgid % nig) / gsz; return true;
    }
    __device__ __forceinline__ void a_ready(const Unit&) const {}
    __device__ __forceinline__ void done(const Unit&) const {}
};
__device__ __forceinline__ unsigned cvt_pk_bf16(float lo, float hi) { unsigned r; asm volatile("v_cvt_pk_bf16_f32 %0, %1, %2" : "=v"(r) : "v"(lo), "v"(hi)); return r; }
typedef float f32x2 __attribute__((ext_vector_type(2)));
template <class Epi, class Sched, bool ALIGN_EPI = false, bool SP2 = false>
__device__ __forceinline__ void gemm_phase(PG8_LAS unsigned char* lds, const Gemm g, const Sched& S, const Epi& E) {
    int tid_ = threadIdx.x; asm volatile("" : "+v"(tid_));
    const int tid = tid_, wid = __builtin_amdgcn_readfirstlane(tid >> 6), lane = tid & 63, wr = wid >> 2, wc = wid & 3, fr = lane & 15, fq = lane >> 4;
    const int K = g.K, nt = K / BK;
    unsigned voffA[2], voffB[2];
#pragma unroll
    for (int i = 0; i < 2; ++i) { int R, C; stage_rc(tid * 16 + i * 8192, R, C); const int Rb = Epi::PERM ? ((R & ~31) + perm32(R & 31)) : R;
        voffA[i] = (unsigned)(R * g.lda + C) * 2u; voffB[i] = (unsigned)(Rb * g.ldb + C) * 2u; }
    const size_t kstep = (size_t)(BK * 2);
    const size_t hstepA = (size_t)HALF * g.lda * 2, hstepB = (size_t)HALF * g.ldb * 2;
    const size_t tstepA = 2 * hstepA, tstepB = 2 * hstepB;
    const unsigned ldsw = (unsigned)wid * 1024u;
    const int aoff = lds_byte(wr * 64 + fr, fq * 8), boff = lds_byte(wc * 32 + fr, fq * 8);
#define PG8_SA(b, h) (((b) * 2 + (h)) * HTB)
#define PG8_SB(b, h) ((4 + (b) * 2 + (h)) * HTB)
#define PG8_STAGE(bufoff, gbase, voff) do { _Pragma("unroll") for (int _i = 0; _i < 2; ++_i) \
        __builtin_amdgcn_global_load_lds((const unsigned*)((const char*)(gbase) + (voff)[_i]), (PG8_LAS unsigned*)(lds + (bufoff) + ldsw + _i * 8192), 16, 0, 0); } while (0)
#define PG8_LDA(dst, b, h) do { _Pragma("unroll") for (int m = 0; m < 4; ++m) _Pragma("unroll") for (int k = 0; k < 2; ++k) dst[m][k] = *(const PG8_LAS bf16x8*)(lds + PG8_SA(b, h) + aoff + m * 2048 + k * 1024); } while (0)
#define PG8_LDB(dst, b, h) do { _Pragma("unroll") for (int n = 0; n < 2; ++n) _Pragma("unroll") for (int k = 0; k < 2; ++k) dst[n][k] = *(const PG8_LAS bf16x8*)(lds + PG8_SB(b, h) + boff + n * 2048 + k * 1024); } while (0)
#define PG8_MMA(ai, bj, At, Bt) do { __builtin_amdgcn_s_setprio(1); _Pragma("unroll") for (int m = 0; m < 4; ++m) _Pragma("unroll") for (int n = 0; n < 2; ++n) _Pragma("unroll") for (int k = 0; k < 2; ++k) \
        acc[ai][bj][m][n] = __builtin_amdgcn_mfma_f32_16x16x32_bf16(Bt[n][k], At[m][k], acc[ai][bj][m][n], 0, 0, 0); __builtin_amdgcn_s_setprio(0); } while (0)
#define PG8_WAIT_V(n) asm volatile("s_waitcnt vmcnt(" #n ")" ::: "memory")
#define PG8_WAIT_L(n) asm volatile("s_waitcnt lgkmcnt(" #n ")" ::: "memory")
#define PG8_BAR __builtin_amdgcn_s_barrier()
#define PG8_SCHED __builtin_amdgcn_sched_barrier(0)
    Unit cur, nxt; int ui = 0;
    if (!S.next(0, cur)) return;
    f32x4 acc[2][2][4][2];
#pragma unroll
    for (int a = 0; a < 2; ++a)
#pragma unroll
        for (int b = 0; b < 2; ++b)
#pragma unroll
            for (int m = 0; m < 4; ++m)
#pragma unroll
                for (int n = 0; n < 2; ++n) acc[a][b][m][n] = (f32x4){0.f, 0.f, 0.f, 0.f};
    bf16x8 At[4][2], B0[2][2], B1[2][2];
    const char* cA = (const char*)g.A + (size_t)cur.pm * tstepA; const char* cB = (const char*)g.Bt + (size_t)cur.pn * tstepB;
    S.a_ready(cur);
    if constexpr (SP2) {
        PG8_STAGE(PG8_SB(0, 0), cB, voffB); PG8_STAGE(PG8_SB(0, 1), cB + hstepB, voffB); PG8_STAGE(PG8_SA(0, 0), cA, voffA); PG8_STAGE(PG8_SA(0, 1), cA + hstepA, voffA);
        if (wr == 1) PG8_BAR;
        PG8_WAIT_V(2); PG8_BAR;
        PG8_STAGE(PG8_SB(1, 0), cB + kstep, voffB); PG8_STAGE(PG8_SA(1, 0), cA + kstep, voffA); PG8_STAGE(PG8_SB(1, 1), cB + hstepB + kstep, voffB);
        PG8_WAIT_V(6); PG8_BAR;
    } else {
        PG8_STAGE(PG8_SB(0, 0), cB, voffB); PG8_STAGE(PG8_SA(0, 0), cA, voffA); PG8_STAGE(PG8_SB(0, 1), cB + hstepB, voffB); PG8_STAGE(PG8_SA(0, 1), cA + hstepA, voffA);
        if (wr == 1) PG8_BAR;
        PG8_WAIT_V(4); PG8_BAR;
        PG8_STAGE(PG8_SB(1, 0), cB + kstep, voffB); PG8_STAGE(PG8_SA(1, 0), cA + kstep, voffA); PG8_STAGE(PG8_SB(1, 1), cB + hstepB + kstep, voffB);
        PG8_WAIT_V(6); PG8_BAR;
    }
    for (;;) {
        const bool has_next = S.next(ui + 1, nxt);
        const char* nA = has_next ? (const char*)g.A + (size_t)nxt.pm * tstepA : cA; const char* nB = has_next ? (const char*)g.Bt + (size_t)nxt.pn * tstepB : cB;
        for (int t = 0; t < nt; t += 2) {
            const bool last = (t == nt - 2);
            const char* a1 = cA + (size_t)(t + 1) * kstep;
            const char* a2 = last ? nA : cA + (size_t)(t + 2) * kstep; const char* b2 = last ? nB : cB + (size_t)(t + 2) * kstep;
            const char* a3 = a2 + kstep; const char* b3 = b2 + kstep;
            if (last && has_next) S.a_ready(nxt);
            if constexpr (SP2) {
            PG8_LDB(B0, 0, 0); PG8_LDB(B1, 0, 1); PG8_SCHED; PG8_LDA(At, 0, 0); PG8_STAGE(PG8_SA(1, 1), a1 + hstepA, voffA);
            PG8_WAIT_V(8); PG8_WAIT_L(0); PG8_BAR; PG8_MMA(0, 0, At, B0); PG8_MMA(0, 1, At, B1); PG8_BAR; PG8_SCHED;
            PG8_LDA(At, 0, 1); PG8_STAGE(PG8_SB(0, 0), b2, voffB); PG8_STAGE(PG8_SB(0, 1), b2 + hstepB, voffB); PG8_STAGE(PG8_SA(0, 0), a2, voffA);
            PG8_WAIT_V(8); PG8_WAIT_L(0); PG8_BAR; PG8_MMA(1, 0, At, B0); PG8_MMA(1, 1, At, B1); PG8_BAR; PG8_SCHED;
            PG8_LDB(B0, 1, 0); PG8_LDB(B1, 1, 1); PG8_SCHED; PG8_LDA(At, 1, 0); PG8_STAGE(PG8_SA(0, 1), a2 + hstepA, voffA);
            PG8_WAIT_V(8); PG8_WAIT_L(0); PG8_BAR; PG8_MMA(0, 0, At, B0); PG8_MMA(0, 1, At, B1); PG8_BAR; PG8_SCHED;
            PG8_LDA(At, 1, 1); PG8_STAGE(PG8_SB(1, 0), b3, voffB); PG8_STAGE(PG8_SB(1, 1), b3 + hstepB, voffB); PG8_STAGE(PG8_SA(1, 0), a3, voffA);
            PG8_WAIT_V(8); PG8_WAIT_L(0); PG8_BAR; PG8_MMA(1, 0, At, B0); PG8_MMA(1, 1, At, B1); PG8_BAR; PG8_SCHED;
            } else {
            PG8_LDB(B0, 0, 0); PG8_SCHED; PG8_LDA(At, 0, 0); PG8_STAGE(PG8_SA(1, 1), a1 + hstepA, voffA);
            PG8_WAIT_L(8); PG8_BAR; PG8_WAIT_L(0); PG8_MMA(0, 0, At, B0); PG8_BAR; PG8_SCHED;
            PG8_LDB(B1, 0, 1); PG8_STAGE(PG8_SB(0, 0), b2, voffB);
            PG8_BAR; PG8_WAIT_L(0); PG8_MMA(0, 1, At, B1); PG8_BAR;
            PG8_LDA(At, 0, 1); PG8_STAGE(PG8_SA(0, 0), a2, voffA);
            PG8_BAR; PG8_WAIT_L(0); PG8_MMA(1, 0, At, B0); PG8_BAR; PG8_SCHED;
            PG8_STAGE(PG8_SB(0, 1), b2 + hstepB, voffB);
            PG8_WAIT_V(6); PG8_BAR; PG8_MMA(1, 1, At, B1); PG8_BAR;
            PG8_LDB(B0, 1, 0); PG8_SCHED; PG8_LDA(At, 1, 0); PG8_STAGE(PG8_SA(0, 1), a2 + hstepA, voffA);
            PG8_WAIT_L(8); PG8_BAR; PG8_WAIT_L(0); PG8_MMA(0, 0, At, B0); PG8_BAR; PG8_SCHED;
            PG8_LDB(B1, 1, 1); PG8_STAGE(PG8_SB(1, 0), b3, voffB);
            PG8_BAR; PG8_WAIT_L(0); PG8_MMA(0, 1, At, B1); PG8_BAR;
            PG8_LDA(At, 1, 1); PG8_STAGE(PG8_SA(1, 0), a3, voffA);
            PG8_BAR; PG8_WAIT_L(0); PG8_MMA(1, 0, At, B0); PG8_BAR; PG8_SCHED;
            PG8_STAGE(PG8_SB(1, 1), b3 + hstepB, voffB);
            PG8_WAIT_V(6); PG8_BAR; PG8_MMA(1, 1, At, B1); PG8_BAR;
            }
        }
        if constexpr (ALIGN_EPI) { if (wr == 0) PG8_BAR; }
        TS_BEGIN(8);
        if constexpr (!Epi::AFTER_DRAIN) { E(acc, cur, wr, wc, fr, fq); S.done(cur); }
        TS_END(8);
        if (!has_next) break;
#pragma unroll
        for (int a = 0; a < 2; ++a)
#pragma unroll
            for (int b = 0; b < 2; ++b)
#pragma unroll
                for (int m = 0; m < 4; ++m)
#pragma unroll
                    for (int n = 0; n < 2; ++n) acc[a][b][m][n] = (f32x4){0.f, 0.f, 0.f, 0.f};
        cur = nxt; cA = nA; cB = nB; ++ui;
        if constexpr (ALIGN_EPI) { if (wr == 1) PG8_BAR; }
    }
    PG8_WAIT_V(0);
    if constexpr (!ALIGN_EPI) { if (wr == 0) PG8_BAR; }
    PG8_BAR;
    if constexpr (Epi::AFTER_DRAIN) { E.fused(acc, cur, wr, wc, fr, fq, lds, wid, lane); S.done(cur); }
#undef PG8_SA
#undef PG8_SB
#undef PG8_STAGE
#undef PG8_LDA
#undef PG8_LDB
#undef PG8_MMA
#undef PG8_WAIT_V
#undef PG8_WAIT_L
#undef PG8_BAR
#undef PG8_SCHED
}
}

#define LAS __attribute__((address_space(3)))
typedef unsigned short bf16_t;
typedef float f32x4 __attribute__((ext_vector_type(4)));
typedef float f32x2 __attribute__((ext_vector_type(2)));
typedef unsigned u32x4 __attribute__((ext_vector_type(4)));
typedef unsigned u32x2 __attribute__((ext_vector_type(2)));
typedef short bf16x8 __attribute__((ext_vector_type(8)));
typedef short bf16x4 __attribute__((ext_vector_type(4)));

constexpr int TL = 32768, TC = 4096, TA = 36864, DM = 1024, FF = 2816, NP = 1792, NMODC = 9216;
constexpr int YC_LD = 1280, DFT_LD = 4160, PQT_LD = 4160, DFTC_LD = 576, PQTC_LD = 576;
constexpr int LDS_BYTES = 131072 + 16;
#ifndef MIXMASK
#define MIXMASK 7
#endif

constexpr float EPSV = 1e-6f;
constexpr float LOG2E = 1.4426950408889634f;

constexpr size_t WS_XC   = 0;
constexpr size_t WS_YH   = WS_XC + (size_t)TA * DM * 2;
constexpr size_t WS_R1   = WS_YH + (size_t)TA * DM * 2;
constexpr size_t WS_PROJ = WS_R1;
constexpr size_t WS_PQT  = WS_PROJ + (size_t)TA * NP * 2;
constexpr size_t WS_PQTC = WS_PQT + (size_t)4096 * PQT_LD * 2;
constexpr size_t WS_YCAT = WS_PQTC + (size_t)4096 * PQTC_LD * 2;
constexpr size_t WS_R1END= WS_YCAT + (size_t)TA * YC_LD * 2;
constexpr size_t WS_W13  = WS_R1END;
constexpr size_t WS_W2T  = WS_W13 + (size_t)4 * 5632 * 1024 * 2;
constexpr size_t WS_WIN  = WS_W2T + (size_t)4 * 1024 * 2816 * 2;
constexpr size_t WS_WOUT = WS_WIN + (size_t)2 * 2304 * 1024 * 2;
constexpr size_t WS_DFT  = WS_WOUT + (size_t)2 * 1024 * YC_LD * 2;
constexpr size_t WS_DFTC = WS_DFT + (size_t)2048 * DFT_LD * 2;
constexpr size_t WS_MOD  = WS_DFTC + (size_t)256 * DFTC_LD * 2;
constexpr size_t WS_ROPE = WS_MOD + (size_t)2 * 17 * NMODC * 4;
constexpr size_t WS_BAR  = WS_ROPE + 64 * 16 * 2 * 4;
constexpr size_t WS_Y2   = WS_BAR + 3456 * 4;
constexpr size_t WS_END  = WS_Y2 + (size_t)TC * DM * 2;
static_assert(WS_END <= (size_t)536870912, "workspace budget (4 x the largest tensor)");
static_assert((size_t)TA * FF * 2 <= WS_R1END - WS_R1, "U must fit in R1");

struct Params {
    const float *x, *c, *ctx, *c_ctx, *w_ada, *b_ada, *norm_g, *w1, *w3, *w2, *w_in, *conv_w, *conv_b, *ln_g, *ln_b, *nat_bias, *sink, *w_out;
    float* out; unsigned char* ws;
};
typedef const __attribute__((address_space(4))) Params CParams;

__device__ __forceinline__ unsigned pk2(float lo, float hi) { return pg8::cvt_pk_bf16(lo, hi); }
__device__ __forceinline__ float bflo(unsigned v) { return __uint_as_float(v << 16); }
__device__ __forceinline__ float bfhi(unsigned v) { return __uint_as_float(v & 0xffff0000u); }
__device__ __forceinline__ int otid() { int t = threadIdx.x; asm volatile("" : "+v"(t)); return t; }
__device__ __forceinline__ int obid() { int t = blockIdx.x; asm volatile("" : "+s"(t)); return t; }
__device__ __forceinline__ float xrow16_max(float x) {
    auto s = __builtin_amdgcn_permlane16_swap(__float_as_uint(x), __float_as_uint(x), false, false);
    x = fmaxf(__uint_as_float(s[0]), __uint_as_float(s[1]));
    auto t = __builtin_amdgcn_permlane32_swap(__float_as_uint(x), __float_as_uint(x), false, false);
    return fmaxf(__uint_as_float(t[0]), __uint_as_float(t[1]));
}
__device__ __forceinline__ float xrow16_sum(float x) {
    auto s = __builtin_amdgcn_permlane16_swap(__float_as_uint(x), __float_as_uint(x), false, false);
    x = __uint_as_float(s[0]) + __uint_as_float(s[1]);
    auto t = __builtin_amdgcn_permlane32_swap(__float_as_uint(x), __float_as_uint(x), false, false);
    return __uint_as_float(t[0]) + __uint_as_float(t[1]);
}
template <int CTRL> __device__ __forceinline__ float dpp_mov(float x) { return __builtin_bit_cast(float, __builtin_amdgcn_mov_dpp(__builtin_bit_cast(int, x), CTRL, 0xf, 0xf, true)); }
__device__ __forceinline__ float wave_sum(float v) {
    v += dpp_mov<0xB1>(v);
    v += dpp_mov<0x4E>(v);
    v += dpp_mov<0x141>(v);
    v += dpp_mov<0x128>(v);
    return xrow16_sum(v);
}
__device__ __forceinline__ float fast_exp2(float x) { return __builtin_amdgcn_exp2f(x); }
__device__ __forceinline__ float fast_rcp(float x) { return __builtin_amdgcn_rcpf(x); }
__device__ __forceinline__ float silu_f(float v) { return v * fast_rcp(1.0f + fast_exp2(-v * LOG2E)); }
__device__ __forceinline__ float sigmoid_f(float v) { return fast_rcp(1.0f + fast_exp2(-v * LOG2E)); }

#define XB_TMO      128
#define XB_XCNT(j)  (256  + 64 * (j))
#define XB_XSUB(j)  (1280 + 64 * (j))
#define XB_XGEN(j)  (2304 + 64 * (j))
#define XB_TOP      3328
#define XB_TOPGEN   3392
#define XCD_BAR_WORDS 3456
#define XB_SPIN_CAP (1u << 18)

__device__ __forceinline__ unsigned xb_ld(unsigned* p)              { return __hip_atomic_load(p, __ATOMIC_RELAXED, __HIP_MEMORY_SCOPE_AGENT); }
__device__ __forceinline__ unsigned xb_add(unsigned* p, unsigned v) { return __hip_atomic_fetch_add(p, v, __ATOMIC_RELAXED, __HIP_MEMORY_SCOPE_AGENT); }
__device__ __forceinline__ unsigned xb_xcc_id() { return (unsigned)__builtin_amdgcn_s_getreg((3 << 11) | 20) & 0xFu; }
#define XB_SPIN(cond, bar) do { unsigned _sp = 0; while (cond) { __builtin_amdgcn_s_sleep(1); \
    if ((++_sp & 255u) == 0u) { if (xb_ld(&(bar)[XB_TMO])) break; if (_sp > XB_SPIN_CAP) { atomicAdd(&(bar)[XB_TMO], 1u); break; } } } } while (0)

struct XcdBarrier {
    unsigned* bar; unsigned x;
    volatile LAS unsigned* st;
};

__device__ __forceinline__ XcdBarrier xcd_barrier_post(unsigned* bar, volatile LAS unsigned* st) {
    XcdBarrier b; b.bar = bar; b.x = xb_xcc_id(); b.st = st;
    if (threadIdx.x == 0) (void)xb_add(&bar[XB_XCNT(b.x)], 1u);
    return b;
}
__device__ __forceinline__ void xcd_barrier_complete(unsigned* bar, unsigned x, unsigned& nloc, unsigned& nx) {
    const unsigned G = gridDim.x * gridDim.y * gridDim.z;
    unsigned sum, cnt, mine, sp = 0u;
    for (;;) {
        sum = 0u; cnt = 0u; mine = 0u;
#pragma unroll
        for (unsigned j = 0; j < 16; ++j) { const unsigned c = xb_ld(&bar[XB_XCNT(j)]); sum += c; cnt += (c > 0u) ? 1u : 0u; mine = (j == x) ? c : mine; }
        if (sum == G) break;
        __builtin_amdgcn_s_sleep(1);
        if ((++sp & 255u) == 0u) { if (xb_ld(&bar[XB_TMO])) break; if (sp > XB_SPIN_CAP) { atomicAdd(&bar[XB_TMO], 1u); break; } }
    }
    nloc = mine > 0u ? mine : 1u; nx = cnt > 0u ? cnt : 1u;
}

__device__ __forceinline__ void xcd_barrier(const XcdBarrier& b) {
    asm volatile("s_waitcnt vmcnt(0)" ::: "memory");
    __syncthreads();
    if (threadIdx.x == 0) {
        unsigned* bar = b.bar;
        __builtin_amdgcn_s_waitcnt(0);
        unsigned nloc = b.st[0], nx = b.st[1];
        if (nloc == 0u) { xcd_barrier_complete(bar, b.x, nloc, nx); b.st[0] = nloc; b.st[1] = nx; }
        const unsigned old = xb_add(&bar[XB_XSUB(b.x)], 1u);
        const unsigned gen = old / nloc;
        if (old + 1u == (gen + 1u) * nloc) {
            __builtin_amdgcn_fence(__ATOMIC_RELEASE, "agent");
            asm volatile("s_waitcnt vmcnt(0)" ::: "memory");
            const unsigned og = xb_add(&bar[XB_TOP], 1u);
            const unsigned tg = og / nx;
            if (og + 1u == (tg + 1u) * nx) xb_add(&bar[XB_TOPGEN], 1u);
            else XB_SPIN(xb_ld(&bar[XB_TOPGEN]) == tg, bar);
            __builtin_amdgcn_fence(__ATOMIC_ACQUIRE, "agent");
            xb_add(&bar[XB_XGEN(b.x)], 1u);
            asm volatile("s_waitcnt vmcnt(0)" ::: "memory");
        } else {
            XB_SPIN(xb_ld(&bar[XB_XGEN(b.x)]) == gen, bar);
            __builtin_amdgcn_fence(__ATOMIC_ACQUIRE, "agent");
            asm volatile("s_waitcnt vmcnt(0)" ::: "memory");
        }
    }
    __syncthreads();
}


struct EpiSwiGLU {
    static constexpr bool PERM = true, AFTER_DRAIN = false;
    bf16_t* U;
    __device__ __forceinline__ void operator()(const f32x4 (&acc)[2][2][4][2], const pg8::Unit& u, int wr, int wc, int fr, int fq) const {
        const int row0 = u.pm * 256 + wr * 64 + fr, col0 = u.pn * 128 + wc * 32 + 8 * fq;
#pragma unroll
        for (int ai = 0; ai < 2; ++ai)
#pragma unroll
            for (int m = 0; m < 4; ++m) {
                bf16_t* rowp = U + (size_t)(row0 + ai * 128 + m * 16) * FF + col0;
                unsigned wv[4];
#pragma unroll
                for (int n = 0; n < 2; ++n)
#pragma unroll
                    for (int h = 0; h < 2; ++h) {
                        const f32x2 g2 = {acc[ai][0][m][n][2 * h], acc[ai][0][m][n][2 * h + 1]}, u2 = {acc[ai][1][m][n][2 * h], acc[ai][1][m][n][2 * h + 1]};
                        const f32x2 t = g2 * (-LOG2E);
                        f32x2 d; d.x = fast_exp2(t.x); d.y = fast_exp2(t.y);
                        d = d + 1.0f;
                        f32x2 r; r.x = fast_rcp(d.x); r.y = fast_rcp(d.y);
                        const f32x2 v = (g2 * u2) * r;
                        wv[n * 2 + h] = pk2(v.x, v.y);
                    }
                u32x4 w; w.x = wv[0]; w.y = wv[1]; w.z = wv[2]; w.w = wv[3];
                *(u32x4*)rowp = w;
            }
    }
};
struct EpiBf16Tile {
    static constexpr bool PERM = true, AFTER_DRAIN = false;
    bf16_t* O; int ldc, row_pn, col_pn;
    __device__ __forceinline__ void operator()(const f32x4 (&acc)[2][2][4][2], const pg8::Unit& u, int wr, int wc, int fr, int fq) const {
        const int row0 = u.pm * 256 + u.pn * row_pn + wr * 64 + fr, col0 = u.pn * col_pn + wc * 32 + 8 * fq;
#pragma unroll
        for (int ai = 0; ai < 2; ++ai)
#pragma unroll
            for (int m = 0; m < 4; ++m) {
                bf16_t* rowp = O + (size_t)(row0 + ai * 128 + m * 16) * ldc + col0;
#pragma unroll
                for (int bj = 0; bj < 2; ++bj) {
                    const f32x4 v0 = acc[ai][bj][m][0], v1 = acc[ai][bj][m][1];
                    u32x4 w; w.x = pk2(v0[0], v0[1]); w.y = pk2(v0[2], v0[3]); w.z = pk2(v1[0], v1[1]); w.w = pk2(v1[2], v1[3]);
                    *(u32x4*)(rowp + bj * 128) = w;
                }
            }
    }
};
struct EpiPQ {
    static constexpr bool PERM = true, AFTER_DRAIN = false;
    bf16_t* PQT; bf16_t* PQTC;
    __device__ __forceinline__ void operator()(const f32x4 (&acc)[2][2][4][2], const pg8::Unit& u, int wr, int wc, int fr, int fq) const {
        const int cl = wc * 32 + 8 * fq;
        const bool isctx = u.pn >= 128;
        const int b = isctx ? u.pn - 128 : u.pn >> 3, n0 = isctx ? 0 : (u.pn & 7) * 256;
        bf16_t* base = isctx ? PQTC : PQT; const int ld = isctx ? PQTC_LD : PQT_LD, half = isctx ? 256 : 2048;
#pragma unroll
        for (int ai = 0; ai < 2; ++ai)
#pragma unroll
            for (int m = 0; m < 4; ++m) {
                const int mp = ai * 128 + wr * 64 + m * 16 + fr;
                const int g = mp >> 6, idx = mp & 63, isq = idx > 32, j = isq ? idx - 32 : idx;
                bf16_t* r1 = base + (size_t)(b * 256 + g * 64 + j) * ld + isq * half + n0 + cl;
                bf16_t* r2 = base + (size_t)(b * 256 + g * 64 + ((64 - j) & 63)) * ld + isq * half + n0 + cl;
                const bool self = (j == 0) || (j == 32);
                const unsigned sgn = isq ? 0x80008000u : 0u;
#pragma unroll
                for (int bj = 0; bj < 2; ++bj) {
                    const f32x4 v0 = acc[ai][bj][m][0], v1 = acc[ai][bj][m][1];
                    u32x4 w; w.x = pk2(v0[0], v0[1]); w.y = pk2(v0[2], v0[3]); w.z = pk2(v1[0], v1[1]); w.w = pk2(v1[2], v1[3]);
                    *(u32x4*)(r1 + bj * 128) = w;
                    if (self) { *(u32x4*)(r1 + half + bj * 128) = (u32x4){0u, 0u, 0u, 0u}; }
                    else { u32x4 wm; wm.x = w.x ^ sgn; wm.y = w.y ^ sgn; wm.z = w.z ^ sgn; wm.w = w.w ^ sgn; *(u32x4*)(r2 + bj * 128) = wm; }
                }
            }
    }
};
struct EpiWin {
    static constexpr bool PERM = false, AFTER_DRAIN = false;
    bf16_t* P; const float* rope;
    __device__ __forceinline__ void operator()(const f32x4 (&acc)[2][2][4][2], const pg8::Unit& u, int wr, int wc, int fr, int fq) const {
        const int row0 = u.pm * 256 + wr * 64 + fr, col0 = u.pn * 256 + wc * 32 + 4 * fq;
        const float qs = (u.pn == 2 || u.pn == 5) ? 0.125f * LOG2E : 1.0f;
        const bool lat = u.pm < 128;
#pragma unroll
        for (int ai = 0; ai < 2; ++ai)
#pragma unroll
            for (int m = 0; m < 4; ++m) {
                const int r = row0 + ai * 128 + m * 16;
                bf16_t* rowp = P + (size_t)r * NP + col0;
                const int t = r & 2047;
                const int pos = (wc & 1) ? (t & 63) : (t >> 6);
#pragma unroll
                for (int bj = 0; bj < 2; ++bj) {
                    f32x4 v0 = acc[ai][bj][m][0], v1 = acc[ai][bj][m][1];
                    const bool dorope = lat && (u.pn == 5 || (u.pn == 6 && bj == 0));
                    if (dorope) {
                        const f32x4 cs0 = *(const f32x4*)(rope + (pos * 16 + 4 * fq) * 2), cs1 = *(const f32x4*)(rope + (pos * 16 + 4 * fq) * 2 + 4);
                        const float c0 = cs0[0], s0 = cs0[1], c1 = cs0[2], s1 = cs0[3], c2 = cs1[0], s2 = cs1[1], c3 = cs1[2], s3 = cs1[3];
                        f32x4 a, b;
                        a[0] = v0[0] * c0 - v1[0] * s0; b[0] = v0[0] * s0 + v1[0] * c0;
                        a[1] = v0[1] * c1 - v1[1] * s1; b[1] = v0[1] * s1 + v1[1] * c1;
                        a[2] = v0[2] * c2 - v1[2] * s2; b[2] = v0[2] * s2 + v1[2] * c2;
                        a[3] = v0[3] * c3 - v1[3] * s3; b[3] = v0[3] * s3 + v1[3] * c3;
                        v0 = a; v1 = b;
                    }
                    v0 = v0 * qs; v1 = v1 * qs;
                    u32x2 w0, w1; w0.x = pk2(v0[0], v0[1]); w0.y = pk2(v0[2], v0[3]); w1.x = pk2(v1[0], v1[1]); w1.y = pk2(v1[2], v1[3]);
                    *(u32x2*)(rowp + bj * 128) = w0; *(u32x2*)(rowp + bj * 128 + 16) = w1;
                }
            }
    }
};

struct TrItem { const float* src; bf16_t* dst; int ld_src, ld_dst; };
__device__ __forceinline__ TrItem tr_decode(CParams& p, int it) {
    constexpr int PER_L = 2 * 704 + 2 * 352 + 224 + 160;
    unsigned char* ws = p.ws;
    const int l = it / PER_L; int q = it % PER_L;
    const float* src; bf16_t* dst; int ld_src, ld_dst, col0, k0, r0;
    if (q < 2 * 704) { const int f = q / 704; q %= 704; const int rt = q >> 4, kt = q & 15, R0 = rt * 128, tile = R0 >> 8, bj = (R0 >> 7) & 1;
        src = (bj ? p.w3 : p.w1) + (size_t)(l * 2 + f) * 1024 * FF; ld_src = FF; col0 = 128 * tile; k0 = 64 * kt; dst = (bf16_t*)(ws + WS_W13) + (size_t)(l * 2 + f) * 5632 * 1024; r0 = R0; ld_dst = 1024; }
    else if (q < 2 * 704 + 2 * 352) { q -= 2 * 704; const int f = q / 352; q %= 352; const int rt = q / 44, kt = q % 44;
        src = p.w2 + (size_t)(l * 2 + f) * FF * 1024; ld_src = 1024; col0 = 128 * rt; k0 = 64 * kt; dst = (bf16_t*)(ws + WS_W2T) + (size_t)(l * 2 + f) * 1024 * FF; r0 = 128 * rt; ld_dst = FF; }
    else if (q < 2 * 704 + 2 * 352 + 224) { q -= 2 * 704 + 2 * 352; const int rt = q >> 4, kt = q & 15, R0 = rt * 128;
        src = p.w_in + (size_t)l * 1024 * 2048; ld_src = 2048; col0 = R0 < 512 ? R0 : R0 + 256; k0 = 64 * kt; dst = (bf16_t*)(ws + WS_WIN) + (size_t)l * 2304 * 1024; r0 = R0; ld_dst = 1024; }
    int ks = -1;
    if (q >= 2 * 704 + 2 * 352 + 224) { q -= 2 * 704 + 2 * 352 + 224; const int rt = q / 20, kt = q % 20;
        src = p.w_out + (size_t)l * 1024 * 1024; ld_src = 1024; col0 = 128 * rt; k0 = 64 * kt; ks = kt < 16 ? 64 * kt : 256 + 64 * (kt - 16); dst = (bf16_t*)(ws + WS_WOUT) + (size_t)l * 1024 * YC_LD; r0 = 128 * rt; ld_dst = YC_LD; }
    if (ks < 0) ks = k0;
    TrItem t; t.src = src + (size_t)ks * ld_src + col0; t.dst = dst + (size_t)r0 * ld_dst + k0; t.ld_src = ld_src; t.ld_dst = ld_dst; return t;
}

__device__ __forceinline__ void phase0(CParams& p, LAS unsigned char* lds) {
    const int tid = otid(), wave = tid >> 6, lane = tid & 63;
    unsigned char* ws = p.ws;
    const int bid = obid(), G = gridDim.x;
    TS_BEGIN(9);
    if (bid < 288) {
        LAS float* sS = (LAS float*)lds;
        LAS float* sR = sS + 17 * 1024;
        for (int i = tid; i < 17 * 1024; i += 512) { const float v = (i < 16384) ? p.c[i] : p.c_ctx[i - 16384]; sS[i] = v / (1.0f + __expf(-v)); }
        __syncthreads();
        for (int r = bid; r < 288; r += G) {
            const int l = r / 144, j0 = (r % 144) * 64, k0 = wave * 128;
            float acc[17];
#pragma unroll
            for (int q = 0; q < 17; ++q) acc[q] = 0.f;
            const float* wp = p.w_ada + ((size_t)l * 1024 + k0) * NMODC + j0 + lane;
            float wv[16];
#pragma unroll
            for (int kk = 0; kk < 16; ++kk) wv[kk] = __builtin_nontemporal_load(wp + (size_t)kk * NMODC);
#pragma unroll 1
            for (int kb = 0; kb < 128; kb += 16) {
                float wn[16];
                const int kn = (kb + 16 < 128) ? kb + 16 : kb;
#pragma unroll
                for (int kk = 0; kk < 16; ++kk) wn[kk] = __builtin_nontemporal_load(wp + (size_t)(kn + kk) * NMODC);
#pragma unroll 1
                for (int k4 = 0; k4 < 16; k4 += 4) {
                    const float w0 = k4 == 0 ? wv[0] : (k4 == 4 ? wv[4] : (k4 == 8 ? wv[8] : wv[12]));
                    const float w1 = k4 == 0 ? wv[1] : (k4 == 4 ? wv[5] : (k4 == 8 ? wv[9] : wv[13]));
                    const float w2 = k4 == 0 ? wv[2] : (k4 == 4 ? wv[6] : (k4 == 8 ? wv[10] : wv[14]));
                    const float w3 = k4 == 0 ? wv[3] : (k4 == 4 ? wv[7] : (k4 == 8 ? wv[11] : wv[15]));
#pragma unroll
                    for (int q = 0; q < 17; ++q) { const f32x4 sv = *(const LAS f32x4*)(sS + q * 1024 + k0 + kb + k4);
                        acc[q] += (sv[0] * w0 + sv[1] * w1) + (sv[2] * w2 + sv[3] * w3); }
                }
#pragma unroll
                for (int kk = 0; kk < 16; ++kk) wv[kk] = wn[kk];
            }
#pragma unroll
            for (int q = 0; q < 17; ++q) sR[(wave * 17 + q) * 64 + lane] = acc[q];
            __syncthreads();
            float* MOD = (float*)(ws + WS_MOD);
            for (int o = tid; o < 17 * 64; o += 512) {
                const int q = o >> 6, ln = o & 63; float s = p.b_ada[l * NMODC + j0 + ln];
#pragma unroll
                for (int w = 0; w < 8; ++w) s += sR[(w * 17 + q) * 64 + ln];
                MOD[(size_t)(l * 17 + q) * NMODC + j0 + ln] = s;
            }
            __syncthreads();
        }
    }
    TS_END(9);
    TS_BEGIN(10);
    {
        constexpr int N_TR = 2 * (2 * 704 + 2 * 352 + 224 + 160);
        LAS float* t = (LAS float*)lds;
        const int lk = tid >> 5, lc = (tid & 31) * 4;
        const int sr = tid >> 2, sk = (tid & 3) * 16;
        const bool bal = (G == 256) && (N_TR == 4992);
        int it = bal ? (bid >= 32 ? (bid - 32) * 21 : 4704 + bid * 9) : bid;
        const int step = bal ? 1 : G, tr_end = bal ? it + (bid >= 32 ? 21 : 9) : N_TR;
        f32x4 pre[4]; TrItem cur;
        if (it < tr_end) { cur = tr_decode(p, it);
#pragma unroll
            for (int i = 0; i < 4; ++i) pre[i] = __builtin_nontemporal_load((const f32x4*)(cur.src + (size_t)(lk + 16 * i) * cur.ld_src + lc)); }
        while (it < tr_end) {
#pragma unroll
            for (int i = 0; i < 4; ++i) { LAS float* d = t + (lk + 16 * i) * 129 + lc; d[0] = pre[i][0]; d[1] = pre[i][1]; d[2] = pre[i][2]; d[3] = pre[i][3]; }
            __syncthreads();
            bf16_t* dp = cur.dst + (size_t)sr * cur.ld_dst + sk;
            const int nxt = it + step;
            if (nxt < tr_end) { cur = tr_decode(p, nxt);
#pragma unroll
                for (int i = 0; i < 4; ++i) pre[i] = __builtin_nontemporal_load((const f32x4*)(cur.src + (size_t)(lk + 16 * i) * cur.ld_src + lc)); }
            { const LAS float* s = t + sk * 129 + sr;
              u32x4 o0, o1;
              o0.x = pk2(s[0 * 129], s[1 * 129]); o0.y = pk2(s[2 * 129], s[3 * 129]); o0.z = pk2(s[4 * 129], s[5 * 129]); o0.w = pk2(s[6 * 129], s[7 * 129]);
              o1.x = pk2(s[8 * 129], s[9 * 129]); o1.y = pk2(s[10 * 129], s[11 * 129]); o1.z = pk2(s[12 * 129], s[13 * 129]); o1.w = pk2(s[14 * 129], s[15 * 129]);
              *(u32x4*)dp = o0; *(u32x4*)(dp + 8) = o1; }
            __syncthreads();
            it = nxt;
        }
    }
    TS_END(10);
    TS_BEGIN(11);
    for (int r = bid; r < 256; r += G) {
        const int l = r >> 7, k0 = (r & 127) * 8;
        LAS float* sW = (LAS float*)lds;
        LAS float* sC = sW + 2048;
        for (int i = tid; i < 2048; i += 512) { const int kk = i >> 8, cc = i & 255; sW[i] = p.w_in[((size_t)l * 1024 + k0 + kk) * 2048 + 512 + cc]; }
        if (tid < 64) sC[tid] = cospif((float)tid * (1.0f / 32.0f));
        __syncthreads();
        const int g = (tid >> 6) & 3, idx = tid & 63, isS = idx > 32, jj = isS ? idx - 32 : idx;
        float acc[8];
#pragma unroll
        for (int q = 0; q < 8; ++q) acc[q] = 0.f;
        for (int c = 0; c < 64; ++c) {
            const int mm = (c * jj) & 63; const float tv = sC[isS ? ((mm - 16) & 63) : mm];
#pragma unroll
            for (int q = 0; q < 8; ++q) acc[q] += sW[q * 256 + g * 64 + c] * tv;
        }
        u32x4 o; o.x = pk2(acc[0] * 0.125f, acc[1] * 0.125f); o.y = pk2(acc[2] * 0.125f, acc[3] * 0.125f); o.z = pk2(acc[4] * 0.125f, acc[5] * 0.125f); o.w = pk2(acc[6] * 0.125f, acc[7] * 0.125f);
        if (tid < 256) *(u32x4*)((bf16_t*)(ws + WS_WIN) + ((size_t)l * 2304 + 1792 + g * 64 + idx) * 1024 + k0) = o;
        __syncthreads();
    }
    {
        LAS float* tab = (LAS float*)lds;
        for (int m = tid; m < 2048; m += 512) tab[m] = cospif((float)m * (1.0f / 1024.0f)) * 0.022097086912079608f;
        __syncthreads();
        for (int r = bid; r < 2048 + 256; r += G) {
            if (r < 2048) {
                float v[8];
#pragma unroll
                for (int e = 0; e < 8; ++e) { const int k = tid * 8 + e, idx = (r * (k & 2047)) & 2047; v[e] = tab[k < 2048 ? idx : ((idx + 512) & 2047)]; }
                u32x4 o; o.x = pk2(v[0], v[1]); o.y = pk2(v[2], v[3]); o.z = pk2(v[4], v[5]); o.w = pk2(v[6], v[7]);
                *(u32x4*)((bf16_t*)(ws + WS_DFT) + (size_t)r * DFT_LD + tid * 8) = o;
            } else if (tid < 64) {
                const int np = r - 2048; const float sc = 2.8284271247461903f;
                float v[8];
#pragma unroll
                for (int e = 0; e < 8; ++e) { const int k = tid * 8 + e, idx = ((np * (k & 255)) & 255) * 8; v[e] = tab[k < 256 ? idx : ((idx + 512) & 2047)] * sc; }
                u32x4 o; o.x = pk2(v[0], v[1]); o.y = pk2(v[2], v[3]); o.z = pk2(v[4], v[5]); o.w = pk2(v[6], v[7]);
                *(u32x4*)((bf16_t*)(ws + WS_DFTC) + (size_t)np * DFTC_LD + tid * 8) = o;
            }
        }
        __syncthreads();
    }
    TS_END(11);
    if (bid == G - 1) {
        float* rtab = (float*)(ws + WS_ROPE);
        for (int e = tid; e < 1024; e += 512) { const int pos = e >> 4, i = e & 15;
            const float inv = fast_exp2(-(float)i * (13.287712379549449f / 16.0f));
            const float tt = (float)pos * inv * 0.3183098861837907f;
            rtab[2 * e] = cospif(tt); rtab[2 * e + 1] = sinpif(tt); }
    }
}

struct EwRow { f32x4 x[4]; u32x2 xb[4]; u32x2 y[4]; u32x2 y2[4]; };
__device__ __forceinline__ void ew_load(EwRow& r, const float* xin_lat, const float* xin_ctx, const bf16_t* xin_bf, const bf16_t* Yp, const bf16_t* Y2p, int t, int lane) {
    if (xin_bf) {
#pragma unroll
        for (int j = 0; j < 4; ++j) r.xb[j] = __builtin_nontemporal_load((const u32x2*)(xin_bf + (size_t)t * DM + 4 * lane + 256 * j));
    } else {
        const float* xr = t < TL ? xin_lat + (size_t)t * DM : xin_ctx + (size_t)(t - TL) * DM;
#pragma unroll
        for (int j = 0; j < 4; ++j) r.x[j] = __builtin_nontemporal_load((const f32x4*)(xr + 4 * lane + 256 * j));
    }
    if (Yp) {
#pragma unroll
        for (int j = 0; j < 4; ++j) r.y[j] = __builtin_nontemporal_load((const u32x2*)(Yp + (size_t)t * DM + 4 * lane + 256 * j));
        if (t >= TL) {
#pragma unroll
            for (int j = 0; j < 4; ++j) r.y2[j] = __builtin_nontemporal_load((const u32x2*)(Y2p + (size_t)(t - TL) * DM + 4 * lane + 256 * j));
        }
    }
}
__device__ __forceinline__ void ew_pass(const float* xin_lat, const float* xin_ctx, const bf16_t* xin_bf, bf16_t* xout_bf, float* xout_f32, const bf16_t* Yp, const bf16_t* Y2p, const float* gpost, float fac, const float* gate,
                                        bf16_t* Hp, const float* gpre, const float* shift, const float* scale, int nrows) {
    const int tid = otid(); const int wave = tid >> 6, lane = tid & 63;
    const int per = (nrows + (int)gridDim.x - 1) / (int)gridDim.x, tbeg = obid() * per + wave, tend = min(obid() * per + per, nrows);
    f32x4 vgp[4], vgt[4], vpre[4], vsh[4], vsc[4];
#pragma unroll
    for (int j = 0; j < 4; ++j) { vgp[j] = Yp ? *(const f32x4*)(gpost + 4 * lane + 256 * j) : (f32x4){0.f, 0.f, 0.f, 0.f}; vpre[j] = Hp ? *(const f32x4*)(gpre + 4 * lane + 256 * j) : (f32x4){0.f, 0.f, 0.f, 0.f};
        vgt[j] = vsh[j] = vsc[j] = (f32x4){0.f, 0.f, 0.f, 0.f}; }
    int bcur = -1;
    EwRow A, B;
    auto process = [&](EwRow& r, int t) {
        const bool lat = t < TL; const int b = lat ? (t >> 11) : 16;
        if (xin_bf) {
#pragma unroll
            for (int j = 0; j < 4; ++j) { const u32x2 w = r.xb[j]; r.x[j][0] = bflo(w.x); r.x[j][1] = bfhi(w.x); r.x[j][2] = bflo(w.y); r.x[j][3] = bfhi(w.y); }
        }
        if (b != bcur) { bcur = b;
#pragma unroll
            for (int j = 0; j < 4; ++j) { const int cidx = 4 * lane + 256 * j;
                if (Yp) vgt[j] = *(const f32x4*)(gate + (size_t)b * NMODC + cidx) * fac;
                if (Hp) { vsh[j] = *(const f32x4*)(shift + (size_t)b * NMODC + cidx); vsc[j] = *(const f32x4*)(scale + (size_t)b * NMODC + cidx) + 1.0f; } } }
        if (Yp) {
            f32x4 y[4]; float ss = 0.f;
#pragma unroll
            for (int j = 0; j < 4; ++j) { const u32x2 w = r.y[j];
                y[j][0] = bflo(w.x); y[j][1] = bfhi(w.x); y[j][2] = bflo(w.y); y[j][3] = bfhi(w.y);
                if (!lat) { const u32x2 w2 = r.y2[j]; y[j][0] += bflo(w2.x); y[j][1] += bfhi(w2.x); y[j][2] += bflo(w2.y); y[j][3] += bfhi(w2.y); }
                ss += (y[j][0] * y[j][0] + y[j][1] * y[j][1]) + (y[j][2] * y[j][2] + y[j][3] * y[j][3]); }
            const float rstd = 1.0f / sqrtf(wave_sum(ss) * (1.0f / DM) + EPSV);
#pragma unroll
            for (int j = 0; j < 4; ++j) r.x[j] = r.x[j] + vgt[j] * (y[j] * rstd * vgp[j]);
        }
        if (xout_f32) {
            float* xo = xout_f32 + (size_t)t * DM;
#pragma unroll
            for (int j = 0; j < 4; ++j) __builtin_nontemporal_store(r.x[j], (f32x4*)(xo + 4 * lane + 256 * j));
        } else if (xout_bf) {
#pragma unroll
            for (int j = 0; j < 4; ++j) { u32x2 w; w.x = pk2(r.x[j][0], r.x[j][1]); w.y = pk2(r.x[j][2], r.x[j][3]);
                __builtin_nontemporal_store(w, (u32x2*)(xout_bf + (size_t)t * DM + 4 * lane + 256 * j));
                r.x[j][0] = bflo(w.x); r.x[j][1] = bfhi(w.x); r.x[j][2] = bflo(w.y); r.x[j][3] = bfhi(w.y); }
        }
        if (Hp) {
            float ss = 0.f;
#pragma unroll
            for (int j = 0; j < 4; ++j) ss += (r.x[j][0] * r.x[j][0] + r.x[j][1] * r.x[j][1]) + (r.x[j][2] * r.x[j][2] + r.x[j][3] * r.x[j][3]);
            const float rstd = 1.0f / sqrtf(wave_sum(ss) * (1.0f / DM) + EPSV);
#pragma unroll
            for (int j = 0; j < 4; ++j) { const f32x4 h = (r.x[j] * rstd * vpre[j]) * vsc[j] + vsh[j];
                u32x2 w; w.x = pk2(h[0], h[1]); w.y = pk2(h[2], h[3]);
                *(u32x2*)(Hp + (size_t)t * DM + 4 * lane + 256 * j) = w; }
        }
    };
    int t = tbeg;
    if (t < tend) ew_load(A, xin_lat, xin_ctx, xin_bf, Yp, Y2p, t, lane);
    while (t < tend) {
        const int tn = t + 8;
        if (tn < tend) ew_load(B, xin_lat, xin_ctx, xin_bf, Yp, Y2p, tn, lane);
        process(A, t);
        const int tnn = tn + 8;
        if (tnn < tend) ew_load(A, xin_lat, xin_ctx, xin_bf, Yp, Y2p, tnn, lane);
        if (tn < tend) process(B, tn);
        t = tnn;
    }
}

__device__ __forceinline__ void conv_item(CParams& p, LAS unsigned char* lds, int l, int s, int tb) {
    const int tid = otid(), wave = tid >> 6, lane = tid & 63;
    const bf16_t* PROJ = (const bf16_t*)(p.ws + WS_PROJ); bf16_t* YCAT = (bf16_t*)(p.ws + WS_YCAT);
    LAS float* sA = (LAS float*)lds;
    const int tokbase = s < 16 ? s * 2048 : TL + (s - 16) * 256, len = s < 16 ? 2048 : 256, t0 = tb * 64;
    {
        u32x4 ua[6], ug[6];
#pragma unroll
        for (int i = 0; i < 6; ++i) {
            const int u = tid + 512 * i, rr = u >> 5, c8 = (u & 31) * 8, tt = t0 - 15 + rr;
            ua[i] = (u32x4){0u, 0u, 0u, 0u}; ug[i] = (u32x4){0u, 0u, 0u, 0u};
            if (u < 94 * 32 && tt >= 0 && tt < len) { const bf16_t* rp = PROJ + (size_t)(tokbase + tt) * NP + c8; ua[i] = *(const u32x4*)rp; ug[i] = *(const u32x4*)(rp + 256); }
        }
#pragma unroll
        for (int i = 0; i < 6; ++i) {
            const int u = tid + 512 * i, rr = u >> 5, c8 = (u & 31) * 8;
            if (u < 94 * 32) {
                float v[8];
                v[0] = bflo(ua[i].x) * sigmoid_f(bflo(ug[i].x)); v[1] = bfhi(ua[i].x) * sigmoid_f(bfhi(ug[i].x));
                v[2] = bflo(ua[i].y) * sigmoid_f(bflo(ug[i].y)); v[3] = bfhi(ua[i].y) * sigmoid_f(bfhi(ug[i].y));
                v[4] = bflo(ua[i].z) * sigmoid_f(bflo(ug[i].z)); v[5] = bfhi(ua[i].z) * sigmoid_f(bfhi(ug[i].z));
                v[6] = bflo(ua[i].w) * sigmoid_f(bflo(ug[i].w)); v[7] = bfhi(ua[i].w) * sigmoid_f(bfhi(ug[i].w));
                *(LAS f32x4*)(sA + rr * 256 + c8) = (f32x4){v[0], v[1], v[2], v[3]};
                *(LAS f32x4*)(sA + rr * 256 + c8 + 4) = (f32x4){v[4], v[5], v[6], v[7]};
            }
        }
    }
    __syncthreads();
    TS_BEGIN(7);
    const int cp = tid & 127, oc = tid >> 7;
    f32x2 out2[2][8];
    {
        f32x2 w2[31];
#pragma unroll
        for (int j = 0; j < 31; ++j) w2[j] = *(const f32x2*)(p.conv_w + ((size_t)l * 31 + j) * 256 + 2 * cp);
        const f32x2 bias2 = *(const f32x2*)(p.conv_b + l * 256 + 2 * cp);
#pragma unroll
        for (int ps = 0; ps < 2; ++ps) {
            const LAS float* ap = sA + ((oc * 2 + ps) * 8) * 256 + 2 * cp;
            f32x2 in2[38];
#pragma unroll
            for (int i = 0; i < 38; ++i) in2[i] = *(const LAS f32x2*)(ap + i * 256);
#pragma unroll
            for (int q = 0; q < 8; ++q) {
                f32x2 acc = bias2;
#pragma unroll
                for (int j = 0; j < 31; ++j) acc = in2[q + j] * w2[j] + acc;
                out2[ps][q] = acc;
            }
        }
    }
    TS_END(7);
    __syncthreads();
#pragma unroll
    for (int ps = 0; ps < 2; ++ps)
#pragma unroll
        for (int q = 0; q < 8; ++q) *(LAS f32x2*)(sA + ((oc * 2 + ps) * 8 + q) * 256 + 2 * cp) = out2[ps][q];
    __syncthreads();
    {
        const f32x4 lg = *(const f32x4*)(p.ln_g + l * 256 + 4 * lane), lb = *(const f32x4*)(p.ln_b + l * 256 + 4 * lane);
#pragma unroll
        for (int q = 0; q < 8; ++q) {
            const int tok = wave * 8 + q;
            const f32x4 v = *(const LAS f32x4*)(sA + tok * 256 + 4 * lane);
            const float mean = wave_sum((v[0] + v[1]) + (v[2] + v[3])) * (1.0f / 256.0f);
            const f32x4 d = v - mean;
            const float var = wave_sum((d[0] * d[0] + d[1] * d[1]) + (d[2] * d[2] + d[3] * d[3])) * (1.0f / 256.0f);
            const float rstd = 1.0f / sqrtf(var + EPSV);
            const f32x4 yn = d * rstd * lg + lb;
            u32x2 o; o.x = pk2(silu_f(yn[0]), silu_f(yn[1])); o.y = pk2(silu_f(yn[2]), silu_f(yn[3]));
            *(u32x2*)(YCAT + (size_t)(tokbase + t0 + tok) * YC_LD + 4 * lane) = o;
        }
    }
    __syncthreads();
}

struct AttnItem {
    int mode;
    int qtok0;
    int qcol0, qcol1, ocol0, ocol1;
    int kcol0, kcol1, vcol0, vcol1; int nslots;
    int nloc, loctok0;
    int ctxtok0;
    int r, rs;
    int q0, kp0;
    int has_sink; float sink0, sink1;
    int h0;
};
constexpr int KROW = 72;
constexpr int KV_BYTES = 64 * KROW * 2;
constexpr int ABUF_BYTES = 4 * KV_BYTES;
typedef short s16x4 __attribute__((ext_vector_type(4)));
template <int OFF> __device__ __forceinline__ s16x4 tr_read(unsigned addr) {
    s16x4 r; asm volatile("ds_read_b64_tr_b16 %0, %1 offset:%2" : "=&v"(r) : "v"(addr), "i"(OFF) : "memory"); return r;
}
template <int NKB>
__device__ __forceinline__ void attn_chunk(const LAS unsigned char* kt, const LAS unsigned char* vt, int kofs, const bf16x8 (&qf)[2], int fr, int fq,
                                           int mtype, int a0, const LAS float* bt, float& mrun, float& lsum, f32x4 (&o)[4]) {
    const unsigned vaddr = (unsigned)(size_t)vt + (unsigned)(((kofs + 4 * fq + (fr >> 2)) * KROW + 4 * (fr & 3)) * 2);
    s16x4 vl[NKB / 2][4], vh[NKB / 2][4];
#pragma unroll
    for (int grp = 0; grp < NKB / 2; ++grp) {
        const unsigned va = vaddr + (unsigned)(grp * 32 * KROW * 2);
        vl[grp][0] = tr_read<0>(va);  vh[grp][0] = tr_read<16 * KROW * 2>(va);
        vl[grp][1] = tr_read<32>(va); vh[grp][1] = tr_read<16 * KROW * 2 + 32>(va);
        vl[grp][2] = tr_read<64>(va); vh[grp][2] = tr_read<16 * KROW * 2 + 64>(va);
        vl[grp][3] = tr_read<96>(va); vh[grp][3] = tr_read<16 * KROW * 2 + 96>(va);
    }
    f32x4 sacc[NKB];
    const int kc0 = (fq ^ (((kofs + fr) >> 1) & 7)) * 16;
    const LAS unsigned char* krow = kt + (kofs + fr) * 128;
    const LAS unsigned char* kp0 = krow + kc0;
    const LAS unsigned char* kp1 = krow + (kc0 ^ 64);
#pragma unroll
    for (int kb = 0; kb < NKB; ++kb) {
        sacc[kb] = (f32x4){0.f, 0.f, 0.f, 0.f};
        const bf16x8 a0v = *(const LAS bf16x8*)(kp0 + 16 * kb * 128);
        const bf16x8 a1v = *(const LAS bf16x8*)(kp1 + 16 * kb * 128);
        sacc[kb] = __builtin_amdgcn_mfma_f32_16x16x32_bf16(a0v, qf[0], sacc[kb], 0, 0, 0);
        sacc[kb] = __builtin_amdgcn_mfma_f32_16x16x32_bf16(a1v, qf[1], sacc[kb], 0, 0, 0);
    }
    if (mtype == 1) {
        const int wsx = min(max(a0 - 8, 0), 48);
        const int lo = wsx - (kofs + 4 * fq);
        const LAS float* bl = bt + (kofs + 4 * fq - a0 + 63);
#pragma unroll
        for (int kb = 0; kb < NKB; ++kb)
#pragma unroll
            for (int j = 0; j < 4; ++j) { const bool ok = (unsigned)(16 * kb + j - lo) < 16u;
                sacc[kb][j] = ok ? sacc[kb][j] + bl[16 * kb + j] : -1.0e30f; }
    } else if (mtype == 2) {
        const int db = a0 + kofs + 4 * fq + 128;
#pragma unroll
        for (int kb = 0; kb < NKB; ++kb)
#pragma unroll
            for (int j = 0; j < 4; ++j) { const bool ok = (unsigned)(db + 16 * kb + j) <= 256u;
                sacc[kb][j] = ok ? sacc[kb][j] : -1.0e30f; }
    }
    float cm = sacc[0][0];
#pragma unroll
    for (int kb = 0; kb < NKB; ++kb)
#pragma unroll
        for (int j = 0; j < 4; ++j) cm = fmaxf(cm, sacc[kb][j]);
    cm = xrow16_max(cm);
    const float mnew = fmaxf(mrun, cm);
    if (__any(mnew > mrun)) {
        const float alpha = fast_exp2(mrun - mnew);
        lsum *= alpha;
#pragma unroll
        for (int db = 0; db < 4; ++db) o[db] = o[db] * alpha;
        mrun = mnew;
    }
    float ps = 0.f;
#pragma unroll
    for (int kb = 0; kb < NKB; ++kb)
#pragma unroll
        for (int j = 0; j < 4; ++j) { sacc[kb][j] = fast_exp2(sacc[kb][j] - mnew); ps += sacc[kb][j]; }
    lsum += ps;
    asm volatile("s_waitcnt lgkmcnt(0)" ::: "memory"); __builtin_amdgcn_sched_barrier(0);
#define ATT_PK(L, H) (bf16x8){L[0], L[1], L[2], L[3], H[0], H[1], H[2], H[3]}
#pragma unroll
    for (int grp = 0; grp < NKB / 2; ++grp) {
        union { bf16x8 v; unsigned u[4]; } pb;
        pb.u[0] = pk2(sacc[2 * grp][0], sacc[2 * grp][1]); pb.u[1] = pk2(sacc[2 * grp][2], sacc[2 * grp][3]);
        pb.u[2] = pk2(sacc[2 * grp + 1][0], sacc[2 * grp + 1][1]); pb.u[3] = pk2(sacc[2 * grp + 1][2], sacc[2 * grp + 1][3]);
#pragma unroll
        for (int db = 0; db < 4; ++db) o[db] = __builtin_amdgcn_mfma_f32_16x16x32_bf16(ATT_PK(vl[grp][db], vh[grp][db]), pb.v, o[db], 0, 0, 0);
    }
#undef ATT_PK
}

__device__ __forceinline__ void attn_item(CParams& p, LAS unsigned char* lds, int l, const AttnItem& it) {
    const int tid = otid(), wave = tid >> 6, lane = tid & 63, g = wave >> 2, wq = wave & 3, fr = lane & 15, fq = lane >> 4;
    const bf16_t* PROJ = (const bf16_t*)(p.ws + WS_PROJ); bf16_t* YCAT = (bf16_t*)(p.ws + WS_YCAT);
    LAS float* sB = (LAS float*)(lds + 2 * ABUF_BYTES);
    const int slot = it.nslots == 2 ? g : 0;
    if (it.mode == 0) { for (int i = tid; i < 2 * 15 * 128; i += 512) { const int h = i / 1920, rem = i % 1920, dr = rem >> 7, dc = (rem & 127) - 48;
            sB[i] = (dc >= 0 && dc < 31) ? p.nat_bias[(size_t)(l * 4 + it.h0 + h) * 465 + dr * 31 + dc] * LOG2E : 0.f; } }
    bf16x8 qf[2];
    { const bf16_t* qp = PROJ + (size_t)(it.qtok0 + wq * 16 + fr) * NP + (g ? it.qcol1 : it.qcol0) + 8 * fq;
      qf[0] = *(const bf16x8*)qp; qf[1] = *(const bf16x8*)(qp + 32); }
    float mrun = -3.0e38f, lsum = 0.f;
    f32x4 o[4];
#pragma unroll
    for (int db = 0; db < 4; ++db) o[db] = (f32x4){0.f, 0.f, 0.f, 0.f};
    const int nchunks = 4 + it.nloc;
    const int srow = tid >> 3, sseg = tid & 7;
    u32x4 kreg[2], vreg[2];
    auto chunk_tok = [&](int c) { return c < 4 ? it.ctxtok0 + 64 * c : it.loctok0 + 64 * (c - 4); };
    auto gload = [&](int c) {
        const bf16_t* rp = PROJ + (size_t)(chunk_tok(c) + srow) * NP + 8 * sseg;
#pragma unroll
        for (int s = 0; s < 2; ++s) if (s < it.nslots) { kreg[s] = *(const u32x4*)(rp + (s ? it.kcol1 : it.kcol0)); vreg[s] = *(const u32x4*)(rp + (s ? it.vcol1 : it.vcol0)); }
    };
    auto lwrite = [&](int c) {
        LAS unsigned char* bufk = lds + (c & 1) * ABUF_BYTES + srow * 128 + ((sseg ^ ((srow >> 1) & 7)) * 16);
        LAS unsigned char* bufv = lds + (c & 1) * ABUF_BYTES + 2 * KV_BYTES + (srow * KROW + 8 * sseg) * 2;
#pragma unroll
        for (int s = 0; s < 2; ++s) if (s < it.nslots) { *(LAS u32x4*)(bufk + s * KV_BYTES) = kreg[s]; *(LAS u32x4*)(bufv + s * KV_BYTES) = vreg[s]; }
    };
    gload(0); lwrite(0);
    if (nchunks > 1) gload(1);
    __syncthreads();
    TS_BEGIN(5);
    const int qi = wq * 16 + fr;
    const int nat_kofs = min(max(16 * wq - 8, 0), 32);
    for (int c = 0; c < nchunks; ++c) {
        if (c + 1 < nchunks) lwrite(c + 1);
        if (c + 2 < nchunks) gload(c + 2);
        const LAS unsigned char* kt = lds + (c & 1) * ABUF_BYTES + slot * KV_BYTES;
        const LAS unsigned char* vt = kt + 2 * KV_BYTES;
        if (c >= 4 && it.mode == 0) {
            const int dr = (it.rs + (c - 4)) - it.r + 7;
            attn_chunk<2>(kt, vt, nat_kofs, qf, fr, fq, 1, qi, sB + g * 1920 + dr * 128, mrun, lsum, o);
        } else if (c >= 4 && it.mode == 1) {
            attn_chunk<4>(kt, vt, 0, qf, fr, fq, 2, it.kp0 + 64 * (c - 4) - (it.q0 + qi), sB, mrun, lsum, o);
        } else {
            attn_chunk<4>(kt, vt, 0, qf, fr, fq, 0, 0, sB, mrun, lsum, o);
        }
        __syncthreads();
    }
    TS_END(5);
    lsum = xrow16_sum(lsum);
    if (it.has_sink) lsum += fast_exp2((g ? it.sink1 : it.sink0) * LOG2E - mrun);
    const float inv = 1.0f / lsum;
    bf16_t* op = YCAT + (size_t)(it.qtok0 + wq * 16 + fr) * YC_LD + (g ? it.ocol1 : it.ocol0) + 4 * fq;
#pragma unroll
    for (int db = 0; db < 4; ++db) { u32x2 w; w.x = pk2(o[db][0] * inv, o[db][1] * inv); w.y = pk2(o[db][2] * inv, o[db][3] * inv); *(u32x2*)(op + 16 * db) = w; }
}

constexpr int C_UA = 0, C_QN = 512, C_KN = 768, C_VN = 1024, C_QS = 1280, C_KS = 1536, C_VS = 1664;

__device__ __forceinline__ void mix_items(CParams& p, LAS unsigned char* lds, int l, int sub) {
    const int n_attn = (l == 0) ? 2304 : 2048;
    const int n_conv = (l == 0) ? 512 + 64 : 512;
    const int start = (obid() + 128) % gridDim.x;
    for (int i = start; i < n_attn + n_conv; i += gridDim.x) {
        if (i >= n_attn) {
            if (!(sub & 4)) continue;
            const int ci = i - n_attn;
            TS_BEGIN(3);
            if (ci < 512) conv_item(p, lds, l, ci >> 5, ci & 31);
            else { const int cj = ci - 512; conv_item(p, lds, l, 16 + (cj >> 2), cj & 3); }
            TS_END(3);
            continue;
        }
        AttnItem it{};
        if (i < 1024) {
            const int b = i >> 6, r = (i >> 1) & 31, hp = i & 1;
            it.mode = 0; it.qtok0 = b * 2048 + r * 64; it.nslots = 2; it.h0 = 2 * hp;
            { const int h = 2 * hp; it.qcol0 = C_QN + 64 * h; it.kcol0 = C_KN + 64 * h; it.vcol0 = C_VN + 64 * h; it.ocol0 = 512 + 64 * h;
              it.qcol1 = it.qcol0 + 64; it.kcol1 = it.kcol0 + 64; it.vcol1 = it.vcol0 + 64; it.ocol1 = it.ocol0 + 64; }
            it.r = r; it.rs = min(max(r - 4, 0), 24); it.nloc = 8; it.loctok0 = b * 2048 + it.rs * 64; it.ctxtok0 = TL + b * 256;
        } else if (i < 2048) {
            const int k = i - 1024, b = k >> 6, qb = (k >> 1) & 31, kvh = k & 1;
            it.mode = 1; it.qtok0 = b * 2048 + qb * 64; it.nslots = 1;
            { const int h = 2 * kvh; it.qcol0 = C_QS + 64 * h; it.ocol0 = 768 + 64 * h; it.sink0 = p.sink[l * 4 + h]; it.sink1 = p.sink[l * 4 + h + 1];
              it.qcol1 = it.qcol0 + 64; it.ocol1 = it.ocol0 + 64; it.kcol0 = it.kcol1 = C_KS + 64 * kvh; it.vcol0 = it.vcol1 = C_VS + 64 * kvh; }
            it.has_sink = 1; it.q0 = qb * 64;
            const int ks = max(qb * 64 - 128, 0), ke = min(qb * 64 + 192, 2048);
            it.kp0 = ks; it.nloc = (ke - ks) >> 6; it.loctok0 = b * 2048 + ks; it.ctxtok0 = TL + b * 256;
        } else if (i < 2176) {
            const int k = i - 2048, b = k >> 3, qb = (k >> 1) & 3, hp = k & 1;
            it.mode = 2; it.qtok0 = TL + b * 256 + qb * 64; it.nslots = 2;
            { const int h = 2 * hp; it.qcol0 = C_QN + 64 * h; it.kcol0 = C_KN + 64 * h; it.vcol0 = C_VN + 64 * h; it.ocol0 = 512 + 64 * h;
              it.qcol1 = it.qcol0 + 64; it.kcol1 = it.kcol0 + 64; it.vcol1 = it.vcol0 + 64; it.ocol1 = it.ocol0 + 64; }
            it.nloc = 0; it.ctxtok0 = TL + b * 256;
        } else {
            const int k = i - 2176, b = k >> 3, qb = (k >> 1) & 3, kvh = k & 1;
            it.mode = 2; it.qtok0 = TL + b * 256 + qb * 64; it.nslots = 1;
            { const int h = 2 * kvh; it.qcol0 = C_QS + 64 * h; it.ocol0 = 768 + 64 * h; it.sink0 = p.sink[l * 4 + h]; it.sink1 = p.sink[l * 4 + h + 1];
              it.qcol1 = it.qcol0 + 64; it.ocol1 = it.ocol0 + 64; it.kcol0 = it.kcol1 = C_KS + 64 * kvh; it.vcol0 = it.vcol1 = C_VS + 64 * kvh; }
            it.has_sink = 1; it.nloc = 0; it.ctxtok0 = TL + b * 256;
        }
        TS_BEGIN(2);
        if (sub & 2) attn_item(p, lds, l, it);
        TS_END(2);
    }
}

constexpr int N_PHASES = 22;
#ifndef PHMASK
#define PHMASK 0xff
#endif

__device__ __forceinline__ void run_phase(CParams& p, LAS unsigned char* lds, int ph, int sub) {
    unsigned char* ws = p.ws;
    bf16_t* YH = (bf16_t*)(ws + WS_YH); bf16_t* U = (bf16_t*)(ws + WS_R1); bf16_t* PROJ = (bf16_t*)(ws + WS_PROJ); bf16_t* YCAT = (bf16_t*)(ws + WS_YCAT);
    const float* MOD = (const float*)(ws + WS_MOD);
    const int G = gridDim.x, c = obid();
    if (ph == 0) { if constexpr ((PHMASK & 1) != 0) phase0(p, lds); return; }
    if (ph == 1) {
        if constexpr ((PHMASK & 2) == 0) return;
        ew_pass(p.x, p.ctx, nullptr, nullptr, nullptr, nullptr, nullptr, nullptr, 0.f, nullptr, YH, p.norm_g, MOD, MOD + 1024, TA); return;
    }
    const int l = (ph - 2) / 10, k = (ph - 2) % 10;
    const float* MODL = MOD + (size_t)l * 17 * NMODC; const float* NG = p.norm_g + (size_t)l * 6 * DM;
    const int rows_late = (l == 0) ? TA : TL;
    switch (k) {
    case 0: case 7: {
        if constexpr ((PHMASK & 4) == 0) break;
        const int f = (k == 7), M = f ? rows_late : TA;
        pg8::Gemm g{YH, (const bf16_t*)(ws + WS_W13) + (size_t)(l * 2 + f) * 5632 * 1024, M, 5632, 1024, 1024, 1024};
        pg8::StaticOrder S; S.init(M, 5632, G, c); EpiSwiGLU E{U};
        pg8::gemm_phase<EpiSwiGLU, pg8::StaticOrder, true, true>(lds, g, S, E);
    } break;
    case 1: case 8: case 5: {
        if constexpr ((PHMASK & 8) == 0) break;
        const bool isout = (k == 5); const int f = (k == 8), M = (k == 1) ? TA : rows_late;
        const int Kd = isout ? YC_LD : FF;
        const bf16_t* Ap = isout ? YCAT : U;
        const bf16_t* Bp = isout ? (const bf16_t*)(ws + WS_WOUT) + (size_t)l * 1024 * YC_LD : (const bf16_t*)(ws + WS_W2T) + (size_t)(l * 2 + f) * 1024 * FF;
        for (int v = 0; v < (M == TA ? 3 : 1); ++v) {
            pg8::Gemm g = v == 0 ? pg8::Gemm{Ap, Bp, TL, 1024, Kd, Kd, Kd}
                                 : pg8::Gemm{Ap + (size_t)TL * Kd + (v - 1) * (Kd / 2), Bp + (v - 1) * (Kd / 2), TC, 1024, Kd / 2, Kd, Kd};
            pg8::StaticOrder S; S.init(g.M, 1024, G, v == 2 ? (c + G - 64) % G : c);
            EpiBf16Tile E{v == 0 ? YH : (v == 1 ? YH + (size_t)TL * DM : (bf16_t*)(ws + WS_Y2)), 1024, 0, 256};
            pg8::gemm_phase<EpiBf16Tile, pg8::StaticOrder, true, true>(lds, g, S, E);
        }
    } break;
    case 2: case 6: case 9: {
        if constexpr ((PHMASK & 2) == 0) break;
        const int gi = (k == 2) ? 2 : (k == 6 ? 5 : 8), ni = (k == 2) ? 1 : (k == 6 ? 3 : 5);
        const int nrows = (k == 2) ? TA : rows_late;
        const bool lastl = (k == 9 && l == 1);
        const float* gpre = (k == 2) ? NG + 2 * DM : (k == 6 ? NG + 4 * DM : p.norm_g + 6 * DM);
        const float* shift = (k == 2) ? MODL + 3 * 1024 : (k == 6 ? MODL + 6 * 1024 : MOD + 17 * NMODC);
        const float* scale = (k == 2) ? MODL + 4 * 1024 : (k == 6 ? MODL + 7 * 1024 : MOD + 17 * NMODC + 1024);
        float* outp = p.out;
        const bool first = (l == 0 && k == 2);
        bf16_t* XS = (bf16_t*)(ws + WS_XC);
        ew_pass(p.x, p.ctx, first ? (const bf16_t*)nullptr : (const bf16_t*)XS, lastl ? (bf16_t*)nullptr : XS, lastl ? outp : (float*)nullptr, YH, (const bf16_t*)(ws + WS_Y2), NG + ni * DM, (k == 6) ? 1.0f : 0.5f, MODL + gi * 1024, lastl ? nullptr : YH, gpre, shift, scale, nrows);
    } break;
    case 3: {
        if constexpr ((PHMASK & 16) == 0) break;
        const bf16_t* W = (const bf16_t*)(ws + WS_WIN) + (size_t)l * 2304 * 1024;
        { pg8::Gemm g{YH, W, TA, NP, 1024, 1024, 1024}; pg8::StaticOrder S; S.init(TA, NP, G, c); EpiWin E{PROJ, (const float*)(ws + WS_ROPE)};
          pg8::gemm_phase<EpiWin, pg8::StaticOrder, true, true>(lds, g, S, E); }
        { const int N = (l == 0) ? TA : TL; pg8::Gemm g{W + (size_t)1792 * 1024, YH, 256, N, 1024, 1024, 1024}; pg8::StaticOrder S; S.init(256, N, G, (c + 16) % G);
          EpiPQ E{(bf16_t*)(ws + WS_PQT), (bf16_t*)(ws + WS_PQTC)};
          pg8::gemm_phase<EpiPQ, pg8::StaticOrder, true, true>(lds, g, S, E); }
    } break;
    case 4: {
        if constexpr ((PHMASK & 32) == 0) break;
        TS_BEGIN(1);
        if (sub & 1)
        for (int v = 0; v < ((l == 0) ? 4 : 2); ++v) {
            const int hs = v & 1, isc = v >> 1;
            const bf16_t* Ap = isc ? (const bf16_t*)(ws + WS_DFTC) + hs * 256 : (const bf16_t*)(ws + WS_DFT) + hs * 2048;
            const bf16_t* Bp = isc ? (const bf16_t*)(ws + WS_PQTC) + hs * 256 : (const bf16_t*)(ws + WS_PQT) + hs * 2048;
            pg8::Gemm g{Ap, Bp, isc ? 256 : 2048, 4096, isc ? 256 : 2048, isc ? DFTC_LD : DFT_LD, isc ? PQTC_LD : PQT_LD};
            pg8::StaticOrder S; S.init(g.M, g.N, G, isc ? (c + G - 16 * hs) % G : (c + G - 128 * hs) % G);
            EpiBf16Tile E{YCAT + (isc ? (size_t)TL * YC_LD : 0) + (hs ? 1024 : 256), YC_LD, isc ? 256 : 2048, 0};
            pg8::gemm_phase<EpiBf16Tile, pg8::StaticOrder, true, true>(lds, g, S, E);
        }
        TS_END(1);
        if (sub & 6) mix_items(p, lds, l, sub);
    } break;
    }
}

__global__ void __launch_bounds__(512, 2) mega(Params p, int ph0, int ph1) {
    extern __shared__ __attribute__((aligned(16))) unsigned char lds_raw[];
    LAS unsigned char* lds = (LAS unsigned char*)lds_raw;
    cg::grid_group grid = cg::this_grid();
    if (ph1 < 0) grid.sync();
    volatile LAS unsigned* xst = (volatile LAS unsigned*)(lds + 131072);
    if (threadIdx.x < 4) xst[threadIdx.x] = 0u;
    __syncthreads();
    XcdBarrier xb = xcd_barrier_post((unsigned*)(p.ws + WS_BAR), xst);
#ifdef TPROBE
    unsigned long long tacc = 0, tprev = __builtin_amdgcn_s_memrealtime();
#endif
    for (int ph = ph0; ph < ph1; ++ph) {
        CParams* q = (CParams*)__builtin_amdgcn_kernarg_segment_ptr(); asm volatile("" : "+s"(q));
        run_phase(*q, lds, ph, 7);
#ifdef DUPK
        { const int kind = ph == 0 ? 10 : (ph == 1 ? 11 : (ph - 2) % 10);
          if ((DUPK >> kind) & 1) { xcd_barrier(xb); run_phase(*q, lds, ph, DUPSUB); } }
#endif
        if (ph + 1 < ph1) xcd_barrier(xb);
#ifdef TPROBE
        { const unsigned long long now = __builtin_amdgcn_s_memrealtime(); const int kind = ph == 0 ? 10 : (ph == 1 ? 11 : (ph - 2) % 10);
          if ((TPROBE >> kind) & 1) tacc += now - tprev; tprev = now; }
#endif
    }
#ifdef TPROBE
    if (blockIdx.x == 0 && threadIdx.x == 0) { const unsigned long long t0 = __builtin_amdgcn_s_memrealtime(); while (__builtin_amdgcn_s_memrealtime() - t0 < tacc) __builtin_amdgcn_s_sleep(8); }
#endif
#ifdef TSUB
    if (blockIdx.x == 0 && threadIdx.x == 0) { const unsigned long long tacc2 = *(volatile LAS unsigned long long*)(lds + 131080); const unsigned long long t0 = __builtin_amdgcn_s_memrealtime(); while (__builtin_amdgcn_s_memrealtime() - t0 < 4ull * tacc2) __builtin_amdgcn_s_sleep(8); }
#endif
#ifdef XSYNC
    for (int i = 0; i < XSYNC; ++i) xcd_barrier(xb);
#endif
}

#ifndef ONE_LAUNCH
#define ONE_LAUNCH 1
#endif

extern "C" void kernel_launch(void* const* d_in, const int* in_sizes, int n_in, void* d_out, int out_size, void* d_ws, size_t ws_size, hipStream_t stream) {
    static int grid = 0;
    if (grid == 0) {
        if (ws_size < WS_END) { fprintf(stderr, "kernel_launch: workspace too small: %zu < %zu\n", ws_size, (size_t)WS_END); grid = -1; return; }
        int dev = 0, cus = 0, per_cu = 0;
        hipGetDevice(&dev); hipDeviceGetAttribute(&cus, hipDeviceAttributeMultiprocessorCount, dev);
        hipFuncSetAttribute((const void*)mega, hipFuncAttributeMaxDynamicSharedMemorySize, LDS_BYTES);
        hipOccupancyMaxActiveBlocksPerMultiprocessor(&per_cu, (const void*)mega, 512, LDS_BYTES);
        if (per_cu < 1) { fprintf(stderr, "kernel_launch: occupancy query says %d blocks per CU\n", per_cu); per_cu = 1; }
        (void)hipGetLastError();
        grid = cus;
    }
    if (grid < 0) return;
    (void)hipMemsetAsync((unsigned char*)d_ws + WS_BAR, 0, 3456 * 4, stream);
    Params p{};
    p.x = (const float*)d_in[0]; p.c = (const float*)d_in[1]; p.ctx = (const float*)d_in[2]; p.c_ctx = (const float*)d_in[3];
    p.w_ada = (const float*)d_in[4]; p.b_ada = (const float*)d_in[5]; p.norm_g = (const float*)d_in[6];
    p.w1 = (const float*)d_in[7]; p.w3 = (const float*)d_in[8]; p.w2 = (const float*)d_in[9]; p.w_in = (const float*)d_in[10];
    p.conv_w = (const float*)d_in[11]; p.conv_b = (const float*)d_in[12]; p.ln_g = (const float*)d_in[13]; p.ln_b = (const float*)d_in[14];
    p.nat_bias = (const float*)d_in[15]; p.sink = (const float*)d_in[16]; p.w_out = (const float*)d_in[17];
    p.out = (float*)d_out; p.ws = (unsigned char*)d_ws;
#if ONE_LAUNCH
    int ph0 = 0, ph1 = N_PHASES;
    void* args[] = {&p, &ph0, &ph1};
    hipError_t e = hipLaunchCooperativeKernel((const void*)mega, dim3(grid), dim3(512), args, LDS_BYTES, stream);
    if (e != hipSuccess) fprintf(stderr, "cooperative launch failed: %s (grid %d)\n", hipGetErrorString(e), grid);
#else
    for (int ph = 0; ph < N_PHASES; ++ph) {
        int ph0 = ph, ph1 = ph + 1;
        void* args[] = {&p, &ph0, &ph1};
        hipError_t e = hipLaunchCooperativeKernel((const void*)mega, dim3(grid), dim3(512), args, LDS_BYTES, stream);
        if (e != hipSuccess) { fprintf(stderr, "launch %d failed: %s (grid %d)\n", ph, hipGetErrorString(e), grid); break; }
    }
#endif
}
```

```cpp
#include <hip/hip_runtime.h>
#include <hip/hip_cooperative_groups.h>
#include <cstdio>
#include <cstdint>
namespace cg = cooperative_groups;
#ifdef TSUB
#define TS_BEGIN(id) do { if ((TSUB) == (id) && threadIdx.x == 0) { *(volatile __attribute__((address_space(3))) unsigned long long*)(lds + 131080) -= __builtin_amdgcn_s_memrealtime(); } } while (0)
#define TS_END(id)   do { if ((TSUB) == (id) && threadIdx.x == 0) { *(volatile __attribute__((address_space(3))) unsigned long long*)(lds + 131080) += __builtin_amdgcn_s_memrealtime(); } } while (0)
#else
#define TS_BEGIN(id) do {} while (0)
#define TS_END(id) do {} while (0)
#endif
namespace pg8 {
#define PG8_LAS __attribute__((address_space(3)))
typedef unsigned short bf16_t;
typedef short bf16x8 __attribute__((ext_vector_type(8)));
typedef float f32x4 __attribute__((ext_vector_type(4)));
typedef unsigned u32x4 __attribute__((ext_vector_type(4)));
constexpr int BM = 256, BK = 64, HALF = 128, HTB = HALF * BK * 2  , STAGE_BYTES = 8 * HTB, NXCD = 8, WGM = 8;

__host__ __device__ __forceinline__ int lds_byte(int r, int c) { const int st = (r >> 4) * 2 + (c >> 5), rr = r & 15, cc = c & 31, ob = rr * 64 + cc * 2; return st * 1024 + (ob ^ (((ob >> 9) & 1) << 5)); }
__host__ __device__ __forceinline__ void stage_rc(int b, int& R, int& C) { const int st = b / 1024, sb = b % 1024, swz = sb ^ (((sb >> 9) & 1) << 5); R = (st >> 1) * 16 + swz / 64; C = (st & 1) * 32 + (swz % 64) / 2; }
__host__ __device__ __forceinline__ int perm32(int rho) { const int n = rho >> 4, i = rho & 15; return 8 * (i >> 2) + 4 * n + (i & 3); }

struct Unit { int pm, pn; };
struct Gemm { const bf16_t* A; const bf16_t* Bt; int M, N, K, lda, ldb; };

struct StaticOrder {
    int nM, nN, nwg, G, c;
    __host__ __device__ void init(int M, int N, int G_, int c_) { nM = M / BM; nN = N / BM; nwg = nM * nN; G = G_; c = c_; }
    __host__ __device__ bool next(int i, Unit& u) const {
        const long L = (long)i * G + c; if (L >= nwg) return false;
        int wgid = (int)L; { const int q = nwg / NXCD, r = nwg % NXCD, xcd = wgid % NXCD, off = wgid / NXCD; wgid = (xcd < r ? xcd * (q + 1) : r * (q + 1) + (xcd - r) * q) + off; }
        const int nig = WGM * nN, gid = wgid / nig, fm = gid * WGM, gsz = (nM - fm) < WGM ? (nM - fm) : WGM;
        u.pm = fm + ((wgid % nig) % gsz); u.pn = (wgid % nig) / gsz; return true;
    }
    __device__ __forceinline__ void a_ready(const Unit&) const {}
    __device__ __forceinline__ void done(const Unit&) const {}
};
__device__ __forceinline__ unsigned cvt_pk_bf16(float lo, float hi) { unsigned r; asm volatile("v_cvt_pk_bf16_f32 %0, %1, %2" : "=v"(r) : "v"(lo), "v"(hi)); return r; }
typedef float f32x2 __attribute__((ext_vector_type(2)));
template <class Epi, class Sched, bool ALIGN_EPI = false, bool SP2 = false>
__device__ __forceinline__ void gemm_phase(PG8_LAS unsigned char* lds, const Gemm g, const Sched& S, const Epi& E) {
    int tid_ = threadIdx.x; asm volatile("" : "+v"(tid_));
    const int tid = tid_, wid = __builtin_amdgcn_readfirstlane(tid >> 6), lane = tid & 63, wr = wid >> 2, wc = wid & 3, fr = lane & 15, fq = lane >> 4;
    const int K = g.K, nt = K / BK;
    unsigned voffA[2], voffB[2];
#pragma unroll
    for (int i = 0; i < 2; ++i) { int R, C; stage_rc(tid * 16 + i * 8192, R, C); const int Rb = Epi::PERM ? ((R & ~31) + perm32(R & 31)) : R;
        voffA[i] = (unsigned)(R * g.lda + C) * 2u; voffB[i] = (unsigned)(Rb * g.ldb + C) * 2u; }
    const size_t kstep = (size_t)(BK * 2);
    const size_t hstepA = (size_t)HALF * g.lda * 2, hstepB = (size_t)HALF * g.ldb * 2;
    const size_t tstepA = 2 * hstepA, tstepB = 2 * hstepB;
    const unsigned ldsw = (unsigned)wid * 1024u;
    const int aoff = lds_byte(wr * 64 + fr, fq * 8), boff = lds_byte(wc * 32 + fr, fq * 8);
#define PG8_SA(b, h) (((b) * 2 + (h)) * HTB)
#define PG8_SB(b, h) ((4 + (b) * 2 + (h)) * HTB)
#define PG8_STAGE(bufoff, gbase, voff) do { _Pragma("unroll") for (int _i = 0; _i < 2; ++_i) \
        __builtin_amdgcn_global_load_lds((const unsigned*)((const char*)(gbase) + (voff)[_i]), (PG8_LAS unsigned*)(lds + (bufoff) + ldsw + _i * 8192), 16, 0, 0); } while (0)
#define PG8_LDA(dst, b, h) do { _Pragma("unroll") for (int m = 0; m < 4; ++m) _Pragma("unroll") for (int k = 0; k < 2; ++k) dst[m][k] = *(const PG8_LAS bf16x8*)(lds + PG8_SA(b, h) + aoff + m * 2048 + k * 1024); } while (0)
#define PG8_LDB(dst, b, h) do { _Pragma("unroll") for (int n = 0; n < 2; ++n) _Pragma("unroll") for (int k = 0; k < 2; ++k) dst[n][k] = *(const PG8_LAS bf16x8*)(lds + PG8_SB(b, h) + boff + n * 2048 + k * 1024); } while (0)
#define PG8_MMA(ai, bj, At, Bt) do { __builtin_amdgcn_s_setprio(1); _Pragma("unroll") for (int m = 0; m < 4; ++m) _Pragma("unroll") for (int n = 0; n < 2; ++n) _Pragma("unroll") for (int k = 0; k < 2; ++k) \
        acc[ai][bj][m][n] = __builtin_amdgcn_mfma_f32_16x16x32_bf16(Bt[n][k], At[m][k], acc[ai][bj][m][n], 0, 0, 0); __builtin_amdgcn_s_setprio(0); } while (0)
#define PG8_WAIT_V(n) asm volatile("s_waitcnt vmcnt(" #n ")" ::: "memory")
#define PG8_WAIT_L(n) asm volatile("s_waitcnt lgkmcnt(" #n ")" ::: "memory")
#define PG8_BAR __builtin_amdgcn_s_barrier()
#define PG8_SCHED __builtin_amdgcn_sched_barrier(0)
    Unit cur, nxt; int ui = 0;
    if (!S.next(0, cur)) return;
    f32x4 acc[2][2][4][2];
#pragma unroll
    for (int a = 0; a < 2; ++a)
#pragma unroll
        for (int b = 0; b < 2; ++b)
#pragma unroll
            for (int m = 0; m < 4; ++m)
#pragma unroll
                for (int n = 0; n < 2; ++n) acc[a][b][m][n] = (f32x4){0.f, 0.f, 0.f, 0.f};
    bf16x8 At[4][2], B0[2][2], B1[2][2];
    const char* cA = (const char*)g.A + (size_t)cur.pm * tstepA; const char* cB = (const char*)g.Bt + (size_t)cur.pn * tstepB;
    S.a_ready(cur);
    if constexpr (SP2) {
        PG8_STAGE(PG8_SB(0, 0), cB, voffB); PG8_STAGE(PG8_SB(0, 1), cB + hstepB, voffB); PG8_STAGE(PG8_SA(0, 0), cA, voffA); PG8_STAGE(PG8_SA(0, 1), cA + hstepA, voffA);
        if (wr == 1) PG8_BAR;
        PG8_WAIT_V(2); PG8_BAR;
        PG8_STAGE(PG8_SB(1, 0), cB + kstep, voffB); PG8_STAGE(PG8_SA(1, 0), cA + kstep, voffA); PG8_STAGE(PG8_SB(1, 1), cB + hstepB + kstep, voffB);
        PG8_WAIT_V(6); PG8_BAR;
    } else {
        PG8_STAGE(PG8_SB(0, 0), cB, voffB); PG8_STAGE(PG8_SA(0, 0), cA, voffA); PG8_STAGE(PG8_SB(0, 1), cB + hstepB, voffB); PG8_STAGE(PG8_SA(0, 1), cA + hstepA, voffA);
        if (wr == 1) PG8_BAR;
        PG8_WAIT_V(4); PG8_BAR;
        PG8_STAGE(PG8_SB(1, 0), cB + kstep, voffB); PG8_STAGE(PG8_SA(1, 0), cA + kstep, voffA); PG8_STAGE(PG8_SB(1, 1), cB + hstepB + kstep, voffB);
        PG8_WAIT_V(6); PG8_BAR;
    }
    for (;;) {
        const bool has_next = S.next(ui + 1, nxt);
        const char* nA = has_next ? (const char*)g.A + (size_t)nxt.pm * tstepA : cA; const char* nB = has_next ? (const char*)g.Bt + (size_t)nxt.pn * tstepB : cB;
        for (int t = 0; t < nt; t += 2) {
            const bool last = (t == nt - 2);
            const char* a1 = cA + (size_t)(t + 1) * kstep;
            const char* a2 = last ? nA : cA + (size_t)(t + 2) * kstep; const char* b2 = last ? nB : cB + (size_t)(t + 2) * kstep;
            const char* a3 = a2 + kstep; const char* b3 = b2 + kstep;
            if (last && has_next) S.a_ready(nxt);
            if constexpr (SP2) {
            PG8_LDB(B0, 0, 0); PG8_LDB(B1, 0, 1); PG8_SCHED; PG8_LDA(At, 0, 0); PG8_STAGE(PG8_SA(1, 1), a1 + hstepA, voffA);
            PG8_WAIT_V(8); PG8_WAIT_L(0); PG8_BAR; PG8_MMA(0, 0, At, B0); PG8_MMA(0, 1, At, B1); PG8_BAR; PG8_SCHED;
            PG8_LDA(At, 0, 1); PG8_STAGE(PG8_SB(0, 0), b2, voffB); PG8_STAGE(PG8_SB(0, 1), b2 + hstepB, voffB); PG8_STAGE(PG8_SA(0, 0), a2, voffA);
            PG8_WAIT_V(8); PG8_WAIT_L(0); PG8_BAR; PG8_MMA(1, 0, At, B0); PG8_MMA(1, 1, At, B1); PG8_BAR; PG8_SCHED;
            PG8_LDB(B0, 1, 0); PG8_LDB(B1, 1, 1); PG8_SCHED; PG8_LDA(At, 1, 0); PG8_STAGE(PG8_SA(0, 1), a2 + hstepA, voffA);
            PG8_WAIT_V(8); PG8_WAIT_L(0); PG8_BAR; PG8_MMA(0, 0, At, B0); PG8_MMA(0, 1, At, B1); PG8_BAR; PG8_SCHED;
            PG8_LDA(At, 1, 1); PG8_STAGE(PG8_SB(1, 0), b3, voffB); PG8_STAGE(PG8_SB(1, 1), b3 + hstepB, voffB); PG8_STAGE(PG8_SA(1, 0), a3, voffA);
            PG8_WAIT_V(8); PG8_WAIT_L(0); PG8_BAR; PG8_MMA(1, 0, At, B0); PG8_MMA(1, 1, At, B1); PG8_BAR; PG8_SCHED;
            } else {
            PG8_LDB(B0, 0, 0); PG8_SCHED; PG8_LDA(At, 0, 0); PG8_STAGE(PG8_SA(1, 1), a1 + hstepA, voffA);
            PG8_WAIT_L(8); PG8_BAR; PG8_WAIT_L(0); PG8_MMA(0, 0, At, B0); PG8_BAR; PG8_SCHED;
            PG8_LDB(B1, 0, 1); PG8_STAGE(PG8_SB(0, 0), b2, voffB);
            PG8_BAR; PG8_WAIT_L(0); PG8_MMA(0, 1, At, B1); PG8_BAR;
            PG8_LDA(At, 0, 1); PG8_STAGE(PG8_SA(0, 0), a2, voffA);
            PG8_BAR; PG8_WAIT_L(0); PG8_MMA(1, 0, At, B0); PG8_BAR; PG8_SCHED;
            PG8_STAGE(PG8_SB(0, 1), b2 + hstepB, voffB);
            PG8_WAIT_V(6); PG8_BAR; PG8_MMA(1, 1, At, B1); PG8_BAR;
            PG8_LDB(B0, 1, 0); PG8_SCHED; PG8_LDA(At, 1, 0); PG8_STAGE(PG8_SA(0, 1), a2 + hstepA, voffA);
            PG8_WAIT_L(8); PG8_BAR; PG8_WAIT_L(0); PG8_MMA(0, 0, At, B0); PG8_BAR; PG8_SCHED;
            PG8_LDB(B1, 1, 1); PG8_STAGE(PG8_SB(1, 0), b3, voffB);
            PG8_BAR; PG8_WAIT_L(0); PG8_MMA(0, 1, At, B1); PG8_BAR;
            PG8_LDA(At, 1, 1); PG8_STAGE(PG8_SA(1, 0), a3, voffA);
            PG8_BAR; PG8_WAIT_L(0); PG8_MMA(1, 0, At, B0); PG8_BAR; PG8_SCHED;
            PG8_STAGE(PG8_SB(1, 1), b3 + hstepB, voffB);
            PG8_WAIT_V(6); PG8_BAR; PG8_MMA(1, 1, At, B1); PG8_BAR;
            }
        }
        if constexpr (ALIGN_EPI) { if (wr == 0) PG8_BAR; }
        TS_BEGIN(8);
        if constexpr (!Epi::AFTER_DRAIN) { E(acc, cur, wr, wc, fr, fq); S.done(cur); }
        TS_END(8);
        if (!has_next) break;
#pragma unroll
        for (int a = 0; a < 2; ++a)
#pragma unroll
            for (int b = 0; b < 2; ++b)
#pragma unroll
                for (int m = 0; m < 4; ++m)
#pragma unroll
                    for (int n = 0; n < 2; ++n) acc[a][b][m][n] = (f32x4){0.f, 0.f, 0.f, 0.f};
        cur = nxt; cA = nA; cB = nB; ++ui;
        if constexpr (ALIGN_EPI) { if (wr == 1) PG8_BAR; }
    }
    PG8_WAIT_V(0);
    if constexpr (!ALIGN_EPI) { if (wr == 0) PG8_BAR; }
    PG8_BAR;
    if constexpr (Epi::AFTER_DRAIN) { E.fused(acc, cur, wr, wc, fr, fq, lds, wid, lane); S.done(cur); }
#undef PG8_SA
#undef PG8_SB
#undef PG8_STAGE
#undef PG8_LDA
#undef PG8_LDB
#undef PG8_MMA
#undef PG8_WAIT_V
#undef PG8_WAIT_L
#undef PG8_BAR
#undef PG8_SCHED
}
}

#define LAS __attribute__((address_space(3)))
typedef unsigned short bf16_t;
typedef float f32x4 __attribute__((ext_vector_type(4)));
typedef float f32x2 __attribute__((ext_vector_type(2)));
typedef unsigned u32x4 __attribute__((ext_vector_type(4)));
typedef unsigned u32x2 __attribute__((ext_vector_type(2)));
typedef short bf16x8 __attribute__((ext_vector_type(8)));
typedef short bf16x4 __attribute__((ext_vector_type(4)));

constexpr int TL = 32768, TC = 4096, TA = 36864, DM = 1024, FF = 2816, NP = 1792, NMODC = 9216;
constexpr int YC_LD = 1280, DFT_LD = 4160, PQT_LD = 4160, DFTC_LD = 576, PQTC_LD = 576;
constexpr int LDS_BYTES = 131072 + 16;
#ifndef MIXMASK
#define MIXMASK 7
#endif

constexpr float EPSV = 1e-6f;
constexpr float LOG2E = 1.4426950408889634f;

constexpr size_t WS_XC   = 0;
constexpr size_t WS_YH   = WS_XC + (size_t)TA * DM * 2;
constexpr size_t WS_R1   = WS_YH + (size_t)TA * DM * 2;
constexpr size_t WS_PROJ = WS_R1;
constexpr size_t WS_PQT  = WS_PROJ + (size_t)TA * NP * 2;
constexpr size_t WS_PQTC = WS_PQT + (size_t)4096 * PQT_LD * 2;
constexpr size_t WS_YCAT = WS_PQTC + (size_t)4096 * PQTC_LD * 2;
constexpr size_t WS_R1END= WS_YCAT + (size_t)TA * YC_LD * 2;
constexpr size_t WS_W13  = WS_R1END;
constexpr size_t WS_W2T  = WS_W13 + (size_t)4 * 5632 * 1024 * 2;
constexpr size_t WS_WIN  = WS_W2T + (size_t)4 * 1024 * 2816 * 2;
constexpr size_t WS_WOUT = WS_WIN + (size_t)2 * 2304 * 1024 * 2;
constexpr size_t WS_DFT  = WS_WOUT + (size_t)2 * 1024 * YC_LD * 2;
constexpr size_t WS_DFTC = WS_DFT + (size_t)2048 * DFT_LD * 2;
constexpr size_t WS_MOD  = WS_DFTC + (size_t)256 * DFTC_LD * 2;
constexpr size_t WS_ROPE = WS_MOD + (size_t)2 * 17 * NMODC * 4;
constexpr size_t WS_BAR  = WS_ROPE + 64 * 16 * 2 * 4;
constexpr size_t WS_Y2   = WS_BAR + 3456 * 4;
constexpr size_t WS_END  = WS_Y2 + (size_t)TC * DM * 2;
static_assert(WS_END <= (size_t)536870912, "workspace budget (4 x the largest tensor)");
static_assert((size_t)TA * FF * 2 <= WS_R1END - WS_R1, "U must fit in R1");

struct Params {
    const float *x, *c, *ctx, *c_ctx, *w_ada, *b_ada, *norm_g, *w1, *w3, *w2, *w_in, *conv_w, *conv_b, *ln_g, *ln_b, *nat_bias, *sink, *w_out;
    float* out; unsigned char* ws;
};
typedef const __attribute__((address_space(4))) Params CParams;

__device__ __forceinline__ unsigned pk2(float lo, float hi) { return pg8::cvt_pk_bf16(lo, hi); }
__device__ __forceinline__ float bflo(unsigned v) { return __uint_as_float(v << 16); }
__device__ __forceinline__ float bfhi(unsigned v) { return __uint_as_float(v & 0xffff0000u); }
__device__ __forceinline__ int otid() { int t = threadIdx.x; asm volatile("" : "+v"(t)); return t; }
__device__ __forceinline__ int obid() { int t = blockIdx.x; asm volatile("" : "+s"(t)); return t; }
__device__ __forceinline__ float xrow16_max(float x) {
    auto s = __builtin_amdgcn_permlane16_swap(__float_as_uint(x), __float_as_uint(x), false, false);
    x = fmaxf(__uint_as_float(s[0]), __uint_as_float(s[1]));
    auto t = __builtin_amdgcn_permlane32_swap(__float_as_uint(x), __float_as_uint(x), false, false);
    return fmaxf(__uint_as_float(t[0]), __uint_as_float(t[1]));
}
__device__ __forceinline__ float xrow16_sum(float x) {
    auto s = __builtin_amdgcn_permlane16_swap(__float_as_uint(x), __float_as_uint(x), false, false);
    x = __uint_as_float(s[0]) + __uint_as_float(s[1]);
    auto t = __builtin_amdgcn_permlane32_swap(__float_as_uint(x), __float_as_uint(x), false, false);
    return __uint_as_float(t[0]) + __uint_as_float(t[1]);
}
template <int CTRL> __device__ __forceinline__ float dpp_mov(float x) { return __builtin_bit_cast(float, __builtin_amdgcn_mov_dpp(__builtin_bit_cast(int, x), CTRL, 0xf, 0xf, true)); }
__device__ __forceinline__ float wave_sum(float v) {
    v += dpp_mov<0xB1>(v);
    v += dpp_mov<0x4E>(v);
    v += dpp_mov<0x141>(v);
    v += dpp_mov<0x128>(v);
    return xrow16_sum(v);
}
__device__ __forceinline__ float fast_exp2(float x) { return __builtin_amdgcn_exp2f(x); }
__device__ __forceinline__ float fast_rcp(float x) { return __builtin_amdgcn_rcpf(x); }
__device__ __forceinline__ float silu_f(float v) { return v * fast_rcp(1.0f + fast_exp2(-v * LOG2E)); }
__device__ __forceinline__ float sigmoid_f(float v) { return fast_rcp(1.0f + fast_exp2(-v * LOG2E)); }

#define XB_TMO      128
#define XB_XCNT(j)  (256  + 64 * (j))
#define XB_XSUB(j)  (1280 + 64 * (j))
#define XB_XGEN(j)  (2304 + 64 * (j))
#define XB_TOP      3328
#define XB_TOPGEN   3392
#define XCD_BAR_WORDS 3456
#define XB_SPIN_CAP (1u << 18)

__device__ __forceinline__ unsigned xb_ld(unsigned* p)              { return __hip_atomic_load(p, __ATOMIC_RELAXED, __HIP_MEMORY_SCOPE_AGENT); }
__device__ __forceinline__ unsigned xb_add(unsigned* p, unsigned v) { return __hip_atomic_fetch_add(p, v, __ATOMIC_RELAXED, __HIP_MEMORY_SCOPE_AGENT); }
__device__ __forceinline__ unsigned xb_xcc_id() { return (unsigned)__builtin_amdgcn_s_getreg((3 << 11) | 20) & 0xFu; }
#define XB_SPIN(cond, bar) do { unsigned _sp = 0; while (cond) { __builtin_amdgcn_s_sleep(1); \
    if ((++_sp & 255u) == 0u) { if (xb_ld(&(bar)[XB_TMO])) break; if (_sp > XB_SPIN_CAP) { atomicAdd(&(bar)[XB_TMO], 1u); break; } } } } while (0)

struct XcdBarrier {
    unsigned* bar; unsigned x;
    volatile LAS unsigned* st;
};

__device__ __forceinline__ XcdBarrier xcd_barrier_post(unsigned* bar, volatile LAS unsigned* st) {
    XcdBarrier b; b.bar = bar; b.x = xb_xcc_id(); b.st = st;
    if (threadIdx.x == 0) (void)xb_add(&bar[XB_XCNT(b.x)], 1u);
    return b;
}
__device__ __forceinline__ void xcd_barrier_complete(unsigned* bar, unsigned x, unsigned& nloc, unsigned& nx) {
    const unsigned G = gridDim.x * gridDim.y * gridDim.z;
    unsigned sum, cnt, mine, sp = 0u;
    for (;;) {
        sum = 0u; cnt = 0u; mine = 0u;
#pragma unroll
        for (unsigned j = 0; j < 16; ++j) { const unsigned c = xb_ld(&bar[XB_XCNT(j)]); sum += c; cnt += (c > 0u) ? 1u : 0u; mine = (j == x) ? c : mine; }
        if (sum == G) break;
        __builtin_amdgcn_s_sleep(1);
        if ((++sp & 255u) == 0u) { if (xb_ld(&bar[XB_TMO])) break; if (sp > XB_SPIN_CAP) { atomicAdd(&bar[XB_TMO], 1u); break; } }
    }
    nloc = mine > 0u ? mine : 1u; nx = cnt > 0u ? cnt : 1u;
}

__device__ __forceinline__ void xcd_barrier(const XcdBarrier& b) {
    asm volatile("s_waitcnt vmcnt(0)" ::: "memory");
    __syncthreads();
    if (threadIdx.x == 0) {
        unsigned* bar = b.bar;
        __builtin_amdgcn_s_waitcnt(0);
        unsigned nloc = b.st[0], nx = b.st[1];
        if (nloc == 0u) { xcd_barrier_complete(bar, b.x, nloc, nx); b.st[0] = nloc; b.st[1] = nx; }
        const unsigned old = xb_add(&bar[XB_XSUB(b.x)], 1u);
        const unsigned gen = old / nloc;
        if (old + 1u == (gen + 1u) * nloc) {
            __builtin_amdgcn_fence(__ATOMIC_RELEASE, "agent");
            asm volatile("s_waitcnt vmcnt(0)" ::: "memory");
            const unsigned og = xb_add(&bar[XB_TOP], 1u);
            const unsigned tg = og / nx;
            if (og + 1u == (tg + 1u) * nx) xb_add(&bar[XB_TOPGEN], 1u);
            else XB_SPIN(xb_ld(&bar[XB_TOPGEN]) == tg, bar);
            __builtin_amdgcn_fence(__ATOMIC_ACQUIRE, "agent");
            xb_add(&bar[XB_XGEN(b.x)], 1u);
            asm volatile("s_waitcnt vmcnt(0)" ::: "memory");
        } else {
            XB_SPIN(xb_ld(&bar[XB_XGEN(b.x)]) == gen, bar);
            __builtin_amdgcn_fence(__ATOMIC_ACQUIRE, "agent");
            asm volatile("s_waitcnt vmcnt(0)" ::: "memory");
        }
    }
    __syncthreads();
}


struct EpiSwiGLU {
    static constexpr bool PERM = true, AFTER_DRAIN = false;
    bf16_t* U;
    __device__ __forceinline__ void operator()(const f32x4 (&acc)[2][2][4][2], const pg8::Unit& u, int wr, int wc, int fr, int fq) const {
        const int row0 = u.pm * 256 + wr * 64 + fr, col0 = u.pn * 128 + wc * 32 + 8 * fq;
#pragma unroll
        for (int ai = 0; ai < 2; ++ai)
#pragma unroll
            for (int m = 0; m < 4; ++m) {
                bf16_t* rowp = U + (size_t)(row0 + ai * 128 + m * 16) * FF + col0;
                unsigned wv[4];
#pragma unroll
                for (int n = 0; n < 2; ++n)
#pragma unroll
                    for (int h = 0; h < 2; ++h) {
                        const f32x2 g2 = {acc[ai][0][m][n][2 * h], acc[ai][0][m][n][2 * h + 1]}, u2 = {acc[ai][1][m][n][2 * h], acc[ai][1][m][n][2 * h + 1]};
                        const f32x2 t = g2 * (-LOG2E);
                        f32x2 d; d.x = fast_exp2(t.x); d.y = fast_exp2(t.y);
                        d = d + 1.0f;
                        f32x2 r; r.x = fast_rcp(d.x); r.y = fast_rcp(d.y);
                        const f32x2 v = (g2 * u2) * r;
                        wv[n * 2 + h] = pk2(v.x, v.y);
                    }
                u32x4 w; w.x = wv[0]; w.y = wv[1]; w.z = wv[2]; w.w = wv[3];
                *(u32x4*)rowp = w;
            }
    }
};
struct EpiBf16Tile {
    static constexpr bool PERM = true, AFTER_DRAIN = false;
    bf16_t* O; int ldc, row_pn, col_pn;
    __device__ __forceinline__ void operator()(const f32x4 (&acc)[2][2][4][2], const pg8::Unit& u, int wr, int wc, int fr, int fq) const {
        const int row0 = u.pm * 256 + u.pn * row_pn + wr * 64 + fr, col0 = u.pn * col_pn + wc * 32 + 8 * fq;
#pragma unroll
        for (int ai = 0; ai < 2; ++ai)
#pragma unroll
            for (int m = 0; m < 4; ++m) {
                bf16_t* rowp = O + (size_t)(row0 + ai * 128 + m * 16) * ldc + col0;
#pragma unroll
                for (int bj = 0; bj < 2; ++bj) {
                    const f32x4 v0 = acc[ai][bj][m][0], v1 = acc[ai][bj][m][1];
                    u32x4 w; w.x = pk2(v0[0], v0[1]); w.y = pk2(v0[2], v0[3]); w.z = pk2(v1[0], v1[1]); w.w = pk2(v1[2], v1[3]);
                    *(u32x4*)(rowp + bj * 128) = w;
                }
            }
    }
};
struct EpiPQ {
    static constexpr bool PERM = true, AFTER_DRAIN = false;
    bf16_t* PQT; bf16_t* PQTC;
    __device__ __forceinline__ void operator()(const f32x4 (&acc)[2][2][4][2], const pg8::Unit& u, int wr, int wc, int fr, int fq) const {
        const int cl = wc * 32 + 8 * fq;
        const bool isctx = u.pn >= 128;
        const int b = isctx ? u.pn - 128 : u.pn >> 3, n0 = isctx ? 0 : (u.pn & 7) * 256;
        bf16_t* base = isctx ? PQTC : PQT; const int ld = isctx ? PQTC_LD : PQT_LD, half = isctx ? 256 : 2048;
#pragma unroll
        for (int ai = 0; ai < 2; ++ai)
#pragma unroll
            for (int m = 0; m < 4; ++m) {
                const int mp = ai * 128 + wr * 64 + m * 16 + fr;
                const int g = mp >> 6, idx = mp & 63, isq = idx > 32, j = isq ? idx - 32 : idx;
                bf16_t* r1 = base + (size_t)(b * 256 + g * 64 + j) * ld + isq * half + n0 + cl;
                bf16_t* r2 = base + (size_t)(b * 256 + g * 64 + ((64 - j) & 63)) * ld + isq * half + n0 + cl;
                const bool self = (j == 0) || (j == 32);
                const unsigned sgn = isq ? 0x80008000u : 0u;
#pragma unroll
                for (int bj = 0; bj < 2; ++bj) {
                    const f32x4 v0 = acc[ai][bj][m][0], v1 = acc[ai][bj][m][1];
                    u32x4 w; w.x = pk2(v0[0], v0[1]); w.y = pk2(v0[2], v0[3]); w.z = pk2(v1[0], v1[1]); w.w = pk2(v1[2], v1[3]);
                    *(u32x4*)(r1 + bj * 128) = w;
                    if (self) { *(u32x4*)(r1 + half + bj * 128) = (u32x4){0u, 0u, 0u, 0u}; }
                    else { u32x4 wm; wm.x = w.x ^ sgn; wm.y = w.y ^ sgn; wm.z = w.z ^ sgn; wm.w = w.w ^ sgn; *(u32x4*)(r2 + bj * 128) = wm; }
                }
            }
    }
};
struct EpiWin {
    static constexpr bool PERM = false, AFTER_DRAIN = false;
    bf16_t* P; const float* rope;
    __device__ __forceinline__ void operator()(const f32x4 (&acc)[2][2][4][2], const pg8::Unit& u, int wr, int wc, int fr, int fq) const {
        const int row0 = u.pm * 256 + wr * 64 + fr, col0 = u.pn * 256 + wc * 32 + 4 * fq;
        const float qs = (u.pn == 2 || u.pn == 5) ? 0.125f * LOG2E : 1.0f;
        const bool lat = u.pm < 128;
#pragma unroll
        for (int ai = 0; ai < 2; ++ai)
#pragma unroll
            for (int m = 0; m < 4; ++m) {
                const int r = row0 + ai * 128 + m * 16;
                bf16_t* rowp = P + (size_t)r * NP + col0;
                const int t = r & 2047;
                const int pos = (wc & 1) ? (t & 63) : (t >> 6);
#pragma unroll
                for (int bj = 0; bj < 2; ++bj) {
                    f32x4 v0 = acc[ai][bj][m][0], v1 = acc[ai][bj][m][1];
                    const bool dorope = lat && (u.pn == 5 || (u.pn == 6 && bj == 0));
                    if (dorope) {
                        const f32x4 cs0 = *(const f32x4*)(rope + (pos * 16 + 4 * fq) * 2), cs1 = *(const f32x4*)(rope + (pos * 16 + 4 * fq) * 2 + 4);
                        const float c0 = cs0[0], s0 = cs0[1], c1 = cs0[2], s1 = cs0[3], c2 = cs1[0], s2 = cs1[1], c3 = cs1[2], s3 = cs1[3];
                        f32x4 a, b;
                        a[0] = v0[0] * c0 - v1[0] * s0; b[0] = v0[0] * s0 + v1[0] * c0;
                        a[1] = v0[1] * c1 - v1[1] * s1; b[1] = v0[1] * s1 + v1[1] * c1;
                        a[2] = v0[2] * c2 - v1[2] * s2; b[2] = v0[2] * s2 + v1[2] * c2;
                        a[3] = v0[3] * c3 - v1[3] * s3; b[3] = v0[3] * s3 + v1[3] * c3;
                        v0 = a; v1 = b;
                    }
                    v0 = v0 * qs; v1 = v1 * qs;
                    u32x2 w0, w1; w0.x = pk2(v0[0], v0[1]); w0.y = pk2(v0[2], v0[3]); w1.x = pk2(v1[0], v1[1]); w1.y = pk2(v1[2], v1[3]);
                    *(u32x2*)(rowp + bj * 128) = w0; *(u32x2*)(rowp + bj * 128 + 16) = w1;
                }
            }
    }
};

struct TrItem { const float* src; bf16_t* dst; int ld_src, ld_dst; };
__device__ __forceinline__ TrItem tr_decode(CParams& p, int it) {
    constexpr int PER_L = 2 * 704 + 2 * 352 + 224 + 160;
    unsigned char* ws = p.ws;
    const int l = it / PER_L; int q = it % PER_L;
    const float* src; bf16_t* dst; int ld_src, ld_dst, col0, k0, r0;
    if (q < 2 * 704) { const int f = q / 704; q %= 704; const int rt = q >> 4, kt = q & 15, R0 = rt * 128, tile = R0 >> 8, bj = (R0 >> 7) & 1;
        src = (bj ? p.w3 : p.w1) + (size_t)(l * 2 + f) * 1024 * FF; ld_src = FF; col0 = 128 * tile; k0 = 64 * kt; dst = (bf16_t*)(ws + WS_W13) + (size_t)(l * 2 + f) * 5632 * 1024; r0 = R0; ld_dst = 1024; }
    else if (q < 2 * 704 + 2 * 352) { q -= 2 * 704; const int f = q / 352; q %= 352; const int rt = q / 44, kt = q % 44;
        src = p.w2 + (size_t)(l * 2 + f) * FF * 1024; ld_src = 1024; col0 = 128 * rt; k0 = 64 * kt; dst = (bf16_t*)(ws + WS_W2T) + (size_t)(l * 2 + f) * 1024 * FF; r0 = 128 * rt; ld_dst = FF; }
    else if (q < 2 * 704 + 2 * 352 + 224) { q -= 2 * 704 + 2 * 352; const int rt = q >> 4, kt = q & 15, R0 = rt * 128;
        src = p.w_in + (size_t)l * 1024 * 2048; ld_src = 2048; col0 = R0 < 512 ? R0 : R0 + 256; k0 = 64 * kt; dst = (bf16_t*)(ws + WS_WIN) + (size_t)l * 2304 * 1024; r0 = R0; ld_dst = 1024; }
    int ks = -1;
    if (q >= 2 * 704 + 2 * 352 + 224) { q -= 2 * 704 + 2 * 352 + 224; const int rt = q / 20, kt = q % 20;
        src = p.w_out + (size_t)l * 1024 * 1024; ld_src = 1024; col0 = 128 * rt; k0 = 64 * kt; ks = kt < 16 ? 64 * kt : 256 + 64 * (kt - 16); dst = (bf16_t*)(ws + WS_WOUT) + (size_t)l * 1024 * YC_LD; r0 = 128 * rt; ld_dst = YC_LD; }
    if (ks < 0) ks = k0;
    TrItem t; t.src = src + (size_t)ks * ld_src + col0; t.dst = dst + (size_t)r0 * ld_dst + k0; t.ld_src = ld_src; t.ld_dst = ld_dst; return t;
}

__device__ __forceinline__ void phase0(CParams& p, LAS unsigned char* lds) {
    const int tid = otid(), wave = tid >> 6, lane = tid & 63;
    unsigned char* ws = p.ws;
    const int bid = obid(), G = gridDim.x;
    TS_BEGIN(9);
    if (bid < 288) {
        LAS float* sS = (LAS float*)lds;
        LAS float* sR = sS + 17 * 1024;
        for (int i = tid; i < 17 * 1024; i += 512) { const float v = (i < 16384) ? p.c[i] : p.c_ctx[i - 16384]; sS[i] = v / (1.0f + __expf(-v)); }
        __syncthreads();
        for (int r = bid; r < 288; r += G) {
            const int l = r / 144, j0 = (r % 144) * 64, k0 = wave * 128;
            float acc[17];
#pragma unroll
            for (int q = 0; q < 17; ++q) acc[q] = 0.f;
            const float* wp = p.w_ada + ((size_t)l * 1024 + k0) * NMODC + j0 + lane;
            float wv[16];
#pragma unroll
            for (int kk = 0; kk < 16; ++kk) wv[kk] = __builtin_nontemporal_load(wp + (size_t)kk * NMODC);
#pragma unroll 1
            for (int kb = 0; kb < 128; kb += 16) {
                float wn[16];
                const int kn = (kb + 16 < 128) ? kb + 16 : kb;
#pragma unroll
                for (int kk = 0; kk < 16; ++kk) wn[kk] = __builtin_nontemporal_load(wp + (size_t)(kn + kk) * NMODC);
#pragma unroll 1
                for (int k4 = 0; k4 < 16; k4 += 4) {
                    const float w0 = k4 == 0 ? wv[0] : (k4 == 4 ? wv[4] : (k4 == 8 ? wv[8] : wv[12]));
                    const float w1 = k4 == 0 ? wv[1] : (k4 == 4 ? wv[5] : (k4 == 8 ? wv[9] : wv[13]));
                    const float w2 = k4 == 0 ? wv[2] : (k4 == 4 ? wv[6] : (k4 == 8 ? wv[10] : wv[14]));
                    const float w3 = k4 == 0 ? wv[3] : (k4 == 4 ? wv[7] : (k4 == 8 ? wv[11] : wv[15]));
#pragma unroll
                    for (int q = 0; q < 17; ++q) { const f32x4 sv = *(const LAS f32x4*)(sS + q * 1024 + k0 + kb + k4);
                        acc[q] += (sv[0] * w0 + sv[1] * w1) + (sv[2] * w2 + sv[3] * w3); }
                }
#pragma unroll
                for (int kk = 0; kk < 16; ++kk) wv[kk] = wn[kk];
            }
#pragma unroll
            for (int q = 0; q < 17; ++q) sR[(wave * 17 + q) * 64 + lane] = acc[q];
            __syncthreads();
            float* MOD = (float*)(ws + WS_MOD);
            for (int o = tid; o < 17 * 64; o += 512) {
                const int q = o >> 6, ln = o & 63; float s = p.b_ada[l * NMODC + j0 + ln];
#pragma unroll
                for (int w = 0; w < 8; ++w) s += sR[(w * 17 + q) * 64 + ln];
                MOD[(size_t)(l * 17 + q) * NMODC + j0 + ln] = s;
            }
            __syncthreads();
        }
    }
    TS_END(9);
    TS_BEGIN(10);
    {
        constexpr int N_TR = 2 * (2 * 704 + 2 * 352 + 224 + 160);
        LAS float* t = (LAS float*)lds;
        const int lk = tid >> 5, lc = (tid & 31) * 4;
        const int sr = tid >> 2, sk = (tid & 3) * 16;
        const bool bal = (G == 256) && (N_TR == 4992);
        int it = bal ? (bid >= 32 ? (bid - 32) * 21 : 4704 + bid * 9) : bid;
        const int step = bal ? 1 : G, tr_end = bal ? it + (bid >= 32 ? 21 : 9) : N_TR;
        f32x4 pre[4]; TrItem cur;
        if (it < tr_end) { cur = tr_decode(p, it);
#pragma unroll
            for (int i = 0; i < 4; ++i) pre[i] = __builtin_nontemporal_load((const f32x4*)(cur.src + (size_t)(lk + 16 * i) * cur.ld_src + lc)); }
        while (it < tr_end) {
#pragma unroll
            for (int i = 0; i < 4; ++i) { LAS float* d = t + (lk + 16 * i) * 129 + lc; d[0] = pre[i][0]; d[1] = pre[i][1]; d[2] = pre[i][2]; d[3] = pre[i][3]; }
            __syncthreads();
            bf16_t* dp = cur.dst + (size_t)sr * cur.ld_dst + sk;
            const int nxt = it + step;
            if (nxt < tr_end) { cur = tr_decode(p, nxt);
#pragma unroll
                for (int i = 0; i < 4; ++i) pre[i] = __builtin_nontemporal_load((const f32x4*)(cur.src + (size_t)(lk + 16 * i) * cur.ld_src + lc)); }
            { const LAS float* s = t + sk * 129 + sr;
              u32x4 o0, o1;
              o0.x = pk2(s[0 * 129], s[1 * 129]); o0.y = pk2(s[2 * 129], s[3 * 129]); o0.z = pk2(s[4 * 129], s[5 * 129]); o0.w = pk2(s[6 * 129], s[7 * 129]);
              o1.x = pk2(s[8 * 129], s[9 * 129]); o1.y = pk2(s[10 * 129], s[11 * 129]); o1.z = pk2(s[12 * 129], s[13 * 129]); o1.w = pk2(s[14 * 129], s[15 * 129]);
              *(u32x4*)dp = o0; *(u32x4*)(dp + 8) = o1; }
            __syncthreads();
            it = nxt;
        }
    }
    TS_END(10);
    TS_BEGIN(11);
    for (int r = bid; r < 256; r += G) {
        const int l = r >> 7, k0 = (r & 127) * 8;
        LAS float* sW = (LAS float*)lds;
        LAS float* sC = sW + 2048;
        for (int i = tid; i < 2048; i += 512) { const int kk = i >> 8, cc = i & 255; sW[i] = p.w_in[((size_t)l * 1024 + k0 + kk) * 2048 + 512 + cc]; }
        if (tid < 64) sC[tid] = cospif((float)tid * (1.0f / 32.0f));
        __syncthreads();
        const int g = (tid >> 6) & 3, idx = tid & 63, isS = idx > 32, jj = isS ? idx - 32 : idx;
        float acc[8];
#pragma unroll
        for (int q = 0; q < 8; ++q) acc[q] = 0.f;
        for (int c = 0; c < 64; ++c) {
            const int mm = (c * jj) & 63; const float tv = sC[isS ? ((mm - 16) & 63) : mm];
#pragma unroll
            for (int q = 0; q < 8; ++q) acc[q] += sW[q * 256 + g * 64 + c] * tv;
        }
        u32x4 o; o.x = pk2(acc[0] * 0.125f, acc[1] * 0.125f); o.y = pk2(acc[2] * 0.125f, acc[3] * 0.125f); o.z = pk2(acc[4] * 0.125f, acc[5] * 0.125f); o.w = pk2(acc[6] * 0.125f, acc[7] * 0.125f);
        if (tid < 256) *(u32x4*)((bf16_t*)(ws + WS_WIN) + ((size_t)l * 2304 + 1792 + g * 64 + idx) * 1024 + k0) = o;
        __syncthreads();
    }
    {
        LAS float* tab = (LAS float*)lds;
        for (int m = tid; m < 2048; m += 512) tab[m] = cospif((float)m * (1.0f / 1024.0f)) * 0.022097086912079608f;
        __syncthreads();
        for (int r = bid; r < 2048 + 256; r += G) {
            if (r < 2048) {
                float v[8];
#pragma unroll
                for (int e = 0; e < 8; ++e) { const int k = tid * 8 + e, idx = (r * (k & 2047)) & 2047; v[e] = tab[k < 2048 ? idx : ((idx + 512) & 2047)]; }
                u32x4 o; o.x = pk2(v[0], v[1]); o.y = pk2(v[2], v[3]); o.z = pk2(v[4], v[5]); o.w = pk2(v[6], v[7]);
                *(u32x4*)((bf16_t*)(ws + WS_DFT) + (size_t)r * DFT_LD + tid * 8) = o;
            } else if (tid < 64) {
                const int np = r - 2048; const float sc = 2.8284271247461903f;
                float v[8];
#pragma unroll
                for (int e = 0; e < 8; ++e) { const int k = tid * 8 + e, idx = ((np * (k & 255)) & 255) * 8; v[e] = tab[k < 256 ? idx : ((idx + 512) & 2047)] * sc; }
                u32x4 o; o.x = pk2(v[0], v[1]); o.y = pk2(v[2], v[3]); o.z = pk2(v[4], v[5]); o.w = pk2(v[6], v[7]);
                *(u32x4*)((bf16_t*)(ws + WS_DFTC) + (size_t)np * DFTC_LD + tid * 8) = o;
            }
        }
        __syncthreads();
    }
    TS_END(11);
    if (bid == G - 1) {
        float* rtab = (float*)(ws + WS_ROPE);
        for (int e = tid; e < 1024; e += 512) { const int pos = e >> 4, i = e & 15;
            const float inv = fast_exp2(-(float)i * (13.287712379549449f / 16.0f));
            const float tt = (float)pos * inv * 0.3183098861837907f;
            rtab[2 * e] = cospif(tt); rtab[2 * e + 1] = sinpif(tt); }
    }
}

struct EwRow { f32x4 x[4]; u32x2 xb[4]; u32x2 y[4]; u32x2 y2[4]; };
__device__ __forceinline__ void ew_load(EwRow& r, const float* xin_lat, const float* xin_ctx, const bf16_t* xin_bf, const bf16_t* Yp, const bf16_t* Y2p, int t, int lane) {
    if (xin_bf) {
#pragma unroll
        for (int j = 0; j < 4; ++j) r.xb[j] = __builtin_nontemporal_load((const u32x2*)(xin_bf + (size_t)t * DM + 4 * lane + 256 * j));
    } else {
        const float* xr = t < TL ? xin_lat + (size_t)t * DM : xin_ctx + (size_t)(t - TL) * DM;
#pragma unroll
        for (int j = 0; j < 4; ++j) r.x[j] = __builtin_nontemporal_load((const f32x4*)(xr + 4 * lane + 256 * j));
    }
    if (Yp) {
#pragma unroll
        for (int j = 0; j < 4; ++j) r.y[j] = __builtin_nontemporal_load((const u32x2*)(Yp + (size_t)t * DM + 4 * lane + 256 * j));
        if (t >= TL) {
#pragma unroll
            for (int j = 0; j < 4; ++j) r.y2[j] = __builtin_nontemporal_load((const u32x2*)(Y2p + (size_t)(t - TL) * DM + 4 * lane + 256 * j));
        }
    }
}
__device__ __forceinline__ void ew_pass(const float* xin_lat, const float* xin_ctx, const bf16_t* xin_bf, bf16_t* xout_bf, float* xout_f32, const bf16_t* Yp, const bf16_t* Y2p, const float* gpost, float fac, const float* gate,
                                        bf16_t* Hp, const float* gpre, const float* shift, const float* scale, int nrows) {
    const int tid = otid(); const int wave = tid >> 6, lane = tid & 63;
    const int per = (nrows + (int)gridDim.x - 1) / (int)gridDim.x, tbeg = obid() * per + wave, tend = min(obid() * per + per, nrows);
    f32x4 vgp[4], vgt[4], vpre[4], vsh[4], vsc[4];
#pragma unroll
    for (int j = 0; j < 4; ++j) { vgp[j] = Yp ? *(const f32x4*)(gpost + 4 * lane + 256 * j) : (f32x4){0.f, 0.f, 0.f, 0.f}; vpre[j] = Hp ? *(const f32x4*)(gpre + 4 * lane + 256 * j) : (f32x4){0.f, 0.f, 0.f, 0.f};
        vgt[j] = vsh[j] = vsc[j] = (f32x4){0.f, 0.f, 0.f, 0.f}; }
    int bcur = -1;
    EwRow A, B;
    auto process = [&](EwRow& r, int t) {
        const bool lat = t < TL; const int b = lat ? (t >> 11) : 16;
        if (xin_bf) {
#pragma unroll
            for (int j = 0; j < 4; ++j) { const u32x2 w = r.xb[j]; r.x[j][0] = bflo(w.x); r.x[j][1] = bfhi(w.x); r.x[j][2] = bflo(w.y); r.x[j][3] = bfhi(w.y); }
        }
        if (b != bcur) { bcur = b;
#pragma unroll
            for (int j = 0; j < 4; ++j) { const int cidx = 4 * lane + 256 * j;
                if (Yp) vgt[j] = *(const f32x4*)(gate + (size_t)b * NMODC + cidx) * fac;
                if (Hp) { vsh[j] = *(const f32x4*)(shift + (size_t)b * NMODC + cidx); vsc[j] = *(const f32x4*)(scale + (size_t)b * NMODC + cidx) + 1.0f; } } }
        if (Yp) {
            f32x4 y[4]; float ss = 0.f;
#pragma unroll
            for (int j = 0; j < 4; ++j) { const u32x2 w = r.y[j];
                y[j][0] = bflo(w.x); y[j][1] = bfhi(w.x); y[j][2] = bflo(w.y); y[j][3] = bfhi(w.y);
                if (!lat) { const u32x2 w2 = r.y2[j]; y[j][0] += bflo(w2.x); y[j][1] += bfhi(w2.x); y[j][2] += bflo(w2.y); y[j][3] += bfhi(w2.y); }
                ss += (y[j][0] * y[j][0] + y[j][1] * y[j][1]) + (y[j][2] * y[j][2] + y[j][3] * y[j][3]); }
            const float rstd = 1.0f / sqrtf(wave_sum(ss) * (1.0f / DM) + EPSV);
#pragma unroll
            for (int j = 0; j < 4; ++j) r.x[j] = r.x[j] + vgt[j] * (y[j] * rstd * vgp[j]);
        }
        if (xout_f32) {
            float* xo = xout_f32 + (size_t)t * DM;
#pragma unroll
            for (int j = 0; j < 4; ++j) __builtin_nontemporal_store(r.x[j], (f32x4*)(xo + 4 * lane + 256 * j));
        } else if (xout_bf) {
#pragma unroll
            for (int j = 0; j < 4; ++j) { u32x2 w; w.x = pk2(r.x[j][0], r.x[j][1]); w.y = pk2(r.x[j][2], r.x[j][3]);
                __builtin_nontemporal_store(w, (u32x2*)(xout_bf + (size_t)t * DM + 4 * lane + 256 * j));
                r.x[j][0] = bflo(w.x); r.x[j][1] = bfhi(w.x); r.x[j][2] = bflo(w.y); r.x[j][3] = bfhi(w.y); }
        }
        if (Hp) {
            float ss = 0.f;
#pragma unroll
            for (int j = 0; j < 4; ++j) ss += (r.x[j][0] * r.x[j][0] + r.x[j][1] * r.x[j][1]) + (r.x[j][2] * r.x[j][2] + r.x[j][3] * r.x[j][3]);
            const float rstd = 1.0f / sqrtf(wave_sum(ss) * (1.0f / DM) + EPSV);
#pragma unroll
            for (int j = 0; j < 4; ++j) { const f32x4 h = (r.x[j] * rstd * vpre[j]) * vsc[j] + vsh[j];
                u32x2 w; w.x = pk2(h[0], h[1]); w.y = pk2(h[2], h[3]);
                *(u32x2*)(Hp + (size_t)t * DM + 4 * lane + 256 * j) = w; }
        }
    };
    int t = tbeg;
    if (t < tend) ew_load(A, xin_lat, xin_ctx, xin_bf, Yp, Y2p, t, lane);
    while (t < tend) {
        const int tn = t + 8;
        if (tn < tend) ew_load(B, xin_lat, xin_ctx, xin_bf, Yp, Y2p, tn, lane);
        process(A, t);
        const int tnn = tn + 8;
        if (tnn < tend) ew_load(A, xin_lat, xin_ctx, xin_bf, Yp, Y2p, tnn, lane);
        if (tn < tend) process(B, tn);
        t = tnn;
    }
}

__device__ __forceinline__ void conv_item(CParams& p, LAS unsigned char* lds, int l, int s, int tb) {
    const int tid = otid(), wave = tid >> 6, lane = tid & 63;
    const bf16_t* PROJ = (const bf16_t*)(p.ws + WS_PROJ); bf16_t* YCAT = (bf16_t*)(p.ws + WS_YCAT);
    LAS float* sA = (LAS float*)lds;
    const int tokbase = s < 16 ? s * 2048 : TL + (s - 16) * 256, len = s < 16 ? 2048 : 256, t0 = tb * 64;
    {
        u32x4 ua[6], ug[6];
#pragma unroll
        for (int i = 0; i < 6; ++i) {
            const int u = tid + 512 * i, rr = u >> 5, c8 = (u & 31) * 8, tt = t0 - 15 + rr;
            ua[i] = (u32x4){0u, 0u, 0u, 0u}; ug[i] = (u32x4){0u, 0u, 0u, 0u};
            if (u < 94 * 32 && tt >= 0 && tt < len) { const bf16_t* rp = PROJ + (size_t)(tokbase + tt) * NP + c8; ua[i] = *(const u32x4*)rp; ug[i] = *(const u32x4*)(rp + 256); }
        }
#pragma unroll
        for (int i = 0; i < 6; ++i) {
            const int u = tid + 512 * i, rr = u >> 5, c8 = (u & 31) * 8;
            if (u < 94 * 32) {
                float v[8];
                v[0] = bflo(ua[i].x) * sigmoid_f(bflo(ug[i].x)); v[1] = bfhi(ua[i].x) * sigmoid_f(bfhi(ug[i].x));
                v[2] = bflo(ua[i].y) * sigmoid_f(bflo(ug[i].y)); v[3] = bfhi(ua[i].y) * sigmoid_f(bfhi(ug[i].y));
                v[4] = bflo(ua[i].z) * sigmoid_f(bflo(ug[i].z)); v[5] = bfhi(ua[i].z) * sigmoid_f(bfhi(ug[i].z));
                v[6] = bflo(ua[i].w) * sigmoid_f(bflo(ug[i].w)); v[7] = bfhi(ua[i].w) * sigmoid_f(bfhi(ug[i].w));
                *(LAS f32x4*)(sA + rr * 256 + c8) = (f32x4){v[0], v[1], v[2], v[3]};
                *(LAS f32x4*)(sA + rr * 256 + c8 + 4) = (f32x4){v[4], v[5], v[6], v[7]};
            }
        }
    }
    __syncthreads();
    TS_BEGIN(7);
    const int cp = tid & 127, oc = tid >> 7;
    f32x2 out2[2][8];
    {
        f32x2 w2[31];
#pragma unroll
        for (int j = 0; j < 31; ++j) w2[j] = *(const f32x2*)(p.conv_w + ((size_t)l * 31 + j) * 256 + 2 * cp);
        const f32x2 bias2 = *(const f32x2*)(p.conv_b + l * 256 + 2 * cp);
#pragma unroll
        for (int ps = 0; ps < 2; ++ps) {
            const LAS float* ap = sA + ((oc * 2 + ps) * 8) * 256 + 2 * cp;
            f32x2 in2[38];
#pragma unroll
            for (int i = 0; i < 38; ++i) in2[i] = *(const LAS f32x2*)(ap + i * 256);
#pragma unroll
            for (int q = 0; q < 8; ++q) {
                f32x2 acc = bias2;
#pragma unroll
                for (int j = 0; j < 31; ++j) acc = in2[q + j] * w2[j] + acc;
                out2[ps][q] = acc;
            }
        }
    }
    TS_END(7);
    __syncthreads();
#pragma unroll
    for (int ps = 0; ps < 2; ++ps)
#pragma unroll
        for (int q = 0; q < 8; ++q) *(LAS f32x2*)(sA + ((oc * 2 + ps) * 8 + q) * 256 + 2 * cp) = out2[ps][q];
    __syncthreads();
    {
        const f32x4 lg = *(const f32x4*)(p.ln_g + l * 256 + 4 * lane), lb = *(const f32x4*)(p.ln_b + l * 256 + 4 * lane);
#pragma unroll
        for (int q = 0; q < 8; ++q) {
            const int tok = wave * 8 + q;
            const f32x4 v = *(const LAS f32x4*)(sA + tok * 256 + 4 * lane);
            const float mean = wave_sum((v[0] + v[1]) + (v[2] + v[3])) * (1.0f / 256.0f);
            const f32x4 d = v - mean;
            const float var = wave_sum((d[0] * d[0] + d[1] * d[1]) + (d[2] * d[2] + d[3] * d[3])) * (1.0f / 256.0f);
            const float rstd = 1.0f / sqrtf(var + EPSV);
            const f32x4 yn = d * rstd * lg + lb;
            u32x2 o; o.x = pk2(silu_f(yn[0]), silu_f(yn[1])); o.y = pk2(silu_f(yn[2]), silu_f(yn[3]));
            *(u32x2*)(YCAT + (size_t)(tokbase + t0 + tok) * YC_LD + 4 * lane) = o;
        }
    }
    __syncthreads();
}

struct AttnItem {
    int mode;
    int qtok0;
    int qcol0, qcol1, ocol0, ocol1;
    int kcol0, kcol1, vcol0, vcol1; int nslots;
    int nloc, loctok0;
    int ctxtok0;
    int r, rs, rsB;
    int q0, kp0;
    int has_sink; float sink0, sink1;
    int h0;
};
constexpr int KROW = 72;
constexpr int KV_BYTES = 64 * KROW * 2;
constexpr int ABUF_BYTES = 4 * KV_BYTES;
typedef short s16x4 __attribute__((ext_vector_type(4)));
template <int OFF> __device__ __forceinline__ s16x4 tr_read(unsigned addr) {
    s16x4 r; asm volatile("ds_read_b64_tr_b16 %0, %1 offset:%2" : "=&v"(r) : "v"(addr), "i"(OFF) : "memory"); return r;
}
template <int NKB>
__device__ __forceinline__ void attn_set(const bf16x8 (&kf)[NKB][2], const s16x4 (&vl)[NKB / 2][4], const s16x4 (&vh)[NKB / 2][4], int kofs, const bf16x8 (&qf)[2], int fq,
                                         int mtype, int a0, const LAS float* bt, float& mrun, float& lsum, f32x4 (&o)[4]) {
    f32x4 sacc[NKB];
#pragma unroll
    for (int kb = 0; kb < NKB; ++kb) {
        sacc[kb] = (f32x4){0.f, 0.f, 0.f, 0.f};
        sacc[kb] = __builtin_amdgcn_mfma_f32_16x16x32_bf16(kf[kb][0], qf[0], sacc[kb], 0, 0, 0);
        sacc[kb] = __builtin_amdgcn_mfma_f32_16x16x32_bf16(kf[kb][1], qf[1], sacc[kb], 0, 0, 0);
    }
    if (mtype == 1) {
        const int wsx = min(max(a0 - 8, 0), 48);
        const int lo = wsx - (kofs + 4 * fq);
        const LAS float* bl = bt + (kofs + 4 * fq - a0 + 63);
#pragma unroll
        for (int kb = 0; kb < NKB; ++kb)
#pragma unroll
            for (int j = 0; j < 4; ++j) { const bool ok = (unsigned)(16 * kb + j - lo) < 16u;
                sacc[kb][j] = ok ? sacc[kb][j] + bl[16 * kb + j] : -1.0e30f; }
    } else if (mtype == 2) {
        const int db = a0 + kofs + 4 * fq + 128;
#pragma unroll
        for (int kb = 0; kb < NKB; ++kb)
#pragma unroll
            for (int j = 0; j < 4; ++j) { const bool ok = (unsigned)(db + 16 * kb + j) <= 256u;
                sacc[kb][j] = ok ? sacc[kb][j] : -1.0e30f; }
    }
    float cm = sacc[0][0];
#pragma unroll
    for (int kb = 0; kb < NKB; ++kb)
#pragma unroll
        for (int j = 0; j < 4; ++j) cm = fmaxf(cm, sacc[kb][j]);
    cm = xrow16_max(cm);
    const float mnew = fmaxf(mrun, cm);
    if (__any(mnew > mrun)) {
        const float alpha = fast_exp2(mrun - mnew);
        lsum *= alpha;
#pragma unroll
        for (int db = 0; db < 4; ++db) o[db] = o[db] * alpha;
        mrun = mnew;
    }
    float ps = 0.f;
#pragma unroll
    for (int kb = 0; kb < NKB; ++kb)
#pragma unroll
        for (int j = 0; j < 4; ++j) { sacc[kb][j] = fast_exp2(sacc[kb][j] - mnew); ps += sacc[kb][j]; }
    lsum += ps;
#define ATT_PK(L, H) (bf16x8){L[0], L[1], L[2], L[3], H[0], H[1], H[2], H[3]}
#pragma unroll
    for (int grp = 0; grp < NKB / 2; ++grp) {
        union { bf16x8 v; unsigned u[4]; } pb;
        pb.u[0] = pk2(sacc[2 * grp][0], sacc[2 * grp][1]); pb.u[1] = pk2(sacc[2 * grp][2], sacc[2 * grp][3]);
        pb.u[2] = pk2(sacc[2 * grp + 1][0], sacc[2 * grp + 1][1]); pb.u[3] = pk2(sacc[2 * grp + 1][2], sacc[2 * grp + 1][3]);
#pragma unroll
        for (int db = 0; db < 4; ++db) o[db] = __builtin_amdgcn_mfma_f32_16x16x32_bf16(ATT_PK(vl[grp][db], vh[grp][db]), pb.v, o[db], 0, 0, 0);
    }
#undef ATT_PK
}
template <int NKB>
__device__ __forceinline__ void attn_chunk2(const LAS unsigned char* kt, const LAS unsigned char* vt, int kofs, const bf16x8 (&qf)[2][2], int fr, int fq,
                                            bool act0, bool act1, int mt0, int mt1, int a00, int a01, const LAS float* bt0, const LAS float* bt1,
                                            float (&mrun)[2], float (&lsum)[2], f32x4 (&o)[2][4]) {
    const unsigned vaddr = (unsigned)(size_t)vt + (unsigned)(((kofs + 4 * fq + (fr >> 2)) * KROW + 4 * (fr & 3)) * 2);
    s16x4 vl[NKB / 2][4], vh[NKB / 2][4];
#pragma unroll
    for (int grp = 0; grp < NKB / 2; ++grp) {
        const unsigned va = vaddr + (unsigned)(grp * 32 * KROW * 2);
        vl[grp][0] = tr_read<0>(va);  vh[grp][0] = tr_read<16 * KROW * 2>(va);
        vl[grp][1] = tr_read<32>(va); vh[grp][1] = tr_read<16 * KROW * 2 + 32>(va);
        vl[grp][2] = tr_read<64>(va); vh[grp][2] = tr_read<16 * KROW * 2 + 64>(va);
        vl[grp][3] = tr_read<96>(va); vh[grp][3] = tr_read<16 * KROW * 2 + 96>(va);
    }
    const int kc0 = (fq ^ (((kofs + fr) >> 1) & 7)) * 16;
    const LAS unsigned char* krow = kt + (kofs + fr) * 128;
    bf16x8 kf[NKB][2];
#pragma unroll
    for (int kb = 0; kb < NKB; ++kb) { kf[kb][0] = *(const LAS bf16x8*)(krow + kc0 + 16 * kb * 128); kf[kb][1] = *(const LAS bf16x8*)(krow + (kc0 ^ 64) + 16 * kb * 128); }
    asm volatile("s_waitcnt lgkmcnt(0)" ::: "memory"); __builtin_amdgcn_sched_barrier(0);
    if (act0) attn_set<NKB>(kf, vl, vh, kofs, qf[0], fq, mt0, a00, bt0, mrun[0], lsum[0], o[0]);
    if (act1) attn_set<NKB>(kf, vl, vh, kofs, qf[1], fq, mt1, a01, bt1, mrun[1], lsum[1], o[1]);
}

__device__ __forceinline__ void attn_item(CParams& p, LAS unsigned char* lds, int l, const AttnItem& it) {
    const int tid = otid(), wave = tid >> 6, lane = tid & 63, g = wave >> 2, wq = wave & 3, fr = lane & 15, fq = lane >> 4;
    const bf16_t* PROJ = (const bf16_t*)(p.ws + WS_PROJ); bf16_t* YCAT = (bf16_t*)(p.ws + WS_YCAT);
    LAS float* sB = (LAS float*)(lds + 2 * ABUF_BYTES);
    const int slot = it.nslots == 2 ? g : 0;
    if (it.mode == 0) { for (int i = tid; i < 2 * 15 * 128; i += 512) { const int h = i / 1920, rem = i % 1920, dr = rem >> 7, dc = (rem & 127) - 48;
            sB[i] = (dc >= 0 && dc < 31) ? p.nat_bias[(size_t)(l * 4 + it.h0 + h) * 465 + dr * 31 + dc] * LOG2E : 0.f; } }
    bf16x8 qf[2][2];
#pragma unroll
    for (int s = 0; s < 2; ++s) { const bf16_t* qp = PROJ + (size_t)(it.qtok0 + 64 * s + wq * 16 + fr) * NP + (g ? it.qcol1 : it.qcol0) + 8 * fq;
        qf[s][0] = *(const bf16x8*)qp; qf[s][1] = *(const bf16x8*)(qp + 32); }
    float mrun[2] = {-3.0e38f, -3.0e38f}, lsum[2] = {0.f, 0.f};
    f32x4 o[2][4];
#pragma unroll
    for (int s = 0; s < 2; ++s)
#pragma unroll
        for (int db = 0; db < 4; ++db) o[s][db] = (f32x4){0.f, 0.f, 0.f, 0.f};
    const int nchunks = 4 + it.nloc;
    const int srow = tid >> 3, sseg = tid & 7;
    u32x4 kreg[2], vreg[2];
    auto chunk_tok = [&](int c) { return c < 4 ? it.ctxtok0 + 64 * c : it.loctok0 + 64 * (c - 4); };
    auto gload = [&](int c) {
        const bf16_t* rp = PROJ + (size_t)(chunk_tok(c) + srow) * NP + 8 * sseg;
#pragma unroll
        for (int s = 0; s < 2; ++s) if (s < it.nslots) { kreg[s] = *(const u32x4*)(rp + (s ? it.kcol1 : it.kcol0)); vreg[s] = *(const u32x4*)(rp + (s ? it.vcol1 : it.vcol0)); }
    };
    auto lwrite = [&](int c) {
        LAS unsigned char* bufk = lds + (c & 1) * ABUF_BYTES + srow * 128 + ((sseg ^ ((srow >> 1) & 7)) * 16);
        LAS unsigned char* bufv = lds + (c & 1) * ABUF_BYTES + 2 * KV_BYTES + (srow * KROW + 8 * sseg) * 2;
#pragma unroll
        for (int s = 0; s < 2; ++s) if (s < it.nslots) { *(LAS u32x4*)(bufk + s * KV_BYTES) = kreg[s]; *(LAS u32x4*)(bufv + s * KV_BYTES) = vreg[s]; }
    };
    gload(0); lwrite(0);
    if (nchunks > 1) gload(1);
    __syncthreads();
    TS_BEGIN(5);
    const int qi = wq * 16 + fr;
    const int nat_kofs = min(max(16 * wq - 8, 0), 32);
    for (int c = 0; c < nchunks; ++c) {
        if (c + 1 < nchunks) lwrite(c + 1);
        if (c + 2 < nchunks) gload(c + 2);
        const LAS unsigned char* kt = lds + (c & 1) * ABUF_BYTES + slot * KV_BYTES;
        const LAS unsigned char* vt = kt + 2 * KV_BYTES;
        if (c >= 4 && it.mode == 0) {
            const int kr = it.rs + (c - 4);
            const bool a0 = kr <= it.rs + 7, a1 = kr >= it.rsB;
            const int dr0 = kr - it.r + 7, dr1 = dr0 - 1;
            attn_chunk2<2>(kt, vt, nat_kofs, qf, fr, fq, a0, a1, 1, 1, qi, qi, sB + g * 1920 + (a0 ? dr0 : 0) * 128, sB + g * 1920 + (a1 ? dr1 : 0) * 128, mrun, lsum, o);
        } else if (c >= 4 && it.mode == 1) {
            const int rel0 = it.kp0 + 64 * (c - 4) - it.q0, rel1 = rel0 - 64;
            const bool a0 = rel0 >= -128 && rel0 <= 128, a1 = rel1 >= -128 && rel1 <= 128;
            attn_chunk2<4>(kt, vt, 0, qf, fr, fq, a0, a1, 2, 2, rel0 - qi, rel1 - qi, sB, sB, mrun, lsum, o);
        } else {
            attn_chunk2<4>(kt, vt, 0, qf, fr, fq, true, true, 0, 0, 0, 0, sB, sB, mrun, lsum, o);
        }
        __syncthreads();
    }
    TS_END(5);
#pragma unroll
    for (int s = 0; s < 2; ++s) {
        float ls = xrow16_sum(lsum[s]);
        if (it.has_sink) ls += fast_exp2((g ? it.sink1 : it.sink0) * LOG2E - mrun[s]);
        const float inv = 1.0f / ls;
        bf16_t* op = YCAT + (size_t)(it.qtok0 + 64 * s + wq * 16 + fr) * YC_LD + (g ? it.ocol1 : it.ocol0) + 4 * fq;
#pragma unroll
        for (int db = 0; db < 4; ++db) { u32x2 w; w.x = pk2(o[s][db][0] * inv, o[s][db][1] * inv); w.y = pk2(o[s][db][2] * inv, o[s][db][3] * inv); *(u32x2*)(op + 16 * db) = w; }
    }
}

constexpr int C_UA = 0, C_QN = 512, C_KN = 768, C_VN = 1024, C_QS = 1280, C_KS = 1536, C_VS = 1664;

__device__ __forceinline__ void mix_items(CParams& p, LAS unsigned char* lds, int l, int sub) {
    const int n_attn = (l == 0) ? 1152 : 1024;
    const int n_conv = (l == 0) ? 512 + 64 : 512;
    const int start = (obid() + 128) % gridDim.x;
    for (int i = start; i < n_attn + n_conv; i += gridDim.x) {
        if (i >= n_attn) {
            if (!(sub & 4)) continue;
            const int ci = i - n_attn;
            TS_BEGIN(3);
            if (ci < 512) conv_item(p, lds, l, ci >> 5, ci & 31);
            else { const int cj = ci - 512; conv_item(p, lds, l, 16 + (cj >> 2), cj & 3); }
            TS_END(3);
            continue;
        }
        AttnItem it{};
        if (i < 512) {
            const int b = i >> 5, r = 2 * ((i >> 1) & 15), hp = i & 1;
            it.mode = 0; it.qtok0 = b * 2048 + r * 64; it.nslots = 2; it.h0 = 2 * hp;
            { const int h = 2 * hp; it.qcol0 = C_QN + 64 * h; it.kcol0 = C_KN + 64 * h; it.vcol0 = C_VN + 64 * h; it.ocol0 = 512 + 64 * h;
              it.qcol1 = it.qcol0 + 64; it.kcol1 = it.kcol0 + 64; it.vcol1 = it.vcol0 + 64; it.ocol1 = it.ocol0 + 64; }
            it.r = r; it.rs = min(max(r - 4, 0), 24); it.rsB = min(max(r + 1 - 4, 0), 24);
            it.nloc = it.rsB + 8 - it.rs; it.loctok0 = b * 2048 + it.rs * 64; it.ctxtok0 = TL + b * 256;
        } else if (i < 1024) {
            const int k = i - 512, b = k >> 5, qb = (k >> 1) & 15, kvh = k & 1;
            it.mode = 1; it.qtok0 = b * 2048 + qb * 128; it.nslots = 1;
            { const int h = 2 * kvh; it.qcol0 = C_QS + 64 * h; it.ocol0 = 768 + 64 * h; it.sink0 = p.sink[l * 4 + h]; it.sink1 = p.sink[l * 4 + h + 1];
              it.qcol1 = it.qcol0 + 64; it.ocol1 = it.ocol0 + 64; it.kcol0 = it.kcol1 = C_KS + 64 * kvh; it.vcol0 = it.vcol1 = C_VS + 64 * kvh; }
            it.has_sink = 1; it.q0 = qb * 128;
            const int ks = max(qb * 128 - 128, 0), ke = min(qb * 128 + 256, 2048);
            it.kp0 = ks; it.nloc = (ke - ks) >> 6; it.loctok0 = b * 2048 + ks; it.ctxtok0 = TL + b * 256;
        } else if (i < 1088) {
            const int k = i - 1024, b = k >> 2, qb = (k >> 1) & 1, hp = k & 1;
            it.mode = 2; it.qtok0 = TL + b * 256 + qb * 128; it.nslots = 2;
            { const int h = 2 * hp; it.qcol0 = C_QN + 64 * h; it.kcol0 = C_KN + 64 * h; it.vcol0 = C_VN + 64 * h; it.ocol0 = 512 + 64 * h;
              it.qcol1 = it.qcol0 + 64; it.kcol1 = it.kcol0 + 64; it.vcol1 = it.vcol0 + 64; it.ocol1 = it.ocol0 + 64; }
            it.nloc = 0; it.ctxtok0 = TL + b * 256;
        } else {
            const int k = i - 1088, b = k >> 2, qb = (k >> 1) & 1, kvh = k & 1;
            it.mode = 2; it.qtok0 = TL + b * 256 + qb * 128; it.nslots = 1;
            { const int h = 2 * kvh; it.qcol0 = C_QS + 64 * h; it.ocol0 = 768 + 64 * h; it.sink0 = p.sink[l * 4 + h]; it.sink1 = p.sink[l * 4 + h + 1];
              it.qcol1 = it.qcol0 + 64; it.ocol1 = it.ocol0 + 64; it.kcol0 = it.kcol1 = C_KS + 64 * kvh; it.vcol0 = it.vcol1 = C_VS + 64 * kvh; }
            it.has_sink = 1; it.nloc = 0; it.ctxtok0 = TL + b * 256;
        }
        TS_BEGIN(2);
        if (sub & 2) attn_item(p, lds, l, it);
        TS_END(2);
    }
}

constexpr int N_PHASES = 22;
#ifndef PHMASK
#define PHMASK 0xff
#endif

__device__ __forceinline__ void run_phase(CParams& p, LAS unsigned char* lds, int ph, int sub) {
    unsigned char* ws = p.ws;
    bf16_t* YH = (bf16_t*)(ws + WS_YH); bf16_t* U = (bf16_t*)(ws + WS_R1); bf16_t* PROJ = (bf16_t*)(ws + WS_PROJ); bf16_t* YCAT = (bf16_t*)(ws + WS_YCAT);
    const float* MOD = (const float*)(ws + WS_MOD);
    const int G = gridDim.x, c = obid();
    if (ph == 0) { if constexpr ((PHMASK & 1) != 0) phase0(p, lds); return; }
    if (ph == 1) {
        if constexpr ((PHMASK & 2) == 0) return;
        ew_pass(p.x, p.ctx, nullptr, nullptr, nullptr, nullptr, nullptr, nullptr, 0.f, nullptr, YH, p.norm_g, MOD, MOD + 1024, TA); return;
    }
    const int l = (ph - 2) / 10, k = (ph - 2) % 10;
    const float* MODL = MOD + (size_t)l * 17 * NMODC; const float* NG = p.norm_g + (size_t)l * 6 * DM;
    const int rows_late = (l == 0) ? TA : TL;
    switch (k) {
    case 0: case 7: {
        if constexpr ((PHMASK & 4) == 0) break;
        const int f = (k == 7), M = f ? rows_late : TA;
        pg8::Gemm g{YH, (const bf16_t*)(ws + WS_W13) + (size_t)(l * 2 + f) * 5632 * 1024, M, 5632, 1024, 1024, 1024};
        pg8::StaticOrder S; S.init(M, 5632, G, c); EpiSwiGLU E{U};
        pg8::gemm_phase<EpiSwiGLU, pg8::StaticOrder, true, true>(lds, g, S, E);
    } break;
    case 1: case 8: case 5: {
        if constexpr ((PHMASK & 8) == 0) break;
        const bool isout = (k == 5); const int f = (k == 8), M = (k == 1) ? TA : rows_late;
        const int Kd = isout ? YC_LD : FF;
        const bf16_t* Ap = isout ? YCAT : U;
        const bf16_t* Bp = isout ? (const bf16_t*)(ws + WS_WOUT) + (size_t)l * 1024 * YC_LD : (const bf16_t*)(ws + WS_W2T) + (size_t)(l * 2 + f) * 1024 * FF;
        for (int v = 0; v < (M == TA ? 3 : 1); ++v) {
            pg8::Gemm g = v == 0 ? pg8::Gemm{Ap, Bp, TL, 1024, Kd, Kd, Kd}
                                 : pg8::Gemm{Ap + (size_t)TL * Kd + (v - 1) * (Kd / 2), Bp + (v - 1) * (Kd / 2), TC, 1024, Kd / 2, Kd, Kd};
            pg8::StaticOrder S; S.init(g.M, 1024, G, v == 2 ? (c + G - 64) % G : c);
            EpiBf16Tile E{v == 0 ? YH : (v == 1 ? YH + (size_t)TL * DM : (bf16_t*)(ws + WS_Y2)), 1024, 0, 256};
            pg8::gemm_phase<EpiBf16Tile, pg8::StaticOrder, true, true>(lds, g, S, E);
        }
    } break;
    case 2: case 6: case 9: {
        if constexpr ((PHMASK & 2) == 0) break;
        const int gi = (k == 2) ? 2 : (k == 6 ? 5 : 8), ni = (k == 2) ? 1 : (k == 6 ? 3 : 5);
        const int nrows = (k == 2) ? TA : rows_late;
        const bool lastl = (k == 9 && l == 1);
        const float* gpre = (k == 2) ? NG + 2 * DM : (k == 6 ? NG + 4 * DM : p.norm_g + 6 * DM);
        const float* shift = (k == 2) ? MODL + 3 * 1024 : (k == 6 ? MODL + 6 * 1024 : MOD + 17 * NMODC);
        const float* scale = (k == 2) ? MODL + 4 * 1024 : (k == 6 ? MODL + 7 * 1024 : MOD + 17 * NMODC + 1024);
        float* outp = p.out;
        const bool first = (l == 0 && k == 2);
        bf16_t* XS = (bf16_t*)(ws + WS_XC);
        ew_pass(p.x, p.ctx, first ? (const bf16_t*)nullptr : (const bf16_t*)XS, lastl ? (bf16_t*)nullptr : XS, lastl ? outp : (float*)nullptr, YH, (const bf16_t*)(ws + WS_Y2), NG + ni * DM, (k == 6) ? 1.0f : 0.5f, MODL + gi * 1024, lastl ? nullptr : YH, gpre, shift, scale, nrows);
    } break;
    case 3: {
        if constexpr ((PHMASK & 16) == 0) break;
        const bf16_t* W = (const bf16_t*)(ws + WS_WIN) + (size_t)l * 2304 * 1024;
        { pg8::Gemm g{YH, W, TA, NP, 1024, 1024, 1024}; pg8::StaticOrder S; S.init(TA, NP, G, c); EpiWin E{PROJ, (const float*)(ws + WS_ROPE)};
          pg8::gemm_phase<EpiWin, pg8::StaticOrder, true, true>(lds, g, S, E); }
        { const int N = (l == 0) ? TA : TL; pg8::Gemm g{W + (size_t)1792 * 1024, YH, 256, N, 1024, 1024, 1024}; pg8::StaticOrder S; S.init(256, N, G, (c + 16) % G);
          EpiPQ E{(bf16_t*)(ws + WS_PQT), (bf16_t*)(ws + WS_PQTC)};
          pg8::gemm_phase<EpiPQ, pg8::StaticOrder, true, true>(lds, g, S, E); }
    } break;
    case 4: {
        if constexpr ((PHMASK & 32) == 0) break;
        TS_BEGIN(1);
        if (sub & 1)
        for (int v = 0; v < ((l == 0) ? 4 : 2); ++v) {
            const int hs = v & 1, isc = v >> 1;
            const bf16_t* Ap = isc ? (const bf16_t*)(ws + WS_DFTC) + hs * 256 : (const bf16_t*)(ws + WS_DFT) + hs * 2048;
            const bf16_t* Bp = isc ? (const bf16_t*)(ws + WS_PQTC) + hs * 256 : (const bf16_t*)(ws + WS_PQT) + hs * 2048;
            pg8::Gemm g{Ap, Bp, isc ? 256 : 2048, 4096, isc ? 256 : 2048, isc ? DFTC_LD : DFT_LD, isc ? PQTC_LD : PQT_LD};
            pg8::StaticOrder S; S.init(g.M, g.N, G, isc ? (c + G - 16 * hs) % G : (c + G - 128 * hs) % G);
            EpiBf16Tile E{YCAT + (isc ? (size_t)TL * YC_LD : 0) + (hs ? 1024 : 256), YC_LD, isc ? 256 : 2048, 0};
            pg8::gemm_phase<EpiBf16Tile, pg8::StaticOrder, true, true>(lds, g, S, E);
        }
        TS_END(1);
        if (sub & 6) mix_items(p, lds, l, sub);
    } break;
    }
}

__global__ void __launch_bounds__(512, 2) mega(Params p, int ph0, int ph1) {
    extern __shared__ __attribute__((aligned(16))) unsigned char lds_raw[];
    LAS unsigned char* lds = (LAS unsigned char*)lds_raw;
    cg::grid_group grid = cg::this_grid();
    if (ph1 < 0) grid.sync();
    volatile LAS unsigned* xst = (volatile LAS unsigned*)(lds + 131072);
    if (threadIdx.x < 4) xst[threadIdx.x] = 0u;
    __syncthreads();
    XcdBarrier xb = xcd_barrier_post((unsigned*)(p.ws + WS_BAR), xst);
#ifdef TPROBE
    unsigned long long tacc = 0, tprev = __builtin_amdgcn_s_memrealtime();
#endif
    for (int ph = ph0; ph < ph1; ++ph) {
        CParams* q = (CParams*)__builtin_amdgcn_kernarg_segment_ptr(); asm volatile("" : "+s"(q));
        run_phase(*q, lds, ph, 7);
#ifdef DUPK
        { const int kind = ph == 0 ? 10 : (ph == 1 ? 11 : (ph - 2) % 10);
          if ((DUPK >> kind) & 1) { xcd_barrier(xb); run_phase(*q, lds, ph, DUPSUB); } }
#endif
        if (ph + 1 < ph1) xcd_barrier(xb);
#ifdef TPROBE
        { const unsigned long long now = __builtin_amdgcn_s_memrealtime(); const int kind = ph == 0 ? 10 : (ph == 1 ? 11 : (ph - 2) % 10);
          if ((TPROBE >> kind) & 1) tacc += now - tprev; tprev = now; }
#endif
    }
#ifdef TPROBE
    if (blockIdx.x == 0 && threadIdx.x == 0) { const unsigned long long t0 = __builtin_amdgcn_s_memrealtime(); while (__builtin_amdgcn_s_memrealtime() - t0 < tacc) __builtin_amdgcn_s_sleep(8); }
#endif
#ifdef TSUB
    if (blockIdx.x == 0 && threadIdx.x == 0) { const unsigned long long tacc2 = *(volatile LAS unsigned long long*)(lds + 131080); const unsigned long long t0 = __builtin_amdgcn_s_memrealtime(); while (__builtin_amdgcn_s_memrealtime() - t0 < 4ull * tacc2) __builtin_amdgcn_s_sleep(8); }
#endif
#ifdef XSYNC
    for (int i = 0; i < XSYNC; ++i) xcd_barrier(xb);
#endif
}

#ifndef ONE_LAUNCH
#define ONE_LAUNCH 1
#endif

extern "C" void kernel_launch(void* const* d_in, const int* in_sizes, int n_in, void* d_out, int out_size, void* d_ws, size_t ws_size, hipStream_t stream) {
    static int grid = 0;
    if (grid == 0) {
        if (ws_size < WS_END) { fprintf(stderr, "kernel_launch: workspace too small: %zu < %zu\n", ws_size, (size_t)WS_END); grid = -1; return; }
        int dev = 0, cus = 0, per_cu = 0;
        hipGetDevice(&dev); hipDeviceGetAttribute(&cus, hipDeviceAttributeMultiprocessorCount, dev);
        hipFuncSetAttribute((const void*)mega, hipFuncAttributeMaxDynamicSharedMemorySize, LDS_BYTES);
        hipOccupancyMaxActiveBlocksPerMultiprocessor(&per_cu, (const void*)mega, 512, LDS_BYTES);
        if (per_cu < 1) { fprintf(stderr, "kernel_launch: occupancy query says %d blocks per CU\n", per_cu); per_cu = 1; }
        (void)hipGetLastError();
        grid = cus;
    }
    if (grid < 0) return;
    (void)hipMemsetAsync((unsigned char*)d_ws + WS_BAR, 0, 3456 * 4, stream);
    Params p{};
    p.x = (const float*)d_in[0]; p.c = (const float*)d_in[1]; p.ctx = (const float*)d_in[2]; p.c_ctx = (const float*)d_in[3];
    p.w_ada = (const float*)d_in[4]; p.b_ada = (const float*)d_in[5]; p.norm_g = (const float*)d_in[6];
    p.w1 = (const float*)d_in[7]; p.w3 = (const float*)d_in[8]; p.w2 = (const float*)d_in[9]; p.w_in = (const float*)d_in[10];
    p.conv_w = (const float*)d_in[11]; p.conv_b = (const float*)d_in[12]; p.ln_g = (const float*)d_in[13]; p.ln_b = (const float*)d_in[14];
    p.nat_bias = (const float*)d_in[15]; p.sink = (const float*)d_in[16]; p.w_out = (const float*)d_in[17];
    p.out = (float*)d_out; p.ws = (unsigned char*)d_ws;
#if ONE_LAUNCH
    int ph0 = 0, ph1 = N_PHASES;
    void* args[] = {&p, &ph0, &ph1};
    hipError_t e = hipLaunchCooperativeKernel((const void*)mega, dim3(grid), dim3(512), args, LDS_BYTES, stream);
    if (e != hipSuccess) fprintf(stderr, "cooperative launch failed: %s (grid %d)\n", hipGetErrorString(e), grid);
#else
    for (int ph = 0; ph < N_PHASES; ++ph) {
        int ph0 = ph, ph1 = ph + 1;
        void* args[] = {&p, &ph0, &ph1};
        hipError_t e = hipLaunchCooperativeKernel((const void*)mega, dim3(grid), dim3(512), args, LDS_BYTES, stream);
        if (e != hipSuccess) { fprintf(stderr, "launch %d failed: %s (grid %d)\n", ph, hipGetErrorString(e), grid); break; }
    }
#endif
}
```
